# Optimizing an MI355X kernel written in HIP

```python
import jax
import jax.numpy as jnp
from jax import lax
import numpy as np

D_MODEL = 1024
BATCH = 8
SEQ = 4096
DEPTH = 2

GRID_W = 64
CTX_LEN = 256

HEAD_DIM = 64
CONV_WIDTH = D_MODEL // 4
CONV_K = 3
RET_WIDTH = D_MODEL // 4
RET_HEADS = RET_WIDTH // HEAD_DIM
RET_CHUNK = 128
ATT_WIDTH = D_MODEL // 2
ATT_HEADS = ATT_WIDTH // HEAD_DIM
ATT_KV_HEADS = ATT_HEADS // 4
ATT_KV_WIDTH = ATT_KV_HEADS * HEAD_DIM
ATT_BLOCK = 128
MIX_WIDTH = CONV_WIDTH + RET_WIDTH + ATT_WIDTH
ROPE_BASE = 10000.0
N_EXPERTS = 32
TOP_K = 4
EXPERT_FF = D_MODEL
SWIGLU_ALPHA = 1.702
SWIGLU_LIMIT = 7.0
MOE_BLOCK = 512
N_MOD = 6
EPS = 1e-6
IN_SPLITS = (CONV_WIDTH, CONV_WIDTH, CONV_WIDTH, RET_WIDTH, RET_WIDTH, RET_WIDTH, RET_WIDTH, ATT_WIDTH, ATT_KV_WIDTH, ATT_KV_WIDTH)
IN_WIDTH = sum(IN_SPLITS)
SPLIT_POINTS = tuple(sum(IN_SPLITS[: i + 1]) for i in range(len(IN_SPLITS) - 1))

kernel_name = 'hybrid_conv_retention_gqa_moe_dit'


def _layer_norm(x, g, b):
    xf = x.astype(jnp.float32)
    mu = xf.mean(-1, keepdims=True)
    var = jnp.square(xf - mu).mean(-1, keepdims=True)
    return ((xf - mu) * lax.rsqrt(var + EPS) * g + b).astype(x.dtype)


def _rms_norm(x, g):
    xf = x.astype(jnp.float32)
    return (xf * lax.rsqrt(jnp.mean(xf * xf, -1, keepdims=True) + EPS) * g).astype(x.dtype)


def _heads(z, n_heads):
    b, l, w = z.shape
    return z.reshape(b, l, n_heads, w // n_heads).transpose(0, 2, 1, 3)


def _merge_heads(y):
    b, n, l, dh = y.shape
    return y.transpose(0, 2, 1, 3).reshape(b, l, n * dh)


def _flip(a):
    return jnp.flip(a, axis=2)


def _axial_rope(seq_len, head_dim):
    rows = seq_len // GRID_W
    axis_dim = head_dim // 2
    inv_freq = ROPE_BASE ** (-jnp.arange(0, axis_dim, 2, dtype=jnp.float32) / axis_dim)
    row = jnp.repeat(jnp.arange(rows, dtype=jnp.float32), GRID_W)
    col = jnp.tile(jnp.arange(GRID_W, dtype=jnp.float32), rows)
    ang = jnp.stack([row[:, None] * inv_freq, col[:, None] * inv_freq], axis=1)
    return jnp.cos(ang), jnp.sin(ang)


def _apply_rope(x, cos, sin):
    b, h, l, dh = x.shape
    xa = x.astype(jnp.float32).reshape(b, h, l, 2, 2, dh // 4)
    x1, x2 = xa[..., 0, :], xa[..., 1, :]
    out = jnp.stack([x1 * cos - x2 * sin, x1 * sin + x2 * cos], axis=-2)
    return out.reshape(b, h, l, dh).astype(x.dtype)


def _short_conv(u, w):
    l = u.shape[1]
    up = jnp.pad(u, ((0, 0), (1, 1), (0, 0)))
    return up[:, :l] * w[:, 0] + up[:, 1:l + 1] * w[:, 1] + up[:, 2:] * w[:, 2]


def _retention_scan(q, k, v, log_gamma, s0, include_diag):
    b, h, l, dk = q.shape
    dv = v.shape[-1]
    nc = l // RET_CHUNK
    qc = q.reshape(b, h, nc, RET_CHUNK, dk)
    kc = k.reshape(b, h, nc, RET_CHUNK, dk)
    vc = v.reshape(b, h, nc, RET_CHUNK, dv)
    pos = jnp.arange(RET_CHUNK, dtype=jnp.float32)
    diff = pos[:, None] - pos[None, :]
    keep = (diff >= 0) if include_diag else (diff > 0)
    decay = jnp.where(keep, jnp.exp(log_gamma[:, None, None] * jnp.maximum(diff, 0.0)), 0.0)
    scores = jnp.einsum('bhnid,bhnjd->bhnij', qc, kc) * decay[:, None]
    y_intra = jnp.einsum('bhnij,bhnjv->bhniv', scores, vc)
    zeta = jnp.exp(log_gamma[:, None] * (RET_CHUNK - 1.0 - pos))
    chunk_kv = jnp.einsum('bhnjd,hj,bhnjv->nbhdv', kc, zeta, vc)
    chunk_decay = jnp.exp(log_gamma * RET_CHUNK)[None, :, None, None]

    def step(state, kv_n):
        return chunk_decay * state + kv_n, state

    s_final, s_prev = lax.scan(step, s0, chunk_kv)
    xi = jnp.exp(log_gamma[:, None] * (pos + 1.0))
    y_cross = jnp.einsum('bhnid,hi,nbhdv->bhniv', qc, xi, s_prev)
    return (y_intra + y_cross).reshape(b, h, l, dv), s_final


def _retention_state(k, v, log_gamma):
    l = k.shape[2]
    w = jnp.exp(log_gamma[:, None] * (l - 1.0 - jnp.arange(l, dtype=jnp.float32)))
    return jnp.einsum('bhld,hl,bhlv->bhdv', k, w, v)


def _ret_output(y, gate_z, gn_g):
    mu = y.mean(-1, keepdims=True)
    var = jnp.square(y - mu).mean(-1, keepdims=True)
    yn = _merge_heads((y - mu) * lax.rsqrt(var + EPS)) * gn_g
    return yn.astype(gate_z.dtype) * jax.nn.silu(gate_z)


def _block_attention(q, k, v):
    b, hq, lq, dh = q.shape
    hkv = k.shape[1]
    g = hq // hkv
    nb = lq // ATT_BLOCK
    qb = q.reshape(b, hkv, g, nb, ATT_BLOCK, dh).transpose(3, 0, 1, 2, 4, 5)
    scale = dh ** -0.5

    def one_block(q_blk):
        s = jnp.einsum('bkgqd,bksd->bkgqs', q_blk, k, preferred_element_type=jnp.float32) * scale
        p = jax.nn.softmax(s, axis=-1)
        return jnp.einsum('bkgqs,bksd->bkgqd', p.astype(v.dtype), v)

    out = lax.map(one_block, qb)
    return out.transpose(1, 2, 3, 0, 4, 5).reshape(b, hq, lq, dh)


def _token_mixers(h_lat, h_ctx, w_in, conv_w, ret_decay_exp, ret_gn_g, q_norm_g, k_norm_g, w_out, with_ctx_out):
    f32 = jnp.float32
    z_lat = jnp.split(h_lat @ w_in, SPLIT_POINTS, axis=-1)
    z_ctx = jnp.split(h_ctx @ w_in, SPLIT_POINTS, axis=-1)
    cos, sin = _axial_rope(h_lat.shape[1], HEAD_DIM)
    log_gamma = jnp.log1p(-jnp.exp2(-ret_decay_exp.astype(f32)))

    def conv_group(z):
        return z[1] * _short_conv(z[2] * z[0], conv_w)

    def ret_q(z):
        return _heads(z[3], RET_HEADS)

    def ret_kv(z):
        return _heads(z[4], RET_HEADS) * HEAD_DIM ** -0.5, _heads(z[5], RET_HEADS)

    def att_q(z):
        return _rms_norm(_heads(z[7], ATT_HEADS), q_norm_g)

    def att_kv(z):
        return _rms_norm(_heads(z[8], ATT_KV_HEADS), k_norm_g), _heads(z[9], ATT_KV_HEADS)

    kc, vc = ret_kv(z_ctx)
    kc, vc = kc.astype(f32), vc.astype(f32)
    ql = _apply_rope(ret_q(z_lat), cos, sin).astype(f32)
    kl, vl = ret_kv(z_lat)
    kl, vl = _apply_rope(kl, cos, sin).astype(f32), vl.astype(f32)
    if with_ctx_out:
        qc = ret_q(z_ctx).astype(f32)
        zeros = jnp.zeros(kc.shape[:2] + (HEAD_DIM, HEAD_DIM), f32)
        yf_c, s_fwd = _retention_scan(qc, kc, vc, log_gamma[0], zeros, True)
        yb_c, s_bwd = _retention_scan(_flip(qc), _flip(kc), _flip(vc), log_gamma[1], zeros, False)
        ret_ctx = yf_c + _flip(yb_c)
    else:
        s_fwd = _retention_state(kc, vc, log_gamma[0])
        s_bwd = _retention_state(_flip(kc), _flip(vc), log_gamma[1])
    yf_l, _ = _retention_scan(ql, kl, vl, log_gamma[0], s_fwd, True)
    yb_l, _ = _retention_scan(_flip(ql), _flip(kl), _flip(vl), log_gamma[1], s_bwd, False)
    ret_lat = yf_l + _flip(yb_l)

    ka_c, va_c = att_kv(z_ctx)
    qa_l = _apply_rope(att_q(z_lat), cos, sin)
    ka_l, va_l = att_kv(z_lat)
    ka_l = _apply_rope(ka_l, cos, sin)
    att_lat = _block_attention(qa_l, jnp.concatenate([ka_c, ka_l], axis=2), jnp.concatenate([va_c, va_l], axis=2))

    y_lat = jnp.concatenate([conv_group(z_lat), _ret_output(ret_lat, z_lat[6], ret_gn_g), _merge_heads(att_lat)], axis=-1) @ w_out
    if with_ctx_out:
        att_ctx = _block_attention(att_q(z_ctx), ka_c, va_c)
        y_ctx = jnp.concatenate([conv_group(z_ctx), _ret_output(ret_ctx, z_ctx[6], ret_gn_g), _merge_heads(att_ctx)], axis=-1) @ w_out
    else:
        y_ctx = None
    return y_lat, y_ctx


def _moe(h, w_router, b_router, w_gate_up, b_gate_up, w_down, b_down):
    t, d = h.shape
    logits = (h @ w_router + b_router).astype(jnp.float32)
    top_v, top_e = lax.top_k(logits, TOP_K)
    top_w = jax.nn.softmax(top_v, axis=-1)
    n_assign = t * TOP_K
    flat_e = top_e.reshape(n_assign).astype(jnp.int32)
    flat_w = top_w.reshape(n_assign)
    flat_tok = jnp.arange(n_assign, dtype=jnp.int32) // TOP_K
    order = jnp.argsort(flat_e)
    e_sorted = flat_e[order]
    counts = jnp.bincount(flat_e, length=N_EXPERTS).astype(jnp.int32)
    padded = (counts + MOE_BLOCK - 1) // MOE_BLOCK * MOE_BLOCK
    grp_start = jnp.cumsum(counts) - counts
    pad_end = jnp.cumsum(padded)
    pad_start = pad_end - padded
    dest = pad_start[e_sorted] + jnp.arange(n_assign, dtype=jnp.int32) - grp_start[e_sorted]
    n_blocks = (n_assign + N_EXPERTS * (MOE_BLOCK - 1) + MOE_BLOCK - 1) // MOE_BLOCK
    n_rows = n_blocks * MOE_BLOCK
    row_tok = jnp.full((n_rows,), t, jnp.int32).at[dest].set(flat_tok[order])
    row_w = jnp.zeros((n_rows,), jnp.float32).at[dest].set(flat_w[order])
    block_e = jnp.minimum(jnp.searchsorted(pad_end, jnp.arange(n_blocks, dtype=jnp.int32) * MOE_BLOCK, side='right'), N_EXPERTS - 1)
    h_pad = jnp.concatenate([h, jnp.zeros((1, d), h.dtype)], axis=0)

    def step(acc, blk):
        tok, wt, e = blk
        xb = h_pad[tok]
        gu = xb @ w_gate_up[e] + b_gate_up[e]
        gate, up = jnp.split(gu, 2, axis=-1)
        gate = jnp.minimum(gate, SWIGLU_LIMIT)
        up = jnp.clip(up, -SWIGLU_LIMIT, SWIGLU_LIMIT)
        act = (up + 1.0) * (gate * jax.nn.sigmoid(SWIGLU_ALPHA * gate))
        yb = act @ w_down[e] + b_down[e]
        return acc.at[tok].add(yb.astype(jnp.float32) * wt[:, None]), None

    acc, _ = lax.scan(step, jnp.zeros((t + 1, d), jnp.float32),
                      (row_tok.reshape(n_blocks, MOE_BLOCK), row_w.reshape(n_blocks, MOE_BLOCK), block_e))
    return acc[:t].astype(h.dtype)


def setup_inputs(seed: int = 0) -> dict:
    key = jax.random.key(seed)
    ks = jax.random.split(key, 24)
    f32 = jnp.float32

    def nrm(k, shape, scale):
        return jax.random.normal(k, shape, f32) * scale

    beta = (8.0 * DEPTH) ** -0.25
    return {
        'x': nrm(ks[0], (BATCH, SEQ, D_MODEL), 1.0),
        'c': nrm(ks[1], (BATCH, D_MODEL), 1.0),
        'ctx': nrm(ks[2], (BATCH, CTX_LEN, D_MODEL), 1.0),
        'c_ctx': nrm(ks[3], (D_MODEL,), 1.0),
        'w_mod': nrm(ks[4], (DEPTH, D_MODEL, N_MOD * D_MODEL), 0.5 * D_MODEL ** -0.5),
        'b_mod': nrm(ks[5], (DEPTH, N_MOD * D_MODEL), 0.02),
        'w_in': nrm(ks[6], (DEPTH, D_MODEL, IN_WIDTH), D_MODEL ** -0.5),
        'conv_w': nrm(ks[7], (DEPTH, CONV_WIDTH, CONV_K), CONV_K ** -0.5),
        'ret_decay_exp': 5.0 + jnp.arange(RET_HEADS, dtype=f32) + 0.25 * jax.random.uniform(ks[8], (DEPTH, 2, RET_HEADS), f32),
        'ret_gn_g': 1.0 + nrm(ks[9], (DEPTH, RET_WIDTH), 0.02),
        'q_norm_g': 1.0 + nrm(ks[10], (DEPTH, HEAD_DIM), 0.02),
        'k_norm_g': 1.0 + nrm(ks[11], (DEPTH, HEAD_DIM), 0.02),
        'w_out': nrm(ks[12], (DEPTH, MIX_WIDTH, D_MODEL), beta * MIX_WIDTH ** -0.5),
        'ln_g': 1.0 + nrm(ks[13], (DEPTH, 2, D_MODEL), 0.02),
        'ln_b': nrm(ks[14], (DEPTH, 2, D_MODEL), 0.02),
        'w_router': nrm(ks[15], (DEPTH, D_MODEL, N_EXPERTS), D_MODEL ** -0.5),
        'b_router': nrm(ks[16], (DEPTH, N_EXPERTS), 0.01),
        'w_gate_up': nrm(ks[17], (DEPTH, N_EXPERTS, D_MODEL, 2 * EXPERT_FF), D_MODEL ** -0.5),
        'b_gate_up': nrm(ks[18], (DEPTH, N_EXPERTS, 2 * EXPERT_FF), 0.01),
        'w_down': nrm(ks[19], (DEPTH, N_EXPERTS, EXPERT_FF, D_MODEL), beta * EXPERT_FF ** -0.5),
        'b_down': nrm(ks[20], (DEPTH, N_EXPERTS, D_MODEL), 0.01),
    }


def reference(x, c, ctx, c_ctx, w_mod, b_mod, w_in, conv_w, ret_decay_exp, ret_gn_g, q_norm_g, k_norm_g, w_out, ln_g, ln_b, w_router, b_router, w_gate_up, b_gate_up, w_down, b_down):
    alpha = (2.0 * DEPTH) ** 0.25
    b, l, d = x.shape
    lc = ctx.shape[1]
    cond = jax.nn.silu(c)
    cond_ctx = jax.nn.silu(c_ctx)
    for layer in range(DEPTH):
        last = layer == DEPTH - 1
        mod = (cond @ w_mod[layer] + b_mod[layer])[:, None, :]
        mod_c = cond_ctx @ w_mod[layer] + b_mod[layer]
        sh1, sc1, g1, sh2, sc2, g2 = jnp.split(mod, N_MOD, axis=-1)
        sh1c, sc1c, g1c, sh2c, sc2c, g2c = jnp.split(mod_c, N_MOD, axis=-1)

        y_lat, y_ctx = _token_mixers(x * (1.0 + sc1) + sh1, ctx * (1.0 + sc1c) + sh1c,
                                     w_in[layer], conv_w[layer], ret_decay_exp[layer], ret_gn_g[layer],
                                     q_norm_g[layer], k_norm_g[layer], w_out[layer], not last)
        x = _layer_norm(alpha * x + g1 * y_lat, ln_g[layer, 0], ln_b[layer, 0])

        h_lat = (x * (1.0 + sc2) + sh2).reshape(b * l, d)
        if not last:
            ctx = _layer_norm(alpha * ctx + g1c * y_ctx, ln_g[layer, 0], ln_b[layer, 0])
            h_ctx = (ctx * (1.0 + sc2c) + sh2c).reshape(b * lc, d)
            f = _moe(jnp.concatenate([h_ctx, h_lat], axis=0), w_router[layer], b_router[layer],
                     w_gate_up[layer], b_gate_up[layer], w_down[layer], b_down[layer])
            f_ctx = f[: b * lc].reshape(b, lc, d)
            f_lat = f[b * lc:].reshape(b, l, d)
            ctx = _layer_norm(alpha * ctx + g2c * f_ctx, ln_g[layer, 1], ln_b[layer, 1])
        else:
            f_lat = _moe(h_lat, w_router[layer], b_router[layer], w_gate_up[layer], b_gate_up[layer],
                         w_down[layer], b_down[layer]).reshape(b, l, d)
        x = _layer_norm(alpha * x + g2 * f_lat, ln_g[layer, 1], ln_b[layer, 1])
    return x
```

```cpp
#include <hip/hip_runtime.h>
#include <cstdio>
#include <cstdint>
__device__ __forceinline__ int opaque_tid() { int t = (int)threadIdx.x; asm volatile("" : "+v"(t)); return t; }
__device__ __forceinline__ int opaque_bid() { int b = (int)blockIdx.x; asm volatile("" : "+s"(b)); return b; }
namespace pg8 {
#define PG8_LAS __attribute__((address_space(3)))
typedef unsigned short bf16_t;
typedef short bf16x8 __attribute__((ext_vector_type(8)));
typedef float f32x4 __attribute__((ext_vector_type(4)));
typedef unsigned u32x4 __attribute__((ext_vector_type(4)));
constexpr int BM = 256, BK = 64, HALF = 128, HTB = HALF * BK * 2  , STAGE_BYTES = 8 * HTB, NXCD = 8, WGM = 8;

__host__ __device__ __forceinline__ int lds_byte(int r, int c) { const int st = (r >> 4) * 2 + (c >> 5), rr = r & 15, cc = c & 31, ob = rr * 64 + cc * 2; return st * 1024 + (ob ^ (((ob >> 9) & 1) << 5)); }
__host__ __device__ __forceinline__ void stage_rc(int b, int& R, int& C) { const int st = b / 1024, sb = b % 1024, swz = sb ^ (((sb >> 9) & 1) << 5); R = (st >> 1) * 16 + swz / 64; C = (st & 1) * 32 + (swz % 64) / 2; }
__host__ __device__ __forceinline__ int perm32(int rho) { const int n = rho >> 4, i = rho & 15; return 8 * (i >> 2) + 4 * n + (i & 3); }

struct Unit { int pm, pn; };
struct Gemm { const bf16_t* A; const bf16_t* Bt; int M, N, K; };

struct StaticOrder {
    int nM, nN, nwg, G, c;
    __host__ __device__ void init(int M, int N, int G_, int c_) { nM = M / BM; nN = N / BM; nwg = nM * nN; G = G_; c = c_; }
    __host__ __device__ bool next(int i, Unit& u) const {
        const long L = (long)i * G + c; if (L >= nwg) return false;
        int wgid = (int)L; { const int q = nwg / NXCD, r = nwg % NXCD, xcd = wgid % NXCD, off = wgid / NXCD; wgid = (xcd < r ? xcd * (q + 1) : r * (q + 1) + (xcd - r) * q) + off; }
        const int nig = WGM * nN, gid = wgid / nig, fm = gid * WGM, gsz = (nM - fm) < WGM ? (nM - fm) : WGM;
        u.pm = fm + ((wgid % nig) % gsz); u.pn = (wgid % nig) / gsz; return true;
    }
    __device__ __forceinline__ void a_ready(const Unit&) const {}
    __device__ __forceinline__ void done(const Unit&) const {}
};

__device__ __forceinline__ unsigned cvt_pk_bf16(float lo, float hi) { unsigned r; asm volatile("v_cvt_pk_bf16_f32 %0, %1, %2" : "=v"(r) : "v"(lo), "v"(hi)); return r; }
typedef float f32x2 __attribute__((ext_vector_type(2)));
struct EpiBf16 {
    static constexpr bool PERM = true, AFTER_DRAIN = false;
    bf16_t* O; int ldc;
    __device__ __forceinline__ void operator()(const f32x4 (&acc)[2][2][4][2], const Unit& u, int wr, int wc, int fr, int fq) const {
        const int row0 = u.pm * BM + wr * 64 + fr; const int col0 = u.pn * BM + wc * 32 + 8 * fq;
#pragma unroll
        for (int ai = 0; ai < 2; ++ai)
#pragma unroll
            for (int m = 0; m < 4; ++m) { bf16_t* rowp = O + (size_t)(row0 + ai * HALF + m * 16) * ldc + col0;
#pragma unroll
                for (int bj = 0; bj < 2; ++bj) { const f32x4 v0 = acc[ai][bj][m][0], v1 = acc[ai][bj][m][1];
                    u32x4 w; w.x = cvt_pk_bf16(v0[0], v0[1]); w.y = cvt_pk_bf16(v0[2], v0[3]); w.z = cvt_pk_bf16(v1[0], v1[1]); w.w = cvt_pk_bf16(v1[2], v1[3]);
                    *(u32x4*)(rowp + bj * HALF) = w; } }
    }
};
struct EpiSwiglu {
    static constexpr bool PERM = true, AFTER_DRAIN = false;
    bf16_t* O; const float* bias;
    static __device__ __forceinline__ float act1(float g, float up) {
        g = fminf(g, 7.0f); up = fminf(fmaxf(up, -7.0f), 7.0f);
        const float s = __builtin_amdgcn_rcpf(1.0f + __builtin_amdgcn_exp2f(g * (-1.702f * 1.4426950408889634f)));
        return (up + 1.0f) * (g * s);
    }
    __device__ __forceinline__ void operator()(const f32x4 (&acc)[2][2][4][2], const Unit& u, int wr, int wc, int fr, int fq) const {
        const int e = u.pn >> 3, pnl = u.pn & 7;
        const int row0 = u.pm * BM + wr * 64 + fr; const int j0 = pnl * HALF + wc * 32 + 8 * fq;
        const float* bg = bias + (size_t)e * 2048 + j0; const float* bu = bg + 1024;
        f32x4 bgv[2], buv[2];
#pragma unroll
        for (int n = 0; n < 2; ++n) { bgv[n] = *(const f32x4*)(bg + 4 * n); buv[n] = *(const f32x4*)(bu + 4 * n); }
#pragma unroll
        for (int ai = 0; ai < 2; ++ai)
#pragma unroll
            for (int m = 0; m < 4; ++m) { bf16_t* rowp = O + (size_t)(row0 + ai * HALF + m * 16) * 1024 + j0;
                f32x4 r0, r1;
                { const f32x4 g = acc[ai][0][m][0] + bgv[0], up = acc[ai][1][m][0] + buv[0];
                  r0[0] = act1(g[0], up[0]); r0[1] = act1(g[1], up[1]); r0[2] = act1(g[2], up[2]); r0[3] = act1(g[3], up[3]); }
                { const f32x4 g = acc[ai][0][m][1] + bgv[1], up = acc[ai][1][m][1] + buv[1];
                  r1[0] = act1(g[0], up[0]); r1[1] = act1(g[1], up[1]); r1[2] = act1(g[2], up[2]); r1[3] = act1(g[3], up[3]); }
                u32x4 w; w.x = cvt_pk_bf16(r0[0], r0[1]); w.y = cvt_pk_bf16(r0[2], r0[3]); w.z = cvt_pk_bf16(r1[0], r1[1]); w.w = cvt_pk_bf16(r1[2], r1[3]);
                *(u32x4*)rowp = w; }
    }
};
struct EpiDown {
    static constexpr bool PERM = true, AFTER_DRAIN = false;
    bf16_t* O; const float* bias; const float* roww;
    __device__ __forceinline__ void operator()(const f32x4 (&acc)[2][2][4][2], const Unit& u, int wr, int wc, int fr, int fq) const {
        const int e = u.pn >> 2, pnl = u.pn & 3;
        const int row0 = u.pm * BM + wr * 64 + fr; const int col0 = pnl * BM + wc * 32 + 8 * fq;
        const float* bp = bias + (size_t)e * 1024 + col0;
        f32x4 bv[2][2];
#pragma unroll
        for (int bj = 0; bj < 2; ++bj)
#pragma unroll
            for (int n = 0; n < 2; ++n) bv[bj][n] = *(const f32x4*)(bp + bj * HALF + 4 * n);
#pragma unroll
        for (int ai = 0; ai < 2; ++ai)
#pragma unroll
            for (int m = 0; m < 4; ++m) { const int row = row0 + ai * HALF + m * 16; bf16_t* rowp = O + (size_t)row * 1024 + col0;
                const float wt = roww[row];
#pragma unroll
                for (int bj = 0; bj < 2; ++bj) { const f32x4 v0 = (acc[ai][bj][m][0] + bv[bj][0]) * wt, v1 = (acc[ai][bj][m][1] + bv[bj][1]) * wt;
                    u32x4 w; w.x = cvt_pk_bf16(v0[0], v0[1]); w.y = cvt_pk_bf16(v0[2], v0[3]); w.z = cvt_pk_bf16(v1[0], v1[1]); w.w = cvt_pk_bf16(v1[2], v1[3]);
                    *(u32x4*)(rowp + bj * HALF) = w; } }
    }
};
struct MoeOrder {
    unsigned pk[11]; int nt, sh, G, c;
    __device__ __forceinline__ bool next(int i, Unit& u) const {
        const int L = i * G + c;
        if (L >= (nt << sh)) return false;
        const int tile = L >> sh, pnl = L & ((1 << sh) - 1); int e = 0;
#pragma unroll
        for (int k = 1; k < 32; ++k) { const int off = (int)((pk[(k - 1) / 3] >> (10 * ((k - 1) % 3))) & 1023u); e += (off <= tile) ? 1 : 0; }
        u.pm = tile; u.pn = (e << sh) + pnl; return true;
    }
    __device__ __forceinline__ void a_ready(const Unit&) const {}
    __device__ __forceinline__ void done(const Unit&) const {}
};

template <class Epi, class Sched, bool ALIGN_EPI = false, bool SP2 = false>
__device__ __forceinline__ void gemm_phase(PG8_LAS unsigned char* lds, const Gemm g, const Sched& S, const Epi& E) {
    const int tid = opaque_tid(), wid = __builtin_amdgcn_readfirstlane(tid >> 6), lane = tid & 63, wr = wid >> 2, wc = wid & 3, fr = lane & 15, fq = lane >> 4;
    const int K = g.K, nt = K / BK;
    unsigned voffA[2], voffB[2];
#pragma unroll
    for (int i = 0; i < 2; ++i) { int R, C; stage_rc(tid * 16 + i * 8192, R, C); const int Rb = Epi::PERM ? ((R & ~31) + perm32(R & 31)) : R;
        voffA[i] = (unsigned)(R * K + C) * 2u; voffB[i] = (unsigned)(Rb * K + C) * 2u; }
    const size_t kstep = (size_t)(BK * 2);
    const size_t hstep = (size_t)HALF * K * 2;
    const size_t tstep = 2 * hstep;
    const unsigned ldsw = (unsigned)wid * 1024u;
    const int aoff = lds_byte(wr * 64 + fr, fq * 8), boff = lds_byte(wc * 32 + fr, fq * 8);
#define PG8_SA(b, h) (((b) * 2 + (h)) * HTB)
#define PG8_SB(b, h) ((4 + (b) * 2 + (h)) * HTB)
#define PG8_STAGE(bufoff, gbase, voff) do { _Pragma("unroll") for (int _i = 0; _i < 2; ++_i) \
        __builtin_amdgcn_global_load_lds((const unsigned*)((const char*)(gbase) + (voff)[_i]), (PG8_LAS unsigned*)(lds + (bufoff) + ldsw + _i * 8192), 16, 0, 0); } while (0)
#define PG8_LDA(dst, b, h) do { _Pragma("unroll") for (int m = 0; m < 4; ++m) _Pragma("unroll") for (int k = 0; k < 2; ++k) dst[m][k] = *(const PG8_LAS bf16x8*)(lds + PG8_SA(b, h) + aoff + m * 2048 + k * 1024); } while (0)
#define PG8_LDB(dst, b, h) do { _Pragma("unroll") for (int n = 0; n < 2; ++n) _Pragma("unroll") for (int k = 0; k < 2; ++k) dst[n][k] = *(const PG8_LAS bf16x8*)(lds + PG8_SB(b, h) + boff + n * 2048 + k * 1024); } while (0)
#define PG8_MMA(ai, bj, At, Bt) do { __builtin_amdgcn_s_setprio(1); _Pragma("unroll") for (int m = 0; m < 4; ++m) _Pragma("unroll") for (int n = 0; n < 2; ++n) _Pragma("unroll") for (int k = 0; k < 2; ++k) \
        acc[ai][bj][m][n] = __builtin_amdgcn_mfma_f32_16x16x32_bf16(Bt[n][k], At[m][k], acc[ai][bj][m][n], 0, 0, 0); __builtin_amdgcn_s_setprio(0); } while (0)
#define PG8_WAIT_V(n) asm volatile("s_waitcnt vmcnt(" #n ")" ::: "memory")
#define PG8_WAIT_L(n) asm volatile("s_waitcnt lgkmcnt(" #n ")" ::: "memory")
#define PG8_BAR __builtin_amdgcn_s_barrier()
#define PG8_SCHED __builtin_amdgcn_sched_barrier(0)
    Unit cur, nxt; int ui = 0;
    if (!S.next(0, cur)) return;
    f32x4 acc[2][2][4][2];
#pragma unroll
    for (int a = 0; a < 2; ++a)
#pragma unroll
        for (int b = 0; b < 2; ++b)
#pragma unroll
            for (int m = 0; m < 4; ++m)
#pragma unroll
                for (int n = 0; n < 2; ++n) acc[a][b][m][n] = (f32x4){0.f, 0.f, 0.f, 0.f};
    bf16x8 At[4][2], B0[2][2], B1[2][2];
    const char* cA = (const char*)g.A + (size_t)cur.pm * tstep; const char* cB = (const char*)g.Bt + (size_t)cur.pn * tstep;
    S.a_ready(cur);
    if constexpr (SP2) {
        PG8_STAGE(PG8_SB(0, 0), cB, voffB); PG8_STAGE(PG8_SB(0, 1), cB + hstep, voffB); PG8_STAGE(PG8_SA(0, 0), cA, voffA); PG8_STAGE(PG8_SA(0, 1), cA + hstep, voffA);
        if (wr == 1) PG8_BAR;
        PG8_WAIT_V(2); PG8_BAR;
        PG8_STAGE(PG8_SB(1, 0), cB + kstep, voffB); PG8_STAGE(PG8_SA(1, 0), cA + kstep, voffA); PG8_STAGE(PG8_SB(1, 1), cB + hstep + kstep, voffB);
        PG8_WAIT_V(6); PG8_BAR;
    } else {
        PG8_STAGE(PG8_SB(0, 0), cB, voffB); PG8_STAGE(PG8_SA(0, 0), cA, voffA); PG8_STAGE(PG8_SB(0, 1), cB + hstep, voffB); PG8_STAGE(PG8_SA(0, 1), cA + hstep, voffA);
        if (wr == 1) PG8_BAR;
        PG8_WAIT_V(4); PG8_BAR;
        PG8_STAGE(PG8_SB(1, 0), cB + kstep, voffB); PG8_STAGE(PG8_SA(1, 0), cA + kstep, voffA); PG8_STAGE(PG8_SB(1, 1), cB + hstep + kstep, voffB);
        PG8_WAIT_V(6); PG8_BAR;
    }
    for (;;) {
        const bool has_next = S.next(ui + 1, nxt);
        const char* nA = has_next ? (const char*)g.A + (size_t)nxt.pm * tstep : cA; const char* nB = has_next ? (const char*)g.Bt + (size_t)nxt.pn * tstep : cB;
        for (int t = 0; t < nt; t += 2) {
            const bool last = (t == nt - 2);
            const char* a1 = cA + (size_t)(t + 1) * kstep;
            const char* a2 = last ? nA : cA + (size_t)(t + 2) * kstep; const char* b2 = last ? nB : cB + (size_t)(t + 2) * kstep;
            const char* a3 = a2 + kstep; const char* b3 = b2 + kstep;
            if (last && has_next) S.a_ready(nxt);
            if constexpr (SP2) {
            PG8_LDB(B0, 0, 0); PG8_LDB(B1, 0, 1); PG8_SCHED; PG8_LDA(At, 0, 0); PG8_STAGE(PG8_SA(1, 1), a1 + hstep, voffA);
            PG8_WAIT_V(8); PG8_WAIT_L(0); PG8_BAR; PG8_MMA(0, 0, At, B0); PG8_MMA(0, 1, At, B1); PG8_BAR; PG8_SCHED;
            PG8_LDA(At, 0, 1); PG8_STAGE(PG8_SB(0, 0), b2, voffB); PG8_STAGE(PG8_SB(0, 1), b2 + hstep, voffB); PG8_STAGE(PG8_SA(0, 0), a2, voffA);
            PG8_WAIT_V(8); PG8_WAIT_L(0); PG8_BAR; PG8_MMA(1, 0, At, B0); PG8_MMA(1, 1, At, B1); PG8_BAR; PG8_SCHED;
            PG8_LDB(B0, 1, 0); PG8_LDB(B1, 1, 1); PG8_SCHED; PG8_LDA(At, 1, 0); PG8_STAGE(PG8_SA(0, 1), a2 + hstep, voffA);
            PG8_WAIT_V(8); PG8_WAIT_L(0); PG8_BAR; PG8_MMA(0, 0, At, B0); PG8_MMA(0, 1, At, B1); PG8_BAR; PG8_SCHED;
            PG8_LDA(At, 1, 1); PG8_STAGE(PG8_SB(1, 0), b3, voffB); PG8_STAGE(PG8_SB(1, 1), b3 + hstep, voffB); PG8_STAGE(PG8_SA(1, 0), a3, voffA);
            PG8_WAIT_V(8); PG8_WAIT_L(0); PG8_BAR; PG8_MMA(1, 0, At, B0); PG8_MMA(1, 1, At, B1); PG8_BAR; PG8_SCHED;
            } else {
            PG8_LDB(B0, 0, 0); PG8_SCHED; PG8_LDA(At, 0, 0); PG8_STAGE(PG8_SA(1, 1), a1 + hstep, voffA);
            PG8_WAIT_L(8); PG8_BAR; PG8_WAIT_L(0); PG8_MMA(0, 0, At, B0); PG8_BAR; PG8_SCHED;
            PG8_LDB(B1, 0, 1); PG8_STAGE(PG8_SB(0, 0), b2, voffB);
            PG8_BAR; PG8_WAIT_L(0); PG8_MMA(0, 1, At, B1); PG8_BAR;
            PG8_LDA(At, 0, 1); PG8_STAGE(PG8_SA(0, 0), a2, voffA);
            PG8_BAR; PG8_WAIT_L(0); PG8_MMA(1, 0, At, B0); PG8_BAR; PG8_SCHED;
            PG8_STAGE(PG8_SB(0, 1), b2 + hstep, voffB);
            PG8_WAIT_V(6); PG8_BAR; PG8_MMA(1, 1, At, B1); PG8_BAR;
            PG8_LDB(B0, 1, 0); PG8_SCHED; PG8_LDA(At, 1, 0); PG8_STAGE(PG8_SA(0, 1), a2 + hstep, voffA);
            PG8_WAIT_L(8); PG8_BAR; PG8_WAIT_L(0); PG8_MMA(0, 0, At, B0); PG8_BAR; PG8_SCHED;
            PG8_LDB(B1, 1, 1); PG8_STAGE(PG8_SB(1, 0), b3, voffB);
            PG8_BAR; PG8_WAIT_L(0); PG8_MMA(0, 1, At, B1); PG8_BAR;
            PG8_LDA(At, 1, 1); PG8_STAGE(PG8_SA(1, 0), a3, voffA);
            PG8_BAR; PG8_WAIT_L(0); PG8_MMA(1, 0, At, B0); PG8_BAR; PG8_SCHED;
            PG8_STAGE(PG8_SB(1, 1), b3 + hstep, voffB);
            PG8_WAIT_V(6); PG8_BAR; PG8_MMA(1, 1, At, B1); PG8_BAR;
            }
        }
        if constexpr (ALIGN_EPI) { if (wr == 0) PG8_BAR; }
        if constexpr (!Epi::AFTER_DRAIN) { E(acc, cur, wr, wc, fr, fq); S.done(cur); }
        if (!has_next) break;
#pragma unroll
        for (int a = 0; a < 2; ++a)
#pragma unroll
            for (int b = 0; b < 2; ++b)
#pragma unroll
                for (int m = 0; m < 4; ++m)
#pragma unroll
                    for (int n = 0; n < 2; ++n) acc[a][b][m][n] = (f32x4){0.f, 0.f, 0.f, 0.f};
        cur = nxt; cA = nA; cB = nB; ++ui;
        if constexpr (ALIGN_EPI) { if (wr == 1) PG8_BAR; }
    }
    PG8_WAIT_V(0);
    if constexpr (!ALIGN_EPI) { if (wr == 0) PG8_BAR; }
    PG8_BAR;
    if constexpr (Epi::AFTER_DRAIN) { E.fused(acc, cur, wr, wc, fr, fq, lds, wid, lane); S.done(cur); }
#undef PG8_SA
#undef PG8_SB
#undef PG8_STAGE
#undef PG8_LDA
#undef PG8_LDB
#undef PG8_MMA
#undef PG8_WAIT_V
#undef PG8_WAIT_L
#undef PG8_BAR
#undef PG8_SCHED
}
}

#include <hip/hip_bf16.h>
#include <cmath>
namespace attn_body {
using bf16=__hip_bfloat16;
using bf16x8=__attribute__((ext_vector_type(8)))short;
using s16x4=__attribute__((ext_vector_type(4)))short;
using f32x16=__attribute__((ext_vector_type(16)))float;
using u32x4=__attribute__((ext_vector_type(4)))unsigned;
constexpr int D=64,QP=512,KP=64,OP=1024;
constexpr int NW=8,QBLK=32,QB=QBLK*NW,KVBLK=64;
constexpr int ATTN_UNIT_ROWS=QB;
__device__ __forceinline__ int crow(int r,int hi){return (r&3)+8*(r>>2)+4*hi;}
#define SBAR() __builtin_amdgcn_sched_barrier(0)
__device__ __forceinline__ void cmask(f32x16&p0,f32x16&p1,int jb,int qrel,int hi){
  const float NEG=-INFINITY; int kb=64*jb+4*hi;
  #pragma unroll
  for(int r=0;r<16;++r){int kv=kb+(r&3)+8*(r>>2); if(kv>qrel)p0[r]=NEG; if(kv+32>qrel)p1[r]=NEG;}
}

constexpr int NSLOT=3, SLOTB=8192;
constexpr int LDS_K=0, LDS_V=NSLOT*SLOTB, LDS_WS=2*NSLOT*SLOTB, LDS_OST=LDS_WS+NW*64*4, LDS_BYTES=LDS_OST+NW*4096;
constexpr float C2=0.125f*1.4426950408889634f;
__device__ __forceinline__ void glds16(const void*gsrc,unsigned lds_dst){unsigned keep;
  asm volatile("s_mov_b32 %0, m0\n\ts_mov_b32 m0, %2\n\ts_nop 0\n\tglobal_load_lds_dwordx4 %1, off\n\ts_mov_b32 m0, %0":"=&s"(keep):"v"(gsrc),"s"(lds_dst):"memory");}
__device__ __forceinline__ float max3f(float a,float b,float c){float r;asm("v_max3_f32 %0, %1, %2, %3":"=v"(r):"v"(a),"v"(b),"v"(c));return r;}
__device__ __forceinline__ float max2f(float a,float b){float r;asm("v_max_f32_e32 %0, %1, %2":"=v"(r):"v"(a),"v"(b));return r;}
__device__ __forceinline__ float fadd_s(float a,float b){float r;asm("v_add_f32_e32 %0, %1, %2":"=v"(r):"v"(a),"v"(b));return r;}
__device__ __forceinline__ float fsub_s(float a,float b){float r;asm("v_sub_f32_e32 %0, %1, %2":"=v"(r):"v"(a),"v"(b));return r;}
typedef float f32x2_t __attribute__((ext_vector_type(2))); typedef __bf16 bf16x2_t __attribute__((ext_vector_type(2)));
__device__ __forceinline__ unsigned cvtpk_s(float lo,float hi){f32x2_t v={lo,hi};bf16x2_t b=__builtin_convertvector(v,bf16x2_t);return __builtin_bit_cast(unsigned,b);}
#define WAIT_BAR(N) asm volatile("s_waitcnt vmcnt(" #N ") lgkmcnt(0)\n\ts_barrier":::"memory")

__device__ __forceinline__ void qkt(f32x16&p0,f32x16&p1,const char*Kslot,const bf16x8*qr,const f32x16&negm,int r32,int hi){
  const char*kb=Kslot+hi*1024+r32*16;
  #pragma unroll
  for(int d0=0;d0<4;++d0){
    const bf16x8 b0=*reinterpret_cast<const bf16x8*>(kb+d0*2048);
    const bf16x8 b1=*reinterpret_cast<const bf16x8*>(kb+d0*2048+512);
    if(d0==0){p0=__builtin_amdgcn_mfma_f32_32x32x16_bf16(b0,qr[0],negm,0,0,0);p1=__builtin_amdgcn_mfma_f32_32x32x16_bf16(b1,qr[0],negm,0,0,0);}
    else{p0=__builtin_amdgcn_mfma_f32_32x32x16_bf16(b0,qr[d0],p0,0,0,0);p1=__builtin_amdgcn_mfma_f32_32x32x16_bf16(b1,qr[d0],p1,0,0,0);}}
}
typedef __attribute__((address_space(3))) const char* lds_cptr;
typedef short v4i16_t __attribute__((ext_vector_type(4)));
__device__ __forceinline__ void kload8(bf16x8*kf,lds_cptr kp){
  kf[0]=*(const __attribute__((address_space(3))) bf16x8*)(kp);      kf[1]=*(const __attribute__((address_space(3))) bf16x8*)(kp+512);
  kf[2]=*(const __attribute__((address_space(3))) bf16x8*)(kp+2048); kf[3]=*(const __attribute__((address_space(3))) bf16x8*)(kp+2560);
  kf[4]=*(const __attribute__((address_space(3))) bf16x8*)(kp+4096); kf[5]=*(const __attribute__((address_space(3))) bf16x8*)(kp+4608);
  kf[6]=*(const __attribute__((address_space(3))) bf16x8*)(kp+6144); kf[7]=*(const __attribute__((address_space(3))) bf16x8*)(kp+6656);
}
__device__ __forceinline__ void kload2(bf16x8*kf,lds_cptr kp,int j){ kf[2*j]=*(const __attribute__((address_space(3))) bf16x8*)(kp+j*2048); kf[2*j+1]=*(const __attribute__((address_space(3))) bf16x8*)(kp+j*2048+512); }
__device__ __forceinline__ s16x4 vtr(lds_cptr p){ return __builtin_bit_cast(s16x4,__builtin_amdgcn_ds_read_tr16_b64_v4i16((__attribute__((address_space(3))) v4i16_t*)p)); }
__device__ __forceinline__ float rowmax(const f32x16&p0,const f32x16&p1){
  float a=max3f(p0[0],p0[1],p1[0]),b=max3f(p0[2],p0[3],p1[1]);a=max3f(a,p1[2],p1[3]);
  #pragma unroll
  for(int r=4;r<16;r+=4){a=max3f(a,p0[r],p0[r+1]);b=max3f(b,p0[r+2],p0[r+3]);a=max3f(a,p1[r],p1[r+1]);b=max3f(b,p1[r+2],p1[r+3]);}
  const float m=max2f(a,b);
  auto rr=__builtin_amdgcn_permlane32_swap(__float_as_uint(m),__float_as_uint(m),false,false);
  return max2f(__uint_as_float(rr[0]),__uint_as_float(rr[1]));
}
__device__ __forceinline__ void pv(f32x16*o,int vb,bf16x8 pa0,bf16x8 pa1,bf16x8 pa2,bf16x8 pa3){
  #pragma unroll
  for(int d0=0;d0<2;++d0){s16x4 lo[4],hi[4];
    #pragma unroll
    for(int ks=0;ks<4;++ks){
      asm volatile("ds_read_b64_tr_b16 %0,%1 offset:%c2":"=&v"(lo[ks]):"v"(vb),"i"(d0*4096+ks*1024):"memory");
      asm volatile("ds_read_b64_tr_b16 %0,%1 offset:%c2":"=&v"(hi[ks]):"v"(vb),"i"(d0*4096+ks*1024+512):"memory");}
    asm volatile("s_waitcnt lgkmcnt(0)":::"memory");SBAR();
    #define PK(k) (bf16x8){lo[k][0],lo[k][1],lo[k][2],lo[k][3],hi[k][0],hi[k][1],hi[k][2],hi[k][3]}
    o[d0]=__builtin_amdgcn_mfma_f32_32x32x16_bf16(pa0,PK(0),o[d0],0,0,0);
    o[d0]=__builtin_amdgcn_mfma_f32_32x32x16_bf16(pa1,PK(1),o[d0],0,0,0);
    o[d0]=__builtin_amdgcn_mfma_f32_32x32x16_bf16(pa2,PK(2),o[d0],0,0,0);
    o[d0]=__builtin_amdgcn_mfma_f32_32x32x16_bf16(pa3,PK(3),o[d0],0,0,0);
    #undef PK
  }
}

#ifndef ATTN_STORE16
#define ATTN_STORE16(p,v) (*(u32x4*)(p)=(v))
#endif
template<int THRL> __device__ __forceinline__ void attn_unit(const bf16*Qu,const bf16*Kh,const bf16*Vh,bf16*Ou,const int NT,char*shm){
  const int tid=opaque_tid(),lane=tid&63,r32=lane&31,hi=lane>>5; const int wid=__builtin_amdgcn_readfirstlane(tid>>6);
  const bf16*Qw=Qu+(long)(wid*QBLK)*QP;
  const unsigned lds0=(unsigned)(uintptr_t)shm;
  float*wsf=(float*)(shm+LDS_WS)+wid*64;
  const bf16*ksrc=Kh+(long)lane*KP+wid*8;
  const bf16*vsrc=Vh+(long)(16*(wid&3)+(lane>>2))*KP+(wid>>2)*32+(lane&3)*8;
  const unsigned kdst=lds0+LDS_K+wid*1024, vdst=lds0+LDS_V+wid*1024;
  #define DMA_K(t,slot) glds16(ksrc+(long)(t)*KVBLK*KP,(unsigned)__builtin_amdgcn_readfirstlane(kdst+(slot)))
  #define DMA_V(t,slot) glds16(vsrc+(long)(t)*KVBLK*KP,(unsigned)__builtin_amdgcn_readfirstlane(vdst+(slot)))
  const int vb0=(int)(lds0+LDS_V)+((lane>>4)&1)*32+(lane&3)*8+(4*hi+((lane&15)>>2))*64;
  const char*Kbase=shm+LDS_K; bf16x8 kf[8];
  const lds_cptr shm3=(lds_cptr)shm; const lds_cptr kp0=shm3+LDS_K+hi*1024+r32*16; const lds_cptr vp0=shm3+LDS_V+((lane>>4)&1)*32+(lane&3)*8+(4*hi+((lane&15)>>2))*64;
  DMA_K(0,0);DMA_V(0,0);DMA_K(1,SLOTB);
  bf16x8 qr[4];
  #pragma unroll
  for(int d0=0;d0<4;++d0)qr[d0]=*reinterpret_cast<const bf16x8*>(&Qw[(long)r32*QP+d0*16+hi*8]);
  float mhat=0.f,l_reg=0.f;f32x16 o[2];o[0]=f32x16{};o[1]=f32x16{};f32x16 negm=f32x16{};asm volatile("":"+v"(negm));
  #define CMASK(P0,P1,t) do{}while(0)
  bool resc=false;
  #define START(P0,P1) do{ const float rm=rowmax(P0,P1); resc=false; \
    { const float dl=rm; mhat=fadd_s(mhat,dl); \
      _Pragma("unroll") for(int r=0;r<16;++r){P0[r]=fsub_s(P0[r],dl);P1[r]=fsub_s(P1[r],dl);} \
      _Pragma("unroll") for(int r=0;r<16;++r)negm[r]=-mhat; asm volatile("":"+v"(negm)); } \
    _Pragma("unroll") for(int r=0;r<16;++r)P0[r]=__builtin_amdgcn_exp2f(P0[r]); }while(0)
  #define RESC() do{ if(resc){ asm volatile("s_waitcnt lgkmcnt(0)":::"memory"); \
      _Pragma("unroll") for(int d_=0;d_<2;++d_) _Pragma("unroll") for(int r=0;r<16;++r)o[d_][r]*=wsf[crow(r,hi)]; } }while(0)
  f32x16 pA0,pA1,pB0,pB1;
  int sl_prev=0,sl_cur=0,sl_next=SLOTB;
  #define ROT() do{sl_prev=sl_cur;sl_cur=sl_next;sl_next=(sl_next==(NSLOT-1)*SLOTB)?0:sl_next+SLOTB;}while(0)
  DMA_K(2,2*SLOTB);
  WAIT_BAR(3);
  qkt(pA0,pA1,Kbase,qr,negm,r32,hi);asm volatile("s_nop 15\n\ts_nop 7":"+v"(pA0),"+v"(pA1));CMASK(pA0,pA1,0);
  START(pA0,pA1);
  _Pragma("unroll") for(int r=0;r<16;++r)pA1[r]=__builtin_amdgcn_exp2f(pA1[r]);
  WAIT_BAR(0);
  DMA_K(3,0);DMA_V(1,SLOTB);
  ROT();
  kload8(kf,kp0+sl_cur);
  WAIT_BAR(2);
  s16x4 vlo[8],vhi[8]; u32x4 pw0,pw1,pw2,pw3;
  #define PKW(P,B) cvtpk_s(P[B],P[B+1])
  #define PAF(k) __builtin_bit_cast(bf16x8,pw##k)
  #define VFR(i) (bf16x8){vlo[i][0],vlo[i][1],vlo[i][2],vlo[i][3],vhi[i][0],vhi[i][1],vhi[i][2],vhi[i][3]}
  #define PIN(x) asm volatile("":"+v"(x))
  #define MX3(a,b,c) __builtin_fmaxf(__builtin_fmaxf((a),(b)),(c))
  #define GAPA(MF,A0,A1,A2,A3,W0,W1,PW) do{ MF; sacc+=A0; sacc+=A1; sacc+=A2; sacc+=A3; PIN(sacc); W0; W1; PIN(PW); SBAR(); }while(0)
  #define EX(v) __builtin_amdgcn_exp2f(v)
  #define GAPB(MF,X,B) do{ MF; X[B]=EX(X[B]); X[B+1]=EX(X[B+1]); X[B+2]=EX(X[B+2]); X[B+3]=EX(X[B+3]); PIN(X); SBAR(); }while(0)
  #define VRD(i) do{ vlo[i]=vtr(vp_+(((i)>>2)*4096+((i)&3)*1024)); vhi[i]=vtr(vp_+(((i)>>2)*4096+((i)&3)*1024+512)); }while(0)
  #define KRD(G,j) do{ if(G){ kload2(kf,kp0+sl_next,j); SBAR(); } }while(0)
  #define STEP(C0,C1,P0,P1,t,GK,GV,GL) do{ SBAR(); \
    const lds_cptr vp_=vp0+sl_prev; \
    VRD(0); SBAR(); float sacc=(P0[0]+P0[1]); \
    GAPA(C0=__builtin_amdgcn_mfma_f32_32x32x16_bf16(kf[0],qr[0],negm,0,0,0), P0[2],P0[3],P0[4],P0[5],     pw0[0]=PKW(P0,0), pw0[1]=PKW(P0,2), pw0); \
    VRD(4); SBAR(); GAPA(C1=__builtin_amdgcn_mfma_f32_32x32x16_bf16(kf[1],qr[0],negm,0,0,0), P0[6],P0[7],P0[8],P0[9],     pw0[2]=PKW(P0,4), pw0[3]=PKW(P0,6), pw0); \
    VRD(1); SBAR(); GAPA(C0=__builtin_amdgcn_mfma_f32_32x32x16_bf16(kf[2],qr[1],C0,0,0,0),   P0[10],P0[11],P0[12],P0[13], pw1[0]=PKW(P0,8), pw1[1]=PKW(P0,10), pw1); \
    VRD(5); SBAR(); GAPA(C1=__builtin_amdgcn_mfma_f32_32x32x16_bf16(kf[3],qr[1],C1,0,0,0),   P0[14],P0[15],P1[0],P1[1],   pw1[2]=PKW(P0,12),pw1[3]=PKW(P0,14), pw1); \
    VRD(2); SBAR(); GAPA(C0=__builtin_amdgcn_mfma_f32_32x32x16_bf16(kf[4],qr[2],C0,0,0,0),   P1[2],P1[3],P1[4],P1[5],     pw2[0]=PKW(P1,0), pw2[1]=PKW(P1,2), pw2); \
    VRD(6); SBAR(); GAPA(C1=__builtin_amdgcn_mfma_f32_32x32x16_bf16(kf[5],qr[2],C1,0,0,0),   P1[6],P1[7],P1[8],P1[9],     pw2[2]=PKW(P1,4), pw2[3]=PKW(P1,6), pw2); \
    VRD(3); SBAR(); GAPA(C0=__builtin_amdgcn_mfma_f32_32x32x16_bf16(kf[6],qr[3],C0,0,0,0),   P1[10],P1[11],P1[12],P1[13], pw3[0]=PKW(P1,8), pw3[1]=PKW(P1,10), pw3); \
    VRD(7); SBAR(); GAPA(C1=__builtin_amdgcn_mfma_f32_32x32x16_bf16(kf[7],qr[3],C1,0,0,0),   P1[14],P1[15],0.f,0.f,       pw3[2]=PKW(P1,12),pw3[3]=PKW(P1,14), pw3); \
    l_reg+=sacc; \
    if(GK){DMA_K((t)+3,sl_cur);} if(GV){DMA_V((t)+1,sl_next);} \
    CMASK(C0,C1,t); \
    { float a=MX3(C0[0],C0[1],C1[0]),b=MX3(C0[2],C0[3],C1[1]); a=MX3(a,C1[2],C1[3]); \
      _Pragma("unroll") for(int r=4;r<16;r+=4){a=MX3(a,C0[r],C0[r+1]);b=MX3(b,C0[r+2],C0[r+3]);a=MX3(a,C1[r],C1[r+1]);b=MX3(b,C1[r+2],C1[r+3]);} \
      float rm=__builtin_fmaxf(a,b); { auto rr=__builtin_amdgcn_permlane32_swap(__float_as_uint(rm),__float_as_uint(rm),false,false); rm=__builtin_fmaxf(__uint_as_float(rr[0]),__uint_as_float(rr[1])); } \
      resc=false; \
      if(__builtin_expect(__any(rm>(float)THRL),0)){ const float dl=__builtin_fmaxf(rm,0.f); mhat+=dl; \
        _Pragma("unroll") for(int r=0;r<16;++r){C0[r]-=dl;C1[r]-=dl;} \
        _Pragma("unroll") for(int r=0;r<16;++r)negm[r]=-mhat; asm volatile("":"+v"(negm)); \
        const float f=__builtin_amdgcn_exp2f(-dl); l_reg*=f; if(hi==0)wsf[r32]=f; resc=true; } } \
    SBAR(); \
    GAPB(o[0]=__builtin_amdgcn_mfma_f32_32x32x16_bf16(PAF(0),VFR(0),o[0],0,0,0), C0,0); \
    GAPB(o[1]=__builtin_amdgcn_mfma_f32_32x32x16_bf16(PAF(0),VFR(4),o[1],0,0,0), C0,4); \
    KRD(GL,0); GAPB(o[0]=__builtin_amdgcn_mfma_f32_32x32x16_bf16(PAF(1),VFR(1),o[0],0,0,0), C0,8); \
    KRD(GL,1); GAPB(o[1]=__builtin_amdgcn_mfma_f32_32x32x16_bf16(PAF(1),VFR(5),o[1],0,0,0), C0,12); \
    KRD(GL,2); GAPB(o[0]=__builtin_amdgcn_mfma_f32_32x32x16_bf16(PAF(2),VFR(2),o[0],0,0,0), C1,0); \
    KRD(GL,3); GAPB(o[1]=__builtin_amdgcn_mfma_f32_32x32x16_bf16(PAF(2),VFR(6),o[1],0,0,0), C1,4); \
    GAPB(o[0]=__builtin_amdgcn_mfma_f32_32x32x16_bf16(PAF(3),VFR(3),o[0],0,0,0), C1,8); \
    GAPB(o[1]=__builtin_amdgcn_mfma_f32_32x32x16_bf16(PAF(3),VFR(7),o[1],0,0,0), C1,12); \
    }while(0)
  int t=1;
  #undef CMASK
  #define CMASK(P0,P1,t) do{}while(0)
  for(;t+5<NT;t+=2){
    STEP(pB0,pB1,pA0,pA1,t,true,true,true);     WAIT_BAR(2); RESC(); ROT();
    STEP(pA0,pA1,pB0,pB1,t+1,true,true,true);   WAIT_BAR(2); RESC(); ROT();
  }
  #undef CMASK
  #define CMASK(P0,P1,t) do{}while(0)
  #define ENDW(tt) do{ if((tt)+3<NT){WAIT_BAR(2);} else if((tt)+2<NT){WAIT_BAR(1);} else {WAIT_BAR(0);} }while(0)
  for(;t+1<NT;t+=2){
    STEP(pB0,pB1,pA0,pA1,t,(t+3<NT),(t+1<NT),(t+1<NT));       ENDW(t);   RESC(); ROT();
    STEP(pA0,pA1,pB0,pB1,t+1,(t+4<NT),(t+2<NT),(t+2<NT));     ENDW(t+1); RESC(); ROT();
  }
  STEP(pB0,pB1,pA0,pA1,NT-1,false,false,false); RESC();
  { float sacc=pB0[0]+pB0[1]; _Pragma("unroll") for(int r=2;r<16;++r)sacc+=pB0[r]; _Pragma("unroll") for(int r=0;r<16;++r)sacc+=pB1[r]; l_reg+=sacc;
    pw0=(u32x4){PKW(pB0,0),PKW(pB0,2),PKW(pB0,4),PKW(pB0,6)};pw1=(u32x4){PKW(pB0,8),PKW(pB0,10),PKW(pB0,12),PKW(pB0,14)};pw2=(u32x4){PKW(pB1,0),PKW(pB1,2),PKW(pB1,4),PKW(pB1,6)};pw3=(u32x4){PKW(pB1,8),PKW(pB1,10),PKW(pB1,12),PKW(pB1,14)};
    SBAR(); pv(o,vb0+sl_cur,PAF(0),PAF(1),PAF(2),PAF(3)); }
  #undef PKW
  #undef PAF
  #undef VFR
  #undef PIN
  #undef MX3
  #undef GAPA
  #undef GAPB
  #undef EX
  #undef VRD
  #undef KRD
  #undef STEP
  #undef ENDW
  {auto rr=__builtin_amdgcn_permlane32_swap(__float_as_uint(l_reg),__float_as_uint(l_reg),false,false);l_reg=__uint_as_float(rr[0])+__uint_as_float(rr[1]);}
  if(hi==0)wsf[32+r32]=l_reg;asm volatile("s_waitcnt lgkmcnt(0)":::"memory");
  float rli[16];
  #pragma unroll
  for(int r=0;r<16;++r)rli[r]=__builtin_amdgcn_rcpf(wsf[32+crow(r,hi)]);
  bf16*Ow=Ou+(long)(wid*QBLK)*OP;
  { bf16*stg=(bf16*)(shm+LDS_OST)+wid*2048;
    #pragma unroll
    for(int r=0;r<16;++r){const int orow=crow(r,hi);
      #pragma unroll
      for(int d0=0;d0<2;++d0)stg[orow*64+d0*32+r32]=__float2bfloat16(o[d0][r]*rli[r]);}
    asm volatile("s_waitcnt lgkmcnt(0)":::"memory");
    #pragma unroll
    for(int i=0;i<4;++i){const int row=i*8+(lane>>3),ch=lane&7; const u32x4 v=*(const u32x4*)(stg+row*64+ch*8); ATTN_STORE16(Ow+(long)row*OP+ch*8,v);} }
  asm volatile("s_waitcnt lgkmcnt(0)\n\ts_barrier":::"memory");
  #undef DMA_K
  #undef DMA_V
  #undef CMASK
  #undef START
  #undef RESC
  #undef ROT
}
constexpr int ATTN_LDS_BYTES=LDS_BYTES;
#undef SBAR
#undef WAIT_BAR
}

constexpr int NWAVES = 8;
#ifndef MK_N_LAUNCHES
#define MK_N_LAUNCHES 1
#endif
constexpr int DM = 1024, NBATCH = 8, SEQL = 4096, CTXL = 256, DEPTH = 2;
constexpr int RCTX = NBATCH * CTXL, RLAT = NBATCH * SEQL, RTOT = RCTX + RLAT;
constexpr int INW = 2560, NEXP = 32, NKEY = CTXL + SEQL, NPF = 34, NMOD = 6 * DM;
constexpr int ZC_U = 0, ZC_B = 256, ZC_C = 512, ZC_RQ = 768, ZC_RK = 1024, ZC_RV = 1280, ZC_RG = 1536, ZC_AQ = 1792, ZC_AK = 2304, ZC_AV = 2432;
constexpr float LN_EPS = 1e-6f, ALPHA = 1.41421356237309505f;
constexpr int N_PRO = 3, N_PER_LAYER = 10, N_PHASES = N_PRO + DEPTH * N_PER_LAYER;
constexpr int N_LAUNCHES = MK_N_LAUNCHES;

constexpr size_t MiB = 1u << 20;
constexpr size_t WS_CTL = 0, CTL_ZERO_BYTES = 1 * MiB;
constexpr size_t WS_MODP = 2 * MiB, WS_MODV = 6 * MiB, WS_ROPE = 7 * MiB;
constexpr size_t WS_RE = 8 * MiB, WS_RP = 9 * MiB, WS_RW = 10 * MiB, WS_SLOT = 11 * MiB, WS_ROWW = 12 * MiB;
constexpr size_t WS_WIN = 14 * MiB, WS_WOUT = 24 * MiB, WS_KVS = 28 * MiB, WS_SS = 62 * MiB, WS_AK = 80 * MiB, WS_AV = 89 * MiB, WS_AQ = 98 * MiB;
constexpr size_t WS_RQ = 132 * MiB, WS_RK = 149 * MiB, WS_WGU = 166 * MiB, WS_WD = 422 * MiB, WS_XSA = 550 * MiB, WS_XH = 618 * MiB, WS_Z = 686 * MiB;
constexpr size_t WS_MIX = 856 * MiB, WS_Y = 924 * MiB, WS_H2 = 992 * MiB, WS_XS2 = 1060 * MiB, WS_ACT = 1348 * MiB, WS_END = 1636 * MiB;
constexpr size_t WS_YB = WS_XS2;
constexpr int MAXTILES = 576;
static_assert(WS_MODP + (size_t)DEPTH * 8 * 9 * NMOD * 4 <= WS_MODV && WS_MODV + (size_t)DEPTH * 9 * NMOD * 4 <= WS_ROPE, "ws map");
static_assert(WS_WIN + (size_t)DEPTH * INW * DM * 2 <= WS_WOUT && WS_WOUT + (size_t)DEPTH * DM * DM * 2 <= WS_KVS, "ws map");
static_assert(WS_KVS + (size_t)NBATCH * 4 * NPF * 2 * 4096 * 4 <= WS_SS && WS_SS + (size_t)NBATCH * 4 * NPF * 2 * 4096 * 2 <= WS_AK, "ws map");
static_assert(WS_AK + (size_t)NBATCH * 2 * NKEY * 64 * 2 <= WS_AV && WS_AV + (size_t)NBATCH * 2 * NKEY * 64 * 2 <= WS_AQ && WS_AQ + (size_t)RTOT * 512 * 2 <= WS_RQ, "ws map");
static_assert(WS_RQ + (size_t)RTOT * 256 * 2 <= WS_RK && WS_RK + (size_t)RTOT * 256 * 2 <= WS_WGU && WS_WGU + (size_t)DEPTH * NEXP * 2048 * DM * 2 <= WS_WD, "ws map");
static_assert(WS_WD + (size_t)DEPTH * NEXP * DM * DM * 2 <= WS_XSA && WS_XSA + (size_t)RTOT * DM * 2 <= WS_XH && WS_XH + (size_t)RTOT * DM * 2 <= WS_Z, "ws map");
static_assert(WS_Z + (size_t)RTOT * INW * 2 <= WS_MIX && WS_MIX + (size_t)RTOT * DM * 2 <= WS_Y && WS_Y + (size_t)RTOT * DM * 2 <= WS_H2 && WS_H2 + (size_t)RTOT * DM * 2 <= WS_XS2, "ws map");
static_assert(WS_XS2 + (size_t)MAXTILES * 256 * DM * 2 <= WS_ACT && WS_ACT + (size_t)MAXTILES * 256 * DM * 2 <= WS_END, "ws map");
constexpr int CW_TMO = 0, CW_CODE = 1, CW_BAR = 4096, CW_GCNT = 8192;

constexpr int RING_OFF = 0, RING_BYTES = 131072;
constexpr int LDSCTL_OFF = RING_BYTES, MISC_OFF = LDSCTL_OFF + 320;
constexpr int OFFT_OFF = LDSCTL_OFF + 512, LCNT_OFF = LDSCTL_OFF + 768, LBASE_OFF = LDSCTL_OFF + 896, ENT_OFF = LDSCTL_OFF + 1024;
constexpr int LDS_BYTES = 147456;
static_assert(ENT_OFF + 4096 <= LDS_BYTES, "LDS map");

#define GAS __attribute__((address_space(1)))
#define LAS __attribute__((address_space(3)))
typedef unsigned short bf16;
typedef unsigned v4u __attribute__((ext_vector_type(4)));
typedef float f32x4 __attribute__((ext_vector_type(4)));
typedef short bf16x8 __attribute__((ext_vector_type(8)));
typedef GAS unsigned gu32;
typedef GAS unsigned long long gu64;
#define RLX_AGENT __ATOMIC_RELAXED, __HIP_MEMORY_SCOPE_AGENT
#define LDS_WAIT() asm volatile("s_waitcnt lgkmcnt(0)" ::: "memory")
#define VM_WAIT() asm volatile("s_waitcnt vmcnt(0)" ::: "memory")
__device__ __forceinline__ unsigned long long rt() { return __builtin_amdgcn_s_memrealtime(); }
__device__ __forceinline__ unsigned f2bf(float f) { unsigned u = __builtin_bit_cast(unsigned, f); return (u + 0x7fffu + ((u >> 16) & 1u)) >> 16; }
__device__ __forceinline__ unsigned pk2(float lo, float hi) { return f2bf(lo) | (f2bf(hi) << 16); }

#define XB_TMO      128
#define XB_XCNT(j)  (256  + 64 * (j))
#define XB_XSUB(j)  (1280 + 64 * (j))
#define XB_XGEN(j)  (2304 + 64 * (j))
#define XB_TOP      3328
#define XB_TOPGEN   3392
#define XCD_BAR_WORDS 3456
#define XB_SPIN_CAP (1u << 18)

__device__ __forceinline__ unsigned xb_ld(unsigned* p)              { return __hip_atomic_load(p, __ATOMIC_RELAXED, __HIP_MEMORY_SCOPE_AGENT); }
__device__ __forceinline__ unsigned xb_add(unsigned* p, unsigned v) { return __hip_atomic_fetch_add(p, v, __ATOMIC_RELAXED, __HIP_MEMORY_SCOPE_AGENT); }
__device__ __forceinline__ unsigned xb_xcc_id() { return (unsigned)__builtin_amdgcn_s_getreg((3 << 11) | 20) & 0xFu; }
#define XB_SPIN(cond, bar) do { unsigned _sp = 0; while (cond) { __builtin_amdgcn_s_sleep(1); \
    if ((++_sp & 255u) == 0u) { if (xb_ld(&(bar)[XB_TMO])) break; if (_sp > XB_SPIN_CAP) { atomicAdd(&(bar)[XB_TMO], 1u); break; } } } } while (0)

struct XcdBarrier {
    unsigned* bar; unsigned x;
    volatile LAS unsigned* st;
};

__device__ __forceinline__ XcdBarrier xcd_barrier_post(unsigned* bar, volatile LAS unsigned* st) {
    XcdBarrier b; b.bar = bar; b.x = xb_xcc_id(); b.st = st;
    if (threadIdx.x == 0) (void)xb_add(&bar[XB_XCNT(b.x)], 1u);
    return b;
}
__device__ __forceinline__ void xcd_barrier_complete(unsigned* bar, unsigned x, unsigned& nloc, unsigned& nx) {
    const unsigned G = gridDim.x * gridDim.y * gridDim.z;
    unsigned sum, cnt, mine, sp = 0u;
    for (;;) {
        sum = 0u; cnt = 0u; mine = 0u;
#pragma unroll
        for (unsigned j = 0; j < 16; ++j) { const unsigned c = xb_ld(&bar[XB_XCNT(j)]); sum += c; cnt += (c > 0u) ? 1u : 0u; mine = (j == x) ? c : mine; }
        if (sum == G) break;
        __builtin_amdgcn_s_sleep(1);
        if ((++sp & 255u) == 0u) { if (xb_ld(&bar[XB_TMO])) break; if (sp > XB_SPIN_CAP) { atomicAdd(&bar[XB_TMO], 1u); break; } }
    }
    nloc = mine > 0u ? mine : 1u; nx = cnt > 0u ? cnt : 1u;
}

__device__ __forceinline__ void xcd_barrier(const XcdBarrier& b) {
    asm volatile("s_waitcnt vmcnt(0)" ::: "memory");
    __syncthreads();
    if (threadIdx.x == 0) {
        unsigned* bar = b.bar;
        __builtin_amdgcn_s_waitcnt(0);
        unsigned nloc = b.st[0], nx = b.st[1];
        if (nloc == 0u) { xcd_barrier_complete(bar, b.x, nloc, nx); b.st[0] = nloc; b.st[1] = nx; }
        const unsigned old = xb_add(&bar[XB_XSUB(b.x)], 1u);
        const unsigned gen = old / nloc;
        if (old + 1u == (gen + 1u) * nloc) {
            __builtin_amdgcn_fence(__ATOMIC_RELEASE, "agent");
            asm volatile("s_waitcnt vmcnt(0)" ::: "memory");
            const unsigned og = xb_add(&bar[XB_TOP], 1u);
            const unsigned tg = og / nx;
            if (og + 1u == (tg + 1u) * nx) xb_add(&bar[XB_TOPGEN], 1u);
            else XB_SPIN(xb_ld(&bar[XB_TOPGEN]) == tg, bar);
            __builtin_amdgcn_fence(__ATOMIC_ACQUIRE, "agent");
            xb_add(&bar[XB_XGEN(b.x)], 1u);
            asm volatile("s_waitcnt vmcnt(0)" ::: "memory");
        } else {
            XB_SPIN(xb_ld(&bar[XB_XGEN(b.x)]) == gen, bar);
            __builtin_amdgcn_fence(__ATOMIC_ACQUIRE, "agent");
            asm volatile("s_waitcnt vmcnt(0)" ::: "memory");
        }
    }
    __syncthreads();
}

struct Args { const float* in[21]; float* out; unsigned char* ws; int ph_lo, ph_hi, li, pad; };
template <int OFF> __device__ __forceinline__ const float* karg_ptr() {
    const float* p;
    asm volatile("s_load_dwordx2 %0, %1, %2\n\ts_waitcnt lgkmcnt(0)\n\ts_nop 4" : "=s"(p) : "s"(__builtin_amdgcn_kernarg_segment_ptr()), "i"(OFF) : "memory");
    return p;
}
#define KIN(i) karg_ptr<8 * (i)>()
#define KOUT() ((float*)karg_ptr<8 * 21>())
#define KWS() ((unsigned char*)karg_ptr<8 * 22>())
typedef float f32x16 __attribute__((ext_vector_type(16)));
typedef unsigned v2u __attribute__((ext_vector_type(2)));
__device__ __forceinline__ float bflo(unsigned u) { return __builtin_bit_cast(float, u << 16); }
__device__ __forceinline__ float bfhi(unsigned u) { return __builtin_bit_cast(float, u & 0xffff0000u); }
__device__ __forceinline__ float bf1(unsigned short h) { return __builtin_bit_cast(float, (unsigned)h << 16); }
__device__ __forceinline__ float wave_sum(float v) {
#pragma unroll
    for (int o = 1; o < 64; o <<= 1) v += __shfl_xor(v, o);
    return v;
}
__device__ __forceinline__ int mod_row(int r) { return r < RCTX ? 8 : ((r - RCTX) >> 12); }
__device__ __forceinline__ void load_row_f32(const float* p, int lane, f32x4 (&v)[4]) {
#pragma unroll
    for (int j = 0; j < 4; ++j) v[j] = *(const f32x4*)(p + 256 * j + 4 * lane);
}
__device__ __forceinline__ void load_row_bf16(const bf16* p, int lane, f32x4 (&v)[4]) {
#pragma unroll
    for (int j = 0; j < 4; ++j) { const uint2 u = *(const uint2*)(p + 256 * j + 4 * lane); v[j] = (f32x4){bflo(u.x), bfhi(u.x), bflo(u.y), bfhi(u.y)}; }
}
__device__ __forceinline__ void store_row_bf16(bf16* p, int lane, const f32x4 (&v)[4]) {
#pragma unroll
    for (int j = 0; j < 4; ++j) { uint2 u; u.x = pk2(v[j][0], v[j][1]); u.y = pk2(v[j][2], v[j][3]); *(uint2*)(p + 256 * j + 4 * lane) = u; }
}
__device__ __forceinline__ void store_row_f32(float* p, int lane, const f32x4 (&v)[4]) {
#pragma unroll
    for (int j = 0; j < 4; ++j) *(f32x4*)(p + 256 * j + 4 * lane) = v[j];
}
__device__ __forceinline__ void ln_row(f32x4 (&v)[4], const float* g, const float* b, int lane) {
    float s = 0.f;
#pragma unroll
    for (int j = 0; j < 4; ++j) s += (v[j][0] + v[j][1]) + (v[j][2] + v[j][3]);
    const float mean = wave_sum(s) * (1.0f / DM); float s2 = 0.f;
#pragma unroll
    for (int j = 0; j < 4; ++j) { v[j] = v[j] - mean; s2 += (v[j][0] * v[j][0] + v[j][1] * v[j][1]) + (v[j][2] * v[j][2] + v[j][3] * v[j][3]); }
    const float rstd = 1.0f / sqrtf(wave_sum(s2) * (1.0f / DM) + LN_EPS);
#pragma unroll
    for (int j = 0; j < 4; ++j) { const f32x4 gg = *(const f32x4*)(g + 256 * j + 4 * lane), bb = *(const f32x4*)(b + 256 * j + 4 * lane); v[j] = v[j] * rstd * gg + bb; }
}
__device__ __forceinline__ void modulate(const f32x4 (&v)[4], const float* sc, const float* sh, int lane, f32x4 (&o)[4]) {
#pragma unroll
    for (int j = 0; j < 4; ++j) { const f32x4 s = *(const f32x4*)(sc + 256 * j + 4 * lane), h = *(const f32x4*)(sh + 256 * j + 4 * lane); o[j] = v[j] * (1.0f + s) + h; }
}
__device__ __forceinline__ float log2_gamma(float dexp) { return log1pf(-exp2f(-dexp)) * 1.4426950408889634f; }

__device__ __forceinline__ void p0_transpose_item(const float* W, int K, int N, bf16* WT, int dest_row0, int k0, int n0, LAS float* scr, int lane) {
#pragma unroll 8
    for (int i = 0; i < 32; ++i) { const int kk = 2 * i + (lane >> 5); scr[kk * 33 + (lane & 31)] = W[(size_t)(k0 + kk) * N + n0 + (lane & 31)]; }
    LDS_WAIT(); asm volatile("" ::: "memory");
    const int c = lane & 7;
#pragma unroll
    for (int j = 0; j < 4; ++j) { const int n = (lane >> 3) + 8 * j; const LAS float* s = scr + (8 * c) * 33 + n;
        v4u o; o.x = pk2(s[0 * 33], s[1 * 33]); o.y = pk2(s[2 * 33], s[3 * 33]); o.z = pk2(s[4 * 33], s[5 * 33]); o.w = pk2(s[6 * 33], s[7 * 33]);
        *(GAS v4u*)(WT + (size_t)(dest_row0 + n) * K + k0 + 8 * c) = o; }
    LDS_WAIT(); asm volatile("" ::: "memory");
}
__device__ __forceinline__ void p0a(const Args& A, LAS unsigned char* lds, int tid, int lane, int wave) {
    unsigned char* ws = KWS();
    const int G = gridDim.x, wg = opaque_bid();
    const float* in_c = KIN(1); const float* in_cctx = KIN(3); const float* in_wmod = KIN(4); const float* in_bmod = KIN(5);
    {
        LAS float* sl = (LAS float*)(lds + RING_OFF);
        float* MODP = (float*)(ws + WS_MODP);
        for (int u = wg; u < DEPTH * 8 * 12; u += G) {
            const int l = u / 96, rem = u % 96, kp = rem / 12, cb = rem % 12;
            for (int i = tid; i < 9 * 128; i += NWAVES * 64) { const int r = i >> 7, k = i & 127;
                const float cv = (r < 8) ? in_c[r * DM + kp * 128 + k] : in_cctx[kp * 128 + k];
                sl[i] = cv / (1.0f + expf(-cv)); }
            __syncthreads();
            const int col = cb * 512 + tid;
            float acc[9];
#pragma unroll
            for (int r = 0; r < 9; ++r) acc[r] = (kp == 0) ? in_bmod[l * NMOD + col] : 0.f;
            const float* wp = in_wmod + ((size_t)l * DM + kp * 128) * NMOD + col;
#pragma unroll 8
            for (int k = 0; k < 128; ++k) { const float w = wp[(size_t)k * NMOD];
#pragma unroll
                for (int r = 0; r < 9; ++r) acc[r] += sl[r * 128 + k] * w; }
#pragma unroll
            for (int r = 0; r < 9; ++r) MODP[((size_t)(l * 8 + kp) * 9 + r) * NMOD + col] = acc[r];
            __syncthreads();
        }
    }
    if (wg == G - 1) {
        const float invf[16] = {1.0f, 0.5623413251903491f, 0.31622776601683794f, 0.1778279410038923f, 0.1f, 0.05623413251903491f, 0.03162277660168379f, 0.01778279410038923f,
                                0.01f, 0.005623413251903491f, 0.0031622776601683794f, 0.0017782794100389228f, 0.001f, 0.0005623413251903491f, 0.00031622776601683794f, 0.00017782794100389227f};
        float2* rope = (float2*)(ws + WS_ROPE);
        for (int i = tid; i < 1024; i += NWAVES * 64) { const int f = i & 15; float fr = invf[0];
#pragma unroll
            for (int q = 1; q < 16; ++q) fr = (f == q) ? invf[q] : fr;
            const float ang = (float)(i >> 4) * fr; rope[i] = make_float2(cosf(ang), sinf(ang)); }
    }
    {
        LAS float* scr = (LAS float*)(lds + RING_OFF + wave * 16384);
        const float* in_win = KIN(6); const float* in_wout = KIN(12); const float* in_wgu = KIN(17); const float* in_wd = KIN(19);
        const int gw = wg * NWAVES + wave, NGW = G * NWAVES;
        constexpr int I_IN = 16 * 80, I_OUT = 16 * 32, I_GU = 16 * 64, I_DN = 16 * 32;
        constexpr int T_IN = DEPTH * I_IN, T_OUT = DEPTH * I_OUT, T_GU = DEPTH * NEXP * I_GU, T_DN = DEPTH * NEXP * I_DN;
        for (int it = gw; it < T_IN + T_OUT + T_GU + T_DN; it += NGW) {
            int r = it;
            if (r < T_IN) { const int l = r / I_IN, q = r % I_IN, kb = q / 80, nb = q % 80;
                p0_transpose_item(in_win + (size_t)l * DM * INW, DM, INW, (bf16*)(ws + WS_WIN) + (size_t)l * INW * DM, 32 * nb, 64 * kb, 32 * nb, scr, lane); continue; }
            r -= T_IN;
            if (r < T_OUT) { const int l = r / I_OUT, q = r % I_OUT, kb = q / 32, nb = q % 32;
                p0_transpose_item(in_wout + (size_t)l * DM * DM, DM, DM, (bf16*)(ws + WS_WOUT) + (size_t)l * DM * DM, 32 * nb, 64 * kb, 32 * nb, scr, lane); continue; }
            r -= T_OUT;
            if (r < T_GU) { const int le = r / I_GU, q = r % I_GU, kb = q / 64, nb = q % 64; const int n0 = 32 * nb;
                const int dest = (n0 < 1024) ? ((n0 >> 7) * 256 + (n0 & 127)) : ((((n0 - 1024) >> 7) * 256) + 128 + ((n0 - 1024) & 127));
                p0_transpose_item(in_wgu + (size_t)le * DM * 2048, DM, 2048, (bf16*)(ws + WS_WGU) + (size_t)le * 2048 * DM, dest, 64 * kb, n0, scr, lane); continue; }
            r -= T_GU;
            { const int le = r / I_DN, q = r % I_DN, kb = q / 32, nb = q % 32;
                p0_transpose_item(in_wd + (size_t)le * DM * DM, DM, DM, (bf16*)(ws + WS_WD) + (size_t)le * DM * DM, 32 * nb, 64 * kb, 32 * nb, scr, lane); }
        }
    }
}
__device__ __forceinline__ void p0b(const Args& A, int tid) {
    const float* MODP = (const float*)(KWS() + WS_MODP); float* MODV = (float*)(KWS() + WS_MODV);
    for (int i = opaque_bid() * (NWAVES * 64) + tid; i < DEPTH * 9 * NMOD; i += gridDim.x * NWAVES * 64) {
        const int l = i / (9 * NMOD), rc = i % (9 * NMOD); float s = 0.f;
#pragma unroll
        for (int kp = 0; kp < 8; ++kp) s += MODP[(size_t)(l * 8 + kp) * 9 * NMOD + rc];
        MODV[i] = s;
    }
}
__device__ __forceinline__ void p0c(const Args& A, int lane, int wave) {
    const float* MODV = (const float*)(KWS() + WS_MODV); bf16* XH = (bf16*)(KWS() + WS_XH);
    const int gw = opaque_bid() * NWAVES + wave, NGW = gridDim.x * NWAVES, RPW = (RTOT + NGW - 1) / NGW;
    for (int r = gw * RPW; r < (gw + 1) * RPW && r < RTOT; ++r) {
        const float* src = (r < RCTX) ? KIN(2) + (size_t)r * DM : KIN(0) + (size_t)(r - RCTX) * DM;
        const float* mv = MODV + (size_t)mod_row(r) * NMOD;
        f32x4 v[4], o[4]; load_row_f32(src, lane, v); modulate(v, mv + 1 * DM, mv + 0 * DM, lane, o); store_row_bf16(XH + (size_t)r * DM, lane, o);
    }
}

__device__ __forceinline__ void unpack4(uint2 u, float (&x)[4]) { x[0] = bflo(u.x); x[1] = bfhi(u.x); x[2] = bflo(u.y); x[3] = bfhi(u.y); }
__device__ __forceinline__ uint2 pack4(const float (&x)[4]) { uint2 u; u.x = pk2(x[0], x[1]); u.y = pk2(x[2], x[3]); return u; }
__device__ __forceinline__ void rope4(float (&x1)[4], float (&x2)[4], const float2* rope, int pos, int f0, bool apply, float scale) {
    if (apply) { const f32x4 a = *(const f32x4*)(rope + pos * 16 + f0), b = *(const f32x4*)(rope + pos * 16 + f0 + 2);
        const float cs[4] = {a[0], a[2], b[0], b[2]}, sn[4] = {a[1], a[3], b[1], b[3]};
#pragma unroll
        for (int i = 0; i < 4; ++i) { const float p = x1[i] * cs[i] - x2[i] * sn[i], q = x1[i] * sn[i] + x2[i] * cs[i]; x1[i] = p; x2[i] = q; } }
#pragma unroll
    for (int i = 0; i < 4; ++i) { x1[i] *= scale; x2[i] *= scale; }
}
__device__ __forceinline__ void p2_row(const Args& A, int l, int r, bool last, int lane) {
    unsigned char* ws = KWS();
    const bf16* zr = (const bf16*)(ws + WS_Z) + (size_t)r * INW; const float2* rope = (const float2*)(ws + WS_ROPE);
    const bool isctx = r < RCTX; const int b = isctx ? (r >> 8) : ((r - RCTX) >> 12), t = isctx ? (r & 255) : ((r - RCTX) & 4095), tlen = isctx ? CTXL : SEQL;
    const bool need_out = !(isctx && last);
    const int prow = t >> 6, pcol = t & 63;
    if (need_out) {
        const int c0 = 4 * lane; float u0[4], cc[4], bb[4], up[4] = {0.f, 0.f, 0.f, 0.f}, cp[4] = {0.f, 0.f, 0.f, 0.f}, un[4] = {0.f, 0.f, 0.f, 0.f}, cn[4] = {0.f, 0.f, 0.f, 0.f};
        unpack4(*(const uint2*)(zr + ZC_U + c0), u0); unpack4(*(const uint2*)(zr + ZC_C + c0), cc); unpack4(*(const uint2*)(zr + ZC_B + c0), bb);
        if (t > 0) { unpack4(*(const uint2*)(zr - INW + ZC_U + c0), up); unpack4(*(const uint2*)(zr - INW + ZC_C + c0), cp); }
        if (t < tlen - 1) { unpack4(*(const uint2*)(zr + INW + ZC_U + c0), un); unpack4(*(const uint2*)(zr + INW + ZC_C + c0), cn); }
        const float* cw = KIN(7) + (size_t)l * 256 * 3 + c0 * 3; const f32x4 w0 = *(const f32x4*)cw, w1 = *(const f32x4*)(cw + 4), w2 = *(const f32x4*)(cw + 8);
        const float wf[12] = {w0[0], w0[1], w0[2], w0[3], w1[0], w1[1], w1[2], w1[3], w2[0], w2[1], w2[2], w2[3]};
        float y[4];
#pragma unroll
        for (int i = 0; i < 4; ++i) y[i] = bb[i] * (wf[3 * i] * (cp[i] * up[i]) + wf[3 * i + 1] * (cc[i] * u0[i]) + wf[3 * i + 2] * (cn[i] * un[i]));
        *(uint2*)((bf16*)(ws + WS_MIX) + (size_t)r * DM + c0) = pack4(y);
    }
    {
        const int which = lane >> 5, blk = (lane >> 2) & 7, j = lane & 3, axis = blk & 1, col = blk * 32 + 4 * j;
        const bf16* src = zr + (which ? ZC_RK : ZC_RQ) + col; float x1[4], x2[4];
        unpack4(*(const uint2*)src, x1); unpack4(*(const uint2*)(src + 16), x2);
        rope4(x1, x2, rope, axis ? pcol : prow, 4 * j, !isctx, which ? 0.125f : 1.0f);
        bf16* dst = (bf16*)(ws + (which ? WS_RK : WS_RQ)) + (size_t)r * 256 + col;
        *(uint2*)dst = pack4(x1); *(uint2*)(dst + 16) = pack4(x2);
    }
    {
        const int blk = lane >> 2, j = lane & 3, axis = blk & 1, col = blk * 32 + 4 * j;
        const bf16* src = zr + ZC_AQ + col; float x1[4], x2[4];
        unpack4(*(const uint2*)src, x1); unpack4(*(const uint2*)(src + 16), x2);
        float ss = 0.f;
#pragma unroll
        for (int i = 0; i < 4; ++i) ss += x1[i] * x1[i] + x2[i] * x2[i];
        ss += __shfl_xor(ss, 1); ss += __shfl_xor(ss, 2); ss += __shfl_xor(ss, 4);
        const float rn = 1.0f / sqrtf(ss * (1.0f / 64.0f) + LN_EPS);
        const float* g = KIN(10) + l * 64 + axis * 32 + 4 * j; const f32x4 g1 = *(const f32x4*)g, g2 = *(const f32x4*)(g + 16);
#pragma unroll
        for (int i = 0; i < 4; ++i) { x1[i] = x1[i] * rn * g1[i]; x2[i] = x2[i] * rn * g2[i]; }
        rope4(x1, x2, rope, axis ? pcol : prow, 4 * j, !isctx, attn_body::C2);
        if (need_out) { bf16* dst = (bf16*)(ws + WS_AQ) + (size_t)r * 512 + col; *(uint2*)dst = pack4(x1); *(uint2*)(dst + 16) = pack4(x2); }
    }
    {
        const int lk = lane & 15, blk = lk >> 2, j = lk & 3, kvh = blk >> 1, axis = blk & 1, col = blk * 32 + 4 * j;
        const bf16* src = zr + ZC_AK + col; float x1[4], x2[4];
        unpack4(*(const uint2*)src, x1); unpack4(*(const uint2*)(src + 16), x2);
        float ss = 0.f;
#pragma unroll
        for (int i = 0; i < 4; ++i) ss += x1[i] * x1[i] + x2[i] * x2[i];
        ss += __shfl_xor(ss, 1); ss += __shfl_xor(ss, 2); ss += __shfl_xor(ss, 4);
        const float rn = 1.0f / sqrtf(ss * (1.0f / 64.0f) + LN_EPS);
        const float* g = KIN(11) + l * 64 + axis * 32 + 4 * j; const f32x4 g1 = *(const f32x4*)g, g2 = *(const f32x4*)(g + 16);
#pragma unroll
        for (int i = 0; i < 4; ++i) { x1[i] = x1[i] * rn * g1[i]; x2[i] = x2[i] * rn * g2[i]; }
        rope4(x1, x2, rope, axis ? pcol : prow, 4 * j, !isctx, 1.0f);
        const int key = isctx ? t : CTXL + t;
        if (lane < 16) { bf16* dst = (bf16*)(ws + WS_AK) + ((size_t)(b * 2 + kvh) * NKEY + key) * 64 + axis * 32 + 4 * j; *(uint2*)dst = pack4(x1); *(uint2*)(dst + 16) = pack4(x2); }
        if (lane >= 32) { const int c = (lane - 32) * 4, kv2 = c >> 6, d = c & 63;
            *(uint2*)((bf16*)(ws + WS_AV) + ((size_t)(b * 2 + kv2) * NKEY + key) * 64 + d) = *(const uint2*)(zr + ZC_AV + c); }
    }
}
constexpr int RT_PITCH = 136;
__device__ __forceinline__ void p2_kv_job(const Args& A, int l, int u, LAS unsigned char* lds, int tid, int lane, int wave) {
    unsigned char* ws = KWS();
    const int h = u & 3, pf = (u >> 2) % NPF, b = (u >> 2) / NPF;
    const bool isctx = pf < 2; const int row0 = isctx ? (b * CTXL + pf * 128) : (RCTX + b * SEQL + (pf - 2) * 128);
    const bf16* Z = (const bf16*)(ws + WS_Z); const float2* rope = (const float2*)(ws + WS_ROPE);
    LAS unsigned short* VT = (LAS unsigned short*)(lds + RING_OFF); LAS unsigned short* KFT = VT + 64 * RT_PITCH; LAS unsigned short* KBT = KFT + 64 * RT_PITCH;
    const float lgf = log2_gamma(KIN(8)[(l * 2 + 0) * 4 + h]), lgb = log2_gamma(KIN(8)[(l * 2 + 1) * 4 + h]);
#pragma unroll
    for (int i = 0; i < 2; ++i) { const int idx = tid + 512 * i, t = idx >> 3, eg = idx & 7;
        const v4u v = *(const v4u*)(Z + (size_t)(row0 + t) * INW + ZC_RV + h * 64 + eg * 8);
        LAS unsigned short* d = VT + (eg * 8) * RT_PITCH + t;
        d[0 * RT_PITCH] = (unsigned short)(v.x & 0xffffu); d[1 * RT_PITCH] = (unsigned short)(v.x >> 16); d[2 * RT_PITCH] = (unsigned short)(v.y & 0xffffu); d[3 * RT_PITCH] = (unsigned short)(v.y >> 16);
        d[4 * RT_PITCH] = (unsigned short)(v.z & 0xffffu); d[5 * RT_PITCH] = (unsigned short)(v.z >> 16); d[6 * RT_PITCH] = (unsigned short)(v.w & 0xffffu); d[7 * RT_PITCH] = (unsigned short)(v.w >> 16); }
    { const int t = tid >> 2, axis = (tid >> 1) & 1, fg = tid & 1;
        const bf16* src = Z + (size_t)(row0 + t) * INW + ZC_RK + h * 64 + axis * 32 + 8 * fg;
        const v4u a = *(const v4u*)src, c = *(const v4u*)(src + 16);
        float x1[8] = {bflo(a.x), bfhi(a.x), bflo(a.y), bfhi(a.y), bflo(a.z), bfhi(a.z), bflo(a.w), bfhi(a.w)};
        float x2[8] = {bflo(c.x), bfhi(c.x), bflo(c.y), bfhi(c.y), bflo(c.z), bfhi(c.z), bflo(c.w), bfhi(c.w)};
        if (!isctx) { const int tt = (pf - 2) * 128 + t, pos = axis ? (tt & 63) : (tt >> 6); const float2* rp = rope + pos * 16 + 8 * fg;
#pragma unroll
            for (int i = 0; i < 8; ++i) { const float2 cs = rp[i]; const float p = x1[i] * cs.x - x2[i] * cs.y, q = x1[i] * cs.y + x2[i] * cs.x; x1[i] = p; x2[i] = q; } }
        const float wf = exp2f((float)(127 - t) * lgf) * 0.125f, wb = exp2f((float)t * lgb) * 0.125f;
        const int d0 = axis * 32 + 8 * fg;
#pragma unroll
        for (int i = 0; i < 8; ++i) {
            KFT[(d0 + i) * RT_PITCH + t] = (unsigned short)f2bf(x1[i] * wf); KFT[(d0 + 16 + i) * RT_PITCH + t] = (unsigned short)f2bf(x2[i] * wf);
            KBT[(d0 + i) * RT_PITCH + t] = (unsigned short)f2bf(x1[i] * wb); KBT[(d0 + 16 + i) * RT_PITCH + t] = (unsigned short)f2bf(x2[i] * wb); }
    }
    __syncthreads();
    { const int dir = wave >> 2, te = (wave >> 1) & 1, td = wave & 1, r32 = lane & 31, hh = lane >> 5;
        const LAS unsigned short* KT = dir ? KBT : KFT;
        f32x16 acc = {};
#pragma unroll
        for (int s = 0; s < 8; ++s) {
            const bf16x8 a = *(const LAS bf16x8*)(VT + (te * 32 + r32) * RT_PITCH + s * 16 + hh * 8);
            const bf16x8 bq = *(const LAS bf16x8*)(KT + (td * 32 + r32) * RT_PITCH + s * 16 + hh * 8);
            acc = __builtin_amdgcn_mfma_f32_32x32x16_bf16(a, bq, acc, 0, 0, 0);
        }
        float* out = (float*)(ws + WS_KVS) + ((size_t)((b * 4 + h) * NPF + pf) * 2 + dir) * 4096;
#pragma unroll
        for (int q = 0; q < 16; ++q) { const int e = te * 32 + (q & 3) + 8 * (q >> 2) + 4 * hh; out[e * 64 + td * 32 + r32] = acc[q]; }
    }
    __syncthreads();
}
__device__ __forceinline__ void p2(const Args& A, int l, LAS unsigned char* lds, int tid, int lane, int wave) {
    const bool last = (l == DEPTH - 1);
    for (int u = opaque_bid(); u < NBATCH * NPF * 4; u += gridDim.x) p2_kv_job(A, l, u, lds, tid, lane, wave);
    const int gw = opaque_bid() * NWAVES + wave, NGW = gridDim.x * NWAVES, RPW = (RTOT + NGW - 1) / NGW;
    for (int r = gw * RPW; r < (gw + 1) * RPW && r < RTOT; ++r) p2_row(A, l, r, last, lane);
}

__device__ __forceinline__ void p4_scan(const Args& A, int l, int tid) {
    const float* KVS = (const float*)(KWS() + WS_KVS); bf16* SS = (bf16*)(KWS() + WS_SS);
    for (int gid = opaque_bid() * (NWAVES * 64) + tid; gid < NBATCH * 4 * 4096; gid += gridDim.x * NWAVES * 64) {
        const int bh = gid >> 12, ed = gid & 4095, h = bh & 3;
        const float gf = exp2f(128.0f * log2_gamma(KIN(8)[(l * 2 + 0) * 4 + h])), gb = exp2f(128.0f * log2_gamma(KIN(8)[(l * 2 + 1) * 4 + h]));
        const size_t base = (size_t)bh * NPF * 2 * 4096 + ed;
        float S = 0.f;
        for (int pf = 0; pf < NPF; ++pf) { const size_t o = base + (size_t)(pf * 2 + 0) * 4096; SS[o] = (bf16)f2bf(S); S = gf * S + KVS[o]; }
        S = 0.f;
        for (int q = 0; q < NPF; ++q) { const int pf = (q == 0) ? 1 : (q == 1) ? 0 : (NPF + 1 - q);
            const size_t o = base + (size_t)(pf * 2 + 1) * 4096; SS[o] = (bf16)f2bf(S); S = gb * S + KVS[o]; }
    }
}
__device__ __forceinline__ void p4_attention(const Args& A, int l, char* lds_ring) {
    using abf = attn_body::bf16;
    const abf* AQ = (const abf*)(KWS() + WS_AQ); const abf* AK = (const abf*)(KWS() + WS_AK); const abf* AV = (const abf*)(KWS() + WS_AV); abf* MIX = (abf*)(KWS() + WS_MIX);
    const int c = opaque_bid(), G = gridDim.x;
    const int x = c & 7, m = c >> 3, per = G >> 3, b = x;
    for (int i = 0; i < 5; ++i) {
        const bool isctx = (i == 4);
        if (isctx && (l == DEPTH - 1 || m >= 8)) break;
        const int uu = m + per * i; if (!isctx && uu >= 128) break;
        const int h = isctx ? m : (uu >> 4), kvh = h >> 2, NT = isctx ? (CTXL / 64) : (NKEY / 64);
        const size_t qrow = isctx ? (size_t)b * CTXL : (size_t)RCTX + (size_t)b * SEQL + (size_t)(uu & 15) * 256;
        attn_body::attn_unit<8>(AQ + qrow * 512 + h * 64, AK + (size_t)(b * 2 + kvh) * NKEY * 64, AV + (size_t)(b * 2 + kvh) * NKEY * 64, MIX + qrow * DM + 512 + h * 64, NT, lds_ring);
    }
}

__device__ __forceinline__ void p5_unit(const Args& A, int l, int g, int hp, LAS unsigned char* lds, int tid, int lane, int wave) {
    unsigned char* ws = KWS();
    const bf16* Z = (const bf16*)(ws + WS_Z); const bf16* RQ = (const bf16*)(ws + WS_RQ); const bf16* RK = (const bf16*)(ws + WS_RK); const bf16* SS = (const bf16*)(ws + WS_SS);
    bf16* MIX = (bf16*)(ws + WS_MIX);
    const int row0 = g * 128;
    int b, pf; if (g < 16) { b = g >> 1; pf = g & 1; } else { b = (g - 16) >> 5; pf = 2 + ((g - 16) & 31); }
    LAS unsigned short* VT = (LAS unsigned short*)(lds + RING_OFF);
#pragma unroll
    for (int i = 0; i < 4; ++i) { const int idx = tid + 512 * i, hl = idx >> 10, t = (idx >> 3) & 127, eg = idx & 7;
        const v4u v = *(const v4u*)(Z + (size_t)(row0 + t) * INW + ZC_RV + (2 * hp + hl) * 64 + eg * 8);
        LAS unsigned short* d = VT + (hl * 64 + eg * 8) * RT_PITCH + t;
        d[0 * RT_PITCH] = (unsigned short)(v.x & 0xffffu); d[1 * RT_PITCH] = (unsigned short)(v.x >> 16); d[2 * RT_PITCH] = (unsigned short)(v.y & 0xffffu); d[3 * RT_PITCH] = (unsigned short)(v.y >> 16);
        d[4 * RT_PITCH] = (unsigned short)(v.z & 0xffffu); d[5 * RT_PITCH] = (unsigned short)(v.z >> 16); d[6 * RT_PITCH] = (unsigned short)(v.w & 0xffffu); d[7 * RT_PITCH] = (unsigned short)(v.w >> 16); }
    __syncthreads();
    {
        const int hl = wave >> 2, h = 2 * hp + hl, ib = wave & 3, r32 = lane & 31, hh = lane >> 5;
        const float lgf = log2_gamma(KIN(8)[(l * 2 + 0) * 4 + h]), lgb = log2_gamma(KIN(8)[(l * 2 + 1) * 4 + h]);
        const int iloc = ib * 32 + r32;
        bf16x8 qf[4];
#pragma unroll
        for (int s = 0; s < 4; ++s) qf[s] = *(const bf16x8*)(RQ + (size_t)(row0 + iloc) * 256 + h * 64 + s * 16 + hh * 8);
        const bf16* Sf = SS + ((size_t)((b * 4 + h) * NPF + pf) * 2 + 0) * 4096; const bf16* Sb = Sf + 4096;
        f32x16 Y[2];
        {
            const float af = exp2f((float)(iloc + 1) * lgf), ab = exp2f((float)(128 - iloc) * lgb);
#pragma unroll
            for (int et = 0; et < 2; ++et) {
                f32x16 cf = {}, cb = {};
#pragma unroll
                for (int s = 0; s < 4; ++s) {
                    const bf16x8 a0 = *(const bf16x8*)(Sf + (et * 32 + r32) * 64 + s * 16 + hh * 8), a1 = *(const bf16x8*)(Sb + (et * 32 + r32) * 64 + s * 16 + hh * 8);
                    cf = __builtin_amdgcn_mfma_f32_32x32x16_bf16(a0, qf[s], cf, 0, 0, 0); cb = __builtin_amdgcn_mfma_f32_32x32x16_bf16(a1, qf[s], cb, 0, 0, 0);
                }
#pragma unroll
                for (int q = 0; q < 16; ++q) Y[et][q] = af * cf[q] + ab * cb[q];
            }
        }
        const LAS unsigned short* VTh = VT + hl * 64 * RT_PITCH;
#pragma unroll 1
        for (int jt = 0; jt < 4; ++jt) {
            f32x16 X = {};
#pragma unroll
            for (int s = 0; s < 4; ++s) { const bf16x8 a = *(const bf16x8*)(RK + (size_t)(row0 + jt * 32 + r32) * 256 + h * 64 + s * 16 + hh * 8);
                X = __builtin_amdgcn_mfma_f32_32x32x16_bf16(a, qf[s], X, 0, 0, 0); }
#pragma unroll
            for (int q = 0; q < 16; ++q) { const int jloc = jt * 32 + (q & 3) + 8 * (q >> 2) + 4 * hh; const int dl = iloc - jloc;
                X[q] *= (dl >= 0) ? exp2f((float)dl * lgf) : exp2f((float)(-dl) * lgb); }
#pragma unroll
            for (int s = 0; s < 2; ++s) {
                v4u pw; pw.x = pk2(X[8 * s + 0], X[8 * s + 1]); pw.y = pk2(X[8 * s + 2], X[8 * s + 3]); pw.z = pk2(X[8 * s + 4], X[8 * s + 5]); pw.w = pk2(X[8 * s + 6], X[8 * s + 7]);
                const bf16x8 bfrag = __builtin_bit_cast(bf16x8, pw);
#pragma unroll
                for (int et = 0; et < 2; ++et) {
                    const LAS unsigned short* vp = VTh + (et * 32 + r32) * RT_PITCH + jt * 32 + 16 * s + 4 * hh;
                    const v2u lo = *(const LAS v2u*)vp, hi2 = *(const LAS v2u*)(vp + 8);
                    v4u aw; aw.x = lo.x; aw.y = lo.y; aw.z = hi2.x; aw.w = hi2.y;
                    Y[et] = __builtin_amdgcn_mfma_f32_32x32x16_bf16(__builtin_bit_cast(bf16x8, aw), bfrag, Y[et], 0, 0, 0);
                }
            }
        }
        float s1 = 0.f;
#pragma unroll
        for (int q = 0; q < 16; ++q) s1 += Y[0][q] + Y[1][q];
        s1 += __shfl_xor(s1, 32); const float mu = s1 * (1.0f / 64.0f); float s2 = 0.f;
#pragma unroll
        for (int q = 0; q < 16; ++q) { const float d0 = Y[0][q] - mu, d1 = Y[1][q] - mu; s2 += d0 * d0 + d1 * d1; }
        s2 += __shfl_xor(s2, 32); const float rstd = 1.0f / sqrtf(s2 * (1.0f / 64.0f) + LN_EPS);
        const size_t row = (size_t)(row0 + iloc);
#pragma unroll
        for (int et = 0; et < 2; ++et)
#pragma unroll
            for (int q4 = 0; q4 < 4; ++q4) { const int e0 = et * 32 + 8 * q4 + 4 * hh;
                float gz[4]; unpack4(*(const uint2*)(Z + row * INW + ZC_RG + h * 64 + e0), gz);
                const f32x4 gn = *(const f32x4*)(KIN(9) + l * 256 + h * 64 + e0);
                float o[4];
#pragma unroll
                for (int i = 0; i < 4; ++i) { const float yn = (Y[et][4 * q4 + i] - mu) * rstd * gn[i]; o[i] = yn * (gz[i] / (1.0f + expf(-gz[i]))); }
                *(uint2*)(MIX + row * DM + 256 + h * 64 + e0) = pack4(o); }
    }
    __syncthreads();
}
__device__ __forceinline__ void p5(const Args& A, int l, LAS unsigned char* lds, int tid, int lane, int wave) {
    const int g0 = (l == DEPTH - 1) ? 16 : 0;
    for (int u = opaque_bid(); u < (272 - g0) * 2; u += gridDim.x) p5_unit(A, l, g0 + (u >> 1), u & 1, lds, tid, lane, wave);
}

__device__ __forceinline__ float reduce32(float (&v)[32], int lane) {
#pragma unroll
    for (int i = 0; i < 16; ++i) { const bool up = lane & 32; const float send = up ? v[i] : v[i + 16], keep = up ? v[i + 16] : v[i]; v[i] = keep + __shfl_xor(send, 32); }
#pragma unroll
    for (int i = 0; i < 8; ++i) { const bool up = lane & 16; const float send = up ? v[i] : v[i + 8], keep = up ? v[i + 8] : v[i]; v[i] = keep + __shfl_xor(send, 16); }
#pragma unroll
    for (int i = 0; i < 4; ++i) { const bool up = lane & 8; const float send = up ? v[i] : v[i + 4], keep = up ? v[i + 4] : v[i]; v[i] = keep + __shfl_xor(send, 8); }
#pragma unroll
    for (int i = 0; i < 2; ++i) { const bool up = lane & 4; const float send = up ? v[i] : v[i + 2], keep = up ? v[i + 2] : v[i]; v[i] = keep + __shfl_xor(send, 4); }
    { const bool up = lane & 2; const float send = up ? v[0] : v[1], keep = up ? v[1] : v[0]; v[0] = keep + __shfl_xor(send, 2); }
    return v[0] + __shfl_xor(v[0], 1);
}
__device__ __forceinline__ void p7_ln(const Args& A, int l, int r, int lane, f32x4 (&hv)[4]) {
    unsigned char* ws = KWS();
    const float* mv = (const float*)(ws + WS_MODV) + (size_t)(l * 9 + mod_row(r)) * NMOD;
    f32x4 v[4], y[4];
    if (l == 0) load_row_f32((r < RCTX) ? KIN(2) + (size_t)r * DM : KIN(0) + (size_t)(r - RCTX) * DM, lane, v);
    else load_row_bf16((const bf16*)(ws + WS_XSA) + (size_t)r * DM, lane, v);
    load_row_bf16((const bf16*)(ws + WS_Y) + (size_t)r * DM, lane, y);
#pragma unroll
    for (int j = 0; j < 4; ++j) { const f32x4 g1 = *(const f32x4*)(mv + 2 * DM + 256 * j + 4 * lane); v[j] = ALPHA * v[j] + g1 * y[j]; }
    ln_row(v, KIN(13) + (size_t)(l * 2 + 0) * DM, KIN(14) + (size_t)(l * 2 + 0) * DM, lane);
    store_row_bf16((bf16*)(ws + WS_XSA) + (size_t)r * DM, lane, v);
    modulate(v, mv + 4 * DM, mv + 3 * DM, lane, hv);
    store_row_bf16((bf16*)(ws + WS_H2) + (size_t)r * DM, lane, hv);
}
__device__ __forceinline__ void p7_route(const Args& A, float logit, int r, int rloc, int lane, LAS int* lcnt, LAS int* ent) {
    float val = logit; const int idx = lane >> 1; float tv[4]; int te[4];
#pragma unroll
    for (int k = 0; k < 4; ++k) {
        float bv = val; int bi = idx;
#pragma unroll
        for (int o = 1; o < 64; o <<= 1) { const float ov = __shfl_xor(bv, o); const int oi = __shfl_xor(bi, o); const bool take = (ov > bv) || (ov == bv && oi < bi); bv = take ? ov : bv; bi = take ? oi : bi; }
        tv[k] = bv; te[k] = bi; val = (idx == bi) ? -INFINITY : val;
    }
    const float p1 = expf(tv[1] - tv[0]), p2 = expf(tv[2] - tv[0]), p3 = expf(tv[3] - tv[0]); const float inv = 1.0f / (1.0f + p1 + p2 + p3);
    if (lane < 4) {
        const int e = (lane == 0) ? te[0] : (lane == 1) ? te[1] : (lane == 2) ? te[2] : te[3];
        const float w = ((lane == 0) ? 1.0f : (lane == 1) ? p1 : (lane == 2) ? p2 : p3) * inv;
        const int lp = __hip_atomic_fetch_add(lcnt + e, 1, __ATOMIC_RELAXED, __HIP_MEMORY_SCOPE_WORKGROUP);
        ent[rloc * 4 + lane] = e | (lp << 8);
        ((float*)(KWS() + WS_RW))[(size_t)r * 4 + lane] = w;
    }
}
__device__ __forceinline__ void p7(const Args& A, int l, LAS unsigned char* lds, int tid, int lane, int wave) {
    unsigned char* ws = KWS();
    const int row_lo = (l == DEPTH - 1) ? RCTX : 0, nrows = RTOT - row_lo;
    const int NGW = gridDim.x * NWAVES, RPW = (nrows + NGW - 1) / NGW, wg_row0 = row_lo + opaque_bid() * NWAVES * RPW;
    LAS f32x4* WL = (LAS f32x4*)(lds + RING_OFF);
    LAS int* lcnt = (LAS int*)(lds + LCNT_OFF); LAS int* lbase = (LAS int*)(lds + LBASE_OFF); LAS int* ent = (LAS int*)(lds + ENT_OFF);
    const float* wr = KIN(15) + (size_t)l * DM * NEXP;
    for (int s = tid; s < 8192; s += NWAVES * 64) { const int ln = s & 63, eg = (s >> 6) & 7, jc = s >> 9; const int k = 256 * (jc >> 2) + 4 * ln + (jc & 3);
        WL[s] = *(const f32x4*)(wr + (size_t)k * NEXP + 4 * eg); }
    if (tid < 32) lcnt[tid] = 0;
    __syncthreads();
    const float bias_e = KIN(16)[l * NEXP + (lane >> 1)];
    const int w_row0 = wg_row0 + wave * RPW;
    for (int i = 0; i < RPW; ++i) {
        const int r0 = w_row0 + i; if (r0 >= RTOT) break;
        f32x4 h0[4];
        p7_ln(A, l, r0, lane, h0);
        f32x4 acc[8];
#pragma unroll
        for (int eg = 0; eg < 8; ++eg) acc[eg] = (f32x4){0.f, 0.f, 0.f, 0.f};
#pragma unroll
        for (int j = 0; j < 4; ++j)
#pragma unroll
            for (int c = 0; c < 4; ++c) { const float xa = h0[j][c];
#pragma unroll
                for (int eg = 0; eg < 8; ++eg) acc[eg] = WL[((j * 4 + c) * 8 + eg) * 64 + lane] * xa + acc[eg]; }
        float a0[32];
#pragma unroll
        for (int e = 0; e < 32; ++e) a0[e] = acc[e >> 2][e & 3];
        const float lg0 = reduce32(a0, lane) + bias_e;
        p7_route(A, lg0, r0, r0 - wg_row0, lane, lcnt, ent);
    }
    __syncthreads();
    if (tid < 32) lbase[tid] = (int)__hip_atomic_fetch_add((unsigned*)(ws + WS_CTL) + CW_GCNT + (l * 32 + tid) * 16, (unsigned)lcnt[tid], __ATOMIC_RELAXED, __HIP_MEMORY_SCOPE_AGENT);
    __syncthreads();
    { const int nent = NWAVES * RPW * 4; int* RE = (int*)(ws + WS_RE); int* RP = (int*)(ws + WS_RP);
        for (int i = tid; i < nent; i += NWAVES * 64) { const int row = wg_row0 + (i >> 2); if (row < RTOT) { const int v = ent[i], e = v & 255, lp = v >> 8;
            RE[(size_t)row * 4 + (i & 3)] = e; RP[(size_t)row * 4 + (i & 3)] = lbase[e] + lp; } } }
    __syncthreads();
}
__device__ __forceinline__ void moe_offsets(const Args& A, int l, LAS unsigned char* lds, int tid) {
    volatile LAS int* offt = (volatile LAS int*)(lds + OFFT_OFF);
    if (tid < 64) {
        const unsigned c = __hip_atomic_load((unsigned*)(KWS() + WS_CTL) + CW_GCNT + (l * 32 + (tid & 31)) * 16, __ATOMIC_RELAXED, __HIP_MEMORY_SCOPE_AGENT);
        int x = (int)((c + 255u) >> 8);
#pragma unroll
        for (int o = 1; o < 32; o <<= 1) { const int v = __shfl_up(x, o); if ((tid & 31) >= o) x += v; }
        if (tid < 32) offt[tid + 1] = x;
        if (tid == 0) offt[0] = 0;
    }
    __syncthreads();
}
__device__ __forceinline__ void p8(const Args& A, int l, LAS unsigned char* lds, int tid, int lane, int wave) {
    unsigned char* ws = KWS();
    moe_offsets(A, l, lds, tid);
    volatile LAS int* offt = (volatile LAS int*)(lds + OFFT_OFF);
    const int row_lo = (l == DEPTH - 1) ? RCTX : 0, nrows = RTOT - row_lo;
    const int NGW = gridDim.x * NWAVES, RPW = (nrows + NGW - 1) / NGW, w_row0 = row_lo + (opaque_bid() * NWAVES + wave) * RPW;
    const int* RE = (const int*)(ws + WS_RE); const int* RP = (const int*)(ws + WS_RP); const float* RW = (const float*)(ws + WS_RW);
    int* SLOT = (int*)(ws + WS_SLOT); float* ROWW = (float*)(ws + WS_ROWW); const bf16* H2 = (const bf16*)(ws + WS_H2); bf16* XS2 = (bf16*)(ws + WS_XS2);
    for (int r = w_row0; r < w_row0 + RPW && r < RTOT; ++r) {
        const int e4 = RE[(size_t)r * 4 + (lane & 3)], p4 = RP[(size_t)r * 4 + (lane & 3)]; const int slot_l = offt[e4 & 31] * 256 + p4;
        const v4u a = *(const v4u*)(H2 + (size_t)r * DM + 8 * lane), b = *(const v4u*)(H2 + (size_t)r * DM + 512 + 8 * lane);
#pragma unroll
        for (int k = 0; k < 4; ++k) { const int slot = __shfl(slot_l, k); bf16* d = XS2 + (size_t)slot * DM; *(v4u*)(d + 8 * lane) = a; *(v4u*)(d + 512 + 8 * lane) = b; }
        if (lane < 4) { SLOT[(size_t)r * 4 + lane] = slot_l; ROWW[slot_l] = RW[(size_t)r * 4 + lane]; }
    }
}
__device__ __forceinline__ void moe_order(pg8::MoeOrder& S, LAS unsigned char* lds, int sh) {
    volatile LAS int* offt = (volatile LAS int*)(lds + OFFT_OFF);
#pragma unroll
    for (int j = 0; j < 11; ++j) { unsigned w = 0;
#pragma unroll
        for (int q = 0; q < 3; ++q) { const int k = 3 * j + q + 1; if (k <= 32) w |= ((unsigned)offt[k] & 1023u) << (10 * q); }
        S.pk[j] = (unsigned)__builtin_amdgcn_readfirstlane((int)w); }
    S.nt = __builtin_amdgcn_readfirstlane(offt[32]); S.sh = sh; S.G = gridDim.x; S.c = opaque_bid();
}
__device__ __forceinline__ void p11(const Args& A, int l, int lane, int wave) {
    unsigned char* ws = KWS();
    const bool last = (l == DEPTH - 1);
    const int row_lo = last ? RCTX : 0, nrows = RTOT - row_lo;
    const int NGW = gridDim.x * NWAVES, RPW = (nrows + NGW - 1) / NGW, w_row0 = row_lo + (opaque_bid() * NWAVES + wave) * RPW;
    const int* SLOT = (const int*)(ws + WS_SLOT); const bf16* YB = (const bf16*)(ws + WS_YB); bf16* XSA = (bf16*)(ws + WS_XSA);
    const float* MODV = (const float*)(ws + WS_MODV);
    for (int r = w_row0; r < w_row0 + RPW && r < RTOT; ++r) {
        const int slot_l = SLOT[(size_t)r * 4 + (lane & 3)];
        f32x4 f[4] = {{0.f, 0.f, 0.f, 0.f}, {0.f, 0.f, 0.f, 0.f}, {0.f, 0.f, 0.f, 0.f}, {0.f, 0.f, 0.f, 0.f}};
#pragma unroll
        for (int k = 0; k < 4; ++k) { const int slot = __shfl(slot_l, k); f32x4 y[4]; load_row_bf16(YB + (size_t)slot * DM, lane, y);
#pragma unroll
            for (int j = 0; j < 4; ++j) f[j] += y[j]; }
        const float* mv = MODV + (size_t)(l * 9 + mod_row(r)) * NMOD;
        f32x4 v[4]; load_row_bf16(XSA + (size_t)r * DM, lane, v);
#pragma unroll
        for (int j = 0; j < 4; ++j) { const f32x4 g2 = *(const f32x4*)(mv + 5 * DM + 256 * j + 4 * lane); v[j] = ALPHA * v[j] + g2 * f[j]; }
        ln_row(v, KIN(13) + (size_t)(l * 2 + 1) * DM, KIN(14) + (size_t)(l * 2 + 1) * DM, lane);
        if (last) store_row_f32(KOUT() + (size_t)(r - RCTX) * DM, lane, v);
        else { store_row_bf16(XSA + (size_t)r * DM, lane, v);
            const float* mn = MODV + (size_t)((l + 1) * 9 + mod_row(r)) * NMOD; f32x4 o[4]; modulate(v, mn + 1 * DM, mn + 0 * DM, lane, o);
            store_row_bf16((bf16*)(ws + WS_XH) + (size_t)r * DM, lane, o); }
    }
}

__global__ void __launch_bounds__(NWAVES * 64, 2) mk_fwd(Args args) {
    extern __shared__ __attribute__((aligned(16))) unsigned char lds_raw[];
    LAS unsigned char* lds = (LAS unsigned char*)lds_raw;
    volatile LAS unsigned* MISC = (volatile LAS unsigned*)(lds + MISC_OFF);
    gu32* ctl = (gu32*)(KWS() + WS_CTL);
    for (int u = threadIdx.x; u < (LDS_BYTES - LDSCTL_OFF) / 4; u += NWAVES * 64) ((LAS unsigned*)(lds + LDSCTL_OFF))[u] = 0u;
    __syncthreads();
    XcdBarrier bar; bar.bar = (unsigned*)(ctl + CW_BAR); bar.x = 0; bar.st = nullptr;
    if (N_LAUNCHES == 1) bar = xcd_barrier_post((unsigned*)(ctl + CW_BAR), MISC + 8);
#define GRID_BAR() do { if (N_LAUNCHES == 1) { xcd_barrier(bar); } } while (0)
    const int lo = args.ph_lo, hi = args.ph_hi;
#define IN(k) (lo <= (k) && (k) < hi)
#define SEAM(k) do { if (IN(k) && IN((k) + 1)) GRID_BAR(); } while (0)
#define IDS() const int tid = opaque_tid(), lane = tid & 63, wave = __builtin_amdgcn_readfirstlane(tid >> 6); (void)lane; (void)wave

    if (IN(0)) { IDS(); p0a(args, lds, tid, lane, wave); } SEAM(0);
    if (IN(1)) { IDS(); p0b(args, tid); } SEAM(1);
    if (IN(2)) { IDS(); p0c(args, lane, wave); } SEAM(2);

#pragma unroll 1
    for (int l = 0; l < DEPTH; ++l) {
        const int pb = N_PRO + l * N_PER_LAYER; const bool last = (l == DEPTH - 1);
        if (IN(pb + 0)) { unsigned char* ws = KWS();
            pg8::Gemm g{(const bf16*)(ws + WS_XH), (const bf16*)(ws + WS_WIN) + (size_t)l * INW * DM, RTOT, INW, DM}; pg8::StaticOrder S; S.init(RTOT, INW, (int)gridDim.x, opaque_bid());
            pg8::EpiBf16 E{(bf16*)(ws + WS_Z), INW};
            pg8::gemm_phase<pg8::EpiBf16, pg8::StaticOrder, true, true>(lds + RING_OFF, g, S, E);
        } SEAM(pb + 0);
        if (IN(pb + 1)) { IDS(); p2(args, l, lds, tid, lane, wave); } SEAM(pb + 1);
        if (IN(pb + 2)) { IDS(); p4_scan(args, l, tid); p4_attention(args, l, (char*)lds_raw + RING_OFF); } SEAM(pb + 2);
        if (IN(pb + 3)) { IDS(); p5(args, l, lds, tid, lane, wave); } SEAM(pb + 3);
        if (IN(pb + 4)) { unsigned char* ws = KWS();
            const int r0 = last ? RCTX : 0, M = RTOT - r0;
            pg8::Gemm g{(const bf16*)(ws + WS_MIX) + (size_t)r0 * DM, (const bf16*)(ws + WS_WOUT) + (size_t)l * DM * DM, M, DM, DM}; pg8::StaticOrder S; S.init(M, DM, (int)gridDim.x, opaque_bid());
            pg8::EpiBf16 E{(bf16*)(ws + WS_Y) + (size_t)r0 * DM, DM};
            pg8::gemm_phase<pg8::EpiBf16, pg8::StaticOrder, true, true>(lds + RING_OFF, g, S, E);
        } SEAM(pb + 4);
        if (IN(pb + 5)) { IDS(); p7(args, l, lds, tid, lane, wave); } SEAM(pb + 5);
        if (IN(pb + 6)) { IDS(); p8(args, l, lds, tid, lane, wave); } SEAM(pb + 6);
        if (IN(pb + 7)) { IDS(); unsigned char* ws = KWS();
            moe_offsets(args, l, lds, tid);
            pg8::MoeOrder S; moe_order(S, lds, 3);
            pg8::Gemm g{(const bf16*)(ws + WS_XS2), (const bf16*)(ws + WS_WGU) + (size_t)l * NEXP * 2048 * DM, MAXTILES * 256, NEXP * 2048, DM};
            pg8::EpiSwiglu E{(bf16*)(ws + WS_ACT), KIN(18) + (size_t)l * NEXP * 2048};
            pg8::gemm_phase<pg8::EpiSwiglu, pg8::MoeOrder, true, true>(lds + RING_OFF, g, S, E);
        } SEAM(pb + 7);
        if (IN(pb + 8)) { IDS(); unsigned char* ws = KWS();
            moe_offsets(args, l, lds, tid);
            pg8::MoeOrder S; moe_order(S, lds, 2);
            pg8::Gemm g{(const bf16*)(ws + WS_ACT), (const bf16*)(ws + WS_WD) + (size_t)l * NEXP * DM * DM, MAXTILES * 256, NEXP * DM, DM};
            pg8::EpiDown E{(bf16*)(ws + WS_YB), KIN(20) + (size_t)l * NEXP * DM, (const float*)(ws + WS_ROWW)};
            pg8::gemm_phase<pg8::EpiDown, pg8::MoeOrder, true, true>(lds + RING_OFF, g, S, E);
        } SEAM(pb + 8);
        if (IN(pb + 9)) { IDS(); p11(args, l, lane, wave); } SEAM(pb + 9);
    }
#undef IN
#undef IDS
#undef SEAM
#undef GRID_BAR
}

extern "C" void kernel_launch(void* const* d_in, const int* in_sizes, int n_in, void* d_out, int out_size, void* d_ws, size_t ws_size, hipStream_t stream) {
    static int grid = 0;
    if (grid == 0) {
        if (n_in != 21 || in_sizes[0] != RLAT * DM || out_size != RLAT * DM || ws_size < WS_END) { fprintf(stderr, "kernel_launch: unexpected shapes / workspace (n_in %d, ws %zu < %zu); nothing launched\n", n_in, ws_size, (size_t)WS_END); grid = -1; return; }
        int dev = 0, cus = 0, per_cu = 0;
        if (hipGetDevice(&dev) != hipSuccess || hipDeviceGetAttribute(&cus, hipDeviceAttributeMultiprocessorCount, dev) != hipSuccess) { grid = -1; return; }
        if (hipFuncSetAttribute((const void*)mk_fwd, hipFuncAttributeMaxDynamicSharedMemorySize, LDS_BYTES) != hipSuccess) { fprintf(stderr, "kernel_launch: hipFuncSetAttribute failed\n"); grid = -1; return; }
        if (hipOccupancyMaxActiveBlocksPerMultiprocessor(&per_cu, (const void*)mk_fwd, NWAVES * 64, LDS_BYTES) != hipSuccess || per_cu < 1) fprintf(stderr, "kernel_launch: occupancy query reports %d\n", per_cu);
        (void)hipGetLastError();
        grid = cus;
        if (grid != 256) { fprintf(stderr, "kernel_launch: built for 256 CUs, found %d; nothing launched\n", grid); grid = -1; return; }
    }
    if (grid < 0) return;
    if (hipMemsetAsync((char*)d_ws + WS_CTL, 0, CTL_ZERO_BYTES, stream) != hipSuccess) return;
    Args a{};
    for (int i = 0; i < 21; ++i) a.in[i] = (const float*)d_in[i];
    a.out = (float*)d_out; a.ws = (unsigned char*)d_ws; a.pad = 0;
    for (int li = 0; li < N_LAUNCHES; ++li) {
        a.ph_lo = (N_LAUNCHES == 1) ? 0 : li; a.ph_hi = (N_LAUNCHES == 1) ? N_PHASES : li + 1; a.li = li;
        hipLaunchKernelGGL(mk_fwd, dim3(grid), dim3(NWAVES * 64), LDS_BYTES, stream, a);
        const hipError_t le = hipPeekAtLastError();
        if (le != hipSuccess) { fprintf(stderr, "kernel_launch: launch %d failed: %s\n", li, hipGetErrorName(le)); break; }
    }
}
```

```cpp
#include <hip/hip_runtime.h>
#include <cstdio>
#include <cstdint>
__device__ __forceinline__ int opaque_tid() { int t = (int)threadIdx.x; asm volatile("" : "+v"(t)); return t; }
__device__ __forceinline__ int opaque_bid() { int b = (int)blockIdx.x; asm volatile("" : "+s"(b)); return b; }
namespace pg8 {
#define PG8_LAS __attribute__((address_space(3)))
typedef unsigned short bf16_t;
typedef short bf16x8 __attribute__((ext_vector_type(8)));
typedef float f32x4 __attribute__((ext_vector_type(4)));
typedef unsigned u32x4 __attribute__((ext_vector_type(4)));
constexpr int BM = 256, BK = 64, HALF = 128, HTB = HALF * BK * 2  , STAGE_BYTES = 8 * HTB, NXCD = 8, WGM = 8;

__host__ __device__ __forceinline__ int lds_byte(int r, int c) { const int st = (r >> 4) * 2 + (c >> 5), rr = r & 15, cc = c & 31, ob = rr * 64 + cc * 2; return st * 1024 + (ob ^ (((ob >> 9) & 1) << 5)); }
__host__ __device__ __forceinline__ void stage_rc(int b, int& R, int& C) { const int st = b / 1024, sb = b % 1024, swz = sb ^ (((sb >> 9) & 1) << 5); R = (st >> 1) * 16 + swz / 64; C = (st & 1) * 32 + (swz % 64) / 2; }
__host__ __device__ __forceinline__ int perm32(int rho) { const int n = rho >> 4, i = rho & 15; return 8 * (i >> 2) + 4 * n + (i & 3); }

struct Unit { int pm, pn; };
struct Gemm { const bf16_t* A; const bf16_t* Bt; int M, N, K; };

struct StaticOrder {
    int nM, nN, nwg, G, c;
    __host__ __device__ void init(int M, int N, int G_, int c_) { nM = M / BM; nN = N / BM; nwg = nM * nN; G = G_; c = c_; }
    __host__ __device__ bool next(int i, Unit& u) const {
        const long L = (long)i * G + c; if (L >= nwg) return false;
        int wgid = (int)L; { const int q = nwg / NXCD, r = nwg % NXCD, xcd = wgid % NXCD, off = wgid / NXCD; wgid = (xcd < r ? xcd * (q + 1) : r * (q + 1) + (xcd - r) * q) + off; }
        const int nig = WGM * nN, gid = wgid / nig, fm = gid * WGM, gsz = (nM - fm) < WGM ? (nM - fm) : WGM;
        u.pm = fm + ((wgid % nig) % gsz); u.pn = (wgid % nig) / gsz; return true;
    }
    __device__ __forceinline__ void a_ready(const Unit&) const {}
    __device__ __forceinline__ void done(const Unit&) const {}
};

__device__ __forceinline__ unsigned cvt_pk_bf16(float lo, float hi) { unsigned r; asm volatile("v_cvt_pk_bf16_f32 %0, %1, %2" : "=v"(r) : "v"(lo), "v"(hi)); return r; }
typedef float f32x2 __attribute__((ext_vector_type(2)));
struct EpiBf16 {
    static constexpr bool PERM = true, AFTER_DRAIN = false;
    bf16_t* O; int ldc;
    __device__ __forceinline__ void operator()(const f32x4 (&acc)[2][2][4][2], const Unit& u, int wr, int wc, int fr, int fq) const {
        const int row0 = u.pm * BM + wr * 64 + fr; const int col0 = u.pn * BM + wc * 32 + 8 * fq;
#pragma unroll
        for (int ai = 0; ai < 2; ++ai)
#pragma unroll
            for (int m = 0; m < 4; ++m) { bf16_t* rowp = O + (size_t)(row0 + ai * HALF + m * 16) * ldc + col0;
#pragma unroll
                for (int bj = 0; bj < 2; ++bj) { const f32x4 v0 = acc[ai][bj][m][0], v1 = acc[ai][bj][m][1];
                    u32x4 w; w.x = cvt_pk_bf16(v0[0], v0[1]); w.y = cvt_pk_bf16(v0[2], v0[3]); w.z = cvt_pk_bf16(v1[0], v1[1]); w.w = cvt_pk_bf16(v1[2], v1[3]);
                    *(u32x4*)(rowp + bj * HALF) = w; } }
    }
};
struct EpiSwiglu {
    static constexpr bool PERM = true, AFTER_DRAIN = false;
    bf16_t* O; const float* bias;
    static __device__ __forceinline__ float act1(float g, float up) {
        g = fminf(g, 7.0f); up = fminf(fmaxf(up, -7.0f), 7.0f);
        const float s = __builtin_amdgcn_rcpf(1.0f + __builtin_amdgcn_exp2f(g * (-1.702f * 1.4426950408889634f)));
        return (up + 1.0f) * (g * s);
    }
    __device__ __forceinline__ void operator()(const f32x4 (&acc)[2][2][4][2], const Unit& u, int wr, int wc, int fr, int fq) const {
        const int e = u.pn >> 3, pnl = u.pn & 7;
        const int row0 = u.pm * BM + wr * 64 + fr; const int j0 = pnl * HALF + wc * 32 + 8 * fq;
        const float* bg = bias + (size_t)e * 2048 + j0; const float* bu = bg + 1024;
        f32x4 bgv[2], buv[2];
#pragma unroll
        for (int n = 0; n < 2; ++n) { bgv[n] = *(const f32x4*)(bg + 4 * n); buv[n] = *(const f32x4*)(bu + 4 * n); }
#pragma unroll
        for (int ai = 0; ai < 2; ++ai)
#pragma unroll
            for (int m = 0; m < 4; ++m) { bf16_t* rowp = O + (size_t)(row0 + ai * HALF + m * 16) * 1024 + j0;
                f32x4 r0, r1;
                { const f32x4 g = acc[ai][0][m][0] + bgv[0], up = acc[ai][1][m][0] + buv[0];
                  r0[0] = act1(g[0], up[0]); r0[1] = act1(g[1], up[1]); r0[2] = act1(g[2], up[2]); r0[3] = act1(g[3], up[3]); }
                { const f32x4 g = acc[ai][0][m][1] + bgv[1], up = acc[ai][1][m][1] + buv[1];
                  r1[0] = act1(g[0], up[0]); r1[1] = act1(g[1], up[1]); r1[2] = act1(g[2], up[2]); r1[3] = act1(g[3], up[3]); }
                u32x4 w; w.x = cvt_pk_bf16(r0[0], r0[1]); w.y = cvt_pk_bf16(r0[2], r0[3]); w.z = cvt_pk_bf16(r1[0], r1[1]); w.w = cvt_pk_bf16(r1[2], r1[3]);
                *(u32x4*)rowp = w; }
    }
};
struct EpiDown {
    static constexpr bool PERM = true, AFTER_DRAIN = false;
    bf16_t* O; const float* bias; const float* roww;
    __device__ __forceinline__ void operator()(const f32x4 (&acc)[2][2][4][2], const Unit& u, int wr, int wc, int fr, int fq) const {
        const int e = u.pn >> 2, pnl = u.pn & 3;
        const int row0 = u.pm * BM + wr * 64 + fr; const int col0 = pnl * BM + wc * 32 + 8 * fq;
        const float* bp = bias + (size_t)e * 1024 + col0;
        f32x4 bv[2][2];
#pragma unroll
        for (int bj = 0; bj < 2; ++bj)
#pragma unroll
            for (int n = 0; n < 2; ++n) bv[bj][n] = *(const f32x4*)(bp + bj * HALF + 4 * n);
#pragma unroll
        for (int ai = 0; ai < 2; ++ai)
#pragma unroll
            for (int m = 0; m < 4; ++m) { const int row = row0 + ai * HALF + m * 16; bf16_t* rowp = O + (size_t)row * 1024 + col0;
                const float wt = roww[row];
#pragma unroll
                for (int bj = 0; bj < 2; ++bj) { const f32x4 v0 = (acc[ai][bj][m][0] + bv[bj][0]) * wt, v1 = (acc[ai][bj][m][1] + bv[bj][1]) * wt;
                    u32x4 w; w.x = cvt_pk_bf16(v0[0], v0[1]); w.y = cvt_pk_bf16(v0[2], v0[3]); w.z = cvt_pk_bf16(v1[0], v1[1]); w.w = cvt_pk_bf16(v1[2], v1[3]);
                    *(u32x4*)(rowp + bj * HALF) = w; } }
    }
};
struct MoeOrder {
    unsigned pk[11]; int nt, sh, G, c;
    __device__ __forceinline__ bool next(int i, Unit& u) const {
        const int L = i * G + c;
        if (L >= (nt << sh)) return false;
        const int tile = L >> sh, pnl = L & ((1 << sh) - 1); int e = 0;
#pragma unroll
        for (int k = 1; k < 32; ++k) { const int off = (int)((pk[(k - 1) / 3] >> (10 * ((k - 1) % 3))) & 1023u); e += (off <= tile) ? 1 : 0; }
        u.pm = tile; u.pn = (e << sh) + pnl; return true;
    }
    __device__ __forceinline__ void a_ready(const Unit&) const {}
    __device__ __forceinline__ void done(const Unit&) const {}
};

template <class Epi, class Sched, bool ALIGN_EPI = false, bool SP2 = false>
__device__ __forceinline__ void gemm_phase(PG8_LAS unsigned char* lds, const Gemm g, const Sched& S, const Epi& E) {
    const int tid = opaque_tid(), wid = __builtin_amdgcn_readfirstlane(tid >> 6), lane = tid & 63, wr = wid >> 2, wc = wid & 3, fr = lane & 15, fq = lane >> 4;
    const int K = g.K, nt = K / BK;
    unsigned voffA[2], voffB[2];
#pragma unroll
    for (int i = 0; i < 2; ++i) { int R, C; stage_rc(tid * 16 + i * 8192, R, C); const int Rb = Epi::PERM ? ((R & ~31) + perm32(R & 31)) : R;
        voffA[i] = (unsigned)(R * K + C) * 2u; voffB[i] = (unsigned)(Rb * K + C) * 2u; }
    const size_t kstep = (size_t)(BK * 2);
    const size_t hstep = (size_t)HALF * K * 2;
    const size_t tstep = 2 * hstep;
    const unsigned ldsw = (unsigned)wid * 1024u;
    const int aoff = lds_byte(wr * 64 + fr, fq * 8), boff = lds_byte(wc * 32 + fr, fq * 8);
#define PG8_SA(b, h) (((b) * 2 + (h)) * HTB)
#define PG8_SB(b, h) ((4 + (b) * 2 + (h)) * HTB)
#define PG8_STAGE(bufoff, gbase, voff) do { _Pragma("unroll") for (int _i = 0; _i < 2; ++_i) \
        __builtin_amdgcn_global_load_lds((const unsigned*)((const char*)(gbase) + (voff)[_i]), (PG8_LAS unsigned*)(lds + (bufoff) + ldsw + _i * 8192), 16, 0, 0); } while (0)
#define PG8_LDA(dst, b, h) do { _Pragma("unroll") for (int m = 0; m < 4; ++m) _Pragma("unroll") for (int k = 0; k < 2; ++k) dst[m][k] = *(const PG8_LAS bf16x8*)(lds + PG8_SA(b, h) + aoff + m * 2048 + k * 1024); } while (0)
#define PG8_LDB(dst, b, h) do { _Pragma("unroll") for (int n = 0; n < 2; ++n) _Pragma("unroll") for (int k = 0; k < 2; ++k) dst[n][k] = *(const PG8_LAS bf16x8*)(lds + PG8_SB(b, h) + boff + n * 2048 + k * 1024); } while (0)
#define PG8_MMA(ai, bj, At, Bt) do { __builtin_amdgcn_s_setprio(1); _Pragma("unroll") for (int m = 0; m < 4; ++m) _Pragma("unroll") for (int n = 0; n < 2; ++n) _Pragma("unroll") for (int k = 0; k < 2; ++k) \
        acc[ai][bj][m][n] = __builtin_amdgcn_mfma_f32_16x16x32_bf16(Bt[n][k], At[m][k], acc[ai][bj][m][n], 0, 0, 0); __builtin_amdgcn_s_setprio(0); } while (0)
#define PG8_WAIT_V(n) asm volatile("s_waitcnt vmcnt(" #n ")" ::: "memory")
#define PG8_WAIT_L(n) asm volatile("s_waitcnt lgkmcnt(" #n ")" ::: "memory")
#define PG8_BAR __builtin_amdgcn_s_barrier()
#define PG8_SCHED __builtin_amdgcn_sched_barrier(0)
    Unit cur, nxt; int ui = 0;
    if (!S.next(0, cur)) return;
    f32x4 acc[2][2][4][2];
#pragma unroll
    for (int a = 0; a < 2; ++a)
#pragma unroll
        for (int b = 0; b < 2; ++b)
#pragma unroll
            for (int m = 0; m < 4; ++m)
#pragma unroll
                for (int n = 0; n < 2; ++n) acc[a][b][m][n] = (f32x4){0.f, 0.f, 0.f, 0.f};
    bf16x8 At[4][2], B0[2][2], B1[2][2];
    const char* cA = (const char*)g.A + (size_t)cur.pm * tstep; const char* cB = (const char*)g.Bt + (size_t)cur.pn * tstep;
    S.a_ready(cur);
    if constexpr (SP2) {
        PG8_STAGE(PG8_SB(0, 0), cB, voffB); PG8_STAGE(PG8_SB(0, 1), cB + hstep, voffB); PG8_STAGE(PG8_SA(0, 0), cA, voffA); PG8_STAGE(PG8_SA(0, 1), cA + hstep, voffA);
        if (wr == 1) PG8_BAR;
        PG8_WAIT_V(2); PG8_BAR;
        PG8_STAGE(PG8_SB(1, 0), cB + kstep, voffB); PG8_STAGE(PG8_SA(1, 0), cA + kstep, voffA); PG8_STAGE(PG8_SB(1, 1), cB + hstep + kstep, voffB);
        PG8_WAIT_V(6); PG8_BAR;
    } else {
        PG8_STAGE(PG8_SB(0, 0), cB, voffB); PG8_STAGE(PG8_SA(0, 0), cA, voffA); PG8_STAGE(PG8_SB(0, 1), cB + hstep, voffB); PG8_STAGE(PG8_SA(0, 1), cA + hstep, voffA);
        if (wr == 1) PG8_BAR;
        PG8_WAIT_V(4); PG8_BAR;
        PG8_STAGE(PG8_SB(1, 0), cB + kstep, voffB); PG8_STAGE(PG8_SA(1, 0), cA + kstep, voffA); PG8_STAGE(PG8_SB(1, 1), cB + hstep + kstep, voffB);
        PG8_WAIT_V(6); PG8_BAR;
    }
    for (;;) {
        const bool has_next = S.next(ui + 1, nxt);
        const char* nA = has_next ? (const char*)g.A + (size_t)nxt.pm * tstep : cA; const char* nB = has_next ? (const char*)g.Bt + (size_t)nxt.pn * tstep : cB;
        for (int t = 0; t < nt; t += 2) {
            const bool last = (t == nt - 2);
            const char* a1 = cA + (size_t)(t + 1) * kstep;
            const char* a2 = last ? nA : cA + (size_t)(t + 2) * kstep; const char* b2 = last ? nB : cB + (size_t)(t + 2) * kstep;
            const char* a3 = a2 + kstep; const char* b3 = b2 + kstep;
            if (last && has_next) S.a_ready(nxt);
            if constexpr (SP2) {
            PG8_LDB(B0, 0, 0); PG8_LDB(B1, 0, 1); PG8_SCHED; PG8_LDA(At, 0, 0); PG8_STAGE(PG8_SA(1, 1), a1 + hstep, voffA);
            PG8_WAIT_V(8); PG8_WAIT_L(0); PG8_BAR; PG8_MMA(0, 0, At, B0); PG8_MMA(0, 1, At, B1); PG8_BAR; PG8_SCHED;
            PG8_LDA(At, 0, 1); PG8_STAGE(PG8_SB(0, 0), b2, voffB); PG8_STAGE(PG8_SB(0, 1), b2 + hstep, voffB); PG8_STAGE(PG8_SA(0, 0), a2, voffA);
            PG8_WAIT_V(8); PG8_WAIT_L(0); PG8_BAR; PG8_MMA(1, 0, At, B0); PG8_MMA(1, 1, At, B1); PG8_BAR; PG8_SCHED;
            PG8_LDB(B0, 1, 0); PG8_LDB(B1, 1, 1); PG8_SCHED; PG8_LDA(At, 1, 0); PG8_STAGE(PG8_SA(0, 1), a2 + hstep, voffA);
            PG8_WAIT_V(8); PG8_WAIT_L(0); PG8_BAR; PG8_MMA(0, 0, At, B0); PG8_MMA(0, 1, At, B1); PG8_BAR; PG8_SCHED;
            PG8_LDA(At, 1, 1); PG8_STAGE(PG8_SB(1, 0), b3, voffB); PG8_STAGE(PG8_SB(1, 1), b3 + hstep, voffB); PG8_STAGE(PG8_SA(1, 0), a3, voffA);
            PG8_WAIT_V(8); PG8_WAIT_L(0); PG8_BAR; PG8_MMA(1, 0, At, B0); PG8_MMA(1, 1, At, B1); PG8_BAR; PG8_SCHED;
            } else {
            PG8_LDB(B0, 0, 0); PG8_SCHED; PG8_LDA(At, 0, 0); PG8_STAGE(PG8_SA(1, 1), a1 + hstep, voffA);
            PG8_WAIT_L(8); PG8_BAR; PG8_WAIT_L(0); PG8_MMA(0, 0, At, B0); PG8_BAR; PG8_SCHED;
            PG8_LDB(B1, 0, 1); PG8_STAGE(PG8_SB(0, 0), b2, voffB);
            PG8_BAR; PG8_WAIT_L(0); PG8_MMA(0, 1, At, B1); PG8_BAR;
            PG8_LDA(At, 0, 1); PG8_STAGE(PG8_SA(0, 0), a2, voffA);
            PG8_BAR; PG8_WAIT_L(0); PG8_MMA(1, 0, At, B0); PG8_BAR; PG8_SCHED;
            PG8_STAGE(PG8_SB(0, 1), b2 + hstep, voffB);
            PG8_WAIT_V(6); PG8_BAR; PG8_MMA(1, 1, At, B1); PG8_BAR;
            PG8_LDB(B0, 1, 0); PG8_SCHED; PG8_LDA(At, 1, 0); PG8_STAGE(PG8_SA(0, 1), a2 + hstep, voffA);
            PG8_WAIT_L(8); PG8_BAR; PG8_WAIT_L(0); PG8_MMA(0, 0, At, B0); PG8_BAR; PG8_SCHED;
            PG8_LDB(B1, 1, 1); PG8_STAGE(PG8_SB(1, 0), b3, voffB);
            PG8_BAR; PG8_WAIT_L(0); PG8_MMA(0, 1, At, B1); PG8_BAR;
            PG8_LDA(At, 1, 1); PG8_STAGE(PG8_SA(1, 0), a3, voffA);
            PG8_BAR; PG8_WAIT_L(0); PG8_MMA(1, 0, At, B0); PG8_BAR; PG8_SCHED;
            PG8_STAGE(PG8_SB(1, 1), b3 + hstep, voffB);
            PG8_WAIT_V(6); PG8_BAR; PG8_MMA(1, 1, At, B1); PG8_BAR;
            }
        }
        if constexpr (ALIGN_EPI) { if (wr == 0) PG8_BAR; }
        if constexpr (!Epi::AFTER_DRAIN) { E(acc, cur, wr, wc, fr, fq); S.done(cur); }
        if (!has_next) break;
#pragma unroll
        for (int a = 0; a < 2; ++a)
#pragma unroll
            for (int b = 0; b < 2; ++b)
#pragma unroll
                for (int m = 0; m < 4; ++m)
#pragma unroll
                    for (int n = 0; n < 2; ++n) acc[a][b][m][n] = (f32x4){0.f, 0.f, 0.f, 0.f};
        cur = nxt; cA = nA; cB = nB; ++ui;
        if constexpr (ALIGN_EPI) { if (wr == 1) PG8_BAR; }
    }
    PG8_WAIT_V(0);
    if constexpr (!ALIGN_EPI) { if (wr == 0) PG8_BAR; }
    PG8_BAR;
    if constexpr (Epi::AFTER_DRAIN) { E.fused(acc, cur, wr, wc, fr, fq, lds, wid, lane); S.done(cur); }
#undef PG8_SA
#undef PG8_SB
#undef PG8_STAGE
#undef PG8_LDA
#undef PG8_LDB
#undef PG8_MMA
#undef PG8_WAIT_V
#undef PG8_WAIT_L
#undef PG8_BAR
#undef PG8_SCHED
}
}

#include <hip/hip_bf16.h>
#include <cmath>
namespace attn_body {
using bf16=__hip_bfloat16;
using bf16x8=__attribute__((ext_vector_type(8)))short;
using s16x4=__attribute__((ext_vector_type(4)))short;
using f32x16=__attribute__((ext_vector_type(16)))float;
using u32x4=__attribute__((ext_vector_type(4)))unsigned;
constexpr int D=64,QP=512,KP=64,OP=1024;
constexpr int NW=8,QBLK=32,QB=QBLK*NW,KVBLK=64;
constexpr int ATTN_UNIT_ROWS=QB;
__device__ __forceinline__ int crow(int r,int hi){return (r&3)+8*(r>>2)+4*hi;}
#define SBAR() __builtin_amdgcn_sched_barrier(0)
__device__ __forceinline__ void cmask(f32x16&p0,f32x16&p1,int jb,int qrel,int hi){
  const float NEG=-INFINITY; int kb=64*jb+4*hi;
  #pragma unroll
  for(int r=0;r<16;++r){int kv=kb+(r&3)+8*(r>>2); if(kv>qrel)p0[r]=NEG; if(kv+32>qrel)p1[r]=NEG;}
}

constexpr int NSLOT=3, SLOTB=8192;
constexpr int LDS_K=0, LDS_V=NSLOT*SLOTB, LDS_WS=2*NSLOT*SLOTB, LDS_OST=LDS_WS+NW*64*4, LDS_BYTES=LDS_OST+NW*4096;
constexpr float C2=0.125f*1.4426950408889634f;
__device__ __forceinline__ void glds16(const void*gsrc,unsigned lds_dst){unsigned keep;
  asm volatile("s_mov_b32 %0, m0\n\ts_mov_b32 m0, %2\n\ts_nop 0\n\tglobal_load_lds_dwordx4 %1, off\n\ts_mov_b32 m0, %0":"=&s"(keep):"v"(gsrc),"s"(lds_dst):"memory");}
__device__ __forceinline__ float max3f(float a,float b,float c){float r;asm("v_max3_f32 %0, %1, %2, %3":"=v"(r):"v"(a),"v"(b),"v"(c));return r;}
__device__ __forceinline__ float max2f(float a,float b){float r;asm("v_max_f32_e32 %0, %1, %2":"=v"(r):"v"(a),"v"(b));return r;}
__device__ __forceinline__ float fadd_s(float a,float b){float r;asm("v_add_f32_e32 %0, %1, %2":"=v"(r):"v"(a),"v"(b));return r;}
__device__ __forceinline__ float fsub_s(float a,float b){float r;asm("v_sub_f32_e32 %0, %1, %2":"=v"(r):"v"(a),"v"(b));return r;}
typedef float f32x2_t __attribute__((ext_vector_type(2))); typedef __bf16 bf16x2_t __attribute__((ext_vector_type(2)));
__device__ __forceinline__ unsigned cvtpk_s(float lo,float hi){f32x2_t v={lo,hi};bf16x2_t b=__builtin_convertvector(v,bf16x2_t);return __builtin_bit_cast(unsigned,b);}
#define WAIT_BAR(N) asm volatile("s_waitcnt vmcnt(" #N ") lgkmcnt(0)\n\ts_barrier":::"memory")

__device__ __forceinline__ void qkt(f32x16&p0,f32x16&p1,const char*Kslot,const bf16x8*qr,const f32x16&negm,int r32,int hi){
  const char*kb=Kslot+hi*1024+r32*16;
  #pragma unroll
  for(int d0=0;d0<4;++d0){
    const bf16x8 b0=*reinterpret_cast<const bf16x8*>(kb+d0*2048);
    const bf16x8 b1=*reinterpret_cast<const bf16x8*>(kb+d0*2048+512);
    if(d0==0){p0=__builtin_amdgcn_mfma_f32_32x32x16_bf16(b0,qr[0],negm,0,0,0);p1=__builtin_amdgcn_mfma_f32_32x32x16_bf16(b1,qr[0],negm,0,0,0);}
    else{p0=__builtin_amdgcn_mfma_f32_32x32x16_bf16(b0,qr[d0],p0,0,0,0);p1=__builtin_amdgcn_mfma_f32_32x32x16_bf16(b1,qr[d0],p1,0,0,0);}}
}
typedef __attribute__((address_space(3))) const char* lds_cptr;
typedef short v4i16_t __attribute__((ext_vector_type(4)));
__device__ __forceinline__ void kload8(bf16x8*kf,lds_cptr kp){
  kf[0]=*(const __attribute__((address_space(3))) bf16x8*)(kp);      kf[1]=*(const __attribute__((address_space(3))) bf16x8*)(kp+512);
  kf[2]=*(const __attribute__((address_space(3))) bf16x8*)(kp+2048); kf[3]=*(const __attribute__((address_space(3))) bf16x8*)(kp+2560);
  kf[4]=*(const __attribute__((address_space(3))) bf16x8*)(kp+4096); kf[5]=*(const __attribute__((address_space(3))) bf16x8*)(kp+4608);
  kf[6]=*(const __attribute__((address_space(3))) bf16x8*)(kp+6144); kf[7]=*(const __attribute__((address_space(3))) bf16x8*)(kp+6656);
}
__device__ __forceinline__ void kload2(bf16x8*kf,lds_cptr kp,int j){ kf[2*j]=*(const __attribute__((address_space(3))) bf16x8*)(kp+j*2048); kf[2*j+1]=*(const __attribute__((address_space(3))) bf16x8*)(kp+j*2048+512); }
__device__ __forceinline__ s16x4 vtr(lds_cptr p){ return __builtin_bit_cast(s16x4,__builtin_amdgcn_ds_read_tr16_b64_v4i16((__attribute__((address_space(3))) v4i16_t*)p)); }
__device__ __forceinline__ float rowmax(const f32x16&p0,const f32x16&p1){
  float a=max3f(p0[0],p0[1],p1[0]),b=max3f(p0[2],p0[3],p1[1]);a=max3f(a,p1[2],p1[3]);
  #pragma unroll
  for(int r=4;r<16;r+=4){a=max3f(a,p0[r],p0[r+1]);b=max3f(b,p0[r+2],p0[r+3]);a=max3f(a,p1[r],p1[r+1]);b=max3f(b,p1[r+2],p1[r+3]);}
  const float m=max2f(a,b);
  auto rr=__builtin_amdgcn_permlane32_swap(__float_as_uint(m),__float_as_uint(m),false,false);
  return max2f(__uint_as_float(rr[0]),__uint_as_float(rr[1]));
}
__device__ __forceinline__ void pv(f32x16*o,int vb,bf16x8 pa0,bf16x8 pa1,bf16x8 pa2,bf16x8 pa3){
  #pragma unroll
  for(int d0=0;d0<2;++d0){s16x4 lo[4],hi[4];
    #pragma unroll
    for(int ks=0;ks<4;++ks){
      asm volatile("ds_read_b64_tr_b16 %0,%1 offset:%c2":"=&v"(lo[ks]):"v"(vb),"i"(d0*4096+ks*1024):"memory");
      asm volatile("ds_read_b64_tr_b16 %0,%1 offset:%c2":"=&v"(hi[ks]):"v"(vb),"i"(d0*4096+ks*1024+512):"memory");}
    asm volatile("s_waitcnt lgkmcnt(0)":::"memory");SBAR();
    #define PK(k) (bf16x8){lo[k][0],lo[k][1],lo[k][2],lo[k][3],hi[k][0],hi[k][1],hi[k][2],hi[k][3]}
    o[d0]=__builtin_amdgcn_mfma_f32_32x32x16_bf16(pa0,PK(0),o[d0],0,0,0);
    o[d0]=__builtin_amdgcn_mfma_f32_32x32x16_bf16(pa1,PK(1),o[d0],0,0,0);
    o[d0]=__builtin_amdgcn_mfma_f32_32x32x16_bf16(pa2,PK(2),o[d0],0,0,0);
    o[d0]=__builtin_amdgcn_mfma_f32_32x32x16_bf16(pa3,PK(3),o[d0],0,0,0);
    #undef PK
  }
}

#ifndef ATTN_STORE16
#define ATTN_STORE16(p,v) (*(u32x4*)(p)=(v))
#endif
template<int THRL> __device__ __forceinline__ void attn_unit(const bf16*Qu,const bf16*Kh,const bf16*Vh,bf16*Ou,const int NT,char*shm){
  const int tid=opaque_tid(),lane=tid&63,r32=lane&31,hi=lane>>5; const int wid=__builtin_amdgcn_readfirstlane(tid>>6);
  const bf16*Qw=Qu+(long)(wid*QBLK)*QP;
  const unsigned lds0=(unsigned)(uintptr_t)shm;
  float*wsf=(float*)(shm+LDS_WS)+wid*64;
  const bf16*ksrc=Kh+(long)lane*KP+wid*8;
  const bf16*vsrc=Vh+(long)(16*(wid&3)+(lane>>2))*KP+(wid>>2)*32+(lane&3)*8;
  const unsigned kdst=lds0+LDS_K+wid*1024, vdst=lds0+LDS_V+wid*1024;
  #define DMA_K(t,slot) glds16(ksrc+(long)(t)*KVBLK*KP,(unsigned)__builtin_amdgcn_readfirstlane(kdst+(slot)))
  #define DMA_V(t,slot) glds16(vsrc+(long)(t)*KVBLK*KP,(unsigned)__builtin_amdgcn_readfirstlane(vdst+(slot)))
  const int vb0=(int)(lds0+LDS_V)+((lane>>4)&1)*32+(lane&3)*8+(4*hi+((lane&15)>>2))*64;
  const char*Kbase=shm+LDS_K; bf16x8 kf[8];
  const lds_cptr shm3=(lds_cptr)shm; const lds_cptr kp0=shm3+LDS_K+hi*1024+r32*16; const lds_cptr vp0=shm3+LDS_V+((lane>>4)&1)*32+(lane&3)*8+(4*hi+((lane&15)>>2))*64;
  DMA_K(0,0);DMA_V(0,0);DMA_K(1,SLOTB);
  bf16x8 qr[4];
  #pragma unroll
  for(int d0=0;d0<4;++d0)qr[d0]=*reinterpret_cast<const bf16x8*>(&Qw[(long)r32*QP+d0*16+hi*8]);
  float mhat=0.f,l_reg=0.f;f32x16 o[2];o[0]=f32x16{};o[1]=f32x16{};f32x16 negm=f32x16{};asm volatile("":"+v"(negm));
  #define CMASK(P0,P1,t) do{}while(0)
  bool resc=false;
  #define START(P0,P1) do{ const float rm=rowmax(P0,P1); resc=false; \
    { const float dl=rm; mhat=fadd_s(mhat,dl); \
      _Pragma("unroll") for(int r=0;r<16;++r){P0[r]=fsub_s(P0[r],dl);P1[r]=fsub_s(P1[r],dl);} \
      _Pragma("unroll") for(int r=0;r<16;++r)negm[r]=-mhat; asm volatile("":"+v"(negm)); } \
    _Pragma("unroll") for(int r=0;r<16;++r)P0[r]=__builtin_amdgcn_exp2f(P0[r]); }while(0)
  #define RESC() do{ if(resc){ asm volatile("s_waitcnt lgkmcnt(0)":::"memory"); \
      _Pragma("unroll") for(int d_=0;d_<2;++d_) _Pragma("unroll") for(int r=0;r<16;++r)o[d_][r]*=wsf[crow(r,hi)]; } }while(0)
  f32x16 pA0,pA1,pB0,pB1;
  int sl_prev=0,sl_cur=0,sl_next=SLOTB;
  #define ROT() do{sl_prev=sl_cur;sl_cur=sl_next;sl_next=(sl_next==(NSLOT-1)*SLOTB)?0:sl_next+SLOTB;}while(0)
  DMA_K(2,2*SLOTB);
  WAIT_BAR(3);
  qkt(pA0,pA1,Kbase,qr,negm,r32,hi);asm volatile("s_nop 15\n\ts_nop 7":"+v"(pA0),"+v"(pA1));CMASK(pA0,pA1,0);
  START(pA0,pA1);
  _Pragma("unroll") for(int r=0;r<16;++r)pA1[r]=__builtin_amdgcn_exp2f(pA1[r]);
  WAIT_BAR(0);
  DMA_K(3,0);DMA_V(1,SLOTB);
  ROT();
  kload8(kf,kp0+sl_cur);
  WAIT_BAR(2);
  s16x4 vlo[8],vhi[8]; u32x4 pw0,pw1,pw2,pw3;
  #define PKW(P,B) cvtpk_s(P[B],P[B+1])
  #define PAF(k) __builtin_bit_cast(bf16x8,pw##k)
  #define VFR(i) (bf16x8){vlo[i][0],vlo[i][1],vlo[i][2],vlo[i][3],vhi[i][0],vhi[i][1],vhi[i][2],vhi[i][3]}
  #define PIN(x) asm volatile("":"+v"(x))
  #define MX3(a,b,c) __builtin_fmaxf(__builtin_fmaxf((a),(b)),(c))
  #define GAPA(MF,A0,A1,A2,A3,W0,W1,PW) do{ MF; sacc+=A0; sacc+=A1; sacc+=A2; sacc+=A3; PIN(sacc); W0; W1; PIN(PW); SBAR(); }while(0)
  #define EX(v) __builtin_amdgcn_exp2f(v)
  #define GAPB(MF,X,B) do{ MF; X[B]=EX(X[B]); X[B+1]=EX(X[B+1]); X[B+2]=EX(X[B+2]); X[B+3]=EX(X[B+3]); PIN(X); SBAR(); }while(0)
  #define VRD(i) do{ vlo[i]=vtr(vp_+(((i)>>2)*4096+((i)&3)*1024)); vhi[i]=vtr(vp_+(((i)>>2)*4096+((i)&3)*1024+512)); }while(0)
  #define KRD(G,j) do{ if(G){ kload2(kf,kp0+sl_next,j); SBAR(); } }while(0)
  #define STEP(C0,C1,P0,P1,t,GK,GV,GL) do{ SBAR(); \
    const lds_cptr vp_=vp0+sl_prev; \
    VRD(0); SBAR(); float sacc=(P0[0]+P0[1]); \
    GAPA(C0=__builtin_amdgcn_mfma_f32_32x32x16_bf16(kf[0],qr[0],negm,0,0,0), P0[2],P0[3],P0[4],P0[5],     pw0[0]=PKW(P0,0), pw0[1]=PKW(P0,2), pw0); \
    VRD(4); SBAR(); GAPA(C1=__builtin_amdgcn_mfma_f32_32x32x16_bf16(kf[1],qr[0],negm,0,0,0), P0[6],P0[7],P0[8],P0[9],     pw0[2]=PKW(P0,4), pw0[3]=PKW(P0,6), pw0); \
    VRD(1); SBAR(); GAPA(C0=__builtin_amdgcn_mfma_f32_32x32x16_bf16(kf[2],qr[1],C0,0,0,0),   P0[10],P0[11],P0[12],P0[13], pw1[0]=PKW(P0,8), pw1[1]=PKW(P0,10), pw1); \
    VRD(5); SBAR(); GAPA(C1=__builtin_amdgcn_mfma_f32_32x32x16_bf16(kf[3],qr[1],C1,0,0,0),   P0[14],P0[15],P1[0],P1[1],   pw1[2]=PKW(P0,12),pw1[3]=PKW(P0,14), pw1); \
    VRD(2); SBAR(); GAPA(C0=__builtin_amdgcn_mfma_f32_32x32x16_bf16(kf[4],qr[2],C0,0,0,0),   P1[2],P1[3],P1[4],P1[5],     pw2[0]=PKW(P1,0), pw2[1]=PKW(P1,2), pw2); \
    VRD(6); SBAR(); GAPA(C1=__builtin_amdgcn_mfma_f32_32x32x16_bf16(kf[5],qr[2],C1,0,0,0),   P1[6],P1[7],P1[8],P1[9],     pw2[2]=PKW(P1,4), pw2[3]=PKW(P1,6), pw2); \
    VRD(3); SBAR(); GAPA(C0=__builtin_amdgcn_mfma_f32_32x32x16_bf16(kf[6],qr[3],C0,0,0,0),   P1[10],P1[11],P1[12],P1[13], pw3[0]=PKW(P1,8), pw3[1]=PKW(P1,10), pw3); \
    VRD(7); SBAR(); GAPA(C1=__builtin_amdgcn_mfma_f32_32x32x16_bf16(kf[7],qr[3],C1,0,0,0),   P1[14],P1[15],0.f,0.f,       pw3[2]=PKW(P1,12),pw3[3]=PKW(P1,14), pw3); \
    l_reg+=sacc; \
    if(GK){DMA_K((t)+3,sl_cur);} if(GV){DMA_V((t)+1,sl_next);} \
    CMASK(C0,C1,t); \
    { float a=MX3(C0[0],C0[1],C1[0]),b=MX3(C0[2],C0[3],C1[1]); a=MX3(a,C1[2],C1[3]); \
      _Pragma("unroll") for(int r=4;r<16;r+=4){a=MX3(a,C0[r],C0[r+1]);b=MX3(b,C0[r+2],C0[r+3]);a=MX3(a,C1[r],C1[r+1]);b=MX3(b,C1[r+2],C1[r+3]);} \
      float rm=__builtin_fmaxf(a,b); { auto rr=__builtin_amdgcn_permlane32_swap(__float_as_uint(rm),__float_as_uint(rm),false,false); rm=__builtin_fmaxf(__uint_as_float(rr[0]),__uint_as_float(rr[1])); } \
      resc=false; \
      if(__builtin_expect(__any(rm>(float)THRL),0)){ const float dl=__builtin_fmaxf(rm,0.f); mhat+=dl; \
        _Pragma("unroll") for(int r=0;r<16;++r){C0[r]-=dl;C1[r]-=dl;} \
        _Pragma("unroll") for(int r=0;r<16;++r)negm[r]=-mhat; asm volatile("":"+v"(negm)); \
        const float f=__builtin_amdgcn_exp2f(-dl); l_reg*=f; if(hi==0)wsf[r32]=f; resc=true; } } \
    SBAR(); \
    GAPB(o[0]=__builtin_amdgcn_mfma_f32_32x32x16_bf16(PAF(0),VFR(0),o[0],0,0,0), C0,0); \
    GAPB(o[1]=__builtin_amdgcn_mfma_f32_32x32x16_bf16(PAF(0),VFR(4),o[1],0,0,0), C0,4); \
    KRD(GL,0); GAPB(o[0]=__builtin_amdgcn_mfma_f32_32x32x16_bf16(PAF(1),VFR(1),o[0],0,0,0), C0,8); \
    KRD(GL,1); GAPB(o[1]=__builtin_amdgcn_mfma_f32_32x32x16_bf16(PAF(1),VFR(5),o[1],0,0,0), C0,12); \
    KRD(GL,2); GAPB(o[0]=__builtin_amdgcn_mfma_f32_32x32x16_bf16(PAF(2),VFR(2),o[0],0,0,0), C1,0); \
    KRD(GL,3); GAPB(o[1]=__builtin_amdgcn_mfma_f32_32x32x16_bf16(PAF(2),VFR(6),o[1],0,0,0), C1,4); \
    GAPB(o[0]=__builtin_amdgcn_mfma_f32_32x32x16_bf16(PAF(3),VFR(3),o[0],0,0,0), C1,8); \
    GAPB(o[1]=__builtin_amdgcn_mfma_f32_32x32x16_bf16(PAF(3),VFR(7),o[1],0,0,0), C1,12); \
    }while(0)
  int t=1;
  #undef CMASK
  #define CMASK(P0,P1,t) do{}while(0)
  for(;t+5<NT;t+=2){
    STEP(pB0,pB1,pA0,pA1,t,true,true,true);     WAIT_BAR(2); RESC(); ROT();
    STEP(pA0,pA1,pB0,pB1,t+1,true,true,true);   WAIT_BAR(2); RESC(); ROT();
  }
  #undef CMASK
  #define CMASK(P0,P1,t) do{}while(0)
  #define ENDW(tt) do{ if((tt)+3<NT){WAIT_BAR(2);} else if((tt)+2<NT){WAIT_BAR(1);} else {WAIT_BAR(0);} }while(0)
  for(;t+1<NT;t+=2){
    STEP(pB0,pB1,pA0,pA1,t,(t+3<NT),(t+1<NT),(t+1<NT));       ENDW(t);   RESC(); ROT();
    STEP(pA0,pA1,pB0,pB1,t+1,(t+4<NT),(t+2<NT),(t+2<NT));     ENDW(t+1); RESC(); ROT();
  }
  STEP(pB0,pB1,pA0,pA1,NT-1,false,false,false); RESC();
  { float sacc=pB0[0]+pB0[1]; _Pragma("unroll") for(int r=2;r<16;++r)sacc+=pB0[r]; _Pragma("unroll") for(int r=0;r<16;++r)sacc+=pB1[r]; l_reg+=sacc;
    pw0=(u32x4){PKW(pB0,0),PKW(pB0,2),PKW(pB0,4),PKW(pB0,6)};pw1=(u32x4){PKW(pB0,8),PKW(pB0,10),PKW(pB0,12),PKW(pB0,14)};pw2=(u32x4){PKW(pB1,0),PKW(pB1,2),PKW(pB1,4),PKW(pB1,6)};pw3=(u32x4){PKW(pB1,8),PKW(pB1,10),PKW(pB1,12),PKW(pB1,14)};
    SBAR(); pv(o,vb0+sl_cur,PAF(0),PAF(1),PAF(2),PAF(3)); }
  #undef PKW
  #undef PAF
  #undef VFR
  #undef PIN
  #undef MX3
  #undef GAPA
  #undef GAPB
  #undef EX
  #undef VRD
  #undef KRD
  #undef STEP
  #undef ENDW
  {auto rr=__builtin_amdgcn_permlane32_swap(__float_as_uint(l_reg),__float_as_uint(l_reg),false,false);l_reg=__uint_as_float(rr[0])+__uint_as_float(rr[1]);}
  if(hi==0)wsf[32+r32]=l_reg;asm volatile("s_waitcnt lgkmcnt(0)":::"memory");
  float rli[16];
  #pragma unroll
  for(int r=0;r<16;++r)rli[r]=__builtin_amdgcn_rcpf(wsf[32+crow(r,hi)]);
  bf16*Ow=Ou+(long)(wid*QBLK)*OP;
  { bf16*stg=(bf16*)(shm+LDS_OST)+wid*2048;
    #pragma unroll
    for(int r=0;r<16;++r){const int orow=crow(r,hi);
      #pragma unroll
      for(int d0=0;d0<2;++d0)stg[orow*64+d0*32+r32]=__float2bfloat16(o[d0][r]*rli[r]);}
    asm volatile("s_waitcnt lgkmcnt(0)":::"memory");
    #pragma unroll
    for(int i=0;i<4;++i){const int row=i*8+(lane>>3),ch=lane&7; const u32x4 v=*(const u32x4*)(stg+row*64+ch*8); ATTN_STORE16(Ow+(long)row*OP+ch*8,v);} }
  asm volatile("s_waitcnt lgkmcnt(0)\n\ts_barrier":::"memory");
  #undef DMA_K
  #undef DMA_V
  #undef CMASK
  #undef START
  #undef RESC
  #undef ROT
}
constexpr int ATTN_LDS_BYTES=LDS_BYTES;
#undef SBAR
#undef WAIT_BAR
}

constexpr int NWAVES = 8;
#ifndef MK_N_LAUNCHES
#define MK_N_LAUNCHES 1
#endif
constexpr int DM = 1024, NBATCH = 8, SEQL = 4096, CTXL = 256, DEPTH = 2;
constexpr int RCTX = NBATCH * CTXL, RLAT = NBATCH * SEQL, RTOT = RCTX + RLAT;
constexpr int INW = 2560, NEXP = 32, NKEY = CTXL + SEQL, NPF = 34, NMOD = 6 * DM;
constexpr int ZC_U = 0, ZC_B = 256, ZC_C = 512, ZC_RQ = 768, ZC_RK = 1024, ZC_RV = 1280, ZC_RG = 1536, ZC_AQ = 1792, ZC_AK = 2304, ZC_AV = 2432;
constexpr float LN_EPS = 1e-6f, ALPHA = 1.41421356237309505f;
constexpr int N_PRO = 3, N_PER_LAYER = 10, N_PHASES = N_PRO + DEPTH * N_PER_LAYER;
constexpr int N_LAUNCHES = MK_N_LAUNCHES;

constexpr size_t MiB = 1u << 20;
constexpr size_t WS_CTL = 0, CTL_ZERO_BYTES = 1 * MiB;
constexpr size_t WS_MODP = 2 * MiB, WS_MODV = 6 * MiB, WS_ROPE = 7 * MiB;
constexpr size_t WS_RE = 8 * MiB, WS_RP = 9 * MiB, WS_RW = 10 * MiB, WS_SLOT = 11 * MiB, WS_ROWW = 12 * MiB;
constexpr size_t WS_WIN = 14 * MiB, WS_WOUT = 24 * MiB, WS_KVS = 28 * MiB, WS_SS = 62 * MiB, WS_AK = 80 * MiB, WS_AV = 89 * MiB, WS_AQ = 98 * MiB;
constexpr size_t WS_RQ = 132 * MiB, WS_RK = 149 * MiB, WS_WGU = 166 * MiB, WS_WD = 422 * MiB, WS_XSA = 550 * MiB, WS_XH = 618 * MiB, WS_Z = 686 * MiB;
constexpr size_t WS_MIX = 856 * MiB, WS_Y = 924 * MiB, WS_H2 = 992 * MiB, WS_XS2 = 1060 * MiB, WS_ACT = 1348 * MiB, WS_END = 1636 * MiB;
constexpr size_t WS_YB = WS_XS2;
constexpr int MAXTILES = 576;
static_assert(WS_MODP + (size_t)DEPTH * 8 * 9 * NMOD * 4 <= WS_MODV && WS_MODV + (size_t)DEPTH * 9 * NMOD * 4 <= WS_ROPE, "ws map");
static_assert(WS_WIN + (size_t)DEPTH * INW * DM * 2 <= WS_WOUT && WS_WOUT + (size_t)DEPTH * DM * DM * 2 <= WS_KVS, "ws map");
static_assert(WS_KVS + (size_t)NBATCH * 4 * NPF * 2 * 4096 * 4 <= WS_SS && WS_SS + (size_t)NBATCH * 4 * NPF * 2 * 4096 * 2 <= WS_AK, "ws map");
static_assert(WS_AK + (size_t)NBATCH * 2 * NKEY * 64 * 2 <= WS_AV && WS_AV + (size_t)NBATCH * 2 * NKEY * 64 * 2 <= WS_AQ && WS_AQ + (size_t)RTOT * 512 * 2 <= WS_RQ, "ws map");
static_assert(WS_RQ + (size_t)RTOT * 256 * 2 <= WS_RK && WS_RK + (size_t)RTOT * 256 * 2 <= WS_WGU && WS_WGU + (size_t)DEPTH * NEXP * 2048 * DM * 2 <= WS_WD, "ws map");
static_assert(WS_WD + (size_t)DEPTH * NEXP * DM * DM * 2 <= WS_XSA && WS_XSA + (size_t)RTOT * DM * 2 <= WS_XH && WS_XH + (size_t)RTOT * DM * 2 <= WS_Z, "ws map");
static_assert(WS_Z + (size_t)RTOT * INW * 2 <= WS_MIX && WS_MIX + (size_t)RTOT * DM * 2 <= WS_Y && WS_Y + (size_t)RTOT * DM * 2 <= WS_H2 && WS_H2 + (size_t)RTOT * DM * 2 <= WS_XS2, "ws map");
static_assert(WS_XS2 + (size_t)MAXTILES * 256 * DM * 2 <= WS_ACT && WS_ACT + (size_t)MAXTILES * 256 * DM * 2 <= WS_END, "ws map");
constexpr int CW_TMO = 0, CW_CODE = 1, CW_BAR = 4096, CW_GCNT = 8192;

constexpr int RING_OFF = 0, RING_BYTES = 131072;
constexpr int LDSCTL_OFF = RING_BYTES, MISC_OFF = LDSCTL_OFF + 320;
constexpr int OFFT_OFF = LDSCTL_OFF + 512, LCNT_OFF = LDSCTL_OFF + 768, LBASE_OFF = LDSCTL_OFF + 896, ENT_OFF = LDSCTL_OFF + 1024;
constexpr int LDS_BYTES = 147456;
static_assert(ENT_OFF + 4096 <= LDS_BYTES, "LDS map");

#define GAS __attribute__((address_space(1)))
#define LAS __attribute__((address_space(3)))
typedef unsigned short bf16;
typedef unsigned v4u __attribute__((ext_vector_type(4)));
typedef float f32x4 __attribute__((ext_vector_type(4)));
typedef short bf16x8 __attribute__((ext_vector_type(8)));
typedef GAS unsigned gu32;
typedef GAS unsigned long long gu64;
#define RLX_AGENT __ATOMIC_RELAXED, __HIP_MEMORY_SCOPE_AGENT
#define LDS_WAIT() asm volatile("s_waitcnt lgkmcnt(0)" ::: "memory")
#define VM_WAIT() asm volatile("s_waitcnt vmcnt(0)" ::: "memory")
__device__ __forceinline__ unsigned long long rt() { return __builtin_amdgcn_s_memrealtime(); }
__device__ __forceinline__ unsigned f2bf(float f) { unsigned u = __builtin_bit_cast(unsigned, f); return (u + 0x7fffu + ((u >> 16) & 1u)) >> 16; }
__device__ __forceinline__ unsigned pk2(float lo, float hi) { return f2bf(lo) | (f2bf(hi) << 16); }

#define XB_TMO      128
#define XB_XCNT(j)  (256  + 64 * (j))
#define XB_XSUB(j)  (1280 + 64 * (j))
#define XB_XGEN(j)  (2304 + 64 * (j))
#define XB_TOP      3328
#define XB_TOPGEN   3392
#define XCD_BAR_WORDS 3456
#define XB_SPIN_CAP (1u << 18)

__device__ __forceinline__ unsigned xb_ld(unsigned* p)              { return __hip_atomic_load(p, __ATOMIC_RELAXED, __HIP_MEMORY_SCOPE_AGENT); }
__device__ __forceinline__ unsigned xb_add(unsigned* p, unsigned v) { return __hip_atomic_fetch_add(p, v, __ATOMIC_RELAXED, __HIP_MEMORY_SCOPE_AGENT); }
__device__ __forceinline__ unsigned xb_xcc_id() { return (unsigned)__builtin_amdgcn_s_getreg((3 << 11) | 20) & 0xFu; }
#define XB_SPIN(cond, bar) do { unsigned _sp = 0; while (cond) { __builtin_amdgcn_s_sleep(1); \
    if ((++_sp & 255u) == 0u) { if (xb_ld(&(bar)[XB_TMO])) break; if (_sp > XB_SPIN_CAP) { atomicAdd(&(bar)[XB_TMO], 1u); break; } } } } while (0)

struct XcdBarrier {
    unsigned* bar; unsigned x;
    volatile LAS unsigned* st;
};

__device__ __forceinline__ XcdBarrier xcd_barrier_post(unsigned* bar, volatile LAS unsigned* st) {
    XcdBarrier b; b.bar = bar; b.x = xb_xcc_id(); b.st = st;
    if (threadIdx.x == 0) (void)xb_add(&bar[XB_XCNT(b.x)], 1u);
    return b;
}
__device__ __forceinline__ void xcd_barrier_complete(unsigned* bar, unsigned x, unsigned& nloc, unsigned& nx) {
    const unsigned G = gridDim.x * gridDim.y * gridDim.z;
    unsigned sum, cnt, mine, sp = 0u;
    for (;;) {
        sum = 0u; cnt = 0u; mine = 0u;
#pragma unroll
        for (unsigned j = 0; j < 16; ++j) { const unsigned c = xb_ld(&bar[XB_XCNT(j)]); sum += c; cnt += (c > 0u) ? 1u : 0u; mine = (j == x) ? c : mine; }
        if (sum == G) break;
        __builtin_amdgcn_s_sleep(1);
        if ((++sp & 255u) == 0u) { if (xb_ld(&bar[XB_TMO])) break; if (sp > XB_SPIN_CAP) { atomicAdd(&bar[XB_TMO], 1u); break; } }
    }
    nloc = mine > 0u ? mine : 1u; nx = cnt > 0u ? cnt : 1u;
}

__device__ __forceinline__ void xcd_barrier(const XcdBarrier& b) {
    asm volatile("s_waitcnt vmcnt(0)" ::: "memory");
    __syncthreads();
    if (threadIdx.x == 0) {
        unsigned* bar = b.bar;
        __builtin_amdgcn_s_waitcnt(0);
        unsigned nloc = b.st[0], nx = b.st[1];
        if (nloc == 0u) { xcd_barrier_complete(bar, b.x, nloc, nx); b.st[0] = nloc; b.st[1] = nx; }
        const unsigned old = xb_add(&bar[XB_XSUB(b.x)], 1u);
        const unsigned gen = old / nloc;
        if (old + 1u == (gen + 1u) * nloc) {
            __builtin_amdgcn_fence(__ATOMIC_RELEASE, "agent");
            asm volatile("s_waitcnt vmcnt(0)" ::: "memory");
            const unsigned og = xb_add(&bar[XB_TOP], 1u);
            const unsigned tg = og / nx;
            if (og + 1u == (tg + 1u) * nx) xb_add(&bar[XB_TOPGEN], 1u);
            else XB_SPIN(xb_ld(&bar[XB_TOPGEN]) == tg, bar);
            __builtin_amdgcn_fence(__ATOMIC_ACQUIRE, "agent");
            xb_add(&bar[XB_XGEN(b.x)], 1u);
            asm volatile("s_waitcnt vmcnt(0)" ::: "memory");
        } else {
            XB_SPIN(xb_ld(&bar[XB_XGEN(b.x)]) == gen, bar);
            __builtin_amdgcn_fence(__ATOMIC_ACQUIRE, "agent");
            asm volatile("s_waitcnt vmcnt(0)" ::: "memory");
        }
    }
    __syncthreads();
}

struct Args { const float* in[21]; float* out; unsigned char* ws; int ph_lo, ph_hi, li, pad; };
template <int OFF> __device__ __forceinline__ const float* karg_ptr() {
    const float* p;
    asm volatile("s_load_dwordx2 %0, %1, %2\n\ts_waitcnt lgkmcnt(0)\n\ts_nop 4" : "=s"(p) : "s"(__builtin_amdgcn_kernarg_segment_ptr()), "i"(OFF) : "memory");
    return p;
}
#define KIN(i) karg_ptr<8 * (i)>()
#define KOUT() ((float*)karg_ptr<8 * 21>())
#define KWS() ((unsigned char*)karg_ptr<8 * 22>())
typedef float f32x16 __attribute__((ext_vector_type(16)));
typedef unsigned v2u __attribute__((ext_vector_type(2)));
__device__ __forceinline__ float bflo(unsigned u) { return __builtin_bit_cast(float, u << 16); }
__device__ __forceinline__ float bfhi(unsigned u) { return __builtin_bit_cast(float, u & 0xffff0000u); }
__device__ __forceinline__ float bf1(unsigned short h) { return __builtin_bit_cast(float, (unsigned)h << 16); }
__device__ __forceinline__ float wave_sum(float v) {
#pragma unroll
    for (int o = 1; o < 64; o <<= 1) v += __shfl_xor(v, o);
    return v;
}
__device__ __forceinline__ int mod_row(int r) { return r < RCTX ? 8 : ((r - RCTX) >> 12); }
__device__ __forceinline__ void load_row_f32(const float* p, int lane, f32x4 (&v)[4]) {
#pragma unroll
    for (int j = 0; j < 4; ++j) v[j] = *(const f32x4*)(p + 256 * j + 4 * lane);
}
__device__ __forceinline__ void load_row_bf16(const bf16* p, int lane, f32x4 (&v)[4]) {
#pragma unroll
    for (int j = 0; j < 4; ++j) { const uint2 u = *(const uint2*)(p + 256 * j + 4 * lane); v[j] = (f32x4){bflo(u.x), bfhi(u.x), bflo(u.y), bfhi(u.y)}; }
}
__device__ __forceinline__ void store_row_bf16(bf16* p, int lane, const f32x4 (&v)[4]) {
#pragma unroll
    for (int j = 0; j < 4; ++j) { uint2 u; u.x = pk2(v[j][0], v[j][1]); u.y = pk2(v[j][2], v[j][3]); *(uint2*)(p + 256 * j + 4 * lane) = u; }
}
__device__ __forceinline__ void store_row_f32(float* p, int lane, const f32x4 (&v)[4]) {
#pragma unroll
    for (int j = 0; j < 4; ++j) *(f32x4*)(p + 256 * j + 4 * lane) = v[j];
}
__device__ __forceinline__ void ln_row(f32x4 (&v)[4], const float* g, const float* b, int lane) {
    float s = 0.f;
#pragma unroll
    for (int j = 0; j < 4; ++j) s += (v[j][0] + v[j][1]) + (v[j][2] + v[j][3]);
    const float mean = wave_sum(s) * (1.0f / DM); float s2 = 0.f;
#pragma unroll
    for (int j = 0; j < 4; ++j) { v[j] = v[j] - mean; s2 += (v[j][0] * v[j][0] + v[j][1] * v[j][1]) + (v[j][2] * v[j][2] + v[j][3] * v[j][3]); }
    const float rstd = 1.0f / sqrtf(wave_sum(s2) * (1.0f / DM) + LN_EPS);
#pragma unroll
    for (int j = 0; j < 4; ++j) { const f32x4 gg = *(const f32x4*)(g + 256 * j + 4 * lane), bb = *(const f32x4*)(b + 256 * j + 4 * lane); v[j] = v[j] * rstd * gg + bb; }
}
__device__ __forceinline__ void modulate(const f32x4 (&v)[4], const float* sc, const float* sh, int lane, f32x4 (&o)[4]) {
#pragma unroll
    for (int j = 0; j < 4; ++j) { const f32x4 s = *(const f32x4*)(sc + 256 * j + 4 * lane), h = *(const f32x4*)(sh + 256 * j + 4 * lane); o[j] = v[j] * (1.0f + s) + h; }
}
__device__ __forceinline__ float log2_gamma(float dexp) { return log1pf(-exp2f(-dexp)) * 1.4426950408889634f; }

__device__ __forceinline__ void p0_transpose_item(const float* W, int K, int N, bf16* WT, int dest_row0, int k0, int n0, LAS unsigned* T, int lane) {
    const float* src = W + (size_t)k0 * N + n0 + lane;
    float v[64];
#pragma unroll
    for (int k = 0; k < 64; ++k) v[k] = src[(size_t)k * N];
#pragma unroll
    for (int kp = 0; kp < 32; ++kp) T[lane * 36 + kp] = pk2(v[2 * kp], v[2 * kp + 1]);
    LDS_WAIT(); asm volatile("" ::: "memory");
    const int c = lane & 7, nr = lane >> 3;
#pragma unroll
    for (int j = 0; j < 8; ++j) { const int n = nr + 8 * j; const v4u o = *(const LAS v4u*)(T + n * 36 + 4 * c);
        *(GAS v4u*)(WT + (size_t)(dest_row0 + n) * K + k0 + 8 * c) = o; }
    LDS_WAIT(); asm volatile("" ::: "memory");
}
__device__ __forceinline__ void p0a(const Args& A, LAS unsigned char* lds, int tid, int lane, int wave) {
    unsigned char* ws = KWS();
    const int G = gridDim.x, wg = opaque_bid();
    const float* in_c = KIN(1); const float* in_cctx = KIN(3); const float* in_wmod = KIN(4); const float* in_bmod = KIN(5);
    {
        LAS float* sl = (LAS float*)(lds + RING_OFF);
        float* MODP = (float*)(ws + WS_MODP);
        for (int u = wg; u < DEPTH * 8 * 12; u += G) {
            const int l = u / 96, rem = u % 96, kp = rem / 12, cb = rem % 12;
            for (int i = tid; i < 9 * 128; i += NWAVES * 64) { const int r = i >> 7, k = i & 127;
                const float cv = (r < 8) ? in_c[r * DM + kp * 128 + k] : in_cctx[kp * 128 + k];
                sl[i] = cv / (1.0f + expf(-cv)); }
            __syncthreads();
            const int col = cb * 512 + tid;
            float acc[9];
#pragma unroll
            for (int r = 0; r < 9; ++r) acc[r] = (kp == 0) ? in_bmod[l * NMOD + col] : 0.f;
            const float* wp = in_wmod + ((size_t)l * DM + kp * 128) * NMOD + col;
#pragma unroll 8
            for (int k = 0; k < 128; ++k) { const float w = wp[(size_t)k * NMOD];
#pragma unroll
                for (int r = 0; r < 9; ++r) acc[r] += sl[r * 128 + k] * w; }
#pragma unroll
            for (int r = 0; r < 9; ++r) MODP[((size_t)(l * 8 + kp) * 9 + r) * NMOD + col] = acc[r];
            __syncthreads();
        }
    }
    if (wg == G - 1) {
        const float invf[16] = {1.0f, 0.5623413251903491f, 0.31622776601683794f, 0.1778279410038923f, 0.1f, 0.05623413251903491f, 0.03162277660168379f, 0.01778279410038923f,
                                0.01f, 0.005623413251903491f, 0.0031622776601683794f, 0.0017782794100389228f, 0.001f, 0.0005623413251903491f, 0.00031622776601683794f, 0.00017782794100389227f};
        float2* rope = (float2*)(ws + WS_ROPE);
        for (int i = tid; i < 1024; i += NWAVES * 64) { const int f = i & 15; float fr = invf[0];
#pragma unroll
            for (int q = 1; q < 16; ++q) fr = (f == q) ? invf[q] : fr;
            const float ang = (float)(i >> 4) * fr; rope[i] = make_float2(cosf(ang), sinf(ang)); }
    }
    {
        LAS unsigned* scr = (LAS unsigned*)(lds + RING_OFF + wave * 16384);
        const float* in_win = KIN(6); const float* in_wout = KIN(12); const float* in_wgu = KIN(17); const float* in_wd = KIN(19);
        const int gw = wg * NWAVES + wave, NGW = G * NWAVES;
        constexpr int I_IN = 16 * 40, I_OUT = 16 * 16, I_GU = 16 * 32, I_DN = 16 * 16;
        constexpr int T_IN = DEPTH * I_IN, T_OUT = DEPTH * I_OUT, T_GU = DEPTH * NEXP * I_GU, T_DN = DEPTH * NEXP * I_DN;
        for (int it = gw; it < T_IN + T_OUT + T_GU + T_DN; it += NGW) {
            int r = it;
            if (r < T_IN) { const int l = r / I_IN, q = r % I_IN, kb = q / 40, nb = q % 40;
                p0_transpose_item(in_win + (size_t)l * DM * INW, DM, INW, (bf16*)(ws + WS_WIN) + (size_t)l * INW * DM, 64 * nb, 64 * kb, 64 * nb, scr, lane); continue; }
            r -= T_IN;
            if (r < T_OUT) { const int l = r / I_OUT, q = r % I_OUT, kb = q / 16, nb = q % 16;
                p0_transpose_item(in_wout + (size_t)l * DM * DM, DM, DM, (bf16*)(ws + WS_WOUT) + (size_t)l * DM * DM, 64 * nb, 64 * kb, 64 * nb, scr, lane); continue; }
            r -= T_OUT;
            if (r < T_GU) { const int le = r / I_GU, q = r % I_GU, kb = q / 32, nb = q % 32; const int n0 = 64 * nb;
                const int dest = (n0 < 1024) ? ((n0 >> 7) * 256 + (n0 & 127)) : ((((n0 - 1024) >> 7) * 256) + 128 + ((n0 - 1024) & 127));
                p0_transpose_item(in_wgu + (size_t)le * DM * 2048, DM, 2048, (bf16*)(ws + WS_WGU) + (size_t)le * 2048 * DM, dest, 64 * kb, n0, scr, lane); continue; }
            r -= T_GU;
            { const int le = r / I_DN, q = r % I_DN, kb = q / 16, nb = q % 16;
                p0_transpose_item(in_wd + (size_t)le * DM * DM, DM, DM, (bf16*)(ws + WS_WD) + (size_t)le * DM * DM, 64 * nb, 64 * kb, 64 * nb, scr, lane); }
        }
    }
    __syncthreads();
}
__device__ __forceinline__ void p0b(const Args& A, int tid) {
    const float* MODP = (const float*)(KWS() + WS_MODP); float* MODV = (float*)(KWS() + WS_MODV);
    for (int i = opaque_bid() * (NWAVES * 64) + tid; i < DEPTH * 9 * NMOD; i += gridDim.x * NWAVES * 64) {
        const int l = i / (9 * NMOD), rc = i % (9 * NMOD); float s = 0.f;
#pragma unroll
        for (int kp = 0; kp < 8; ++kp) s += MODP[(size_t)(l * 8 + kp) * 9 * NMOD + rc];
        MODV[i] = s;
    }
}
__device__ __forceinline__ void p0c(const Args& A, int lane, int wave) {
    const float* MODV = (const float*)(KWS() + WS_MODV); bf16* XH = (bf16*)(KWS() + WS_XH);
    const int gw = opaque_bid() * NWAVES + wave, NGW = gridDim.x * NWAVES, RPW = (RTOT + NGW - 1) / NGW;
    for (int r = gw * RPW; r < (gw + 1) * RPW && r < RTOT; ++r) {
        const float* src = (r < RCTX) ? KIN(2) + (size_t)r * DM : KIN(0) + (size_t)(r - RCTX) * DM;
        const float* mv = MODV + (size_t)mod_row(r) * NMOD;
        f32x4 v[4], o[4]; load_row_f32(src, lane, v); modulate(v, mv + 1 * DM, mv + 0 * DM, lane, o); store_row_bf16(XH + (size_t)r * DM, lane, o);
    }
}

__device__ __forceinline__ void unpack4(uint2 u, float (&x)[4]) { x[0] = bflo(u.x); x[1] = bfhi(u.x); x[2] = bflo(u.y); x[3] = bfhi(u.y); }
__device__ __forceinline__ uint2 pack4(const float (&x)[4]) { uint2 u; u.x = pk2(x[0], x[1]); u.y = pk2(x[2], x[3]); return u; }
__device__ __forceinline__ void rope4(float (&x1)[4], float (&x2)[4], const float2* rope, int pos, int f0, bool apply, float scale) {
    if (apply) { const f32x4 a = *(const f32x4*)(rope + pos * 16 + f0), b = *(const f32x4*)(rope + pos * 16 + f0 + 2);
        const float cs[4] = {a[0], a[2], b[0], b[2]}, sn[4] = {a[1], a[3], b[1], b[3]};
#pragma unroll
        for (int i = 0; i < 4; ++i) { const float p = x1[i] * cs[i] - x2[i] * sn[i], q = x1[i] * sn[i] + x2[i] * cs[i]; x1[i] = p; x2[i] = q; } }
#pragma unroll
    for (int i = 0; i < 4; ++i) { x1[i] *= scale; x2[i] *= scale; }
}
__device__ __forceinline__ void p2_row(const Args& A, int l, int r, bool last, int lane) {
    unsigned char* ws = KWS();
    const bf16* zr = (const bf16*)(ws + WS_Z) + (size_t)r * INW; const float2* rope = (const float2*)(ws + WS_ROPE);
    const bool isctx = r < RCTX; const int b = isctx ? (r >> 8) : ((r - RCTX) >> 12), t = isctx ? (r & 255) : ((r - RCTX) & 4095), tlen = isctx ? CTXL : SEQL;
    const bool need_out = !(isctx && last);
    const int prow = t >> 6, pcol = t & 63;
    if (need_out) {
        const int c0 = 4 * lane; float u0[4], cc[4], bb[4], up[4] = {0.f, 0.f, 0.f, 0.f}, cp[4] = {0.f, 0.f, 0.f, 0.f}, un[4] = {0.f, 0.f, 0.f, 0.f}, cn[4] = {0.f, 0.f, 0.f, 0.f};
        unpack4(*(const uint2*)(zr + ZC_U + c0), u0); unpack4(*(const uint2*)(zr + ZC_C + c0), cc); unpack4(*(const uint2*)(zr + ZC_B + c0), bb);
        if (t > 0) { unpack4(*(const uint2*)(zr - INW + ZC_U + c0), up); unpack4(*(const uint2*)(zr - INW + ZC_C + c0), cp); }
        if (t < tlen - 1) { unpack4(*(const uint2*)(zr + INW + ZC_U + c0), un); unpack4(*(const uint2*)(zr + INW + ZC_C + c0), cn); }
        const float* cw = KIN(7) + (size_t)l * 256 * 3 + c0 * 3; const f32x4 w0 = *(const f32x4*)cw, w1 = *(const f32x4*)(cw + 4), w2 = *(const f32x4*)(cw + 8);
        const float wf[12] = {w0[0], w0[1], w0[2], w0[3], w1[0], w1[1], w1[2], w1[3], w2[0], w2[1], w2[2], w2[3]};
        float y[4];
#pragma unroll
        for (int i = 0; i < 4; ++i) y[i] = bb[i] * (wf[3 * i] * (cp[i] * up[i]) + wf[3 * i + 1] * (cc[i] * u0[i]) + wf[3 * i + 2] * (cn[i] * un[i]));
        *(uint2*)((bf16*)(ws + WS_MIX) + (size_t)r * DM + c0) = pack4(y);
    }
    {
        const int which = lane >> 5, blk = (lane >> 2) & 7, j = lane & 3, axis = blk & 1, col = blk * 32 + 4 * j;
        const bf16* src = zr + (which ? ZC_RK : ZC_RQ) + col; float x1[4], x2[4];
        unpack4(*(const uint2*)src, x1); unpack4(*(const uint2*)(src + 16), x2);
        rope4(x1, x2, rope, axis ? pcol : prow, 4 * j, !isctx, which ? 0.125f : 1.0f);
        bf16* dst = (bf16*)(ws + (which ? WS_RK : WS_RQ)) + (size_t)r * 256 + col;
        *(uint2*)dst = pack4(x1); *(uint2*)(dst + 16) = pack4(x2);
    }
    {
        const int blk = lane >> 2, j = lane & 3, axis = blk & 1, col = blk * 32 + 4 * j;
        const bf16* src = zr + ZC_AQ + col; float x1[4], x2[4];
        unpack4(*(const uint2*)src, x1); unpack4(*(const uint2*)(src + 16), x2);
        float ss = 0.f;
#pragma unroll
        for (int i = 0; i < 4; ++i) ss += x1[i] * x1[i] + x2[i] * x2[i];
        ss += __shfl_xor(ss, 1); ss += __shfl_xor(ss, 2); ss += __shfl_xor(ss, 4);
        const float rn = 1.0f / sqrtf(ss * (1.0f / 64.0f) + LN_EPS);
        const float* g = KIN(10) + l * 64 + axis * 32 + 4 * j; const f32x4 g1 = *(const f32x4*)g, g2 = *(const f32x4*)(g + 16);
#pragma unroll
        for (int i = 0; i < 4; ++i) { x1[i] = x1[i] * rn * g1[i]; x2[i] = x2[i] * rn * g2[i]; }
        rope4(x1, x2, rope, axis ? pcol : prow, 4 * j, !isctx, attn_body::C2);
        if (need_out) { bf16* dst = (bf16*)(ws + WS_AQ) + (size_t)r * 512 + col; *(uint2*)dst = pack4(x1); *(uint2*)(dst + 16) = pack4(x2); }
    }
    {
        const int lk = lane & 15, blk = lk >> 2, j = lk & 3, kvh = blk >> 1, axis = blk & 1, col = blk * 32 + 4 * j;
        const bf16* src = zr + ZC_AK + col; float x1[4], x2[4];
        unpack4(*(const uint2*)src, x1); unpack4(*(const uint2*)(src + 16), x2);
        float ss = 0.f;
#pragma unroll
        for (int i = 0; i < 4; ++i) ss += x1[i] * x1[i] + x2[i] * x2[i];
        ss += __shfl_xor(ss, 1); ss += __shfl_xor(ss, 2); ss += __shfl_xor(ss, 4);
        const float rn = 1.0f / sqrtf(ss * (1.0f / 64.0f) + LN_EPS);
        const float* g = KIN(11) + l * 64 + axis * 32 + 4 * j; const f32x4 g1 = *(const f32x4*)g, g2 = *(const f32x4*)(g + 16);
#pragma unroll
        for (int i = 0; i < 4; ++i) { x1[i] = x1[i] * rn * g1[i]; x2[i] = x2[i] * rn * g2[i]; }
        rope4(x1, x2, rope, axis ? pcol : prow, 4 * j, !isctx, 1.0f);
        const int key = isctx ? t : CTXL + t;
        if (lane < 16) { bf16* dst = (bf16*)(ws + WS_AK) + ((size_t)(b * 2 + kvh) * NKEY + key) * 64 + axis * 32 + 4 * j; *(uint2*)dst = pack4(x1); *(uint2*)(dst + 16) = pack4(x2); }
        if (lane >= 32) { const int c = (lane - 32) * 4, kv2 = c >> 6, d = c & 63;
            *(uint2*)((bf16*)(ws + WS_AV) + ((size_t)(b * 2 + kv2) * NKEY + key) * 64 + d) = *(const uint2*)(zr + ZC_AV + c); }
    }
}
constexpr int RT_PITCH = 136;
__device__ __forceinline__ void p2_kv_job(const Args& A, int l, int u, LAS unsigned char* lds, int tid, int lane, int wave) {
    unsigned char* ws = KWS();
    const int h = u & 3, pf = (u >> 2) % NPF, b = (u >> 2) / NPF;
    const bool isctx = pf < 2; const int row0 = isctx ? (b * CTXL + pf * 128) : (RCTX + b * SEQL + (pf - 2) * 128);
    const bf16* Z = (const bf16*)(ws + WS_Z); const float2* rope = (const float2*)(ws + WS_ROPE);
    LAS unsigned short* VT = (LAS unsigned short*)(lds + RING_OFF); LAS unsigned short* KFT = VT + 64 * RT_PITCH; LAS unsigned short* KBT = KFT + 64 * RT_PITCH;
    const float lgf = log2_gamma(KIN(8)[(l * 2 + 0) * 4 + h]), lgb = log2_gamma(KIN(8)[(l * 2 + 1) * 4 + h]);
#pragma unroll
    for (int i = 0; i < 2; ++i) { const int idx = tid + 512 * i, t = idx >> 3, eg = idx & 7;
        const v4u v = *(const v4u*)(Z + (size_t)(row0 + t) * INW + ZC_RV + h * 64 + eg * 8);
        LAS unsigned short* d = VT + (eg * 8) * RT_PITCH + t;
        d[0 * RT_PITCH] = (unsigned short)(v.x & 0xffffu); d[1 * RT_PITCH] = (unsigned short)(v.x >> 16); d[2 * RT_PITCH] = (unsigned short)(v.y & 0xffffu); d[3 * RT_PITCH] = (unsigned short)(v.y >> 16);
        d[4 * RT_PITCH] = (unsigned short)(v.z & 0xffffu); d[5 * RT_PITCH] = (unsigned short)(v.z >> 16); d[6 * RT_PITCH] = (unsigned short)(v.w & 0xffffu); d[7 * RT_PITCH] = (unsigned short)(v.w >> 16); }
    { const int t = tid >> 2, axis = (tid >> 1) & 1, fg = tid & 1;
        const bf16* src = Z + (size_t)(row0 + t) * INW + ZC_RK + h * 64 + axis * 32 + 8 * fg;
        const v4u a = *(const v4u*)src, c = *(const v4u*)(src + 16);
        float x1[8] = {bflo(a.x), bfhi(a.x), bflo(a.y), bfhi(a.y), bflo(a.z), bfhi(a.z), bflo(a.w), bfhi(a.w)};
        float x2[8] = {bflo(c.x), bfhi(c.x), bflo(c.y), bfhi(c.y), bflo(c.z), bfhi(c.z), bflo(c.w), bfhi(c.w)};
        if (!isctx) { const int tt = (pf - 2) * 128 + t, pos = axis ? (tt & 63) : (tt >> 6); const float2* rp = rope + pos * 16 + 8 * fg;
#pragma unroll
            for (int i = 0; i < 8; ++i) { const float2 cs = rp[i]; const float p = x1[i] * cs.x - x2[i] * cs.y, q = x1[i] * cs.y + x2[i] * cs.x; x1[i] = p; x2[i] = q; } }
        const float wf = exp2f((float)(127 - t) * lgf) * 0.125f, wb = exp2f((float)t * lgb) * 0.125f;
        const int d0 = axis * 32 + 8 * fg;
#pragma unroll
        for (int i = 0; i < 8; ++i) {
            KFT[(d0 + i) * RT_PITCH + t] = (unsigned short)f2bf(x1[i] * wf); KFT[(d0 + 16 + i) * RT_PITCH + t] = (unsigned short)f2bf(x2[i] * wf);
            KBT[(d0 + i) * RT_PITCH + t] = (unsigned short)f2bf(x1[i] * wb); KBT[(d0 + 16 + i) * RT_PITCH + t] = (unsigned short)f2bf(x2[i] * wb); }
    }
    __syncthreads();
    { const int dir = wave >> 2, te = (wave >> 1) & 1, td = wave & 1, r32 = lane & 31, hh = lane >> 5;
        const LAS unsigned short* KT = dir ? KBT : KFT;
        f32x16 acc = {};
#pragma unroll
        for (int s = 0; s < 8; ++s) {
            const bf16x8 a = *(const LAS bf16x8*)(VT + (te * 32 + r32) * RT_PITCH + s * 16 + hh * 8);
            const bf16x8 bq = *(const LAS bf16x8*)(KT + (td * 32 + r32) * RT_PITCH + s * 16 + hh * 8);
            acc = __builtin_amdgcn_mfma_f32_32x32x16_bf16(a, bq, acc, 0, 0, 0);
        }
        float* out = (float*)(ws + WS_KVS) + ((size_t)((b * 4 + h) * NPF + pf) * 2 + dir) * 4096;
#pragma unroll
        for (int q = 0; q < 16; ++q) { const int e = te * 32 + (q & 3) + 8 * (q >> 2) + 4 * hh; out[e * 64 + td * 32 + r32] = acc[q]; }
    }
    __syncthreads();
}
__device__ __forceinline__ void p2(const Args& A, int l, LAS unsigned char* lds, int tid, int lane, int wave) {
    const bool last = (l == DEPTH - 1);
    for (int u = opaque_bid(); u < NBATCH * NPF * 4; u += gridDim.x) p2_kv_job(A, l, u, lds, tid, lane, wave);
    const int gw = opaque_bid() * NWAVES + wave, NGW = gridDim.x * NWAVES, RPW = (RTOT + NGW - 1) / NGW;
    for (int r = gw * RPW; r < (gw + 1) * RPW && r < RTOT; ++r) p2_row(A, l, r, last, lane);
}

__device__ __forceinline__ void p4_scan(const Args& A, int l, int tid) {
    const float* KVS = (const float*)(KWS() + WS_KVS); bf16* SS = (bf16*)(KWS() + WS_SS);
    for (int gid = opaque_bid() * (NWAVES * 64) + tid; gid < NBATCH * 4 * 4096; gid += gridDim.x * NWAVES * 64) {
        const int bh = gid >> 12, ed = gid & 4095, h = bh & 3;
        const float gf = exp2f(128.0f * log2_gamma(KIN(8)[(l * 2 + 0) * 4 + h])), gb = exp2f(128.0f * log2_gamma(KIN(8)[(l * 2 + 1) * 4 + h]));
        const size_t base = (size_t)bh * NPF * 2 * 4096 + ed;
        float S = 0.f;
        for (int pf = 0; pf < NPF; ++pf) { const size_t o = base + (size_t)(pf * 2 + 0) * 4096; SS[o] = (bf16)f2bf(S); S = gf * S + KVS[o]; }
        S = 0.f;
        for (int q = 0; q < NPF; ++q) { const int pf = (q == 0) ? 1 : (q == 1) ? 0 : (NPF + 1 - q);
            const size_t o = base + (size_t)(pf * 2 + 1) * 4096; SS[o] = (bf16)f2bf(S); S = gb * S + KVS[o]; }
    }
}
__device__ __forceinline__ void p4_attention(const Args& A, int l, char* lds_ring) {
    using abf = attn_body::bf16;
    const abf* AQ = (const abf*)(KWS() + WS_AQ); const abf* AK = (const abf*)(KWS() + WS_AK); const abf* AV = (const abf*)(KWS() + WS_AV); abf* MIX = (abf*)(KWS() + WS_MIX);
    const int c = opaque_bid(), G = gridDim.x;
    const int x = c & 7, m = c >> 3, per = G >> 3, b = x;
    for (int i = 0; i < 5; ++i) {
        const bool isctx = (i == 4);
        if (isctx && (l == DEPTH - 1 || m >= 8)) break;
        const int uu = m + per * i; if (!isctx && uu >= 128) break;
        const int h = isctx ? m : (uu >> 4), kvh = h >> 2, NT = isctx ? (CTXL / 64) : (NKEY / 64);
        const size_t qrow = isctx ? (size_t)b * CTXL : (size_t)RCTX + (size_t)b * SEQL + (size_t)(uu & 15) * 256;
        attn_body::attn_unit<8>(AQ + qrow * 512 + h * 64, AK + (size_t)(b * 2 + kvh) * NKEY * 64, AV + (size_t)(b * 2 + kvh) * NKEY * 64, MIX + qrow * DM + 512 + h * 64, NT, lds_ring);
    }
}

__device__ __forceinline__ void p5_unit(const Args& A, int l, int g, int hp, LAS unsigned char* lds, int tid, int lane, int wave) {
    unsigned char* ws = KWS();
    const bf16* Z = (const bf16*)(ws + WS_Z); const bf16* RQ = (const bf16*)(ws + WS_RQ); const bf16* RK = (const bf16*)(ws + WS_RK); const bf16* SS = (const bf16*)(ws + WS_SS);
    bf16* MIX = (bf16*)(ws + WS_MIX);
    const int row0 = g * 128;
    int b, pf; if (g < 16) { b = g >> 1; pf = g & 1; } else { b = (g - 16) >> 5; pf = 2 + ((g - 16) & 31); }
    LAS unsigned short* VT = (LAS unsigned short*)(lds + RING_OFF);
#pragma unroll
    for (int i = 0; i < 4; ++i) { const int idx = tid + 512 * i, hl = idx >> 10, t = (idx >> 3) & 127, eg = idx & 7;
        const v4u v = *(const v4u*)(Z + (size_t)(row0 + t) * INW + ZC_RV + (2 * hp + hl) * 64 + eg * 8);
        LAS unsigned short* d = VT + (hl * 64 + eg * 8) * RT_PITCH + t;
        d[0 * RT_PITCH] = (unsigned short)(v.x & 0xffffu); d[1 * RT_PITCH] = (unsigned short)(v.x >> 16); d[2 * RT_PITCH] = (unsigned short)(v.y & 0xffffu); d[3 * RT_PITCH] = (unsigned short)(v.y >> 16);
        d[4 * RT_PITCH] = (unsigned short)(v.z & 0xffffu); d[5 * RT_PITCH] = (unsigned short)(v.z >> 16); d[6 * RT_PITCH] = (unsigned short)(v.w & 0xffffu); d[7 * RT_PITCH] = (unsigned short)(v.w >> 16); }
    __syncthreads();
    {
        const int hl = wave >> 2, h = 2 * hp + hl, ib = wave & 3, r32 = lane & 31, hh = lane >> 5;
        const float lgf = log2_gamma(KIN(8)[(l * 2 + 0) * 4 + h]), lgb = log2_gamma(KIN(8)[(l * 2 + 1) * 4 + h]);
        const int iloc = ib * 32 + r32;
        bf16x8 qf[4];
#pragma unroll
        for (int s = 0; s < 4; ++s) qf[s] = *(const bf16x8*)(RQ + (size_t)(row0 + iloc) * 256 + h * 64 + s * 16 + hh * 8);
        const bf16* Sf = SS + ((size_t)((b * 4 + h) * NPF + pf) * 2 + 0) * 4096; const bf16* Sb = Sf + 4096;
        f32x16 Y[2];
        {
            const float af = exp2f((float)(iloc + 1) * lgf), ab = exp2f((float)(128 - iloc) * lgb);
#pragma unroll
            for (int et = 0; et < 2; ++et) {
                f32x16 cf = {}, cb = {};
#pragma unroll
                for (int s = 0; s < 4; ++s) {
                    const bf16x8 a0 = *(const bf16x8*)(Sf + (et * 32 + r32) * 64 + s * 16 + hh * 8), a1 = *(const bf16x8*)(Sb + (et * 32 + r32) * 64 + s * 16 + hh * 8);
                    cf = __builtin_amdgcn_mfma_f32_32x32x16_bf16(a0, qf[s], cf, 0, 0, 0); cb = __builtin_amdgcn_mfma_f32_32x32x16_bf16(a1, qf[s], cb, 0, 0, 0);
                }
#pragma unroll
                for (int q = 0; q < 16; ++q) Y[et][q] = af * cf[q] + ab * cb[q];
            }
        }
        const LAS unsigned short* VTh = VT + hl * 64 * RT_PITCH;
#pragma unroll 1
        for (int jt = 0; jt < 4; ++jt) {
            f32x16 X = {};
#pragma unroll
            for (int s = 0; s < 4; ++s) { const bf16x8 a = *(const bf16x8*)(RK + (size_t)(row0 + jt * 32 + r32) * 256 + h * 64 + s * 16 + hh * 8);
                X = __builtin_amdgcn_mfma_f32_32x32x16_bf16(a, qf[s], X, 0, 0, 0); }
#pragma unroll
            for (int q = 0; q < 16; ++q) { const int jloc = jt * 32 + (q & 3) + 8 * (q >> 2) + 4 * hh; const int dl = iloc - jloc;
                X[q] *= (dl >= 0) ? exp2f((float)dl * lgf) : exp2f((float)(-dl) * lgb); }
#pragma unroll
            for (int s = 0; s < 2; ++s) {
                v4u pw; pw.x = pk2(X[8 * s + 0], X[8 * s + 1]); pw.y = pk2(X[8 * s + 2], X[8 * s + 3]); pw.z = pk2(X[8 * s + 4], X[8 * s + 5]); pw.w = pk2(X[8 * s + 6], X[8 * s + 7]);
                const bf16x8 bfrag = __builtin_bit_cast(bf16x8, pw);
#pragma unroll
                for (int et = 0; et < 2; ++et) {
                    const LAS unsigned short* vp = VTh + (et * 32 + r32) * RT_PITCH + jt * 32 + 16 * s + 4 * hh;
                    const v2u lo = *(const LAS v2u*)vp, hi2 = *(const LAS v2u*)(vp + 8);
                    v4u aw; aw.x = lo.x; aw.y = lo.y; aw.z = hi2.x; aw.w = hi2.y;
                    Y[et] = __builtin_amdgcn_mfma_f32_32x32x16_bf16(__builtin_bit_cast(bf16x8, aw), bfrag, Y[et], 0, 0, 0);
                }
            }
        }
        float s1 = 0.f;
#pragma unroll
        for (int q = 0; q < 16; ++q) s1 += Y[0][q] + Y[1][q];
        s1 += __shfl_xor(s1, 32); const float mu = s1 * (1.0f / 64.0f); float s2 = 0.f;
#pragma unroll
        for (int q = 0; q < 16; ++q) { const float d0 = Y[0][q] - mu, d1 = Y[1][q] - mu; s2 += d0 * d0 + d1 * d1; }
        s2 += __shfl_xor(s2, 32); const float rstd = 1.0f / sqrtf(s2 * (1.0f / 64.0f) + LN_EPS);
        const size_t row = (size_t)(row0 + iloc);
#pragma unroll
        for (int et = 0; et < 2; ++et)
#pragma unroll
            for (int q4 = 0; q4 < 4; ++q4) { const int e0 = et * 32 + 8 * q4 + 4 * hh;
                float gz[4]; unpack4(*(const uint2*)(Z + row * INW + ZC_RG + h * 64 + e0), gz);
                const f32x4 gn = *(const f32x4*)(KIN(9) + l * 256 + h * 64 + e0);
                float o[4];
#pragma unroll
                for (int i = 0; i < 4; ++i) { const float yn = (Y[et][4 * q4 + i] - mu) * rstd * gn[i]; o[i] = yn * (gz[i] / (1.0f + expf(-gz[i]))); }
                *(uint2*)(MIX + row * DM + 256 + h * 64 + e0) = pack4(o); }
    }
    __syncthreads();
}
__device__ __forceinline__ void p5(const Args& A, int l, LAS unsigned char* lds, int tid, int lane, int wave) {
    const int g0 = (l == DEPTH - 1) ? 16 : 0;
    for (int u = opaque_bid(); u < (272 - g0) * 2; u += gridDim.x) p5_unit(A, l, g0 + (u >> 1), u & 1, lds, tid, lane, wave);
}

__device__ __forceinline__ float reduce32(float (&v)[32], int lane) {
#pragma unroll
    for (int i = 0; i < 16; ++i) { const bool up = lane & 32; const float send = up ? v[i] : v[i + 16], keep = up ? v[i + 16] : v[i]; v[i] = keep + __shfl_xor(send, 32); }
#pragma unroll
    for (int i = 0; i < 8; ++i) { const bool up = lane & 16; const float send = up ? v[i] : v[i + 8], keep = up ? v[i + 8] : v[i]; v[i] = keep + __shfl_xor(send, 16); }
#pragma unroll
    for (int i = 0; i < 4; ++i) { const bool up = lane & 8; const float send = up ? v[i] : v[i + 4], keep = up ? v[i + 4] : v[i]; v[i] = keep + __shfl_xor(send, 8); }
#pragma unroll
    for (int i = 0; i < 2; ++i) { const bool up = lane & 4; const float send = up ? v[i] : v[i + 2], keep = up ? v[i + 2] : v[i]; v[i] = keep + __shfl_xor(send, 4); }
    { const bool up = lane & 2; const float send = up ? v[0] : v[1], keep = up ? v[1] : v[0]; v[0] = keep + __shfl_xor(send, 2); }
    return v[0] + __shfl_xor(v[0], 1);
}
__device__ __forceinline__ void p7_ln(const Args& A, int l, int r, int lane, f32x4 (&hv)[4]) {
    unsigned char* ws = KWS();
    const float* mv = (const float*)(ws + WS_MODV) + (size_t)(l * 9 + mod_row(r)) * NMOD;
    f32x4 v[4], y[4];
    if (l == 0) load_row_f32((r < RCTX) ? KIN(2) + (size_t)r * DM : KIN(0) + (size_t)(r - RCTX) * DM, lane, v);
    else load_row_bf16((const bf16*)(ws + WS_XSA) + (size_t)r * DM, lane, v);
    load_row_bf16((const bf16*)(ws + WS_Y) + (size_t)r * DM, lane, y);
#pragma unroll
    for (int j = 0; j < 4; ++j) { const f32x4 g1 = *(const f32x4*)(mv + 2 * DM + 256 * j + 4 * lane); v[j] = ALPHA * v[j] + g1 * y[j]; }
    ln_row(v, KIN(13) + (size_t)(l * 2 + 0) * DM, KIN(14) + (size_t)(l * 2 + 0) * DM, lane);
    store_row_bf16((bf16*)(ws + WS_XSA) + (size_t)r * DM, lane, v);
    modulate(v, mv + 4 * DM, mv + 3 * DM, lane, hv);
    store_row_bf16((bf16*)(ws + WS_H2) + (size_t)r * DM, lane, hv);
}
__device__ __forceinline__ void p7_route(const Args& A, float logit, int r, int rloc, int lane, LAS int* lcnt, LAS int* ent) {
    float val = logit; const int idx = lane >> 1; float tv[4]; int te[4];
#pragma unroll
    for (int k = 0; k < 4; ++k) {
        float bv = val; int bi = idx;
#pragma unroll
        for (int o = 1; o < 64; o <<= 1) { const float ov = __shfl_xor(bv, o); const int oi = __shfl_xor(bi, o); const bool take = (ov > bv) || (ov == bv && oi < bi); bv = take ? ov : bv; bi = take ? oi : bi; }
        tv[k] = bv; te[k] = bi; val = (idx == bi) ? -INFINITY : val;
    }
    const float p1 = expf(tv[1] - tv[0]), p2 = expf(tv[2] - tv[0]), p3 = expf(tv[3] - tv[0]); const float inv = 1.0f / (1.0f + p1 + p2 + p3);
    if (lane < 4) {
        const int e = (lane == 0) ? te[0] : (lane == 1) ? te[1] : (lane == 2) ? te[2] : te[3];
        const float w = ((lane == 0) ? 1.0f : (lane == 1) ? p1 : (lane == 2) ? p2 : p3) * inv;
        const int lp = __hip_atomic_fetch_add(lcnt + e, 1, __ATOMIC_RELAXED, __HIP_MEMORY_SCOPE_WORKGROUP);
        ent[rloc * 4 + lane] = e | (lp << 8);
        ((float*)(KWS() + WS_RW))[(size_t)r * 4 + lane] = w;
    }
}
__device__ __forceinline__ void p7(const Args& A, int l, LAS unsigned char* lds, int tid, int lane, int wave) {
    unsigned char* ws = KWS();
    const int row_lo = (l == DEPTH - 1) ? RCTX : 0, nrows = RTOT - row_lo;
    const int NGW = gridDim.x * NWAVES, RPW = (nrows + NGW - 1) / NGW, wg_row0 = row_lo + opaque_bid() * NWAVES * RPW;
    LAS f32x4* WL = (LAS f32x4*)(lds + RING_OFF);
    LAS int* lcnt = (LAS int*)(lds + LCNT_OFF); LAS int* lbase = (LAS int*)(lds + LBASE_OFF); LAS int* ent = (LAS int*)(lds + ENT_OFF);
    const float* wr = KIN(15) + (size_t)l * DM * NEXP;
    for (int s = tid; s < 8192; s += NWAVES * 64) { const int ln = s & 63, eg = (s >> 6) & 7, jc = s >> 9; const int k = 256 * (jc >> 2) + 4 * ln + (jc & 3);
        WL[s] = *(const f32x4*)(wr + (size_t)k * NEXP + 4 * eg); }
    if (tid < 32) lcnt[tid] = 0;
    __syncthreads();
    const float bias_e = KIN(16)[l * NEXP + (lane >> 1)];
    const int w_row0 = wg_row0 + wave * RPW;
    for (int i = 0; i < RPW; ++i) {
        const int r0 = w_row0 + i; if (r0 >= RTOT) break;
        f32x4 h0[4];
        p7_ln(A, l, r0, lane, h0);
        f32x4 acc[8];
#pragma unroll
        for (int eg = 0; eg < 8; ++eg) acc[eg] = (f32x4){0.f, 0.f, 0.f, 0.f};
#pragma unroll
        for (int j = 0; j < 4; ++j)
#pragma unroll
            for (int c = 0; c < 4; ++c) { const float xa = h0[j][c];
#pragma unroll
                for (int eg = 0; eg < 8; ++eg) acc[eg] = WL[((j * 4 + c) * 8 + eg) * 64 + lane] * xa + acc[eg]; }
        float a0[32];
#pragma unroll
        for (int e = 0; e < 32; ++e) a0[e] = acc[e >> 2][e & 3];
        const float lg0 = reduce32(a0, lane) + bias_e;
        p7_route(A, lg0, r0, r0 - wg_row0, lane, lcnt, ent);
    }
    __syncthreads();
    if (tid < 32) lbase[tid] = (int)__hip_atomic_fetch_add((unsigned*)(ws + WS_CTL) + CW_GCNT + (l * 32 + tid) * 16, (unsigned)lcnt[tid], __ATOMIC_RELAXED, __HIP_MEMORY_SCOPE_AGENT);
    __syncthreads();
    { const int nent = NWAVES * RPW * 4; int* RE = (int*)(ws + WS_RE); int* RP = (int*)(ws + WS_RP);
        for (int i = tid; i < nent; i += NWAVES * 64) { const int row = wg_row0 + (i >> 2); if (row < RTOT) { const int v = ent[i], e = v & 255, lp = v >> 8;
            RE[(size_t)row * 4 + (i & 3)] = e; RP[(size_t)row * 4 + (i & 3)] = lbase[e] + lp; } } }
    __syncthreads();
}
__device__ __forceinline__ void moe_offsets(const Args& A, int l, LAS unsigned char* lds, int tid) {
    volatile LAS int* offt = (volatile LAS int*)(lds + OFFT_OFF);
    if (tid < 64) {
        const unsigned c = __hip_atomic_load((unsigned*)(KWS() + WS_CTL) + CW_GCNT + (l * 32 + (tid & 31)) * 16, __ATOMIC_RELAXED, __HIP_MEMORY_SCOPE_AGENT);
        int x = (int)((c + 255u) >> 8);
#pragma unroll
        for (int o = 1; o < 32; o <<= 1) { const int v = __shfl_up(x, o); if ((tid & 31) >= o) x += v; }
        if (tid < 32) offt[tid + 1] = x;
        if (tid == 0) offt[0] = 0;
    }
    __syncthreads();
}
__device__ __forceinline__ void p8(const Args& A, int l, LAS unsigned char* lds, int tid, int lane, int wave) {
    unsigned char* ws = KWS();
    moe_offsets(A, l, lds, tid);
    volatile LAS int* offt = (volatile LAS int*)(lds + OFFT_OFF);
    const int row_lo = (l == DEPTH - 1) ? RCTX : 0, nrows = RTOT - row_lo;
    const int NGW = gridDim.x * NWAVES, RPW = (nrows + NGW - 1) / NGW, w_row0 = row_lo + (opaque_bid() * NWAVES + wave) * RPW;
    const int* RE = (const int*)(ws + WS_RE); const int* RP = (const int*)(ws + WS_RP); const float* RW = (const float*)(ws + WS_RW);
    int* SLOT = (int*)(ws + WS_SLOT); float* ROWW = (float*)(ws + WS_ROWW); const bf16* H2 = (const bf16*)(ws + WS_H2); bf16* XS2 = (bf16*)(ws + WS_XS2);
    for (int r = w_row0; r < w_row0 + RPW && r < RTOT; ++r) {
        const int e4 = RE[(size_t)r * 4 + (lane & 3)], p4 = RP[(size_t)r * 4 + (lane & 3)]; const int slot_l = offt[e4 & 31] * 256 + p4;
        const v4u a = *(const v4u*)(H2 + (size_t)r * DM + 8 * lane), b = *(const v4u*)(H2 + (size_t)r * DM + 512 + 8 * lane);
#pragma unroll
        for (int k = 0; k < 4; ++k) { const int slot = __shfl(slot_l, k); bf16* d = XS2 + (size_t)slot * DM; *(v4u*)(d + 8 * lane) = a; *(v4u*)(d + 512 + 8 * lane) = b; }
        if (lane < 4) { SLOT[(size_t)r * 4 + lane] = slot_l; ROWW[slot_l] = RW[(size_t)r * 4 + lane]; }
    }
}
__device__ __forceinline__ void moe_order(pg8::MoeOrder& S, LAS unsigned char* lds, int sh) {
    volatile LAS int* offt = (volatile LAS int*)(lds + OFFT_OFF);
#pragma unroll
    for (int j = 0; j < 11; ++j) { unsigned w = 0;
#pragma unroll
        for (int q = 0; q < 3; ++q) { const int k = 3 * j + q + 1; if (k <= 32) w |= ((unsigned)offt[k] & 1023u) << (10 * q); }
        S.pk[j] = (unsigned)__builtin_amdgcn_readfirstlane((int)w); }
    S.nt = __builtin_amdgcn_readfirstlane(offt[32]); S.sh = sh; S.G = gridDim.x; S.c = opaque_bid();
}
__device__ __forceinline__ void p11(const Args& A, int l, int lane, int wave) {
    unsigned char* ws = KWS();
    const bool last = (l == DEPTH - 1);
    const int row_lo = last ? RCTX : 0, nrows = RTOT - row_lo;
    const int NGW = gridDim.x * NWAVES, RPW = (nrows + NGW - 1) / NGW, w_row0 = row_lo + (opaque_bid() * NWAVES + wave) * RPW;
    const int* SLOT = (const int*)(ws + WS_SLOT); const bf16* YB = (const bf16*)(ws + WS_YB); bf16* XSA = (bf16*)(ws + WS_XSA);
    const float* MODV = (const float*)(ws + WS_MODV);
    for (int r = w_row0; r < w_row0 + RPW && r < RTOT; ++r) {
        const int slot_l = SLOT[(size_t)r * 4 + (lane & 3)];
        f32x4 f[4] = {{0.f, 0.f, 0.f, 0.f}, {0.f, 0.f, 0.f, 0.f}, {0.f, 0.f, 0.f, 0.f}, {0.f, 0.f, 0.f, 0.f}};
#pragma unroll
        for (int k = 0; k < 4; ++k) { const int slot = __shfl(slot_l, k); f32x4 y[4]; load_row_bf16(YB + (size_t)slot * DM, lane, y);
#pragma unroll
            for (int j = 0; j < 4; ++j) f[j] += y[j]; }
        const float* mv = MODV + (size_t)(l * 9 + mod_row(r)) * NMOD;
        f32x4 v[4]; load_row_bf16(XSA + (size_t)r * DM, lane, v);
#pragma unroll
        for (int j = 0; j < 4; ++j) { const f32x4 g2 = *(const f32x4*)(mv + 5 * DM + 256 * j + 4 * lane); v[j] = ALPHA * v[j] + g2 * f[j]; }
        ln_row(v, KIN(13) + (size_t)(l * 2 + 1) * DM, KIN(14) + (size_t)(l * 2 + 1) * DM, lane);
        if (last) store_row_f32(KOUT() + (size_t)(r - RCTX) * DM, lane, v);
        else { store_row_bf16(XSA + (size_t)r * DM, lane, v);
            const float* mn = MODV + (size_t)((l + 1) * 9 + mod_row(r)) * NMOD; f32x4 o[4]; modulate(v, mn + 1 * DM, mn + 0 * DM, lane, o);
            store_row_bf16((bf16*)(ws + WS_XH) + (size_t)r * DM, lane, o); }
    }
}

__global__ void __launch_bounds__(NWAVES * 64, 2) mk_fwd(Args args) {
    extern __shared__ __attribute__((aligned(16))) unsigned char lds_raw[];
    LAS unsigned char* lds = (LAS unsigned char*)lds_raw;
    volatile LAS unsigned* MISC = (volatile LAS unsigned*)(lds + MISC_OFF);
    gu32* ctl = (gu32*)(KWS() + WS_CTL);
    for (int u = threadIdx.x; u < (LDS_BYTES - LDSCTL_OFF) / 4; u += NWAVES * 64) ((LAS unsigned*)(lds + LDSCTL_OFF))[u] = 0u;
    __syncthreads();
    XcdBarrier bar; bar.bar = (unsigned*)(ctl + CW_BAR); bar.x = 0; bar.st = nullptr;
    if (N_LAUNCHES == 1) bar = xcd_barrier_post((unsigned*)(ctl + CW_BAR), MISC + 8);
#define GRID_BAR() do { if (N_LAUNCHES == 1) { xcd_barrier(bar); } } while (0)
    const int lo = args.ph_lo, hi = args.ph_hi;
#define IN(k) (lo <= (k) && (k) < hi)
#define SEAM(k) do { if (IN(k) && IN((k) + 1)) GRID_BAR(); } while (0)
#ifndef PROBE_MASK
#define PROBE_MASK 0
#endif
#define REP(p) for (int rep_ = 0; rep_ < (((PROBE_MASK) >> (p)) & 1) + 1; ++rep_)
#define IDS() const int tid = opaque_tid(), lane = tid & 63, wave = __builtin_amdgcn_readfirstlane(tid >> 6); (void)lane; (void)wave

    if (IN(0)) REP(10) { IDS(); p0a(args, lds, tid, lane, wave); } SEAM(0);
    if (IN(1)) REP(11) { IDS(); p0b(args, tid); } SEAM(1);
    if (IN(2)) REP(12) { IDS(); p0c(args, lane, wave); } SEAM(2);

#pragma unroll 1
    for (int l = 0; l < DEPTH; ++l) {
        const int pb = N_PRO + l * N_PER_LAYER; const bool last = (l == DEPTH - 1);
        if (IN(pb + 0)) REP(0) { unsigned char* ws = KWS();
            pg8::Gemm g{(const bf16*)(ws + WS_XH), (const bf16*)(ws + WS_WIN) + (size_t)l * INW * DM, RTOT, INW, DM}; pg8::StaticOrder S; S.init(RTOT, INW, (int)gridDim.x, opaque_bid());
            pg8::EpiBf16 E{(bf16*)(ws + WS_Z), INW};
            pg8::gemm_phase<pg8::EpiBf16, pg8::StaticOrder, true, true>(lds + RING_OFF, g, S, E);
        } SEAM(pb + 0);
        if (IN(pb + 1)) REP(1) { IDS(); p2(args, l, lds, tid, lane, wave); } SEAM(pb + 1);
        if (IN(pb + 2)) REP(2) { IDS(); p4_scan(args, l, tid); p4_attention(args, l, (char*)lds_raw + RING_OFF); } SEAM(pb + 2);
        if (IN(pb + 3)) REP(3) { IDS(); p5(args, l, lds, tid, lane, wave); } SEAM(pb + 3);
        if (IN(pb + 4)) REP(4) { unsigned char* ws = KWS();
            const int r0 = last ? RCTX : 0, M = RTOT - r0;
            pg8::Gemm g{(const bf16*)(ws + WS_MIX) + (size_t)r0 * DM, (const bf16*)(ws + WS_WOUT) + (size_t)l * DM * DM, M, DM, DM}; pg8::StaticOrder S; S.init(M, DM, (int)gridDim.x, opaque_bid());
            pg8::EpiBf16 E{(bf16*)(ws + WS_Y) + (size_t)r0 * DM, DM};
            pg8::gemm_phase<pg8::EpiBf16, pg8::StaticOrder, true, true>(lds + RING_OFF, g, S, E);
        } SEAM(pb + 4);
        if (IN(pb + 5)) { IDS(); p7(args, l, lds, tid, lane, wave); } SEAM(pb + 5);
        if (IN(pb + 6)) REP(6) { IDS(); p8(args, l, lds, tid, lane, wave); } SEAM(pb + 6);
        if (IN(pb + 7)) REP(7) { IDS(); unsigned char* ws = KWS();
            moe_offsets(args, l, lds, tid);
            pg8::MoeOrder S; moe_order(S, lds, 3);
            pg8::Gemm g{(const bf16*)(ws + WS_XS2), (const bf16*)(ws + WS_WGU) + (size_t)l * NEXP * 2048 * DM, MAXTILES * 256, NEXP * 2048, DM};
            pg8::EpiSwiglu E{(bf16*)(ws + WS_ACT), KIN(18) + (size_t)l * NEXP * 2048};
            pg8::gemm_phase<pg8::EpiSwiglu, pg8::MoeOrder, true, true>(lds + RING_OFF, g, S, E);
        } SEAM(pb + 7);
        if (IN(pb + 8)) REP(8) { IDS(); unsigned char* ws = KWS();
            moe_offsets(args, l, lds, tid);
            pg8::MoeOrder S; moe_order(S, lds, 2);
            pg8::Gemm g{(const bf16*)(ws + WS_ACT), (const bf16*)(ws + WS_WD) + (size_t)l * NEXP * DM * DM, MAXTILES * 256, NEXP * DM, DM};
            pg8::EpiDown E{(bf16*)(ws + WS_YB), KIN(20) + (size_t)l * NEXP * DM, (const float*)(ws + WS_ROWW)};
            pg8::gemm_phase<pg8::EpiDown, pg8::MoeOrder, true, true>(lds + RING_OFF, g, S, E);
        } SEAM(pb + 8);
        if (IN(pb + 9)) { IDS(); p11(args, l, lane, wave); } SEAM(pb + 9);
    }
#undef IN
#undef IDS
#undef SEAM
#undef GRID_BAR
}

extern "C" void kernel_launch(void* const* d_in, const int* in_sizes, int n_in, void* d_out, int out_size, void* d_ws, size_t ws_size, hipStream_t stream) {
    static int grid = 0;
    if (grid == 0) {
        if (n_in != 21 || in_sizes[0] != RLAT * DM || out_size != RLAT * DM || ws_size < WS_END) { fprintf(stderr, "kernel_launch: unexpected shapes / workspace (n_in %d, ws %zu < %zu); nothing launched\n", n_in, ws_size, (size_t)WS_END); grid = -1; return; }
        int dev = 0, cus = 0, per_cu = 0;
        if (hipGetDevice(&dev) != hipSuccess || hipDeviceGetAttribute(&cus, hipDeviceAttributeMultiprocessorCount, dev) != hipSuccess) { grid = -1; return; }
        if (hipFuncSetAttribute((const void*)mk_fwd, hipFuncAttributeMaxDynamicSharedMemorySize, LDS_BYTES) != hipSuccess) { fprintf(stderr, "kernel_launch: hipFuncSetAttribute failed\n"); grid = -1; return; }
        if (hipOccupancyMaxActiveBlocksPerMultiprocessor(&per_cu, (const void*)mk_fwd, NWAVES * 64, LDS_BYTES) != hipSuccess || per_cu < 1) fprintf(stderr, "kernel_launch: occupancy query reports %d\n", per_cu);
        (void)hipGetLastError();
        grid = cus;
        if (grid != 256) { fprintf(stderr, "kernel_launch: built for 256 CUs, found %d; nothing launched\n", grid); grid = -1; return; }
    }
    if (grid < 0) return;
    if (hipMemsetAsync((char*)d_ws + WS_CTL, 0, CTL_ZERO_BYTES, stream) != hipSuccess) return;
    Args a{};
    for (int i = 0; i < 21; ++i) a.in[i] = (const float*)d_in[i];
    a.out = (float*)d_out; a.ws = (unsigned char*)d_ws; a.pad = 0;
    for (int li = 0; li < N_LAUNCHES; ++li) {
        a.ph_lo = (N_LAUNCHES == 1) ? 0 : li; a.ph_hi = (N_LAUNCHES == 1) ? N_PHASES : li + 1; a.li = li;
        hipLaunchKernelGGL(mk_fwd, dim3(grid), dim3(NWAVES * 64), LDS_BYTES, stream, a);
        const hipError_t le = hipPeekAtLastError();
        if (le != hipSuccess) { fprintf(stderr, "kernel_launch: launch %d failed: %s\n", li, hipGetErrorName(le)); break; }
    }
}
```

```cpp
#include <hip/hip_runtime.h>
#include <cstdio>
#include <cstdint>
__device__ __forceinline__ int opaque_tid() { int t = (int)threadIdx.x; asm volatile("" : "+v"(t)); return t; }
__device__ __forceinline__ int opaque_bid() { int b = (int)blockIdx.x; asm volatile("" : "+s"(b)); return b; }
namespace pg8 {
#define PG8_LAS __attribute__((address_space(3)))
typedef unsigned short bf16_t;
typedef short bf16x8 __attribute__((ext_vector_type(8)));
typedef float f32x4 __attribute__((ext_vector_type(4)));
typedef unsigned u32x4 __attribute__((ext_vector_type(4)));
constexpr int BM = 256, BK = 64, HALF = 128, HTB = HALF * BK * 2  , STAGE_BYTES = 8 * HTB, NXCD = 8, WGM = 8;

__host__ __device__ __forceinline__ int lds_byte(int r, int c) { const int st = (r >> 4) * 2 + (c >> 5), rr = r & 15, cc = c & 31, ob = rr * 64 + cc * 2; return st * 1024 + (ob ^ (((ob >> 9) & 1) << 5)); }
__host__ __device__ __forceinline__ void stage_rc(int b, int& R, int& C) { const int st = b / 1024, sb = b % 1024, swz = sb ^ (((sb >> 9) & 1) << 5); R = (st >> 1) * 16 + swz / 64; C = (st & 1) * 32 + (swz % 64) / 2; }
__host__ __device__ __forceinline__ int perm32(int rho) { const int n = rho >> 4, i = rho & 15; return 8 * (i >> 2) + 4 * n + (i & 3); }

struct Unit { int pm, pn; };
struct Gemm { const bf16_t* A; const bf16_t* Bt; int M, N, K; };

struct StaticOrder {
    int nM, nN, nwg, G, c;
    __host__ __device__ void init(int M, int N, int G_, int c_) { nM = M / BM; nN = N / BM; nwg = nM * nN; G = G_; c = c_; }
    __host__ __device__ bool next(int i, Unit& u) const {
        const long L = (long)i * G + c; if (L >= nwg) return false;
        int wgid = (int)L; { const int q = nwg / NXCD, r = nwg % NXCD, xcd = wgid % NXCD, off = wgid / NXCD; wgid = (xcd < r ? xcd * (q + 1) : r * (q + 1) + (xcd - r) * q) + off; }
        const int nig = WGM * nN, gid = wgid / nig, fm = gid * WGM, gsz = (nM - fm) < WGM ? (nM - fm) : WGM;
        u.pm = fm + ((wgid % nig) % gsz); u.pn = (wgid % nig) / gsz; return true;
    }
    __device__ __forceinline__ void a_ready(const Unit&) const {}
    __device__ __forceinline__ void done(const Unit&) const {}
};

__device__ __forceinline__ unsigned cvt_pk_bf16(float lo, float hi) { unsigned r; asm volatile("v_cvt_pk_bf16_f32 %0, %1, %2" : "=v"(r) : "v"(lo), "v"(hi)); return r; }
typedef float f32x2 __attribute__((ext_vector_type(2)));
struct EpiBf16 {
    static constexpr bool PERM = true, AFTER_DRAIN = false;
    bf16_t* O; int ldc;
    __device__ __forceinline__ void operator()(const f32x4 (&acc)[2][2][4][2], const Unit& u, int wr, int wc, int fr, int fq) const {
        const int row0 = u.pm * BM + wr * 64 + fr; const int col0 = u.pn * BM + wc * 32 + 8 * fq;
#pragma unroll
        for (int ai = 0; ai < 2; ++ai)
#pragma unroll
            for (int m = 0; m < 4; ++m) { bf16_t* rowp = O + (size_t)(row0 + ai * HALF + m * 16) * ldc + col0;
#pragma unroll
                for (int bj = 0; bj < 2; ++bj) { const f32x4 v0 = acc[ai][bj][m][0], v1 = acc[ai][bj][m][1];
                    u32x4 w; w.x = cvt_pk_bf16(v0[0], v0[1]); w.y = cvt_pk_bf16(v0[2], v0[3]); w.z = cvt_pk_bf16(v1[0], v1[1]); w.w = cvt_pk_bf16(v1[2], v1[3]);
                    *(u32x4*)(rowp + bj * HALF) = w; } }
    }
};
struct EpiSwiglu {
    static constexpr bool PERM = true, AFTER_DRAIN = false;
    unsigned char* O; const float* bias;
    static __device__ __forceinline__ float act1(float g, float up) {
        g = fminf(g, 7.0f); up = fminf(fmaxf(up, -7.0f), 7.0f);
        const float s = __builtin_amdgcn_rcpf(1.0f + __builtin_amdgcn_exp2f(g * (-1.702f * 1.4426950408889634f)));
        return (up + 1.0f) * (g * s);
    }
    __device__ __forceinline__ void operator()(const f32x4 (&acc)[2][2][4][2], const Unit& u, int wr, int wc, int fr, int fq) const {
        const int e = u.pn >> 3, pnl = u.pn & 7;
        const int row0 = u.pm * BM + wr * 64 + fr; const int j0 = pnl * HALF + wc * 32 + 8 * fq;
        const float* bg = bias + (size_t)e * 2048 + j0; const float* bu = bg + 1024;
        f32x4 bgv[2], buv[2];
#pragma unroll
        for (int n = 0; n < 2; ++n) { bgv[n] = *(const f32x4*)(bg + 4 * n); buv[n] = *(const f32x4*)(bu + 4 * n); }
#pragma unroll
        for (int ai = 0; ai < 2; ++ai)
#pragma unroll
            for (int m = 0; m < 4; ++m) { unsigned char* rowp = O + (size_t)(row0 + ai * HALF + m * 16) * 1024 + j0;
                f32x4 r0, r1;
                { const f32x4 g = acc[ai][0][m][0] * 0.03125f + bgv[0], up = acc[ai][1][m][0] * 0.03125f + buv[0];
                  r0[0] = act1(g[0], up[0]); r0[1] = act1(g[1], up[1]); r0[2] = act1(g[2], up[2]); r0[3] = act1(g[3], up[3]); }
                { const f32x4 g = acc[ai][0][m][1] * 0.03125f + bgv[1], up = acc[ai][1][m][1] * 0.03125f + buv[1];
                  r1[0] = act1(g[0], up[0]); r1[1] = act1(g[1], up[1]); r1[2] = act1(g[2], up[2]); r1[3] = act1(g[3], up[3]); }
                typedef unsigned u32x2 __attribute__((ext_vector_type(2))); u32x2 w;
                w.x = (unsigned)__builtin_amdgcn_cvt_pk_fp8_f32(r0[2], r0[3], __builtin_amdgcn_cvt_pk_fp8_f32(r0[0], r0[1], 0, false), true);
                w.y = (unsigned)__builtin_amdgcn_cvt_pk_fp8_f32(r1[2], r1[3], __builtin_amdgcn_cvt_pk_fp8_f32(r1[0], r1[1], 0, false), true);
                *(u32x2*)rowp = w; }
    }
};
struct EpiDown {
    static constexpr bool PERM = true, AFTER_DRAIN = false;
    bf16_t* O; const float* bias; const float* roww;
    __device__ __forceinline__ void operator()(const f32x4 (&acc)[2][2][4][2], const Unit& u, int wr, int wc, int fr, int fq) const {
        const int e = u.pn >> 2, pnl = u.pn & 3;
        const int row0 = u.pm * BM + wr * 64 + fr; const int col0 = pnl * BM + wc * 32 + 8 * fq;
        const float* bp = bias + (size_t)e * 1024 + col0;
        f32x4 bv[2][2];
#pragma unroll
        for (int bj = 0; bj < 2; ++bj)
#pragma unroll
            for (int n = 0; n < 2; ++n) bv[bj][n] = *(const f32x4*)(bp + bj * HALF + 4 * n);
#pragma unroll
        for (int ai = 0; ai < 2; ++ai)
#pragma unroll
            for (int m = 0; m < 4; ++m) { const int row = row0 + ai * HALF + m * 16; bf16_t* rowp = O + (size_t)row * 1024 + col0;
                const float wt = roww[row];
#pragma unroll
                for (int bj = 0; bj < 2; ++bj) { const f32x4 v0 = (acc[ai][bj][m][0] * 0.015625f + bv[bj][0]) * wt, v1 = (acc[ai][bj][m][1] * 0.015625f + bv[bj][1]) * wt;
                    u32x4 w; w.x = cvt_pk_bf16(v0[0], v0[1]); w.y = cvt_pk_bf16(v0[2], v0[3]); w.z = cvt_pk_bf16(v1[0], v1[1]); w.w = cvt_pk_bf16(v1[2], v1[3]);
                    *(u32x4*)(rowp + bj * HALF) = w; } }
    }
};
struct MoeOrder {
    unsigned pk[11]; int nt, sh, G, c;
    __device__ __forceinline__ bool next(int i, Unit& u) const {
        const int L = i * G + c;
        if (L >= (nt << sh)) return false;
        const int tile = L >> sh, pnl = L & ((1 << sh) - 1); int e = 0;
#pragma unroll
        for (int k = 1; k < 32; ++k) { const int off = (int)((pk[(k - 1) / 3] >> (10 * ((k - 1) % 3))) & 1023u); e += (off <= tile) ? 1 : 0; }
        u.pm = __builtin_amdgcn_readfirstlane(tile); u.pn = __builtin_amdgcn_readfirstlane((e << sh) + pnl); return true;
    }
    __device__ __forceinline__ void a_ready(const Unit&) const {}
    __device__ __forceinline__ void done(const Unit&) const {}
};

template <class Epi, class Sched, bool ALIGN_EPI = false, bool SP2 = false, bool F8 = false>
__device__ __forceinline__ void gemm_phase(PG8_LAS unsigned char* lds, const Gemm g, const Sched& S, const Epi& E) {
    const int tid = opaque_tid(), wid = __builtin_amdgcn_readfirstlane(tid >> 6), lane = tid & 63, wr = wid >> 2, wc = wid & 3, fr = lane & 15, fq = lane >> 4;
    const int K = g.K, nt = K / BK;
    unsigned voffA[2], voffB[2];
#pragma unroll
    for (int i = 0; i < 2; ++i) { int R, C; stage_rc(tid * 16 + i * 8192, R, C); const int Rb = Epi::PERM ? ((R & ~31) + perm32(R & 31)) : R;
        voffA[i] = (unsigned)(R * K + C) * 2u; voffB[i] = (unsigned)(Rb * K + C) * 2u; }
    const size_t kstep = (size_t)(BK * 2);
    const size_t hstep = (size_t)HALF * K * 2;
    const size_t tstep = 2 * hstep;
    const unsigned ldsw = (unsigned)wid * 1024u;
    const int aoff = lds_byte(wr * 64 + fr, fq * 8), boff = lds_byte(wc * 32 + fr, fq * 8);
#define PG8_SA(b, h) (((b) * 2 + (h)) * HTB)
#define PG8_SB(b, h) ((4 + (b) * 2 + (h)) * HTB)
#define PG8_STAGE(bufoff, gbase, voff) do { _Pragma("unroll") for (int _i = 0; _i < 2; ++_i) { unsigned vo_ = (voff)[_i]; asm volatile("" : "+v"(vo_));     \
        __builtin_amdgcn_global_load_lds((const unsigned*)((const char*)(gbase) + vo_), (PG8_LAS unsigned*)(lds + (bufoff) + ldsw + _i * 8192), 16, 0, 0); } } while (0)
#define PG8_LDA(dst, b, h) do { _Pragma("unroll") for (int m = 0; m < 4; ++m) { if constexpr (F8) { \
            const i32x4_t lo_ = *(const PG8_LAS i32x4_t*)(lds + PG8_SA(b, h) + aoff + m * 2048), hi_ = *(const PG8_LAS i32x4_t*)(lds + PG8_SA(b, h) + aoff + m * 2048 + 1024); \
            dst##8[m] = __builtin_shufflevector(lo_, hi_, 0, 1, 2, 3, 4, 5, 6, 7); \
        } else { _Pragma("unroll") for (int k = 0; k < 2; ++k) dst[m][k] = *(const PG8_LAS bf16x8*)(lds + PG8_SA(b, h) + aoff + m * 2048 + k * 1024); } } } while (0)
#define PG8_LDB(dst, b, h) do { _Pragma("unroll") for (int n = 0; n < 2; ++n) { if constexpr (F8) { \
            const i32x4_t lo_ = *(const PG8_LAS i32x4_t*)(lds + PG8_SB(b, h) + boff + n * 2048), hi_ = *(const PG8_LAS i32x4_t*)(lds + PG8_SB(b, h) + boff + n * 2048 + 1024); \
            dst##8[n] = __builtin_shufflevector(lo_, hi_, 0, 1, 2, 3, 4, 5, 6, 7); \
        } else { _Pragma("unroll") for (int k = 0; k < 2; ++k) dst[n][k] = *(const PG8_LAS bf16x8*)(lds + PG8_SB(b, h) + boff + n * 2048 + k * 1024); } } } while (0)
#define PG8_MMA(ai, bj, At, Bt) do { __builtin_amdgcn_s_setprio(1); _Pragma("unroll") for (int m = 0; m < 4; ++m) _Pragma("unroll") for (int n = 0; n < 2; ++n) { \
        if constexpr (F8) {   \
            acc[ai][bj][m][n] = __builtin_amdgcn_mfma_scale_f32_16x16x128_f8f6f4(Bt##8[n], At##8[m], acc[ai][bj][m][n], 0, 0, 0, 0, 0, 0); \
        } else { _Pragma("unroll") for (int k = 0; k < 2; ++k) acc[ai][bj][m][n] = __builtin_amdgcn_mfma_f32_16x16x32_bf16(Bt[n][k], At[m][k], acc[ai][bj][m][n], 0, 0, 0); } } \
        __builtin_amdgcn_s_setprio(0); } while (0)
#define PG8_WAIT_V(n) asm volatile("s_waitcnt vmcnt(" #n ")" ::: "memory")
#define PG8_WAIT_L(n) asm volatile("s_waitcnt lgkmcnt(" #n ")" ::: "memory")
#define PG8_BAR __builtin_amdgcn_s_barrier()
#define PG8_SCHED __builtin_amdgcn_sched_barrier(0)
    Unit cur, nxt; int ui = 0;
    if (!S.next(0, cur)) return;
    f32x4 acc[2][2][4][2];
#pragma unroll
    for (int a = 0; a < 2; ++a)
#pragma unroll
        for (int b = 0; b < 2; ++b)
#pragma unroll
            for (int m = 0; m < 4; ++m)
#pragma unroll
                for (int n = 0; n < 2; ++n) acc[a][b][m][n] = (f32x4){0.f, 0.f, 0.f, 0.f};
    typedef int i32x4_t __attribute__((ext_vector_type(4))); typedef int i32x8_t __attribute__((ext_vector_type(8)));
    bf16x8 At[4][2], B0[2][2], B1[2][2];
    i32x8_t At8[4], B08[2], B18[2];
    const char* cA = (const char*)g.A + (size_t)cur.pm * tstep; const char* cB = (const char*)g.Bt + (size_t)cur.pn * tstep;
    S.a_ready(cur);
    if constexpr (SP2) {
        PG8_STAGE(PG8_SB(0, 0), cB, voffB); PG8_STAGE(PG8_SB(0, 1), cB + hstep, voffB); PG8_STAGE(PG8_SA(0, 0), cA, voffA); PG8_STAGE(PG8_SA(0, 1), cA + hstep, voffA);
        if (wr == 1) PG8_BAR;
        PG8_WAIT_V(2); PG8_BAR;
        PG8_STAGE(PG8_SB(1, 0), cB + kstep, voffB); PG8_STAGE(PG8_SA(1, 0), cA + kstep, voffA); PG8_STAGE(PG8_SB(1, 1), cB + hstep + kstep, voffB);
        PG8_WAIT_V(6); PG8_BAR;
    } else {
        PG8_STAGE(PG8_SB(0, 0), cB, voffB); PG8_STAGE(PG8_SA(0, 0), cA, voffA); PG8_STAGE(PG8_SB(0, 1), cB + hstep, voffB); PG8_STAGE(PG8_SA(0, 1), cA + hstep, voffA);
        if (wr == 1) PG8_BAR;
        PG8_WAIT_V(4); PG8_BAR;
        PG8_STAGE(PG8_SB(1, 0), cB + kstep, voffB); PG8_STAGE(PG8_SA(1, 0), cA + kstep, voffA); PG8_STAGE(PG8_SB(1, 1), cB + hstep + kstep, voffB);
        PG8_WAIT_V(6); PG8_BAR;
    }
    for (;;) {
        const bool has_next = S.next(ui + 1, nxt);
        const char* nA = has_next ? (const char*)g.A + (size_t)nxt.pm * tstep : cA; const char* nB = has_next ? (const char*)g.Bt + (size_t)nxt.pn * tstep : cB;
#pragma unroll 1
        for (int t = 0; t < nt; t += 2) {
            const bool last = (t == nt - 2);
            const char* a1 = cA + (size_t)(t + 1) * kstep;
            const char* a2 = last ? nA : cA + (size_t)(t + 2) * kstep; const char* b2 = last ? nB : cB + (size_t)(t + 2) * kstep;
            const char* a3 = a2 + kstep; const char* b3 = b2 + kstep;
            const char* a1h = a1 + hstep; const char* a2h = a2 + hstep; const char* b2h = b2 + hstep; const char* a3h = a3 + hstep; const char* b3h = b3 + hstep;
            asm volatile("" : "+s"(a1h), "+s"(a2), "+s"(a2h), "+s"(b2), "+s"(b2h), "+s"(a3), "+s"(a3h), "+s"(b3), "+s"(b3h));
            if (last && has_next) S.a_ready(nxt);
            if constexpr (SP2) {
            PG8_LDB(B0, 0, 0); PG8_LDB(B1, 0, 1); PG8_SCHED; PG8_LDA(At, 0, 0); PG8_STAGE(PG8_SA(1, 1), a1h, voffA);
            PG8_WAIT_V(8); PG8_WAIT_L(0); PG8_BAR; PG8_MMA(0, 0, At, B0); PG8_MMA(0, 1, At, B1); PG8_BAR; PG8_SCHED;
            PG8_LDA(At, 0, 1); PG8_STAGE(PG8_SB(0, 0), b2, voffB); PG8_STAGE(PG8_SB(0, 1), b2h, voffB); PG8_STAGE(PG8_SA(0, 0), a2, voffA);
            PG8_WAIT_V(8); PG8_WAIT_L(0); PG8_BAR; PG8_MMA(1, 0, At, B0); PG8_MMA(1, 1, At, B1); PG8_BAR; PG8_SCHED;
            PG8_LDB(B0, 1, 0); PG8_LDB(B1, 1, 1); PG8_SCHED; PG8_LDA(At, 1, 0); PG8_STAGE(PG8_SA(0, 1), a2h, voffA);
            PG8_WAIT_V(8); PG8_WAIT_L(0); PG8_BAR; PG8_MMA(0, 0, At, B0); PG8_MMA(0, 1, At, B1); PG8_BAR; PG8_SCHED;
            PG8_LDA(At, 1, 1); PG8_STAGE(PG8_SB(1, 0), b3, voffB); PG8_STAGE(PG8_SB(1, 1), b3h, voffB); PG8_STAGE(PG8_SA(1, 0), a3, voffA);
            PG8_WAIT_V(8); PG8_WAIT_L(0); PG8_BAR; PG8_MMA(1, 0, At, B0); PG8_MMA(1, 1, At, B1); PG8_BAR; PG8_SCHED;
            } else {
            PG8_LDB(B0, 0, 0); PG8_SCHED; PG8_LDA(At, 0, 0); PG8_STAGE(PG8_SA(1, 1), a1h, voffA);
            PG8_WAIT_L(8); PG8_BAR; PG8_WAIT_L(0); PG8_MMA(0, 0, At, B0); PG8_BAR; PG8_SCHED;
            PG8_LDB(B1, 0, 1); PG8_STAGE(PG8_SB(0, 0), b2, voffB);
            PG8_BAR; PG8_WAIT_L(0); PG8_MMA(0, 1, At, B1); PG8_BAR;
            PG8_LDA(At, 0, 1); PG8_STAGE(PG8_SA(0, 0), a2, voffA);
            PG8_BAR; PG8_WAIT_L(0); PG8_MMA(1, 0, At, B0); PG8_BAR; PG8_SCHED;
            PG8_STAGE(PG8_SB(0, 1), b2h, voffB);
            PG8_WAIT_V(6); PG8_BAR; PG8_MMA(1, 1, At, B1); PG8_BAR;
            PG8_LDB(B0, 1, 0); PG8_SCHED; PG8_LDA(At, 1, 0); PG8_STAGE(PG8_SA(0, 1), a2h, voffA);
            PG8_WAIT_L(8); PG8_BAR; PG8_WAIT_L(0); PG8_MMA(0, 0, At, B0); PG8_BAR; PG8_SCHED;
            PG8_LDB(B1, 1, 1); PG8_STAGE(PG8_SB(1, 0), b3, voffB);
            PG8_BAR; PG8_WAIT_L(0); PG8_MMA(0, 1, At, B1); PG8_BAR;
            PG8_LDA(At, 1, 1); PG8_STAGE(PG8_SA(1, 0), a3, voffA);
            PG8_BAR; PG8_WAIT_L(0); PG8_MMA(1, 0, At, B0); PG8_BAR; PG8_SCHED;
            PG8_STAGE(PG8_SB(1, 1), b3h, voffB);
            PG8_WAIT_V(6); PG8_BAR; PG8_MMA(1, 1, At, B1); PG8_BAR;
            }
        }
        if constexpr (ALIGN_EPI) { if (wr == 0) PG8_BAR; }
        if constexpr (!Epi::AFTER_DRAIN) { unsigned ones_ = ~0u; asm volatile("" : "+s"(ones_)); const int ln_ = (int)__builtin_amdgcn_mbcnt_hi(ones_, __builtin_amdgcn_mbcnt_lo(ones_, 0u)); const int fr_ = ln_ & 15, fq_ = ln_ >> 4;
            E(acc, cur, wr, wc, fr_, fq_); S.done(cur); }
        if (!has_next) break;
#pragma unroll
        for (int a = 0; a < 2; ++a)
#pragma unroll
            for (int b = 0; b < 2; ++b)
#pragma unroll
                for (int m = 0; m < 4; ++m)
#pragma unroll
                    for (int n = 0; n < 2; ++n) acc[a][b][m][n] = (f32x4){0.f, 0.f, 0.f, 0.f};
        cur = nxt; cA = nA; cB = nB; ++ui;
        if constexpr (ALIGN_EPI) { if (wr == 1) PG8_BAR; }
    }
    PG8_WAIT_V(0);
    if constexpr (!ALIGN_EPI) { if (wr == 0) PG8_BAR; }
    PG8_BAR;
    if constexpr (Epi::AFTER_DRAIN) { E.fused(acc, cur, wr, wc, fr, fq, lds, wid, lane); S.done(cur); }
#undef PG8_SA
#undef PG8_SB
#undef PG8_STAGE
#undef PG8_LDA
#undef PG8_LDB
#undef PG8_MMA
#undef PG8_WAIT_V
#undef PG8_WAIT_L
#undef PG8_BAR
#undef PG8_SCHED
}
}

#include <hip/hip_bf16.h>
#include <cmath>
namespace attn_body {
using bf16=__hip_bfloat16;
using bf16x8=__attribute__((ext_vector_type(8)))short;
using s16x4=__attribute__((ext_vector_type(4)))short;
using f32x16=__attribute__((ext_vector_type(16)))float;
using u32x4=__attribute__((ext_vector_type(4)))unsigned;
constexpr int D=64,QP=512,KP=64,OP=1024;
constexpr int NW=8,QBLK=32,QB=QBLK*NW,KVBLK=64;
constexpr int ATTN_UNIT_ROWS=QB;
__device__ __forceinline__ int crow(int r,int hi){return (r&3)+8*(r>>2)+4*hi;}
#define SBAR() __builtin_amdgcn_sched_barrier(0)
__device__ __forceinline__ void cmask(f32x16&p0,f32x16&p1,int jb,int qrel,int hi){
  const float NEG=-INFINITY; int kb=64*jb+4*hi;
  #pragma unroll
  for(int r=0;r<16;++r){int kv=kb+(r&3)+8*(r>>2); if(kv>qrel)p0[r]=NEG; if(kv+32>qrel)p1[r]=NEG;}
}

constexpr int NSLOT=3, SLOTB=8192;
constexpr int LDS_K=0, LDS_V=NSLOT*SLOTB, LDS_WS=2*NSLOT*SLOTB, LDS_OST=LDS_WS+NW*64*4, LDS_BYTES=LDS_OST+NW*4096;
constexpr float C2=0.125f*1.4426950408889634f;
__device__ __forceinline__ void glds16(const void*gsrc,unsigned lds_dst){unsigned keep;
  asm volatile("s_mov_b32 %0, m0\n\ts_mov_b32 m0, %2\n\ts_nop 0\n\tglobal_load_lds_dwordx4 %1, off\n\ts_mov_b32 m0, %0":"=&s"(keep):"v"(gsrc),"s"(lds_dst):"memory");}
__device__ __forceinline__ float max3f(float a,float b,float c){float r;asm("v_max3_f32 %0, %1, %2, %3":"=v"(r):"v"(a),"v"(b),"v"(c));return r;}
__device__ __forceinline__ float max2f(float a,float b){float r;asm("v_max_f32_e32 %0, %1, %2":"=v"(r):"v"(a),"v"(b));return r;}
__device__ __forceinline__ float fadd_s(float a,float b){float r;asm("v_add_f32_e32 %0, %1, %2":"=v"(r):"v"(a),"v"(b));return r;}
__device__ __forceinline__ float fsub_s(float a,float b){float r;asm("v_sub_f32_e32 %0, %1, %2":"=v"(r):"v"(a),"v"(b));return r;}
typedef float f32x2_t __attribute__((ext_vector_type(2))); typedef __bf16 bf16x2_t __attribute__((ext_vector_type(2)));
__device__ __forceinline__ unsigned cvtpk_s(float lo,float hi){f32x2_t v={lo,hi};bf16x2_t b=__builtin_convertvector(v,bf16x2_t);return __builtin_bit_cast(unsigned,b);}
#define WAIT_BAR(N) asm volatile("s_waitcnt vmcnt(" #N ") lgkmcnt(0)\n\ts_barrier":::"memory")

__device__ __forceinline__ void qkt(f32x16&p0,f32x16&p1,const char*Kslot,const bf16x8*qr,const f32x16&negm,int r32,int hi){
  const char*kb=Kslot+hi*1024+r32*16;
  #pragma unroll
  for(int d0=0;d0<4;++d0){
    const bf16x8 b0=*reinterpret_cast<const bf16x8*>(kb+d0*2048);
    const bf16x8 b1=*reinterpret_cast<const bf16x8*>(kb+d0*2048+512);
    if(d0==0){p0=__builtin_amdgcn_mfma_f32_32x32x16_bf16(b0,qr[0],negm,0,0,0);p1=__builtin_amdgcn_mfma_f32_32x32x16_bf16(b1,qr[0],negm,0,0,0);}
    else{p0=__builtin_amdgcn_mfma_f32_32x32x16_bf16(b0,qr[d0],p0,0,0,0);p1=__builtin_amdgcn_mfma_f32_32x32x16_bf16(b1,qr[d0],p1,0,0,0);}}
}
typedef __attribute__((address_space(3))) const char* lds_cptr;
typedef short v4i16_t __attribute__((ext_vector_type(4)));
__device__ __forceinline__ void kload8(bf16x8*kf,lds_cptr kp){
  kf[0]=*(const __attribute__((address_space(3))) bf16x8*)(kp);      kf[1]=*(const __attribute__((address_space(3))) bf16x8*)(kp+512);
  kf[2]=*(const __attribute__((address_space(3))) bf16x8*)(kp+2048); kf[3]=*(const __attribute__((address_space(3))) bf16x8*)(kp+2560);
  kf[4]=*(const __attribute__((address_space(3))) bf16x8*)(kp+4096); kf[5]=*(const __attribute__((address_space(3))) bf16x8*)(kp+4608);
  kf[6]=*(const __attribute__((address_space(3))) bf16x8*)(kp+6144); kf[7]=*(const __attribute__((address_space(3))) bf16x8*)(kp+6656);
}
__device__ __forceinline__ void kload2(bf16x8*kf,lds_cptr kp,int j){ kf[2*j]=*(const __attribute__((address_space(3))) bf16x8*)(kp+j*2048); kf[2*j+1]=*(const __attribute__((address_space(3))) bf16x8*)(kp+j*2048+512); }
__device__ __forceinline__ s16x4 vtr(lds_cptr p){ return __builtin_bit_cast(s16x4,__builtin_amdgcn_ds_read_tr16_b64_v4i16((__attribute__((address_space(3))) v4i16_t*)p)); }
__device__ __forceinline__ float rowmax(const f32x16&p0,const f32x16&p1){
  float a=max3f(p0[0],p0[1],p1[0]),b=max3f(p0[2],p0[3],p1[1]);a=max3f(a,p1[2],p1[3]);
  #pragma unroll
  for(int r=4;r<16;r+=4){a=max3f(a,p0[r],p0[r+1]);b=max3f(b,p0[r+2],p0[r+3]);a=max3f(a,p1[r],p1[r+1]);b=max3f(b,p1[r+2],p1[r+3]);}
  const float m=max2f(a,b);
  auto rr=__builtin_amdgcn_permlane32_swap(__float_as_uint(m),__float_as_uint(m),false,false);
  return max2f(__uint_as_float(rr[0]),__uint_as_float(rr[1]));
}
__device__ __forceinline__ void pv(f32x16*o,int vb,bf16x8 pa0,bf16x8 pa1,bf16x8 pa2,bf16x8 pa3){
  #pragma unroll
  for(int d0=0;d0<2;++d0){s16x4 lo[4],hi[4];
    #pragma unroll
    for(int ks=0;ks<4;++ks){
      asm volatile("ds_read_b64_tr_b16 %0,%1 offset:%c2":"=&v"(lo[ks]):"v"(vb),"i"(d0*4096+ks*1024):"memory");
      asm volatile("ds_read_b64_tr_b16 %0,%1 offset:%c2":"=&v"(hi[ks]):"v"(vb),"i"(d0*4096+ks*1024+512):"memory");}
    asm volatile("s_waitcnt lgkmcnt(0)":::"memory");SBAR();
    #define PK(k) (bf16x8){lo[k][0],lo[k][1],lo[k][2],lo[k][3],hi[k][0],hi[k][1],hi[k][2],hi[k][3]}
    o[d0]=__builtin_amdgcn_mfma_f32_32x32x16_bf16(pa0,PK(0),o[d0],0,0,0);
    o[d0]=__builtin_amdgcn_mfma_f32_32x32x16_bf16(pa1,PK(1),o[d0],0,0,0);
    o[d0]=__builtin_amdgcn_mfma_f32_32x32x16_bf16(pa2,PK(2),o[d0],0,0,0);
    o[d0]=__builtin_amdgcn_mfma_f32_32x32x16_bf16(pa3,PK(3),o[d0],0,0,0);
    #undef PK
  }
}

#ifndef ATTN_STORE16
#define ATTN_STORE16(p,v) (*(u32x4*)(p)=(v))
#endif
template<int THRL> __device__ __forceinline__ void attn_unit(const bf16*Qu,const bf16*Kh,const bf16*Vh,bf16*Ou,const int NT,char*shm){
  const int tid=opaque_tid(),lane=tid&63,r32=lane&31,hi=lane>>5; const int wid=__builtin_amdgcn_readfirstlane(tid>>6);
  const bf16*Qw=Qu+(long)(wid*QBLK)*QP;
  const unsigned lds0=(unsigned)(uintptr_t)shm;
  float*wsf=(float*)(shm+LDS_WS)+wid*64;
  const bf16*ksrc=Kh+(long)lane*KP+wid*8;
  const bf16*vsrc=Vh+(long)(16*(wid&3)+(lane>>2))*KP+(wid>>2)*32+(lane&3)*8;
  const unsigned kdst=lds0+LDS_K+wid*1024, vdst=lds0+LDS_V+wid*1024;
  #define DMA_K(t,slot) glds16(ksrc+(long)(t)*KVBLK*KP,(unsigned)__builtin_amdgcn_readfirstlane(kdst+(slot)))
  #define DMA_V(t,slot) glds16(vsrc+(long)(t)*KVBLK*KP,(unsigned)__builtin_amdgcn_readfirstlane(vdst+(slot)))
  const int vb0=(int)(lds0+LDS_V)+((lane>>4)&1)*32+(lane&3)*8+(4*hi+((lane&15)>>2))*64;
  const char*Kbase=shm+LDS_K; bf16x8 kf[8];
  const lds_cptr shm3=(lds_cptr)shm; const lds_cptr kp0=shm3+LDS_K+hi*1024+r32*16; const lds_cptr vp0=shm3+LDS_V+((lane>>4)&1)*32+(lane&3)*8+(4*hi+((lane&15)>>2))*64;
  DMA_K(0,0);DMA_V(0,0);DMA_K(1,SLOTB);
  bf16x8 qr[4];
  #pragma unroll
  for(int d0=0;d0<4;++d0)qr[d0]=*reinterpret_cast<const bf16x8*>(&Qw[(long)r32*QP+d0*16+hi*8]);
  float mhat=0.f,l_reg=0.f;f32x16 o[2];o[0]=f32x16{};o[1]=f32x16{};f32x16 negm=f32x16{};asm volatile("":"+v"(negm));
  #define CMASK(P0,P1,t) do{}while(0)
  bool resc=false;
  #define START(P0,P1) do{ const float rm=rowmax(P0,P1); resc=false; \
    { const float dl=rm; mhat=fadd_s(mhat,dl); \
      _Pragma("unroll") for(int r=0;r<16;++r){P0[r]=fsub_s(P0[r],dl);P1[r]=fsub_s(P1[r],dl);} \
      _Pragma("unroll") for(int r=0;r<16;++r)negm[r]=-mhat; asm volatile("":"+v"(negm)); } \
    _Pragma("unroll") for(int r=0;r<16;++r)P0[r]=__builtin_amdgcn_exp2f(P0[r]); }while(0)
  #define RESC() do{ if(resc){ asm volatile("s_waitcnt lgkmcnt(0)":::"memory"); \
      _Pragma("unroll") for(int d_=0;d_<2;++d_) _Pragma("unroll") for(int r=0;r<16;++r)o[d_][r]*=wsf[crow(r,hi)]; } }while(0)
  f32x16 pA0,pA1,pB0,pB1;
  int sl_prev=0,sl_cur=0,sl_next=SLOTB;
  #define ROT() do{sl_prev=sl_cur;sl_cur=sl_next;sl_next=(sl_next==(NSLOT-1)*SLOTB)?0:sl_next+SLOTB;}while(0)
  DMA_K(2,2*SLOTB);
  WAIT_BAR(3);
  qkt(pA0,pA1,Kbase,qr,negm,r32,hi);asm volatile("s_nop 15\n\ts_nop 7":"+v"(pA0),"+v"(pA1));CMASK(pA0,pA1,0);
  START(pA0,pA1);
  _Pragma("unroll") for(int r=0;r<16;++r)pA1[r]=__builtin_amdgcn_exp2f(pA1[r]);
  WAIT_BAR(0);
  DMA_K(3,0);DMA_V(1,SLOTB);
  ROT();
  kload8(kf,kp0+sl_cur);
  WAIT_BAR(2);
  s16x4 vlo[8],vhi[8]; u32x4 pw0,pw1,pw2,pw3;
  #define PKW(P,B) cvtpk_s(P[B],P[B+1])
  #define PAF(k) __builtin_bit_cast(bf16x8,pw##k)
  #define VFR(i) (bf16x8){vlo[i][0],vlo[i][1],vlo[i][2],vlo[i][3],vhi[i][0],vhi[i][1],vhi[i][2],vhi[i][3]}
  #define PIN(x) asm volatile("":"+v"(x))
  #define MX3(a,b,c) __builtin_fmaxf(__builtin_fmaxf((a),(b)),(c))
  #define GAPA(MF,A0,A1,A2,A3,W0,W1,PW) do{ MF; sacc+=A0; sacc+=A1; sacc+=A2; sacc+=A3; PIN(sacc); W0; W1; PIN(PW); SBAR(); }while(0)
  #define EX(v) __builtin_amdgcn_exp2f(v)
  #define GAPB(MF,X,B) do{ MF; X[B]=EX(X[B]); X[B+1]=EX(X[B+1]); X[B+2]=EX(X[B+2]); X[B+3]=EX(X[B+3]); PIN(X); SBAR(); }while(0)
  #define VRD(i) do{ vlo[i]=vtr(vp_+(((i)>>2)*4096+((i)&3)*1024)); vhi[i]=vtr(vp_+(((i)>>2)*4096+((i)&3)*1024+512)); }while(0)
  #define KRD(G,j) do{ if(G){ kload2(kf,kp0+sl_next,j); SBAR(); } }while(0)
  #define STEP(C0,C1,P0,P1,t,GK,GV,GL) do{ SBAR(); \
    const lds_cptr vp_=vp0+sl_prev; \
    VRD(0); SBAR(); float sacc=(P0[0]+P0[1]); \
    GAPA(C0=__builtin_amdgcn_mfma_f32_32x32x16_bf16(kf[0],qr[0],negm,0,0,0), P0[2],P0[3],P0[4],P0[5],     pw0[0]=PKW(P0,0), pw0[1]=PKW(P0,2), pw0); \
    VRD(4); SBAR(); GAPA(C1=__builtin_amdgcn_mfma_f32_32x32x16_bf16(kf[1],qr[0],negm,0,0,0), P0[6],P0[7],P0[8],P0[9],     pw0[2]=PKW(P0,4), pw0[3]=PKW(P0,6), pw0); \
    VRD(1); SBAR(); GAPA(C0=__builtin_amdgcn_mfma_f32_32x32x16_bf16(kf[2],qr[1],C0,0,0,0),   P0[10],P0[11],P0[12],P0[13], pw1[0]=PKW(P0,8), pw1[1]=PKW(P0,10), pw1); \
    VRD(5); SBAR(); GAPA(C1=__builtin_amdgcn_mfma_f32_32x32x16_bf16(kf[3],qr[1],C1,0,0,0),   P0[14],P0[15],P1[0],P1[1],   pw1[2]=PKW(P0,12),pw1[3]=PKW(P0,14), pw1); \
    VRD(2); SBAR(); GAPA(C0=__builtin_amdgcn_mfma_f32_32x32x16_bf16(kf[4],qr[2],C0,0,0,0),   P1[2],P1[3],P1[4],P1[5],     pw2[0]=PKW(P1,0), pw2[1]=PKW(P1,2), pw2); \
    VRD(6); SBAR(); GAPA(C1=__builtin_amdgcn_mfma_f32_32x32x16_bf16(kf[5],qr[2],C1,0,0,0),   P1[6],P1[7],P1[8],P1[9],     pw2[2]=PKW(P1,4), pw2[3]=PKW(P1,6), pw2); \
    VRD(3); SBAR(); GAPA(C0=__builtin_amdgcn_mfma_f32_32x32x16_bf16(kf[6],qr[3],C0,0,0,0),   P1[10],P1[11],P1[12],P1[13], pw3[0]=PKW(P1,8), pw3[1]=PKW(P1,10), pw3); \
    VRD(7); SBAR(); GAPA(C1=__builtin_amdgcn_mfma_f32_32x32x16_bf16(kf[7],qr[3],C1,0,0,0),   P1[14],P1[15],0.f,0.f,       pw3[2]=PKW(P1,12),pw3[3]=PKW(P1,14), pw3); \
    l_reg+=sacc; \
    if(GK){DMA_K((t)+3,sl_cur);} if(GV){DMA_V((t)+1,sl_next);} \
    CMASK(C0,C1,t); \
    { float a=MX3(C0[0],C0[1],C1[0]),b=MX3(C0[2],C0[3],C1[1]); a=MX3(a,C1[2],C1[3]); \
      _Pragma("unroll") for(int r=4;r<16;r+=4){a=MX3(a,C0[r],C0[r+1]);b=MX3(b,C0[r+2],C0[r+3]);a=MX3(a,C1[r],C1[r+1]);b=MX3(b,C1[r+2],C1[r+3]);} \
      float rm=__builtin_fmaxf(a,b); { auto rr=__builtin_amdgcn_permlane32_swap(__float_as_uint(rm),__float_as_uint(rm),false,false); rm=__builtin_fmaxf(__uint_as_float(rr[0]),__uint_as_float(rr[1])); } \
      resc=false; \
      if(__builtin_expect(__any(rm>(float)THRL),0)){ const float dl=__builtin_fmaxf(rm,0.f); mhat+=dl; \
        _Pragma("unroll") for(int r=0;r<16;++r){C0[r]-=dl;C1[r]-=dl;} \
        _Pragma("unroll") for(int r=0;r<16;++r)negm[r]=-mhat; asm volatile("":"+v"(negm)); \
        const float f=__builtin_amdgcn_exp2f(-dl); l_reg*=f; if(hi==0)wsf[r32]=f; resc=true; } } \
    SBAR(); \
    GAPB(o[0]=__builtin_amdgcn_mfma_f32_32x32x16_bf16(PAF(0),VFR(0),o[0],0,0,0), C0,0); \
    GAPB(o[1]=__builtin_amdgcn_mfma_f32_32x32x16_bf16(PAF(0),VFR(4),o[1],0,0,0), C0,4); \
    KRD(GL,0); GAPB(o[0]=__builtin_amdgcn_mfma_f32_32x32x16_bf16(PAF(1),VFR(1),o[0],0,0,0), C0,8); \
    KRD(GL,1); GAPB(o[1]=__builtin_amdgcn_mfma_f32_32x32x16_bf16(PAF(1),VFR(5),o[1],0,0,0), C0,12); \
    KRD(GL,2); GAPB(o[0]=__builtin_amdgcn_mfma_f32_32x32x16_bf16(PAF(2),VFR(2),o[0],0,0,0), C1,0); \
    KRD(GL,3); GAPB(o[1]=__builtin_amdgcn_mfma_f32_32x32x16_bf16(PAF(2),VFR(6),o[1],0,0,0), C1,4); \
    GAPB(o[0]=__builtin_amdgcn_mfma_f32_32x32x16_bf16(PAF(3),VFR(3),o[0],0,0,0), C1,8); \
    GAPB(o[1]=__builtin_amdgcn_mfma_f32_32x32x16_bf16(PAF(3),VFR(7),o[1],0,0,0), C1,12); \
    }while(0)
  int t=1;
  #undef CMASK
  #define CMASK(P0,P1,t) do{}while(0)
  for(;t+5<NT;t+=2){
    STEP(pB0,pB1,pA0,pA1,t,true,true,true);     WAIT_BAR(2); RESC(); ROT();
    STEP(pA0,pA1,pB0,pB1,t+1,true,true,true);   WAIT_BAR(2); RESC(); ROT();
  }
  #undef CMASK
  #define CMASK(P0,P1,t) do{}while(0)
  #define ENDW(tt) do{ if((tt)+3<NT){WAIT_BAR(2);} else if((tt)+2<NT){WAIT_BAR(1);} else {WAIT_BAR(0);} }while(0)
  for(;t+1<NT;t+=2){
    STEP(pB0,pB1,pA0,pA1,t,(t+3<NT),(t+1<NT),(t+1<NT));       ENDW(t);   RESC(); ROT();
    STEP(pA0,pA1,pB0,pB1,t+1,(t+4<NT),(t+2<NT),(t+2<NT));     ENDW(t+1); RESC(); ROT();
  }
  STEP(pB0,pB1,pA0,pA1,NT-1,false,false,false); RESC();
  { float sacc=pB0[0]+pB0[1]; _Pragma("unroll") for(int r=2;r<16;++r)sacc+=pB0[r]; _Pragma("unroll") for(int r=0;r<16;++r)sacc+=pB1[r]; l_reg+=sacc;
    pw0=(u32x4){PKW(pB0,0),PKW(pB0,2),PKW(pB0,4),PKW(pB0,6)};pw1=(u32x4){PKW(pB0,8),PKW(pB0,10),PKW(pB0,12),PKW(pB0,14)};pw2=(u32x4){PKW(pB1,0),PKW(pB1,2),PKW(pB1,4),PKW(pB1,6)};pw3=(u32x4){PKW(pB1,8),PKW(pB1,10),PKW(pB1,12),PKW(pB1,14)};
    SBAR(); pv(o,vb0+sl_cur,PAF(0),PAF(1),PAF(2),PAF(3)); }
  #undef PKW
  #undef PAF
  #undef VFR
  #undef PIN
  #undef MX3
  #undef GAPA
  #undef GAPB
  #undef EX
  #undef VRD
  #undef KRD
  #undef STEP
  #undef ENDW
  {auto rr=__builtin_amdgcn_permlane32_swap(__float_as_uint(l_reg),__float_as_uint(l_reg),false,false);l_reg=__uint_as_float(rr[0])+__uint_as_float(rr[1]);}
  if(hi==0)wsf[32+r32]=l_reg;asm volatile("s_waitcnt lgkmcnt(0)":::"memory");
  float rli[16];
  #pragma unroll
  for(int r=0;r<16;++r)rli[r]=__builtin_amdgcn_rcpf(wsf[32+crow(r,hi)]);
  bf16*Ow=Ou+(long)(wid*QBLK)*OP;
  { bf16*stg=(bf16*)(shm+LDS_OST)+wid*2048;
    #pragma unroll
    for(int r=0;r<16;++r){const int orow=crow(r,hi);
      #pragma unroll
      for(int d0=0;d0<2;++d0)stg[orow*64+d0*32+r32]=__float2bfloat16(o[d0][r]*rli[r]);}
    asm volatile("s_waitcnt lgkmcnt(0)":::"memory");
    #pragma unroll
    for(int i=0;i<4;++i){const int row=i*8+(lane>>3),ch=lane&7; const u32x4 v=*(const u32x4*)(stg+row*64+ch*8); ATTN_STORE16(Ow+(long)row*OP+ch*8,v);} }
  asm volatile("s_waitcnt lgkmcnt(0)\n\ts_barrier":::"memory");
  #undef DMA_K
  #undef DMA_V
  #undef CMASK
  #undef START
  #undef RESC
  #undef ROT
}
constexpr int ATTN_LDS_BYTES=LDS_BYTES;
#undef SBAR
#undef WAIT_BAR
}

constexpr int NWAVES = 8;
#ifndef MK_N_LAUNCHES
#define MK_N_LAUNCHES 1
#endif
constexpr int DM = 1024, NBATCH = 8, SEQL = 4096, CTXL = 256, DEPTH = 2;
constexpr int RCTX = NBATCH * CTXL, RLAT = NBATCH * SEQL, RTOT = RCTX + RLAT;
constexpr int INW = 2560, NEXP = 32, NKEY = CTXL + SEQL, NPF = 34, NMOD = 6 * DM;
constexpr int ZC_U = 0, ZC_B = 256, ZC_C = 512, ZC_RQ = 768, ZC_RK = 1024, ZC_RV = 1280, ZC_RG = 1536, ZC_AQ = 1792, ZC_AK = 2304, ZC_AV = 2432;
constexpr float LN_EPS = 1e-6f, ALPHA = 1.41421356237309505f;
constexpr int N_PRO = 3, N_PER_LAYER = 10, N_PHASES = N_PRO + DEPTH * N_PER_LAYER;
constexpr int N_LAUNCHES = MK_N_LAUNCHES;

constexpr size_t MiB = 1u << 20;
constexpr size_t WS_CTL = 0, CTL_ZERO_BYTES = 1 * MiB;
constexpr size_t WS_MODP = 2 * MiB, WS_MODV = 6 * MiB, WS_ROPE = 7 * MiB;
constexpr size_t WS_RE = 8 * MiB, WS_RP = 9 * MiB, WS_RW = 10 * MiB, WS_SLOT = 11 * MiB, WS_ROWW = 12 * MiB;
constexpr size_t WS_WIN = 14 * MiB, WS_WOUT = 24 * MiB, WS_KVS = 28 * MiB, WS_SS = 62 * MiB, WS_AK = 80 * MiB, WS_AV = 89 * MiB, WS_AQ = 98 * MiB;
constexpr size_t WS_RQ = 132 * MiB, WS_RK = 149 * MiB, WS_WGU = 166 * MiB, WS_WD = 422 * MiB, WS_XSA = 550 * MiB, WS_XH = 618 * MiB, WS_Z = 686 * MiB;
constexpr size_t WS_MIX = 856 * MiB, WS_Y = 924 * MiB, WS_H2 = 992 * MiB, WS_XS2 = 1060 * MiB, WS_ACT = 1348 * MiB, WS_END = 1636 * MiB;
constexpr size_t WS_YB = WS_XS2;
constexpr int MAXTILES = 576;
static_assert(WS_MODP + (size_t)DEPTH * 8 * 9 * NMOD * 4 <= WS_MODV && WS_MODV + (size_t)DEPTH * 9 * NMOD * 4 <= WS_ROPE, "ws map");
static_assert(WS_WIN + (size_t)DEPTH * INW * DM * 2 <= WS_WOUT && WS_WOUT + (size_t)DEPTH * DM * DM * 2 <= WS_KVS, "ws map");
static_assert(WS_KVS + (size_t)NBATCH * 4 * NPF * 2 * 4096 * 4 <= WS_SS && WS_SS + (size_t)NBATCH * 4 * NPF * 2 * 4096 * 2 <= WS_AK, "ws map");
static_assert(WS_AK + (size_t)NBATCH * 2 * NKEY * 64 * 2 <= WS_AV && WS_AV + (size_t)NBATCH * 2 * NKEY * 64 * 2 <= WS_AQ && WS_AQ + (size_t)RTOT * 512 * 2 <= WS_RQ, "ws map");
static_assert(WS_RQ + (size_t)RTOT * 256 * 2 <= WS_RK && WS_RK + (size_t)RTOT * 256 * 2 <= WS_WGU && WS_WGU + (size_t)DEPTH * NEXP * 2048 * DM * 2 <= WS_WD, "ws map");
static_assert(WS_WD + (size_t)DEPTH * NEXP * DM * DM * 2 <= WS_XSA && WS_XSA + (size_t)RTOT * DM * 2 <= WS_XH && WS_XH + (size_t)RTOT * DM * 2 <= WS_Z, "ws map");
static_assert(WS_Z + (size_t)RTOT * INW * 2 <= WS_MIX && WS_MIX + (size_t)RTOT * DM * 2 <= WS_Y && WS_Y + (size_t)RTOT * DM * 2 <= WS_H2 && WS_H2 + (size_t)RTOT * DM * 2 <= WS_XS2, "ws map");
static_assert(WS_XS2 + (size_t)MAXTILES * 256 * DM * 2 <= WS_ACT && WS_ACT + (size_t)MAXTILES * 256 * DM * 2 <= WS_END, "ws map");
constexpr int CW_TMO = 0, CW_CODE = 1, CW_BAR = 4096, CW_GCNT = 8192;

constexpr int RING_OFF = 0, RING_BYTES = 131072;
constexpr int LDSCTL_OFF = RING_BYTES, MISC_OFF = LDSCTL_OFF + 320;
constexpr int OFFT_OFF = LDSCTL_OFF + 512, LCNT_OFF = LDSCTL_OFF + 768, LBASE_OFF = LDSCTL_OFF + 896, ENT_OFF = LDSCTL_OFF + 1024;
constexpr int LDS_BYTES = 147456;
static_assert(ENT_OFF + 4096 <= LDS_BYTES, "LDS map");

#define GAS __attribute__((address_space(1)))
#define LAS __attribute__((address_space(3)))
typedef unsigned short bf16;
typedef unsigned v4u __attribute__((ext_vector_type(4)));
typedef float f32x4 __attribute__((ext_vector_type(4)));
typedef short bf16x8 __attribute__((ext_vector_type(8)));
typedef GAS unsigned gu32;
typedef GAS unsigned long long gu64;
#define RLX_AGENT __ATOMIC_RELAXED, __HIP_MEMORY_SCOPE_AGENT
#define LDS_WAIT() asm volatile("s_waitcnt lgkmcnt(0)" ::: "memory")
#define VM_WAIT() asm volatile("s_waitcnt vmcnt(0)" ::: "memory")
__device__ __forceinline__ unsigned long long rt() { return __builtin_amdgcn_s_memrealtime(); }
__device__ __forceinline__ unsigned f2bf(float f) { unsigned u = __builtin_bit_cast(unsigned, f); return (u + 0x7fffu + ((u >> 16) & 1u)) >> 16; }
__device__ __forceinline__ unsigned pk2(float lo, float hi) { return f2bf(lo) | (f2bf(hi) << 16); }

#define XB_TMO      128
#define XB_XCNT(j)  (256  + 64 * (j))
#define XB_XSUB(j)  (1280 + 64 * (j))
#define XB_XGEN(j)  (2304 + 64 * (j))
#define XB_TOP      3328
#define XB_TOPGEN   3392
#define XCD_BAR_WORDS 3456
#define XB_SPIN_CAP (1u << 18)

__device__ __forceinline__ unsigned xb_ld(unsigned* p)              { return __hip_atomic_load(p, __ATOMIC_RELAXED, __HIP_MEMORY_SCOPE_AGENT); }
__device__ __forceinline__ unsigned xb_add(unsigned* p, unsigned v) { return __hip_atomic_fetch_add(p, v, __ATOMIC_RELAXED, __HIP_MEMORY_SCOPE_AGENT); }
__device__ __forceinline__ unsigned xb_xcc_id() { return (unsigned)__builtin_amdgcn_s_getreg((3 << 11) | 20) & 0xFu; }
#define XB_SPIN(cond, bar) do { unsigned _sp = 0; while (cond) { __builtin_amdgcn_s_sleep(1); \
    if ((++_sp & 255u) == 0u) { if (xb_ld(&(bar)[XB_TMO])) break; if (_sp > XB_SPIN_CAP) { atomicAdd(&(bar)[XB_TMO], 1u); break; } } } } while (0)

struct XcdBarrier {
    unsigned* bar; unsigned x;
    volatile LAS unsigned* st;
};

__device__ __forceinline__ XcdBarrier xcd_barrier_post(unsigned* bar, volatile LAS unsigned* st) {
    XcdBarrier b; b.bar = bar; b.x = xb_xcc_id(); b.st = st;
    if (threadIdx.x == 0) (void)xb_add(&bar[XB_XCNT(b.x)], 1u);
    return b;
}
__device__ __forceinline__ void xcd_barrier_complete(unsigned* bar, unsigned x, unsigned& nloc, unsigned& nx) {
    const unsigned G = gridDim.x * gridDim.y * gridDim.z;
    unsigned sum, cnt, mine, sp = 0u;
    for (;;) {
        sum = 0u; cnt = 0u; mine = 0u;
#pragma unroll
        for (unsigned j = 0; j < 16; ++j) { const unsigned c = xb_ld(&bar[XB_XCNT(j)]); sum += c; cnt += (c > 0u) ? 1u : 0u; mine = (j == x) ? c : mine; }
        if (sum == G) break;
        __builtin_amdgcn_s_sleep(1);
        if ((++sp & 255u) == 0u) { if (xb_ld(&bar[XB_TMO])) break; if (sp > XB_SPIN_CAP) { atomicAdd(&bar[XB_TMO], 1u); break; } }
    }
    nloc = mine > 0u ? mine : 1u; nx = cnt > 0u ? cnt : 1u;
}

__device__ __forceinline__ void xcd_barrier(const XcdBarrier& b) {
    asm volatile("s_waitcnt vmcnt(0)" ::: "memory");
    __syncthreads();
    if (threadIdx.x == 0) {
        unsigned* bar = b.bar;
        __builtin_amdgcn_s_waitcnt(0);
        unsigned nloc = b.st[0], nx = b.st[1];
        if (nloc == 0u) { xcd_barrier_complete(bar, b.x, nloc, nx); b.st[0] = nloc; b.st[1] = nx; }
        const unsigned old = xb_add(&bar[XB_XSUB(b.x)], 1u);
        const unsigned gen = old / nloc;
        if (old + 1u == (gen + 1u) * nloc) {
            __builtin_amdgcn_fence(__ATOMIC_RELEASE, "agent");
            asm volatile("s_waitcnt vmcnt(0)" ::: "memory");
            const unsigned og = xb_add(&bar[XB_TOP], 1u);
            const unsigned tg = og / nx;
            if (og + 1u == (tg + 1u) * nx) xb_add(&bar[XB_TOPGEN], 1u);
            else XB_SPIN(xb_ld(&bar[XB_TOPGEN]) == tg, bar);
            __builtin_amdgcn_fence(__ATOMIC_ACQUIRE, "agent");
            xb_add(&bar[XB_XGEN(b.x)], 1u);
            asm volatile("s_waitcnt vmcnt(0)" ::: "memory");
        } else {
            XB_SPIN(xb_ld(&bar[XB_XGEN(b.x)]) == gen, bar);
            __builtin_amdgcn_fence(__ATOMIC_ACQUIRE, "agent");
            asm volatile("s_waitcnt vmcnt(0)" ::: "memory");
        }
    }
    __syncthreads();
}

struct Args { const float* in[21]; float* out; unsigned char* ws; int ph_lo, ph_hi, li, pad; };
template <int OFF> __device__ __forceinline__ const float* karg_ptr() {
    const float* p;
    asm volatile("s_load_dwordx2 %0, %1, %2\n\ts_waitcnt lgkmcnt(0)\n\ts_nop 4" : "=s"(p) : "s"(__builtin_amdgcn_kernarg_segment_ptr()), "i"(OFF) : "memory");
    return p;
}
#define KIN(i) karg_ptr<8 * (i)>()
#define KOUT() ((float*)karg_ptr<8 * 21>())
#define KWS() ((unsigned char*)karg_ptr<8 * 22>())
typedef float f32x16 __attribute__((ext_vector_type(16)));
typedef unsigned v2u __attribute__((ext_vector_type(2)));
__device__ __forceinline__ float bflo(unsigned u) { return __builtin_bit_cast(float, u << 16); }
__device__ __forceinline__ float bfhi(unsigned u) { return __builtin_bit_cast(float, u & 0xffff0000u); }
__device__ __forceinline__ float bf1(unsigned short h) { return __builtin_bit_cast(float, (unsigned)h << 16); }
__device__ __forceinline__ float wave_sum(float v) {
#pragma unroll
    for (int o = 1; o < 64; o <<= 1) v += __shfl_xor(v, o);
    return v;
}
__device__ __forceinline__ int mod_row(int r) { return r < RCTX ? 8 : ((r - RCTX) >> 12); }
__device__ __forceinline__ void load_row_f32(const float* p, int lane, f32x4 (&v)[4]) {
#pragma unroll
    for (int j = 0; j < 4; ++j) v[j] = *(const f32x4*)(p + 256 * j + 4 * lane);
}
__device__ __forceinline__ void load_row_bf16(const bf16* p, int lane, f32x4 (&v)[4]) {
#pragma unroll
    for (int j = 0; j < 4; ++j) { const uint2 u = *(const uint2*)(p + 256 * j + 4 * lane); v[j] = (f32x4){bflo(u.x), bfhi(u.x), bflo(u.y), bfhi(u.y)}; }
}
__device__ __forceinline__ void store_row_bf16(bf16* p, int lane, const f32x4 (&v)[4]) {
#pragma unroll
    for (int j = 0; j < 4; ++j) { uint2 u; u.x = pk2(v[j][0], v[j][1]); u.y = pk2(v[j][2], v[j][3]); *(uint2*)(p + 256 * j + 4 * lane) = u; }
}
__device__ __forceinline__ void store_row_f32(float* p, int lane, const f32x4 (&v)[4]) {
#pragma unroll
    for (int j = 0; j < 4; ++j) *(f32x4*)(p + 256 * j + 4 * lane) = v[j];
}
__device__ __forceinline__ void ln_row(f32x4 (&v)[4], const float* g, const float* b, int lane) {
    float s = 0.f;
#pragma unroll
    for (int j = 0; j < 4; ++j) s += (v[j][0] + v[j][1]) + (v[j][2] + v[j][3]);
    const float mean = wave_sum(s) * (1.0f / DM); float s2 = 0.f;
#pragma unroll
    for (int j = 0; j < 4; ++j) { v[j] = v[j] - mean; s2 += (v[j][0] * v[j][0] + v[j][1] * v[j][1]) + (v[j][2] * v[j][2] + v[j][3] * v[j][3]); }
    const float rstd = 1.0f / sqrtf(wave_sum(s2) * (1.0f / DM) + LN_EPS);
#pragma unroll
    for (int j = 0; j < 4; ++j) { const f32x4 gg = *(const f32x4*)(g + 256 * j + 4 * lane), bb = *(const f32x4*)(b + 256 * j + 4 * lane); v[j] = v[j] * rstd * gg + bb; }
}
__device__ __forceinline__ void modulate(const f32x4 (&v)[4], const float* sc, const float* sh, int lane, f32x4 (&o)[4]) {
#pragma unroll
    for (int j = 0; j < 4; ++j) { const f32x4 s = *(const f32x4*)(sc + 256 * j + 4 * lane), h = *(const f32x4*)(sh + 256 * j + 4 * lane); o[j] = v[j] * (1.0f + s) + h; }
}
__device__ __forceinline__ float log2_gamma(float dexp) { return log1pf(-exp2f(-dexp)) * 1.4426950408889634f; }

__device__ __forceinline__ void p0_transpose_item(const float* W, int K, int N, bf16* WT, int dest_row0, int k0, int n0, LAS unsigned* T, int lane) {
    const float* src = W + (size_t)k0 * N + n0 + lane;
    float v[64];
#pragma unroll
    for (int k = 0; k < 64; ++k) v[k] = src[(size_t)k * N];
#pragma unroll
    for (int kp = 0; kp < 32; ++kp) T[lane * 36 + kp] = pk2(v[2 * kp], v[2 * kp + 1]);
    LDS_WAIT(); asm volatile("" ::: "memory");
    const int c = lane & 7, nr = lane >> 3;
#pragma unroll
    for (int j = 0; j < 8; ++j) { const int n = nr + 8 * j; const v4u o = *(const LAS v4u*)(T + n * 36 + 4 * c);
        *(GAS v4u*)(WT + (size_t)(dest_row0 + n) * K + k0 + 8 * c) = o; }
    LDS_WAIT(); asm volatile("" ::: "memory");
}
__device__ __forceinline__ void p0_transpose_item_f8(const float* W, int K, int N, unsigned char* WT, int dest_row0, int k0, int n0, float scale, LAS unsigned* T, int lane) {
    const float* src = W + (size_t)k0 * N + n0 + lane;
    float v[64];
#pragma unroll
    for (int k = 0; k < 64; ++k) v[k] = src[(size_t)k * N];
#pragma unroll
    for (int kq = 0; kq < 16; ++kq) T[lane * 20 + kq] = (unsigned)__builtin_amdgcn_cvt_pk_fp8_f32(v[4 * kq + 2] * scale, v[4 * kq + 3] * scale, __builtin_amdgcn_cvt_pk_fp8_f32(v[4 * kq] * scale, v[4 * kq + 1] * scale, 0, false), true);
    LDS_WAIT(); asm volatile("" ::: "memory");
    const int c = lane & 3, nr = lane >> 2;
#pragma unroll
    for (int j = 0; j < 4; ++j) { const int n = nr + 16 * j; const v4u o = *(const LAS v4u*)(T + n * 20 + 4 * c);
        *(GAS v4u*)(WT + (size_t)(dest_row0 + n) * K + k0 + 16 * c) = o; }
    LDS_WAIT(); asm volatile("" ::: "memory");
}
__device__ __forceinline__ void p0a(const Args& A, LAS unsigned char* lds, int tid, int lane, int wave) {
    unsigned char* ws = KWS();
    const int G = gridDim.x, wg = opaque_bid();
    const float* in_c = KIN(1); const float* in_cctx = KIN(3); const float* in_wmod = KIN(4); const float* in_bmod = KIN(5);
    {
        LAS float* sl = (LAS float*)(lds + RING_OFF);
        float* MODP = (float*)(ws + WS_MODP);
        for (int u = wg; u < DEPTH * 8 * 12; u += G) {
            const int l = u / 96, rem = u % 96, kp = rem / 12, cb = rem % 12;
            for (int i = tid; i < 9 * 128; i += NWAVES * 64) { const int r = i >> 7, k = i & 127;
                const float cv = (r < 8) ? in_c[r * DM + kp * 128 + k] : in_cctx[kp * 128 + k];
                sl[i] = cv / (1.0f + expf(-cv)); }
            __syncthreads();
            const int col = cb * 512 + tid;
            float acc[9];
#pragma unroll
            for (int r = 0; r < 9; ++r) acc[r] = (kp == 0) ? in_bmod[l * NMOD + col] : 0.f;
            const float* wp = in_wmod + ((size_t)l * DM + kp * 128) * NMOD + col;
#pragma unroll 8
            for (int k = 0; k < 128; ++k) { const float w = wp[(size_t)k * NMOD];
#pragma unroll
                for (int r = 0; r < 9; ++r) acc[r] += sl[r * 128 + k] * w; }
#pragma unroll
            for (int r = 0; r < 9; ++r) MODP[((size_t)(l * 8 + kp) * 9 + r) * NMOD + col] = acc[r];
            __syncthreads();
        }
    }
    if (wg == G - 1) {
        const float invf[16] = {1.0f, 0.5623413251903491f, 0.31622776601683794f, 0.1778279410038923f, 0.1f, 0.05623413251903491f, 0.03162277660168379f, 0.01778279410038923f,
                                0.01f, 0.005623413251903491f, 0.0031622776601683794f, 0.0017782794100389228f, 0.001f, 0.0005623413251903491f, 0.00031622776601683794f, 0.00017782794100389227f};
        float2* rope = (float2*)(ws + WS_ROPE);
        for (int i = tid; i < 1024; i += NWAVES * 64) { const int f = i & 15; float fr = invf[0];
#pragma unroll
            for (int q = 1; q < 16; ++q) fr = (f == q) ? invf[q] : fr;
            const float ang = (float)(i >> 4) * fr; rope[i] = make_float2(cosf(ang), sinf(ang)); }
    }
    {
        LAS unsigned* scr = (LAS unsigned*)(lds + RING_OFF + wave * 16384);
        const float* in_win = KIN(6); const float* in_wout = KIN(12); const float* in_wgu = KIN(17); const float* in_wd = KIN(19);
        const int gw = wg * NWAVES + wave, NGW = G * NWAVES;
        constexpr int I_IN = 16 * 40, I_OUT = 16 * 16, I_GU = 16 * 32, I_DN = 16 * 16;
        constexpr int T_IN = DEPTH * I_IN, T_OUT = DEPTH * I_OUT, T_GU = DEPTH * NEXP * I_GU, T_DN = DEPTH * NEXP * I_DN;
        for (int it = gw; it < T_IN + T_OUT + T_GU + T_DN; it += NGW) {
            int r = it;
            if (r < T_IN) { const int l = r / I_IN, q = r % I_IN, kb = q / 40, nb = q % 40;
                p0_transpose_item(in_win + (size_t)l * DM * INW, DM, INW, (bf16*)(ws + WS_WIN) + (size_t)l * INW * DM, 64 * nb, 64 * kb, 64 * nb, scr, lane); continue; }
            r -= T_IN;
            if (r < T_OUT) { const int l = r / I_OUT, q = r % I_OUT, kb = q / 16, nb = q % 16;
                p0_transpose_item(in_wout + (size_t)l * DM * DM, DM, DM, (bf16*)(ws + WS_WOUT) + (size_t)l * DM * DM, 64 * nb, 64 * kb, 64 * nb, scr, lane); continue; }
            r -= T_OUT;
            if (r < T_GU) { const int le = r / I_GU, q = r % I_GU, kb = q / 32, nb = q % 32; const int n0 = 64 * nb;
                const int dest = (n0 < 1024) ? ((n0 >> 7) * 256 + (n0 & 127)) : ((((n0 - 1024) >> 7) * 256) + 128 + ((n0 - 1024) & 127));
                p0_transpose_item_f8(in_wgu + (size_t)le * DM * 2048, DM, 2048, ws + WS_WGU + (size_t)le * 2048 * DM, dest, 64 * kb, n0, 32.0f, scr, lane); continue; }
            r -= T_GU;
            { const int le = r / I_DN, q = r % I_DN, kb = q / 16, nb = q % 16;
                p0_transpose_item_f8(in_wd + (size_t)le * DM * DM, DM, DM, ws + WS_WD + (size_t)le * DM * DM, 64 * nb, 64 * kb, 64 * nb, 64.0f, scr, lane); }
        }
    }
    __syncthreads();
}
__device__ __forceinline__ void p0b(const Args& A, int tid) {
    const float* MODP = (const float*)(KWS() + WS_MODP); float* MODV = (float*)(KWS() + WS_MODV);
    for (int i = opaque_bid() * (NWAVES * 64) + tid; i < DEPTH * 9 * NMOD; i += gridDim.x * NWAVES * 64) {
        const int l = i / (9 * NMOD), rc = i % (9 * NMOD); float s = 0.f;
#pragma unroll
        for (int kp = 0; kp < 8; ++kp) s += MODP[(size_t)(l * 8 + kp) * 9 * NMOD + rc];
        MODV[i] = s;
    }
}
__device__ __forceinline__ void p0c(const Args& A, int lane, int wave) {
    const float* MODV = (const float*)(KWS() + WS_MODV); bf16* XH = (bf16*)(KWS() + WS_XH);
    const int gw = opaque_bid() * NWAVES + wave, NGW = gridDim.x * NWAVES, RPW = (RTOT + NGW - 1) / NGW;
    for (int r = gw * RPW; r < (gw + 1) * RPW && r < RTOT; ++r) {
        const float* src = (r < RCTX) ? KIN(2) + (size_t)r * DM : KIN(0) + (size_t)(r - RCTX) * DM;
        const float* mv = MODV + (size_t)mod_row(r) * NMOD;
        f32x4 v[4], o[4]; load_row_f32(src, lane, v); modulate(v, mv + 1 * DM, mv + 0 * DM, lane, o); store_row_bf16(XH + (size_t)r * DM, lane, o);
    }
}

__device__ __forceinline__ void unpack4(uint2 u, float (&x)[4]) { x[0] = bflo(u.x); x[1] = bfhi(u.x); x[2] = bflo(u.y); x[3] = bfhi(u.y); }
__device__ __forceinline__ uint2 pack4(const float (&x)[4]) { uint2 u; u.x = pk2(x[0], x[1]); u.y = pk2(x[2], x[3]); return u; }
__device__ __forceinline__ void rope4(float (&x1)[4], float (&x2)[4], const float2* rope, int pos, int f0, bool apply, float scale) {
    if (apply) { const f32x4 a = *(const f32x4*)(rope + pos * 16 + f0), b = *(const f32x4*)(rope + pos * 16 + f0 + 2);
        const float cs[4] = {a[0], a[2], b[0], b[2]}, sn[4] = {a[1], a[3], b[1], b[3]};
#pragma unroll
        for (int i = 0; i < 4; ++i) { const float p = x1[i] * cs[i] - x2[i] * sn[i], q = x1[i] * sn[i] + x2[i] * cs[i]; x1[i] = p; x2[i] = q; } }
#pragma unroll
    for (int i = 0; i < 4; ++i) { x1[i] *= scale; x2[i] *= scale; }
}
__device__ __forceinline__ void p2_row(const Args& A, int l, int r, bool last, int lane) {
    unsigned char* ws = KWS();
    const bf16* zr = (const bf16*)(ws + WS_Z) + (size_t)r * INW; const float2* rope = (const float2*)(ws + WS_ROPE);
    const bool isctx = r < RCTX; const int b = isctx ? (r >> 8) : ((r - RCTX) >> 12), t = isctx ? (r & 255) : ((r - RCTX) & 4095), tlen = isctx ? CTXL : SEQL;
    const bool need_out = !(isctx && last);
    const int prow = t >> 6, pcol = t & 63;
    if (need_out) {
        const int c0 = 4 * lane; float u0[4], cc[4], bb[4], up[4] = {0.f, 0.f, 0.f, 0.f}, cp[4] = {0.f, 0.f, 0.f, 0.f}, un[4] = {0.f, 0.f, 0.f, 0.f}, cn[4] = {0.f, 0.f, 0.f, 0.f};
        unpack4(*(const uint2*)(zr + ZC_U + c0), u0); unpack4(*(const uint2*)(zr + ZC_C + c0), cc); unpack4(*(const uint2*)(zr + ZC_B + c0), bb);
        if (t > 0) { unpack4(*(const uint2*)(zr - INW + ZC_U + c0), up); unpack4(*(const uint2*)(zr - INW + ZC_C + c0), cp); }
        if (t < tlen - 1) { unpack4(*(const uint2*)(zr + INW + ZC_U + c0), un); unpack4(*(const uint2*)(zr + INW + ZC_C + c0), cn); }
        const float* cw = KIN(7) + (size_t)l * 256 * 3 + c0 * 3; const f32x4 w0 = *(const f32x4*)cw, w1 = *(const f32x4*)(cw + 4), w2 = *(const f32x4*)(cw + 8);
        const float wf[12] = {w0[0], w0[1], w0[2], w0[3], w1[0], w1[1], w1[2], w1[3], w2[0], w2[1], w2[2], w2[3]};
        float y[4];
#pragma unroll
        for (int i = 0; i < 4; ++i) y[i] = bb[i] * (wf[3 * i] * (cp[i] * up[i]) + wf[3 * i + 1] * (cc[i] * u0[i]) + wf[3 * i + 2] * (cn[i] * un[i]));
        *(uint2*)((bf16*)(ws + WS_MIX) + (size_t)r * DM + c0) = pack4(y);
    }
    {
        const int which = lane >> 5, blk = (lane >> 2) & 7, j = lane & 3, axis = blk & 1, col = blk * 32 + 4 * j;
        const bf16* src = zr + (which ? ZC_RK : ZC_RQ) + col; float x1[4], x2[4];
        unpack4(*(const uint2*)src, x1); unpack4(*(const uint2*)(src + 16), x2);
        rope4(x1, x2, rope, axis ? pcol : prow, 4 * j, !isctx, which ? 0.125f : 1.0f);
        bf16* dst = (bf16*)(ws + (which ? WS_RK : WS_RQ)) + (size_t)r * 256 + col;
        *(uint2*)dst = pack4(x1); *(uint2*)(dst + 16) = pack4(x2);
    }
    {
        const int blk = lane >> 2, j = lane & 3, axis = blk & 1, col = blk * 32 + 4 * j;
        const bf16* src = zr + ZC_AQ + col; float x1[4], x2[4];
        unpack4(*(const uint2*)src, x1); unpack4(*(const uint2*)(src + 16), x2);
        float ss = 0.f;
#pragma unroll
        for (int i = 0; i < 4; ++i) ss += x1[i] * x1[i] + x2[i] * x2[i];
        ss += __shfl_xor(ss, 1); ss += __shfl_xor(ss, 2); ss += __shfl_xor(ss, 4);
        const float rn = 1.0f / sqrtf(ss * (1.0f / 64.0f) + LN_EPS);
        const float* g = KIN(10) + l * 64 + axis * 32 + 4 * j; const f32x4 g1 = *(const f32x4*)g, g2 = *(const f32x4*)(g + 16);
#pragma unroll
        for (int i = 0; i < 4; ++i) { x1[i] = x1[i] * rn * g1[i]; x2[i] = x2[i] * rn * g2[i]; }
        rope4(x1, x2, rope, axis ? pcol : prow, 4 * j, !isctx, attn_body::C2);
        if (need_out) { bf16* dst = (bf16*)(ws + WS_AQ) + (size_t)r * 512 + col; *(uint2*)dst = pack4(x1); *(uint2*)(dst + 16) = pack4(x2); }
    }
    {
        const int lk = lane & 15, blk = lk >> 2, j = lk & 3, kvh = blk >> 1, axis = blk & 1, col = blk * 32 + 4 * j;
        const bf16* src = zr + ZC_AK + col; float x1[4], x2[4];
        unpack4(*(const uint2*)src, x1); unpack4(*(const uint2*)(src + 16), x2);
        float ss = 0.f;
#pragma unroll
        for (int i = 0; i < 4; ++i) ss += x1[i] * x1[i] + x2[i] * x2[i];
        ss += __shfl_xor(ss, 1); ss += __shfl_xor(ss, 2); ss += __shfl_xor(ss, 4);
        const float rn = 1.0f / sqrtf(ss * (1.0f / 64.0f) + LN_EPS);
        const float* g = KIN(11) + l * 64 + axis * 32 + 4 * j; const f32x4 g1 = *(const f32x4*)g, g2 = *(const f32x4*)(g + 16);
#pragma unroll
        for (int i = 0; i < 4; ++i) { x1[i] = x1[i] * rn * g1[i]; x2[i] = x2[i] * rn * g2[i]; }
        rope4(x1, x2, rope, axis ? pcol : prow, 4 * j, !isctx, 1.0f);
        const int key = isctx ? t : CTXL + t;
        if (lane < 16) { bf16* dst = (bf16*)(ws + WS_AK) + ((size_t)(b * 2 + kvh) * NKEY + key) * 64 + axis * 32 + 4 * j; *(uint2*)dst = pack4(x1); *(uint2*)(dst + 16) = pack4(x2); }
        if (lane >= 32) { const int c = (lane - 32) * 4, kv2 = c >> 6, d = c & 63;
            *(uint2*)((bf16*)(ws + WS_AV) + ((size_t)(b * 2 + kv2) * NKEY + key) * 64 + d) = *(const uint2*)(zr + ZC_AV + c); }
    }
}
constexpr int RT_PITCH = 136;
__device__ __forceinline__ void p2_kv_job(const Args& A, int l, int u, LAS unsigned char* lds, int tid, int lane, int wave) {
    unsigned char* ws = KWS();
    const int h = u & 3, pf = (u >> 2) % NPF, b = (u >> 2) / NPF;
    const bool isctx = pf < 2; const int row0 = isctx ? (b * CTXL + pf * 128) : (RCTX + b * SEQL + (pf - 2) * 128);
    const bf16* Z = (const bf16*)(ws + WS_Z); const float2* rope = (const float2*)(ws + WS_ROPE);
    LAS unsigned short* VT = (LAS unsigned short*)(lds + RING_OFF); LAS unsigned short* KFT = VT + 64 * RT_PITCH; LAS unsigned short* KBT = KFT + 64 * RT_PITCH;
    const float lgf = log2_gamma(KIN(8)[(l * 2 + 0) * 4 + h]), lgb = log2_gamma(KIN(8)[(l * 2 + 1) * 4 + h]);
#pragma unroll
    for (int i = 0; i < 2; ++i) { const int idx = tid + 512 * i, t = idx >> 3, eg = idx & 7;
        const v4u v = *(const v4u*)(Z + (size_t)(row0 + t) * INW + ZC_RV + h * 64 + eg * 8);
        LAS unsigned short* d = VT + (eg * 8) * RT_PITCH + t;
        d[0 * RT_PITCH] = (unsigned short)(v.x & 0xffffu); d[1 * RT_PITCH] = (unsigned short)(v.x >> 16); d[2 * RT_PITCH] = (unsigned short)(v.y & 0xffffu); d[3 * RT_PITCH] = (unsigned short)(v.y >> 16);
        d[4 * RT_PITCH] = (unsigned short)(v.z & 0xffffu); d[5 * RT_PITCH] = (unsigned short)(v.z >> 16); d[6 * RT_PITCH] = (unsigned short)(v.w & 0xffffu); d[7 * RT_PITCH] = (unsigned short)(v.w >> 16); }
    { const int t = tid >> 2, axis = (tid >> 1) & 1, fg = tid & 1;
        const bf16* src = Z + (size_t)(row0 + t) * INW + ZC_RK + h * 64 + axis * 32 + 8 * fg;
        const v4u a = *(const v4u*)src, c = *(const v4u*)(src + 16);
        float x1[8] = {bflo(a.x), bfhi(a.x), bflo(a.y), bfhi(a.y), bflo(a.z), bfhi(a.z), bflo(a.w), bfhi(a.w)};
        float x2[8] = {bflo(c.x), bfhi(c.x), bflo(c.y), bfhi(c.y), bflo(c.z), bfhi(c.z), bflo(c.w), bfhi(c.w)};
        if (!isctx) { const int tt = (pf - 2) * 128 + t, pos = axis ? (tt & 63) : (tt >> 6); const float2* rp = rope + pos * 16 + 8 * fg;
#pragma unroll
            for (int i = 0; i < 8; ++i) { const float2 cs = rp[i]; const float p = x1[i] * cs.x - x2[i] * cs.y, q = x1[i] * cs.y + x2[i] * cs.x; x1[i] = p; x2[i] = q; } }
        const float wf = exp2f((float)(127 - t) * lgf) * 0.125f, wb = exp2f((float)t * lgb) * 0.125f;
        const int d0 = axis * 32 + 8 * fg;
#pragma unroll
        for (int i = 0; i < 8; ++i) {
            KFT[(d0 + i) * RT_PITCH + t] = (unsigned short)f2bf(x1[i] * wf); KFT[(d0 + 16 + i) * RT_PITCH + t] = (unsigned short)f2bf(x2[i] * wf);
            KBT[(d0 + i) * RT_PITCH + t] = (unsigned short)f2bf(x1[i] * wb); KBT[(d0 + 16 + i) * RT_PITCH + t] = (unsigned short)f2bf(x2[i] * wb); }
    }
    __syncthreads();
    { const int dir = wave >> 2, te = (wave >> 1) & 1, td = wave & 1, r32 = lane & 31, hh = lane >> 5;
        const LAS unsigned short* KT = dir ? KBT : KFT;
        f32x16 acc = {};
#pragma unroll
        for (int s = 0; s < 8; ++s) {
            const bf16x8 a = *(const LAS bf16x8*)(VT + (te * 32 + r32) * RT_PITCH + s * 16 + hh * 8);
            const bf16x8 bq = *(const LAS bf16x8*)(KT + (td * 32 + r32) * RT_PITCH + s * 16 + hh * 8);
            acc = __builtin_amdgcn_mfma_f32_32x32x16_bf16(a, bq, acc, 0, 0, 0);
        }
        float* out = (float*)(ws + WS_KVS) + ((size_t)((b * 4 + h) * NPF + pf) * 2 + dir) * 4096;
#pragma unroll
        for (int q = 0; q < 16; ++q) { const int e = te * 32 + (q & 3) + 8 * (q >> 2) + 4 * hh; out[e * 64 + td * 32 + r32] = acc[q]; }
    }
    __syncthreads();
}
__device__ __forceinline__ void p2(const Args& A, int l, LAS unsigned char* lds, int tid, int lane, int wave) {
    const bool last = (l == DEPTH - 1);
    for (int u = opaque_bid(); u < NBATCH * NPF * 4; u += gridDim.x) p2_kv_job(A, l, u, lds, tid, lane, wave);
    const int gw = opaque_bid() * NWAVES + wave, NGW = gridDim.x * NWAVES, RPW = (RTOT + NGW - 1) / NGW;
    for (int r = gw * RPW; r < (gw + 1) * RPW && r < RTOT; ++r) p2_row(A, l, r, last, lane);
}

__device__ __forceinline__ void p4_scan(const Args& A, int l, int tid) {
    const float* KVS = (const float*)(KWS() + WS_KVS); bf16* SS = (bf16*)(KWS() + WS_SS);
    for (int gid = opaque_bid() * (NWAVES * 64) + tid; gid < NBATCH * 4 * 4096; gid += gridDim.x * NWAVES * 64) {
        const int bh = gid >> 12, ed = gid & 4095, h = bh & 3;
        const float gf = exp2f(128.0f * log2_gamma(KIN(8)[(l * 2 + 0) * 4 + h])), gb = exp2f(128.0f * log2_gamma(KIN(8)[(l * 2 + 1) * 4 + h]));
        const size_t base = (size_t)bh * NPF * 2 * 4096 + ed;
        float S = 0.f;
        for (int pf = 0; pf < NPF; ++pf) { const size_t o = base + (size_t)(pf * 2 + 0) * 4096; SS[o] = (bf16)f2bf(S); S = gf * S + KVS[o]; }
        S = 0.f;
        for (int q = 0; q < NPF; ++q) { const int pf = (q == 0) ? 1 : (q == 1) ? 0 : (NPF + 1 - q);
            const size_t o = base + (size_t)(pf * 2 + 1) * 4096; SS[o] = (bf16)f2bf(S); S = gb * S + KVS[o]; }
    }
}
__device__ __forceinline__ void p4_attention(const Args& A, int l, char* lds_ring) {
    using abf = attn_body::bf16;
    const abf* AQ = (const abf*)(KWS() + WS_AQ); const abf* AK = (const abf*)(KWS() + WS_AK); const abf* AV = (const abf*)(KWS() + WS_AV); abf* MIX = (abf*)(KWS() + WS_MIX);
    const int c = opaque_bid(), G = gridDim.x;
    const int x = c & 7, m = c >> 3, per = G >> 3, b = x;
    for (int i = 0; i < 5; ++i) {
        const bool isctx = (i == 4);
        if (isctx && (l == DEPTH - 1 || m >= 8)) break;
        const int uu = m + per * i; if (!isctx && uu >= 128) break;
        const int h = isctx ? m : (uu >> 4), kvh = h >> 2, NT = isctx ? (CTXL / 64) : (NKEY / 64);
        const size_t qrow = isctx ? (size_t)b * CTXL : (size_t)RCTX + (size_t)b * SEQL + (size_t)(uu & 15) * 256;
        attn_body::attn_unit<8>(AQ + qrow * 512 + h * 64, AK + (size_t)(b * 2 + kvh) * NKEY * 64, AV + (size_t)(b * 2 + kvh) * NKEY * 64, MIX + qrow * DM + 512 + h * 64, NT, lds_ring);
    }
}

__device__ __forceinline__ void p5_unit(const Args& A, int l, int g, int hp, LAS unsigned char* lds, int tid, int lane, int wave) {
    unsigned char* ws = KWS();
    const bf16* Z = (const bf16*)(ws + WS_Z); const bf16* RQ = (const bf16*)(ws + WS_RQ); const bf16* RK = (const bf16*)(ws + WS_RK); const bf16* SS = (const bf16*)(ws + WS_SS);
    bf16* MIX = (bf16*)(ws + WS_MIX);
    const int row0 = g * 128;
    int b, pf; if (g < 16) { b = g >> 1; pf = g & 1; } else { b = (g - 16) >> 5; pf = 2 + ((g - 16) & 31); }
    LAS unsigned short* VT = (LAS unsigned short*)(lds + RING_OFF);
#pragma unroll
    for (int i = 0; i < 4; ++i) { const int idx = tid + 512 * i, hl = idx >> 10, t = (idx >> 3) & 127, eg = idx & 7;
        const v4u v = *(const v4u*)(Z + (size_t)(row0 + t) * INW + ZC_RV + (2 * hp + hl) * 64 + eg * 8);
        LAS unsigned short* d = VT + (hl * 64 + eg * 8) * RT_PITCH + t;
        d[0 * RT_PITCH] = (unsigned short)(v.x & 0xffffu); d[1 * RT_PITCH] = (unsigned short)(v.x >> 16); d[2 * RT_PITCH] = (unsigned short)(v.y & 0xffffu); d[3 * RT_PITCH] = (unsigned short)(v.y >> 16);
        d[4 * RT_PITCH] = (unsigned short)(v.z & 0xffffu); d[5 * RT_PITCH] = (unsigned short)(v.z >> 16); d[6 * RT_PITCH] = (unsigned short)(v.w & 0xffffu); d[7 * RT_PITCH] = (unsigned short)(v.w >> 16); }
    __syncthreads();
    {
        const int hl = wave >> 2, h = 2 * hp + hl, ib = wave & 3, r32 = lane & 31, hh = lane >> 5;
        const float lgf = log2_gamma(KIN(8)[(l * 2 + 0) * 4 + h]), lgb = log2_gamma(KIN(8)[(l * 2 + 1) * 4 + h]);
        const int iloc = ib * 32 + r32;
        bf16x8 qf[4];
#pragma unroll
        for (int s = 0; s < 4; ++s) qf[s] = *(const bf16x8*)(RQ + (size_t)(row0 + iloc) * 256 + h * 64 + s * 16 + hh * 8);
        const bf16* Sf = SS + ((size_t)((b * 4 + h) * NPF + pf) * 2 + 0) * 4096; const bf16* Sb = Sf + 4096;
        f32x16 Y[2];
        {
            const float af = exp2f((float)(iloc + 1) * lgf), ab = exp2f((float)(128 - iloc) * lgb);
#pragma unroll
            for (int et = 0; et < 2; ++et) {
                f32x16 cf = {}, cb = {};
#pragma unroll
                for (int s = 0; s < 4; ++s) {
                    const bf16x8 a0 = *(const bf16x8*)(Sf + (et * 32 + r32) * 64 + s * 16 + hh * 8), a1 = *(const bf16x8*)(Sb + (et * 32 + r32) * 64 + s * 16 + hh * 8);
                    cf = __builtin_amdgcn_mfma_f32_32x32x16_bf16(a0, qf[s], cf, 0, 0, 0); cb = __builtin_amdgcn_mfma_f32_32x32x16_bf16(a1, qf[s], cb, 0, 0, 0);
                }
#pragma unroll
                for (int q = 0; q < 16; ++q) Y[et][q] = af * cf[q] + ab * cb[q];
            }
        }
        const LAS unsigned short* VTh = VT + hl * 64 * RT_PITCH;
#pragma unroll 1
        for (int jt = 0; jt < 4; ++jt) {
            f32x16 X = {};
#pragma unroll
            for (int s = 0; s < 4; ++s) { const bf16x8 a = *(const bf16x8*)(RK + (size_t)(row0 + jt * 32 + r32) * 256 + h * 64 + s * 16 + hh * 8);
                X = __builtin_amdgcn_mfma_f32_32x32x16_bf16(a, qf[s], X, 0, 0, 0); }
#pragma unroll
            for (int q = 0; q < 16; ++q) { const int jloc = jt * 32 + (q & 3) + 8 * (q >> 2) + 4 * hh; const int dl = iloc - jloc;
                X[q] *= (dl >= 0) ? exp2f((float)dl * lgf) : exp2f((float)(-dl) * lgb); }
#pragma unroll
            for (int s = 0; s < 2; ++s) {
                v4u pw; pw.x = pk2(X[8 * s + 0], X[8 * s + 1]); pw.y = pk2(X[8 * s + 2], X[8 * s + 3]); pw.z = pk2(X[8 * s + 4], X[8 * s + 5]); pw.w = pk2(X[8 * s + 6], X[8 * s + 7]);
                const bf16x8 bfrag = __builtin_bit_cast(bf16x8, pw);
#pragma unroll
                for (int et = 0; et < 2; ++et) {
                    const LAS unsigned short* vp = VTh + (et * 32 + r32) * RT_PITCH + jt * 32 + 16 * s + 4 * hh;
                    const v2u lo = *(const LAS v2u*)vp, hi2 = *(const LAS v2u*)(vp + 8);
                    v4u aw; aw.x = lo.x; aw.y = lo.y; aw.z = hi2.x; aw.w = hi2.y;
                    Y[et] = __builtin_amdgcn_mfma_f32_32x32x16_bf16(__builtin_bit_cast(bf16x8, aw), bfrag, Y[et], 0, 0, 0);
                }
            }
        }
        float s1 = 0.f;
#pragma unroll
        for (int q = 0; q < 16; ++q) s1 += Y[0][q] + Y[1][q];
        s1 += __shfl_xor(s1, 32); const float mu = s1 * (1.0f / 64.0f); float s2 = 0.f;
#pragma unroll
        for (int q = 0; q < 16; ++q) { const float d0 = Y[0][q] - mu, d1 = Y[1][q] - mu; s2 += d0 * d0 + d1 * d1; }
        s2 += __shfl_xor(s2, 32); const float rstd = 1.0f / sqrtf(s2 * (1.0f / 64.0f) + LN_EPS);
        const size_t row = (size_t)(row0 + iloc);
#pragma unroll
        for (int et = 0; et < 2; ++et)
#pragma unroll
            for (int q4 = 0; q4 < 4; ++q4) { const int e0 = et * 32 + 8 * q4 + 4 * hh;
                float gz[4]; unpack4(*(const uint2*)(Z + row * INW + ZC_RG + h * 64 + e0), gz);
                const f32x4 gn = *(const f32x4*)(KIN(9) + l * 256 + h * 64 + e0);
                float o[4];
#pragma unroll
                for (int i = 0; i < 4; ++i) { const float yn = (Y[et][4 * q4 + i] - mu) * rstd * gn[i]; o[i] = yn * (gz[i] / (1.0f + expf(-gz[i]))); }
                *(uint2*)(MIX + row * DM + 256 + h * 64 + e0) = pack4(o); }
    }
    __syncthreads();
}
__device__ __forceinline__ void p5(const Args& A, int l, LAS unsigned char* lds, int tid, int lane, int wave) {
    const int g0 = (l == DEPTH - 1) ? 16 : 0;
    for (int u = opaque_bid(); u < (272 - g0) * 2; u += gridDim.x) p5_unit(A, l, g0 + (u >> 1), u & 1, lds, tid, lane, wave);
}

__device__ __forceinline__ float reduce32(float (&v)[32], int lane) {
#pragma unroll
    for (int i = 0; i < 16; ++i) { const bool up = lane & 32; const float send = up ? v[i] : v[i + 16], keep = up ? v[i + 16] : v[i]; v[i] = keep + __shfl_xor(send, 32); }
#pragma unroll
    for (int i = 0; i < 8; ++i) { const bool up = lane & 16; const float send = up ? v[i] : v[i + 8], keep = up ? v[i + 8] : v[i]; v[i] = keep + __shfl_xor(send, 16); }
#pragma unroll
    for (int i = 0; i < 4; ++i) { const bool up = lane & 8; const float send = up ? v[i] : v[i + 4], keep = up ? v[i + 4] : v[i]; v[i] = keep + __shfl_xor(send, 8); }
#pragma unroll
    for (int i = 0; i < 2; ++i) { const bool up = lane & 4; const float send = up ? v[i] : v[i + 2], keep = up ? v[i + 2] : v[i]; v[i] = keep + __shfl_xor(send, 4); }
    { const bool up = lane & 2; const float send = up ? v[0] : v[1], keep = up ? v[1] : v[0]; v[0] = keep + __shfl_xor(send, 2); }
    return v[0] + __shfl_xor(v[0], 1);
}
struct P7Raw { v4u x[4]; uint2 y[4]; };
__device__ __forceinline__ void p7_load(int l, int r, int lane, const float* xin_lat, const float* xin_ctx, const bf16* XSA, const bf16* Y, P7Raw& R) {
    if (l == 0) { const float* p = (r < RCTX) ? xin_ctx + (size_t)r * DM : xin_lat + (size_t)(r - RCTX) * DM;
#pragma unroll
        for (int j = 0; j < 4; ++j) R.x[j] = *(const v4u*)(p + 256 * j + 4 * lane); }
    else { const bf16* p = XSA + (size_t)r * DM;
#pragma unroll
        for (int j = 0; j < 4; ++j) { const uint2 u = *(const uint2*)(p + 256 * j + 4 * lane); R.x[j] = (v4u){u.x, u.y, 0u, 0u}; } }
    const bf16* q = Y + (size_t)r * DM;
#pragma unroll
    for (int j = 0; j < 4; ++j) R.y[j] = *(const uint2*)(q + 256 * j + 4 * lane);
}
__device__ __forceinline__ void p7_ln(int l, int r, int lane, const P7Raw& R, const float* mv, const float* lng, const float* lnb, bf16* XSA, unsigned char* H2, f32x4 (&hv)[4]) {
    f32x4 v[4];
#pragma unroll
    for (int j = 0; j < 4; ++j) {
        f32x4 x;
        if (l == 0) x = __builtin_bit_cast(f32x4, R.x[j]);
        else { const unsigned a = R.x[j][0], b = R.x[j][1]; x = (f32x4){bflo(a), bfhi(a), bflo(b), bfhi(b)}; }
        const f32x4 y = (f32x4){bflo(R.y[j].x), bfhi(R.y[j].x), bflo(R.y[j].y), bfhi(R.y[j].y)};
        const f32x4 g1 = *(const f32x4*)(mv + 2 * DM + 256 * j + 4 * lane); v[j] = ALPHA * x + g1 * y; }
    ln_row(v, lng, lnb, lane);
    store_row_bf16(XSA + (size_t)r * DM, lane, v);
    modulate(v, mv + 4 * DM, mv + 3 * DM, lane, hv);
#pragma unroll
    for (int j = 0; j < 4; ++j) *(unsigned*)(H2 + (size_t)r * DM + 256 * j + 4 * lane) = (unsigned)__builtin_amdgcn_cvt_pk_fp8_f32(hv[j][2], hv[j][3], __builtin_amdgcn_cvt_pk_fp8_f32(hv[j][0], hv[j][1], 0, false), true);
}
__device__ __forceinline__ void p7_route(const Args& A, float logit, int r, int rloc, int lane, LAS int* lcnt, LAS int* ent) {
    float val = logit; const int idx = lane >> 1; float tv[4]; int te[4];
#pragma unroll
    for (int k = 0; k < 4; ++k) {
        float bv = val; int bi = idx;
#pragma unroll
        for (int o = 1; o < 64; o <<= 1) { const float ov = __shfl_xor(bv, o); const int oi = __shfl_xor(bi, o); const bool take = (ov > bv) || (ov == bv && oi < bi); bv = take ? ov : bv; bi = take ? oi : bi; }
        tv[k] = bv; te[k] = bi; val = (idx == bi) ? -INFINITY : val;
    }
    const float p1 = expf(tv[1] - tv[0]), p2 = expf(tv[2] - tv[0]), p3 = expf(tv[3] - tv[0]); const float inv = 1.0f / (1.0f + p1 + p2 + p3);
    if (lane < 4) {
        const int e = (lane == 0) ? te[0] : (lane == 1) ? te[1] : (lane == 2) ? te[2] : te[3];
        const float w = ((lane == 0) ? 1.0f : (lane == 1) ? p1 : (lane == 2) ? p2 : p3) * inv;
        const int lp = __hip_atomic_fetch_add(lcnt + e, 1, __ATOMIC_RELAXED, __HIP_MEMORY_SCOPE_WORKGROUP);
        ent[rloc * 4 + lane] = e | (lp << 8);
        ((float*)(KWS() + WS_RW))[(size_t)r * 4 + lane] = w;
    }
}
__device__ __forceinline__ void p7(const Args& A, int l, LAS unsigned char* lds, int tid, int lane, int wave) {
    unsigned char* ws = KWS();
    const int row_lo = (l == DEPTH - 1) ? RCTX : 0, nrows = RTOT - row_lo;
    const int NGW = gridDim.x * NWAVES, RPW = (nrows + NGW - 1) / NGW, wg_row0 = row_lo + opaque_bid() * NWAVES * RPW;
    LAS f32x4* WL = (LAS f32x4*)(lds + RING_OFF);
    LAS int* lcnt = (LAS int*)(lds + LCNT_OFF); LAS int* lbase = (LAS int*)(lds + LBASE_OFF); LAS int* ent = (LAS int*)(lds + ENT_OFF);
    const float* wr = KIN(15) + (size_t)l * DM * NEXP;
    for (int s = tid; s < 8192; s += NWAVES * 64) { const int ln = s & 63, eg = (s >> 6) & 7, jc = s >> 9; const int k = 256 * (jc >> 2) + 4 * ln + (jc & 3);
        WL[s] = *(const f32x4*)(wr + (size_t)k * NEXP + 4 * eg); }
    if (tid < 32) lcnt[tid] = 0;
    __syncthreads();
    const float bias_e = KIN(16)[l * NEXP + (lane >> 1)];
    const int w_row0 = wg_row0 + wave * RPW;
    const float* xin_lat = KIN(0); const float* xin_ctx = KIN(2); const float* lng = KIN(13) + (size_t)(l * 2 + 0) * DM; const float* lnb = KIN(14) + (size_t)(l * 2 + 0) * DM;
    bf16* XSA = (bf16*)(ws + WS_XSA); const bf16* Yb = (const bf16*)(ws + WS_Y); unsigned char* H2 = ws + WS_H2; const float* MODV = (const float*)(ws + WS_MODV);
    const int nmy = (w_row0 + RPW <= RTOT) ? RPW : ((RTOT > w_row0) ? RTOT - w_row0 : 0);
    P7Raw cur, nxt;
    if (nmy > 0) p7_load(l, w_row0, lane, xin_lat, xin_ctx, XSA, Yb, cur);
    for (int i = 0; i < nmy; ++i) {
        const int r0 = w_row0 + i;
        p7_load(l, (i + 1 < nmy) ? r0 + 1 : r0, lane, xin_lat, xin_ctx, XSA, Yb, nxt);
        f32x4 h0[4];
        p7_ln(l, r0, lane, cur, MODV + (size_t)(l * 9 + mod_row(r0)) * NMOD, lng, lnb, XSA, H2, h0);
        cur = nxt;
        f32x4 acc[8];
#pragma unroll
        for (int eg = 0; eg < 8; ++eg) acc[eg] = (f32x4){0.f, 0.f, 0.f, 0.f};
#pragma unroll
        for (int j = 0; j < 4; ++j)
#pragma unroll
            for (int c = 0; c < 4; ++c) { const float xa = h0[j][c];
#pragma unroll
                for (int eg = 0; eg < 8; ++eg) acc[eg] = WL[((j * 4 + c) * 8 + eg) * 64 + lane] * xa + acc[eg]; }
        float a0[32];
#pragma unroll
        for (int e = 0; e < 32; ++e) a0[e] = acc[e >> 2][e & 3];
        const float lg0 = reduce32(a0, lane) + bias_e;
        p7_route(A, lg0, r0, r0 - wg_row0, lane, lcnt, ent);
    }
    __syncthreads();
    if (tid < 32) lbase[tid] = (int)__hip_atomic_fetch_add((unsigned*)(ws + WS_CTL) + CW_GCNT + (l * 32 + tid) * 16, (unsigned)lcnt[tid], __ATOMIC_RELAXED, __HIP_MEMORY_SCOPE_AGENT);
    __syncthreads();
    { const int nent = NWAVES * RPW * 4; int* RE = (int*)(ws + WS_RE); int* RP = (int*)(ws + WS_RP);
        for (int i = tid; i < nent; i += NWAVES * 64) { const int row = wg_row0 + (i >> 2); if (row < RTOT) { const int v = ent[i], e = v & 255, lp = v >> 8;
            RE[(size_t)row * 4 + (i & 3)] = e; RP[(size_t)row * 4 + (i & 3)] = lbase[e] + lp; } } }
    __syncthreads();
}
__device__ __forceinline__ void moe_offsets(const Args& A, int l, LAS unsigned char* lds, int tid) {
    volatile LAS int* offt = (volatile LAS int*)(lds + OFFT_OFF);
    if (tid < 64) {
        const unsigned c = __hip_atomic_load((unsigned*)(KWS() + WS_CTL) + CW_GCNT + (l * 32 + (tid & 31)) * 16, __ATOMIC_RELAXED, __HIP_MEMORY_SCOPE_AGENT);
        int x = (int)((c + 255u) >> 8);
#pragma unroll
        for (int o = 1; o < 32; o <<= 1) { const int v = __shfl_up(x, o); if ((tid & 31) >= o) x += v; }
        if (tid < 32) offt[tid + 1] = x;
        if (tid == 0) offt[0] = 0;
    }
    __syncthreads();
}
__device__ __forceinline__ void p8(const Args& A, int l, LAS unsigned char* lds, int tid, int lane, int wave) {
    unsigned char* ws = KWS();
    moe_offsets(A, l, lds, tid);
    volatile LAS int* offt = (volatile LAS int*)(lds + OFFT_OFF);
    const int row_lo = (l == DEPTH - 1) ? RCTX : 0, nrows = RTOT - row_lo;
    const int NGW = gridDim.x * NWAVES, RPW = (nrows + NGW - 1) / NGW, w_row0 = row_lo + (opaque_bid() * NWAVES + wave) * RPW;
    const int* RE = (const int*)(ws + WS_RE); const int* RP = (const int*)(ws + WS_RP); const float* RW = (const float*)(ws + WS_RW);
    int* SLOT = (int*)(ws + WS_SLOT); float* ROWW = (float*)(ws + WS_ROWW); const unsigned char* H2 = ws + WS_H2; unsigned char* XS2 = ws + WS_XS2;
    for (int r = w_row0; r < w_row0 + RPW && r < RTOT; ++r) {
        const int e4 = RE[(size_t)r * 4 + (lane & 3)], p4 = RP[(size_t)r * 4 + (lane & 3)]; const int slot_l = offt[e4 & 31] * 256 + p4;
        const v4u a = *(const v4u*)(H2 + (size_t)r * DM + 16 * lane);
#pragma unroll
        for (int k = 0; k < 4; ++k) { const int slot = __shfl(slot_l, k); *(v4u*)(XS2 + (size_t)slot * DM + 16 * lane) = a; }
        if (lane < 4) { SLOT[(size_t)r * 4 + lane] = slot_l; ROWW[slot_l] = RW[(size_t)r * 4 + lane]; }
    }
}
__device__ __forceinline__ void moe_order(pg8::MoeOrder& S, LAS unsigned char* lds, int sh) {
    volatile LAS int* offt = (volatile LAS int*)(lds + OFFT_OFF);
#pragma unroll
    for (int j = 0; j < 11; ++j) { unsigned w = 0;
#pragma unroll
        for (int q = 0; q < 3; ++q) { const int k = 3 * j + q + 1; if (k <= 32) w |= ((unsigned)offt[k] & 1023u) << (10 * q); }
        S.pk[j] = (unsigned)__builtin_amdgcn_readfirstlane((int)w); }
    S.nt = __builtin_amdgcn_readfirstlane(offt[32]); S.sh = sh; S.G = gridDim.x; S.c = opaque_bid();
}
struct P11Raw { uint2 y[4][4]; uint2 x[4]; };
__device__ __forceinline__ void p11_load(int r, int lane, int s0, int s1, int s2, int s3, const bf16* YB, const bf16* XSA, P11Raw& R) {
    const int sl[4] = {s0, s1, s2, s3};
#pragma unroll
    for (int k = 0; k < 4; ++k) { const bf16* p = YB + (size_t)sl[k] * DM;
#pragma unroll
        for (int j = 0; j < 4; ++j) R.y[k][j] = *(const uint2*)(p + 256 * j + 4 * lane); }
    const bf16* q = XSA + (size_t)r * DM;
#pragma unroll
    for (int j = 0; j < 4; ++j) R.x[j] = *(const uint2*)(q + 256 * j + 4 * lane);
}
__device__ __forceinline__ void p11(const Args& A, int l, int lane, int wave) {
    unsigned char* ws = KWS();
    const bool last = (l == DEPTH - 1);
    const int row_lo = last ? RCTX : 0, nrows = RTOT - row_lo;
    const int NGW = gridDim.x * NWAVES, RPW = (nrows + NGW - 1) / NGW, w_row0 = row_lo + (opaque_bid() * NWAVES + wave) * RPW;
    const int* SLOT = (const int*)(ws + WS_SLOT); const bf16* YB = (const bf16*)(ws + WS_YB); bf16* XSA = (bf16*)(ws + WS_XSA); bf16* XH = (bf16*)(ws + WS_XH);
    const float* MODV = (const float*)(ws + WS_MODV); float* outp = KOUT();
    const float* lng = KIN(13) + (size_t)(l * 2 + 1) * DM; const float* lnb = KIN(14) + (size_t)(l * 2 + 1) * DM;
    const int nmy = (w_row0 + RPW <= RTOT) ? RPW : ((RTOT > w_row0) ? RTOT - w_row0 : 0);
    const int sa = (lane < nmy * 4) ? SLOT[(size_t)w_row0 * 4 + lane] : 0, sb = (64 + lane < nmy * 4) ? SLOT[(size_t)w_row0 * 4 + 64 + lane] : 0;
#define P11_SLOT(idx) (((idx) < 64) ? __builtin_amdgcn_readlane(sa, (idx) & 63) : __builtin_amdgcn_readlane(sb, (idx) & 63))
    P11Raw cur, nxt;
    if (nmy > 0) p11_load(w_row0, lane, P11_SLOT(0), P11_SLOT(1), P11_SLOT(2), P11_SLOT(3), YB, XSA, cur);
    for (int i = 0; i < nmy; ++i) {
        const int r = w_row0 + i;
        { const int in = (i + 1 < nmy) ? i + 1 : i, q = 4 * in; p11_load(w_row0 + in, lane, P11_SLOT(q), P11_SLOT(q + 1), P11_SLOT(q + 2), P11_SLOT(q + 3), YB, XSA, nxt); }
        const float* mv = MODV + (size_t)(l * 9 + mod_row(r)) * NMOD;
        f32x4 v[4];
#pragma unroll
        for (int j = 0; j < 4; ++j) {
            f32x4 f = {0.f, 0.f, 0.f, 0.f};
#pragma unroll
            for (int k = 0; k < 4; ++k) f += (f32x4){bflo(cur.y[k][j].x), bfhi(cur.y[k][j].x), bflo(cur.y[k][j].y), bfhi(cur.y[k][j].y)};
            const f32x4 x = (f32x4){bflo(cur.x[j].x), bfhi(cur.x[j].x), bflo(cur.x[j].y), bfhi(cur.x[j].y)};
            const f32x4 g2 = *(const f32x4*)(mv + 5 * DM + 256 * j + 4 * lane); v[j] = ALPHA * x + g2 * f; }
        ln_row(v, lng, lnb, lane);
        if (last) store_row_f32(outp + (size_t)(r - RCTX) * DM, lane, v);
        else { store_row_bf16(XSA + (size_t)r * DM, lane, v);
            const float* mn = MODV + (size_t)((l + 1) * 9 + mod_row(r)) * NMOD; f32x4 o[4]; modulate(v, mn + 1 * DM, mn + 0 * DM, lane, o);
            store_row_bf16(XH + (size_t)r * DM, lane, o); }
        cur = nxt;
    }
#undef P11_SLOT
}

#define GRID_BAR() do { if (N_LAUNCHES == 1) { xcd_barrier(bar); } } while (0)
#define IN(k) (lo <= (k) && (k) < hi)
#define SEAM(k) do { if (IN(k) && IN((k) + 1)) GRID_BAR(); } while (0)
#ifndef PROBE_MASK
#define PROBE_MASK 0
#endif
#define REP(p) for (int rep_ = 0; rep_ < (((PROBE_MASK) >> (p)) & 1) + 1; ++rep_)
#define IDS() const int tid = opaque_tid(), lane = tid & 63, wave = __builtin_amdgcn_readfirstlane(tid >> 6); (void)lane; (void)wave
template <int L> __device__ __forceinline__ void layer_phases(const Args& args, LAS unsigned char* lds, unsigned char* lds_raw, const XcdBarrier& bar, int lo, int hi) {
        constexpr int l = L;
        const int pb = N_PRO + l * N_PER_LAYER; const bool last = (l == DEPTH - 1);
        if (IN(pb + 0)) REP(0) { unsigned char* ws = KWS();
            pg8::Gemm g{(const bf16*)(ws + WS_XH), (const bf16*)(ws + WS_WIN) + (size_t)l * INW * DM, RTOT, INW, DM}; pg8::StaticOrder S; S.init(RTOT, INW, (int)gridDim.x, opaque_bid());
            pg8::EpiBf16 E{(bf16*)(ws + WS_Z), INW};
            pg8::gemm_phase<pg8::EpiBf16, pg8::StaticOrder, true, true>(lds + RING_OFF, g, S, E);
        } SEAM(pb + 0);
        if (IN(pb + 1)) REP(1) { IDS(); p2(args, l, lds, tid, lane, wave); } SEAM(pb + 1);
        if (IN(pb + 2)) REP(2) { IDS(); p4_scan(args, l, tid); p4_attention(args, l, (char*)lds_raw + RING_OFF); } SEAM(pb + 2);
        if (IN(pb + 3)) REP(3) { IDS(); p5(args, l, lds, tid, lane, wave); } SEAM(pb + 3);
        if (IN(pb + 4)) REP(4) { unsigned char* ws = KWS();
            const int r0 = last ? RCTX : 0, M = RTOT - r0;
            pg8::Gemm g{(const bf16*)(ws + WS_MIX) + (size_t)r0 * DM, (const bf16*)(ws + WS_WOUT) + (size_t)l * DM * DM, M, DM, DM}; pg8::StaticOrder S; S.init(M, DM, (int)gridDim.x, opaque_bid());
            pg8::EpiBf16 E{(bf16*)(ws + WS_Y) + (size_t)r0 * DM, DM};
            pg8::gemm_phase<pg8::EpiBf16, pg8::StaticOrder, true, true>(lds + RING_OFF, g, S, E);
        } SEAM(pb + 4);
        if (IN(pb + 5)) { IDS(); p7(args, l, lds, tid, lane, wave); } SEAM(pb + 5);
        if (IN(pb + 6)) REP(6) { IDS(); p8(args, l, lds, tid, lane, wave); } SEAM(pb + 6);
        if (IN(pb + 7)) REP(7) { IDS(); unsigned char* ws = KWS();
            moe_offsets(args, l, lds, tid);
            pg8::MoeOrder S; moe_order(S, lds, 3);
            pg8::Gemm g{(const bf16*)(ws + WS_XS2), (const bf16*)(ws + WS_WGU + (size_t)l * NEXP * 2048 * DM), MAXTILES * 256, NEXP * 2048, DM / 2};
            pg8::EpiSwiglu E{ws + WS_ACT, KIN(18) + (size_t)l * NEXP * 2048};
            pg8::gemm_phase<pg8::EpiSwiglu, pg8::MoeOrder, true, true, true>(lds + RING_OFF, g, S, E);
        } SEAM(pb + 7);
        if (IN(pb + 8)) REP(8) { IDS(); unsigned char* ws = KWS();
            moe_offsets(args, l, lds, tid);
            pg8::MoeOrder S; moe_order(S, lds, 2);
            pg8::Gemm g{(const bf16*)(ws + WS_ACT), (const bf16*)(ws + WS_WD + (size_t)l * NEXP * DM * DM), MAXTILES * 256, NEXP * DM, DM / 2};
            pg8::EpiDown E{(bf16*)(ws + WS_YB), KIN(20) + (size_t)l * NEXP * DM, (const float*)(ws + WS_ROWW)};
            pg8::gemm_phase<pg8::EpiDown, pg8::MoeOrder, true, true, true>(lds + RING_OFF, g, S, E);
        } SEAM(pb + 8);
        if (IN(pb + 9)) { IDS(); p11(args, l, lane, wave); } SEAM(pb + 9);
}

__global__ void __launch_bounds__(NWAVES * 64, 2) mk_fwd(Args args) {
    extern __shared__ __attribute__((aligned(16))) unsigned char lds_raw[];
    LAS unsigned char* lds = (LAS unsigned char*)lds_raw;
    volatile LAS unsigned* MISC = (volatile LAS unsigned*)(lds + MISC_OFF);
    gu32* ctl = (gu32*)(KWS() + WS_CTL);
    for (int u = threadIdx.x; u < (LDS_BYTES - LDSCTL_OFF) / 4; u += NWAVES * 64) ((LAS unsigned*)(lds + LDSCTL_OFF))[u] = 0u;
    __syncthreads();
    XcdBarrier bar; bar.bar = (unsigned*)(ctl + CW_BAR); bar.x = 0; bar.st = nullptr;
    if (N_LAUNCHES == 1) bar = xcd_barrier_post((unsigned*)(ctl + CW_BAR), MISC + 8);
    const int lo = args.ph_lo, hi = args.ph_hi;

    if (IN(0)) REP(10) { IDS(); p0a(args, lds, tid, lane, wave); } SEAM(0);
    if (IN(1)) REP(11) { IDS(); p0b(args, tid); } SEAM(1);
    if (IN(2)) REP(12) { IDS(); p0c(args, lane, wave); } SEAM(2);

    layer_phases<0>(args, lds, lds_raw, bar, lo, hi);
    layer_phases<1>(args, lds, lds_raw, bar, lo, hi);
    static_assert(DEPTH == 2, "two layer instances");
}
#undef IN
#undef IDS
#undef SEAM
#undef GRID_BAR

extern "C" void kernel_launch(void* const* d_in, const int* in_sizes, int n_in, void* d_out, int out_size, void* d_ws, size_t ws_size, hipStream_t stream) {
    static int grid = 0;
    if (grid == 0) {
        if (n_in != 21 || in_sizes[0] != RLAT * DM || out_size != RLAT * DM || ws_size < WS_END) { fprintf(stderr, "kernel_launch: unexpected shapes / workspace (n_in %d, ws %zu < %zu); nothing launched\n", n_in, ws_size, (size_t)WS_END); grid = -1; return; }
        int dev = 0, cus = 0, per_cu = 0;
        if (hipGetDevice(&dev) != hipSuccess || hipDeviceGetAttribute(&cus, hipDeviceAttributeMultiprocessorCount, dev) != hipSuccess) { grid = -1; return; }
        if (hipFuncSetAttribute((const void*)mk_fwd, hipFuncAttributeMaxDynamicSharedMemorySize, LDS_BYTES) != hipSuccess) { fprintf(stderr, "kernel_launch: hipFuncSetAttribute failed\n"); grid = -1; return; }
        if (hipOccupancyMaxActiveBlocksPerMultiprocessor(&per_cu, (const void*)mk_fwd, NWAVES * 64, LDS_BYTES) != hipSuccess || per_cu < 1) fprintf(stderr, "kernel_launch: occupancy query reports %d\n", per_cu);
        (void)hipGetLastError();
        grid = cus;
        if (grid != 256) { fprintf(stderr, "kernel_launch: built for 256 CUs, found %d; nothing launched\n", grid); grid = -1; return; }
    }
    if (grid < 0) return;
    if (hipMemsetAsync((char*)d_ws + WS_CTL, 0, CTL_ZERO_BYTES, stream) != hipSuccess) return;
    Args a{};
    for (int i = 0; i < 21; ++i) a.in[i] = (const float*)d_in[i];
    a.out = (float*)d_out; a.ws = (unsigned char*)d_ws; a.pad = 0;
    for (int li = 0; li < N_LAUNCHES; ++li) {
        a.ph_lo = (N_LAUNCHES == 1) ? 0 : li; a.ph_hi = (N_LAUNCHES == 1) ? N_PHASES : li + 1; a.li = li;
        hipLaunchKernelGGL(mk_fwd, dim3(grid), dim3(NWAVES * 64), LDS_BYTES, stream, a);
        const hipError_t le = hipPeekAtLastError();
        if (le != hipSuccess) { fprintf(stderr, "kernel_launch: launch %d failed: %s\n", li, hipGetErrorName(le)); break; }
    }
}
```

```cpp
#include <hip/hip_runtime.h>
#include <cstdio>
#include <cstdint>
__device__ __forceinline__ int opaque_tid() { int t = (int)threadIdx.x; asm volatile("" : "+v"(t)); return t; }
__device__ __forceinline__ int opaque_bid() { int b = (int)blockIdx.x; asm volatile("" : "+s"(b)); return b; }
namespace pg8 {
#define PG8_LAS __attribute__((address_space(3)))
typedef unsigned short bf16_t;
typedef short bf16x8 __attribute__((ext_vector_type(8)));
typedef float f32x4 __attribute__((ext_vector_type(4)));
typedef unsigned u32x4 __attribute__((ext_vector_type(4)));
constexpr int BM = 256, BK = 64, HALF = 128, HTB = HALF * BK * 2  , STAGE_BYTES = 8 * HTB, NXCD = 8, WGM = 8;

__host__ __device__ __forceinline__ int lds_byte(int r, int c) { const int st = (r >> 4) * 2 + (c >> 5), rr = r & 15, cc = c & 31, ob = rr * 64 + cc * 2; return st * 1024 + (ob ^ (((ob >> 9) & 1) << 5)); }
__host__ __device__ __forceinline__ void stage_rc(int b, int& R, int& C) { const int st = b / 1024, sb = b % 1024, swz = sb ^ (((sb >> 9) & 1) << 5); R = (st >> 1) * 16 + swz / 64; C = (st & 1) * 32 + (swz % 64) / 2; }
__host__ __device__ __forceinline__ int perm32(int rho) { const int n = rho >> 4, i = rho & 15; return 8 * (i >> 2) + 4 * n + (i & 3); }

struct Unit { int pm, pn; };
struct Gemm { const bf16_t* A; const bf16_t* Bt; int M, N, K; };

struct StaticOrder {
    int nM, nN, nwg, G, c;
    __host__ __device__ void init(int M, int N, int G_, int c_) { nM = M / BM; nN = N / BM; nwg = nM * nN; G = G_; c = c_; }
    __host__ __device__ bool next(int i, Unit& u) const {
        const long L = (long)i * G + c; if (L >= nwg) return false;
        int wgid = (int)L; { const int q = nwg / NXCD, r = nwg % NXCD, xcd = wgid % NXCD, off = wgid / NXCD; wgid = (xcd < r ? xcd * (q + 1) : r * (q + 1) + (xcd - r) * q) + off; }
        const int nig = WGM * nN, gid = wgid / nig, fm = gid * WGM, gsz = (nM - fm) < WGM ? (nM - fm) : WGM;
        u.pm = fm + ((wgid % nig) % gsz); u.pn = (wgid % nig) / gsz; return true;
    }
    __device__ __forceinline__ void a_ready(const Unit&) const {}
    __device__ __forceinline__ void done(const Unit&) const {}
};

__device__ __forceinline__ unsigned cvt_pk_bf16(float lo, float hi) { unsigned r; asm volatile("v_cvt_pk_bf16_f32 %0, %1, %2" : "=v"(r) : "v"(lo), "v"(hi)); return r; }
typedef float f32x2 __attribute__((ext_vector_type(2)));
struct EpiBf16 {
    static constexpr bool PERM = true, AFTER_DRAIN = false;
    bf16_t* O; int ldc;
    __device__ __forceinline__ void operator()(const f32x4 (&acc)[2][2][4][2], const Unit& u, int wr, int wc, int fr, int fq) const {
        const int row0 = u.pm * BM + wr * 64 + fr; const int col0 = u.pn * BM + wc * 32 + 8 * fq;
#pragma unroll
        for (int ai = 0; ai < 2; ++ai)
#pragma unroll
            for (int m = 0; m < 4; ++m) { bf16_t* rowp = O + (size_t)(row0 + ai * HALF + m * 16) * ldc + col0;
#pragma unroll
                for (int bj = 0; bj < 2; ++bj) { const f32x4 v0 = acc[ai][bj][m][0], v1 = acc[ai][bj][m][1];
                    u32x4 w; w.x = cvt_pk_bf16(v0[0], v0[1]); w.y = cvt_pk_bf16(v0[2], v0[3]); w.z = cvt_pk_bf16(v1[0], v1[1]); w.w = cvt_pk_bf16(v1[2], v1[3]);
                    *(u32x4*)(rowp + bj * HALF) = w; } }
    }
};
struct EpiSwiglu {
    static constexpr bool PERM = true, AFTER_DRAIN = false;
    unsigned char* O; const float* bias;
    static __device__ __forceinline__ float act1(float g, float up) {
        g = fminf(g, 7.0f); up = fminf(fmaxf(up, -7.0f), 7.0f);
        const float s = __builtin_amdgcn_rcpf(1.0f + __builtin_amdgcn_exp2f(g * (-1.702f * 1.4426950408889634f)));
        return (up + 1.0f) * (g * s);
    }
    __device__ __forceinline__ void operator()(const f32x4 (&acc)[2][2][4][2], const Unit& u, int wr, int wc, int fr, int fq) const {
        const int e = u.pn >> 3, pnl = u.pn & 7;
        const int row0 = u.pm * BM + wr * 64 + fr; const int j0 = pnl * HALF + wc * 32 + 8 * fq;
        const float* bg = bias + (size_t)e * 2048 + j0; const float* bu = bg + 1024;
        f32x4 bgv[2], buv[2];
#pragma unroll
        for (int n = 0; n < 2; ++n) { bgv[n] = *(const f32x4*)(bg + 4 * n); buv[n] = *(const f32x4*)(bu + 4 * n); }
#pragma unroll
        for (int ai = 0; ai < 2; ++ai)
#pragma unroll
            for (int m = 0; m < 4; ++m) { unsigned char* rowp = O + (size_t)(row0 + ai * HALF + m * 16) * 1024 + j0;
                f32x4 r0, r1;
                { const f32x4 g = acc[ai][0][m][0] * 0.03125f + bgv[0], up = acc[ai][1][m][0] * 0.03125f + buv[0];
                  r0[0] = act1(g[0], up[0]); r0[1] = act1(g[1], up[1]); r0[2] = act1(g[2], up[2]); r0[3] = act1(g[3], up[3]); }
                { const f32x4 g = acc[ai][0][m][1] * 0.03125f + bgv[1], up = acc[ai][1][m][1] * 0.03125f + buv[1];
                  r1[0] = act1(g[0], up[0]); r1[1] = act1(g[1], up[1]); r1[2] = act1(g[2], up[2]); r1[3] = act1(g[3], up[3]); }
                typedef unsigned u32x2 __attribute__((ext_vector_type(2))); u32x2 w;
                w.x = (unsigned)__builtin_amdgcn_cvt_pk_fp8_f32(r0[2], r0[3], __builtin_amdgcn_cvt_pk_fp8_f32(r0[0], r0[1], 0, false), true);
                w.y = (unsigned)__builtin_amdgcn_cvt_pk_fp8_f32(r1[2], r1[3], __builtin_amdgcn_cvt_pk_fp8_f32(r1[0], r1[1], 0, false), true);
                *(u32x2*)rowp = w; }
    }
};
struct EpiDown {
    static constexpr bool PERM = true, AFTER_DRAIN = false;
    unsigned char* O; const float* bias; const float* roww;
    __device__ __forceinline__ void operator()(const f32x4 (&acc)[2][2][4][2], const Unit& u, int wr, int wc, int fr, int fq) const {
        const int e = u.pn >> 2, pnl = u.pn & 3;
        const int row0 = u.pm * BM + wr * 64 + fr; const int col0 = pnl * BM + wc * 32 + 8 * fq;
        const float* bp = bias + (size_t)e * 1024 + col0;
        f32x4 bv[2][2];
#pragma unroll
        for (int bj = 0; bj < 2; ++bj)
#pragma unroll
            for (int n = 0; n < 2; ++n) bv[bj][n] = *(const f32x4*)(bp + bj * HALF + 4 * n);
#pragma unroll
        for (int ai = 0; ai < 2; ++ai)
#pragma unroll
            for (int m = 0; m < 4; ++m) { const int row = row0 + ai * HALF + m * 16; unsigned char* rowp = O + (size_t)row * 1024 + col0;
                const float wt = roww[row];
#pragma unroll
                for (int bj = 0; bj < 2; ++bj) { const f32x4 v0 = (acc[ai][bj][m][0] * 0.015625f + bv[bj][0]) * wt, v1 = (acc[ai][bj][m][1] * 0.015625f + bv[bj][1]) * wt;
                    typedef unsigned u32x2 __attribute__((ext_vector_type(2))); u32x2 w;
                    w.x = (unsigned)__builtin_amdgcn_cvt_pk_fp8_f32(v0[2], v0[3], __builtin_amdgcn_cvt_pk_fp8_f32(v0[0], v0[1], 0, false), true);
                    w.y = (unsigned)__builtin_amdgcn_cvt_pk_fp8_f32(v1[2], v1[3], __builtin_amdgcn_cvt_pk_fp8_f32(v1[0], v1[1], 0, false), true);
                    *(u32x2*)(rowp + bj * HALF) = w; } }
    }
};
struct MoeOrder {
    unsigned pk[11]; int nt, sh, G, c;
    __device__ __forceinline__ bool next(int i, Unit& u) const {
        const int L = i * G + c;
        if (L >= (nt << sh)) return false;
        const int tile = L >> sh, pnl = L & ((1 << sh) - 1); int e = 0;
#pragma unroll
        for (int k = 1; k < 32; ++k) { const int off = (int)((pk[(k - 1) / 3] >> (10 * ((k - 1) % 3))) & 1023u); e += (off <= tile) ? 1 : 0; }
        u.pm = __builtin_amdgcn_readfirstlane(tile); u.pn = __builtin_amdgcn_readfirstlane((e << sh) + pnl); return true;
    }
    __device__ __forceinline__ void a_ready(const Unit&) const {}
    __device__ __forceinline__ void done(const Unit&) const {}
};

template <class Epi, class Sched, bool ALIGN_EPI = false, bool SP2 = false, bool F8 = false>
__device__ __forceinline__ void gemm_phase(PG8_LAS unsigned char* lds, const Gemm g, const Sched& S, const Epi& E) {
    const int tid = opaque_tid(), wid = __builtin_amdgcn_readfirstlane(tid >> 6), lane = tid & 63, wr = wid >> 2, wc = wid & 3, fr = lane & 15, fq = lane >> 4;
    const int K = g.K, nt = K / BK;
    unsigned voffA[2], voffB[2];
#pragma unroll
    for (int i = 0; i < 2; ++i) { int R, C; stage_rc(tid * 16 + i * 8192, R, C); const int Rb = Epi::PERM ? ((R & ~31) + perm32(R & 31)) : R;
        voffA[i] = (unsigned)(R * K + C) * 2u; voffB[i] = (unsigned)(Rb * K + C) * 2u; }
    const size_t kstep = (size_t)(BK * 2);
    const size_t hstep = (size_t)HALF * K * 2;
    const size_t tstep = 2 * hstep;
    const unsigned ldsw = (unsigned)wid * 1024u;
    const int aoff = lds_byte(wr * 64 + fr, fq * 8), boff = lds_byte(wc * 32 + fr, fq * 8);
#define PG8_SA(b, h) (((b) * 2 + (h)) * HTB)
#define PG8_SB(b, h) ((4 + (b) * 2 + (h)) * HTB)
#define PG8_STAGE(bufoff, gbase, voff) do { _Pragma("unroll") for (int _i = 0; _i < 2; ++_i) { unsigned vo_ = (voff)[_i]; asm volatile("" : "+v"(vo_));     \
        __builtin_amdgcn_global_load_lds((const unsigned*)((const char*)(gbase) + vo_), (PG8_LAS unsigned*)(lds + (bufoff) + ldsw + _i * 8192), 16, 0, 0); } } while (0)
#define PG8_LDA(dst, b, h) do { _Pragma("unroll") for (int m = 0; m < 4; ++m) { if constexpr (F8) { \
            const i32x4_t lo_ = *(const PG8_LAS i32x4_t*)(lds + PG8_SA(b, h) + aoff + m * 2048), hi_ = *(const PG8_LAS i32x4_t*)(lds + PG8_SA(b, h) + aoff + m * 2048 + 1024); \
            dst##8[m] = __builtin_shufflevector(lo_, hi_, 0, 1, 2, 3, 4, 5, 6, 7); \
        } else { _Pragma("unroll") for (int k = 0; k < 2; ++k) dst[m][k] = *(const PG8_LAS bf16x8*)(lds + PG8_SA(b, h) + aoff + m * 2048 + k * 1024); } } } while (0)
#define PG8_LDB(dst, b, h) do { _Pragma("unroll") for (int n = 0; n < 2; ++n) { if constexpr (F8) { \
            const i32x4_t lo_ = *(const PG8_LAS i32x4_t*)(lds + PG8_SB(b, h) + boff + n * 2048), hi_ = *(const PG8_LAS i32x4_t*)(lds + PG8_SB(b, h) + boff + n * 2048 + 1024); \
            dst##8[n] = __builtin_shufflevector(lo_, hi_, 0, 1, 2, 3, 4, 5, 6, 7); \
        } else { _Pragma("unroll") for (int k = 0; k < 2; ++k) dst[n][k] = *(const PG8_LAS bf16x8*)(lds + PG8_SB(b, h) + boff + n * 2048 + k * 1024); } } } while (0)
#define PG8_MMA(ai, bj, At, Bt) do { __builtin_amdgcn_s_setprio(1); _Pragma("unroll") for (int m = 0; m < 4; ++m) _Pragma("unroll") for (int n = 0; n < 2; ++n) { \
        if constexpr (F8) {   \
            acc[ai][bj][m][n] = __builtin_amdgcn_mfma_scale_f32_16x16x128_f8f6f4(Bt##8[n], At##8[m], acc[ai][bj][m][n], 0, 0, 0, 0, 0, 0); \
        } else { _Pragma("unroll") for (int k = 0; k < 2; ++k) acc[ai][bj][m][n] = __builtin_amdgcn_mfma_f32_16x16x32_bf16(Bt[n][k], At[m][k], acc[ai][bj][m][n], 0, 0, 0); } } \
        __builtin_amdgcn_s_setprio(0); } while (0)
#define PG8_WAIT_V(n) asm volatile("s_waitcnt vmcnt(" #n ")" ::: "memory")
#define PG8_WAIT_L(n) asm volatile("s_waitcnt lgkmcnt(" #n ")" ::: "memory")
#define PG8_BAR __builtin_amdgcn_s_barrier()
#define PG8_SCHED __builtin_amdgcn_sched_barrier(0)
    Unit cur, nxt; int ui = 0;
    if (!S.next(0, cur)) return;
    f32x4 acc[2][2][4][2];
#pragma unroll
    for (int a = 0; a < 2; ++a)
#pragma unroll
        for (int b = 0; b < 2; ++b)
#pragma unroll
            for (int m = 0; m < 4; ++m)
#pragma unroll
                for (int n = 0; n < 2; ++n) acc[a][b][m][n] = (f32x4){0.f, 0.f, 0.f, 0.f};
    typedef int i32x4_t __attribute__((ext_vector_type(4))); typedef int i32x8_t __attribute__((ext_vector_type(8)));
    bf16x8 At[4][2], B0[2][2], B1[2][2];
    i32x8_t At8[4], B08[2], B18[2];
    const char* cA = (const char*)g.A + (size_t)cur.pm * tstep; const char* cB = (const char*)g.Bt + (size_t)cur.pn * tstep;
    S.a_ready(cur);
    if constexpr (SP2) {
        PG8_STAGE(PG8_SB(0, 0), cB, voffB); PG8_STAGE(PG8_SB(0, 1), cB + hstep, voffB); PG8_STAGE(PG8_SA(0, 0), cA, voffA); PG8_STAGE(PG8_SA(0, 1), cA + hstep, voffA);
        if (wr == 1) PG8_BAR;
        PG8_WAIT_V(2); PG8_BAR;
        PG8_STAGE(PG8_SB(1, 0), cB + kstep, voffB); PG8_STAGE(PG8_SA(1, 0), cA + kstep, voffA); PG8_STAGE(PG8_SB(1, 1), cB + hstep + kstep, voffB);
        PG8_WAIT_V(6); PG8_BAR;
    } else {
        PG8_STAGE(PG8_SB(0, 0), cB, voffB); PG8_STAGE(PG8_SA(0, 0), cA, voffA); PG8_STAGE(PG8_SB(0, 1), cB + hstep, voffB); PG8_STAGE(PG8_SA(0, 1), cA + hstep, voffA);
        if (wr == 1) PG8_BAR;
        PG8_WAIT_V(4); PG8_BAR;
        PG8_STAGE(PG8_SB(1, 0), cB + kstep, voffB); PG8_STAGE(PG8_SA(1, 0), cA + kstep, voffA); PG8_STAGE(PG8_SB(1, 1), cB + hstep + kstep, voffB);
        PG8_WAIT_V(6); PG8_BAR;
    }
    for (;;) {
        const bool has_next = S.next(ui + 1, nxt);
        const char* nA = has_next ? (const char*)g.A + (size_t)nxt.pm * tstep : cA; const char* nB = has_next ? (const char*)g.Bt + (size_t)nxt.pn * tstep : cB;
#pragma unroll 1
        for (int t = 0; t < nt; t += 2) {
            const bool last = (t == nt - 2);
            const char* a1 = cA + (size_t)(t + 1) * kstep;
            const char* a2 = last ? nA : cA + (size_t)(t + 2) * kstep; const char* b2 = last ? nB : cB + (size_t)(t + 2) * kstep;
            const char* a3 = a2 + kstep; const char* b3 = b2 + kstep;
            const char* a1h = a1 + hstep; const char* a2h = a2 + hstep; const char* b2h = b2 + hstep; const char* a3h = a3 + hstep; const char* b3h = b3 + hstep;
            asm volatile("" : "+s"(a1h), "+s"(a2), "+s"(a2h), "+s"(b2), "+s"(b2h), "+s"(a3), "+s"(a3h), "+s"(b3), "+s"(b3h));
            if (last && has_next) S.a_ready(nxt);
            if constexpr (SP2) {
            PG8_LDB(B0, 0, 0); PG8_LDB(B1, 0, 1); PG8_SCHED; PG8_LDA(At, 0, 0); PG8_STAGE(PG8_SA(1, 1), a1h, voffA);
            PG8_WAIT_V(8); PG8_WAIT_L(0); PG8_BAR; PG8_MMA(0, 0, At, B0); PG8_MMA(0, 1, At, B1); PG8_BAR; PG8_SCHED;
            PG8_LDA(At, 0, 1); PG8_STAGE(PG8_SB(0, 0), b2, voffB); PG8_STAGE(PG8_SB(0, 1), b2h, voffB); PG8_STAGE(PG8_SA(0, 0), a2, voffA);
            PG8_WAIT_V(8); PG8_WAIT_L(0); PG8_BAR; PG8_MMA(1, 0, At, B0); PG8_MMA(1, 1, At, B1); PG8_BAR; PG8_SCHED;
            PG8_LDB(B0, 1, 0); PG8_LDB(B1, 1, 1); PG8_SCHED; PG8_LDA(At, 1, 0); PG8_STAGE(PG8_SA(0, 1), a2h, voffA);
            PG8_WAIT_V(8); PG8_WAIT_L(0); PG8_BAR; PG8_MMA(0, 0, At, B0); PG8_MMA(0, 1, At, B1); PG8_BAR; PG8_SCHED;
            PG8_LDA(At, 1, 1); PG8_STAGE(PG8_SB(1, 0), b3, voffB); PG8_STAGE(PG8_SB(1, 1), b3h, voffB); PG8_STAGE(PG8_SA(1, 0), a3, voffA);
            PG8_WAIT_V(8); PG8_WAIT_L(0); PG8_BAR; PG8_MMA(1, 0, At, B0); PG8_MMA(1, 1, At, B1); PG8_BAR; PG8_SCHED;
            } else {
            PG8_LDB(B0, 0, 0); PG8_SCHED; PG8_LDA(At, 0, 0); PG8_STAGE(PG8_SA(1, 1), a1h, voffA);
            PG8_WAIT_L(8); PG8_BAR; PG8_WAIT_L(0); PG8_MMA(0, 0, At, B0); PG8_BAR; PG8_SCHED;
            PG8_LDB(B1, 0, 1); PG8_STAGE(PG8_SB(0, 0), b2, voffB);
            PG8_BAR; PG8_WAIT_L(0); PG8_MMA(0, 1, At, B1); PG8_BAR;
            PG8_LDA(At, 0, 1); PG8_STAGE(PG8_SA(0, 0), a2, voffA);
            PG8_BAR; PG8_WAIT_L(0); PG8_MMA(1, 0, At, B0); PG8_BAR; PG8_SCHED;
            PG8_STAGE(PG8_SB(0, 1), b2h, voffB);
            PG8_WAIT_V(6); PG8_BAR; PG8_MMA(1, 1, At, B1); PG8_BAR;
            PG8_LDB(B0, 1, 0); PG8_SCHED; PG8_LDA(At, 1, 0); PG8_STAGE(PG8_SA(0, 1), a2h, voffA);
            PG8_WAIT_L(8); PG8_BAR; PG8_WAIT_L(0); PG8_MMA(0, 0, At, B0); PG8_BAR; PG8_SCHED;
            PG8_LDB(B1, 1, 1); PG8_STAGE(PG8_SB(1, 0), b3, voffB);
            PG8_BAR; PG8_WAIT_L(0); PG8_MMA(0, 1, At, B1); PG8_BAR;
            PG8_LDA(At, 1, 1); PG8_STAGE(PG8_SA(1, 0), a3, voffA);
            PG8_BAR; PG8_WAIT_L(0); PG8_MMA(1, 0, At, B0); PG8_BAR; PG8_SCHED;
            PG8_STAGE(PG8_SB(1, 1), b3h, voffB);
            PG8_WAIT_V(6); PG8_BAR; PG8_MMA(1, 1, At, B1); PG8_BAR;
            }
        }
        if constexpr (ALIGN_EPI) { if (wr == 0) PG8_BAR; }
        if constexpr (!Epi::AFTER_DRAIN) { unsigned ones_ = ~0u; asm volatile("" : "+s"(ones_)); const int ln_ = (int)__builtin_amdgcn_mbcnt_hi(ones_, __builtin_amdgcn_mbcnt_lo(ones_, 0u)); const int fr_ = ln_ & 15, fq_ = ln_ >> 4;
            E(acc, cur, wr, wc, fr_, fq_); S.done(cur); }
        if (!has_next) break;
#pragma unroll
        for (int a = 0; a < 2; ++a)
#pragma unroll
            for (int b = 0; b < 2; ++b)
#pragma unroll
                for (int m = 0; m < 4; ++m)
#pragma unroll
                    for (int n = 0; n < 2; ++n) acc[a][b][m][n] = (f32x4){0.f, 0.f, 0.f, 0.f};
        cur = nxt; cA = nA; cB = nB; ++ui;
        if constexpr (ALIGN_EPI) { if (wr == 1) PG8_BAR; }
    }
    PG8_WAIT_V(0);
    if constexpr (!ALIGN_EPI) { if (wr == 0) PG8_BAR; }
    PG8_BAR;
    if constexpr (Epi::AFTER_DRAIN) { E.fused(acc, cur, wr, wc, fr, fq, lds, wid, lane); S.done(cur); }
#undef PG8_SA
#undef PG8_SB
#undef PG8_STAGE
#undef PG8_LDA
#undef PG8_LDB
#undef PG8_MMA
#undef PG8_WAIT_V
#undef PG8_WAIT_L
#undef PG8_BAR
#undef PG8_SCHED
}
}

#include <hip/hip_bf16.h>
#include <cmath>
namespace attn_body {
using bf16=__hip_bfloat16;
using bf16x8=__attribute__((ext_vector_type(8)))short;
using s16x4=__attribute__((ext_vector_type(4)))short;
using f32x16=__attribute__((ext_vector_type(16)))float;
using u32x4=__attribute__((ext_vector_type(4)))unsigned;
constexpr int D=64,QP=512,KP=64,OP=1024;
constexpr int NW=8,QBLK=32,QB=QBLK*NW,KVBLK=64;
constexpr int ATTN_UNIT_ROWS=QB;
__device__ __forceinline__ int crow(int r,int hi){return (r&3)+8*(r>>2)+4*hi;}
#define SBAR() __builtin_amdgcn_sched_barrier(0)
__device__ __forceinline__ void cmask(f32x16&p0,f32x16&p1,int jb,int qrel,int hi){
  const float NEG=-INFINITY; int kb=64*jb+4*hi;
  #pragma unroll
  for(int r=0;r<16;++r){int kv=kb+(r&3)+8*(r>>2); if(kv>qrel)p0[r]=NEG; if(kv+32>qrel)p1[r]=NEG;}
}

constexpr int NSLOT=3, SLOTB=8192;
constexpr int LDS_K=0, LDS_V=NSLOT*SLOTB, LDS_WS=2*NSLOT*SLOTB, LDS_OST=LDS_WS+NW*64*4, LDS_BYTES=LDS_OST+NW*4096;
constexpr float C2=0.125f*1.4426950408889634f;
__device__ __forceinline__ void glds16(const void*gsrc,unsigned lds_dst){unsigned keep;
  asm volatile("s_mov_b32 %0, m0\n\ts_mov_b32 m0, %2\n\ts_nop 0\n\tglobal_load_lds_dwordx4 %1, off\n\ts_mov_b32 m0, %0":"=&s"(keep):"v"(gsrc),"s"(lds_dst):"memory");}
__device__ __forceinline__ float max3f(float a,float b,float c){float r;asm("v_max3_f32 %0, %1, %2, %3":"=v"(r):"v"(a),"v"(b),"v"(c));return r;}
__device__ __forceinline__ float max2f(float a,float b){float r;asm("v_max_f32_e32 %0, %1, %2":"=v"(r):"v"(a),"v"(b));return r;}
__device__ __forceinline__ float fadd_s(float a,float b){float r;asm("v_add_f32_e32 %0, %1, %2":"=v"(r):"v"(a),"v"(b));return r;}
__device__ __forceinline__ float fsub_s(float a,float b){float r;asm("v_sub_f32_e32 %0, %1, %2":"=v"(r):"v"(a),"v"(b));return r;}
typedef float f32x2_t __attribute__((ext_vector_type(2))); typedef __bf16 bf16x2_t __attribute__((ext_vector_type(2)));
__device__ __forceinline__ unsigned cvtpk_s(float lo,float hi){f32x2_t v={lo,hi};bf16x2_t b=__builtin_convertvector(v,bf16x2_t);return __builtin_bit_cast(unsigned,b);}
#define WAIT_BAR(N) asm volatile("s_waitcnt vmcnt(" #N ") lgkmcnt(0)\n\ts_barrier":::"memory")

__device__ __forceinline__ void qkt(f32x16&p0,f32x16&p1,const char*Kslot,const bf16x8*qr,const f32x16&negm,int r32,int hi){
  const char*kb=Kslot+hi*1024+r32*16;
  #pragma unroll
  for(int d0=0;d0<4;++d0){
    const bf16x8 b0=*reinterpret_cast<const bf16x8*>(kb+d0*2048);
    const bf16x8 b1=*reinterpret_cast<const bf16x8*>(kb+d0*2048+512);
    if(d0==0){p0=__builtin_amdgcn_mfma_f32_32x32x16_bf16(b0,qr[0],negm,0,0,0);p1=__builtin_amdgcn_mfma_f32_32x32x16_bf16(b1,qr[0],negm,0,0,0);}
    else{p0=__builtin_amdgcn_mfma_f32_32x32x16_bf16(b0,qr[d0],p0,0,0,0);p1=__builtin_amdgcn_mfma_f32_32x32x16_bf16(b1,qr[d0],p1,0,0,0);}}
}
typedef __attribute__((address_space(3))) const char* lds_cptr;
typedef short v4i16_t __attribute__((ext_vector_type(4)));
__device__ __forceinline__ void kload8(bf16x8*kf,lds_cptr kp){
  kf[0]=*(const __attribute__((address_space(3))) bf16x8*)(kp);      kf[1]=*(const __attribute__((address_space(3))) bf16x8*)(kp+512);
  kf[2]=*(const __attribute__((address_space(3))) bf16x8*)(kp+2048); kf[3]=*(const __attribute__((address_space(3))) bf16x8*)(kp+2560);
  kf[4]=*(const __attribute__((address_space(3))) bf16x8*)(kp+4096); kf[5]=*(const __attribute__((address_space(3))) bf16x8*)(kp+4608);
  kf[6]=*(const __attribute__((address_space(3))) bf16x8*)(kp+6144); kf[7]=*(const __attribute__((address_space(3))) bf16x8*)(kp+6656);
}
__device__ __forceinline__ void kload2(bf16x8*kf,lds_cptr kp,int j){ kf[2*j]=*(const __attribute__((address_space(3))) bf16x8*)(kp+j*2048); kf[2*j+1]=*(const __attribute__((address_space(3))) bf16x8*)(kp+j*2048+512); }
__device__ __forceinline__ s16x4 vtr(lds_cptr p){ return __builtin_bit_cast(s16x4,__builtin_amdgcn_ds_read_tr16_b64_v4i16((__attribute__((address_space(3))) v4i16_t*)p)); }
__device__ __forceinline__ float rowmax(const f32x16&p0,const f32x16&p1){
  float a=max3f(p0[0],p0[1],p1[0]),b=max3f(p0[2],p0[3],p1[1]);a=max3f(a,p1[2],p1[3]);
  #pragma unroll
  for(int r=4;r<16;r+=4){a=max3f(a,p0[r],p0[r+1]);b=max3f(b,p0[r+2],p0[r+3]);a=max3f(a,p1[r],p1[r+1]);b=max3f(b,p1[r+2],p1[r+3]);}
  const float m=max2f(a,b);
  auto rr=__builtin_amdgcn_permlane32_swap(__float_as_uint(m),__float_as_uint(m),false,false);
  return max2f(__uint_as_float(rr[0]),__uint_as_float(rr[1]));
}
__device__ __forceinline__ void pv(f32x16*o,int vb,bf16x8 pa0,bf16x8 pa1,bf16x8 pa2,bf16x8 pa3){
  #pragma unroll
  for(int d0=0;d0<2;++d0){s16x4 lo[4],hi[4];
    #pragma unroll
    for(int ks=0;ks<4;++ks){
      asm volatile("ds_read_b64_tr_b16 %0,%1 offset:%c2":"=&v"(lo[ks]):"v"(vb),"i"(d0*4096+ks*1024):"memory");
      asm volatile("ds_read_b64_tr_b16 %0,%1 offset:%c2":"=&v"(hi[ks]):"v"(vb),"i"(d0*4096+ks*1024+512):"memory");}
    asm volatile("s_waitcnt lgkmcnt(0)":::"memory");SBAR();
    #define PK(k) (bf16x8){lo[k][0],lo[k][1],lo[k][2],lo[k][3],hi[k][0],hi[k][1],hi[k][2],hi[k][3]}
    o[d0]=__builtin_amdgcn_mfma_f32_32x32x16_bf16(pa0,PK(0),o[d0],0,0,0);
    o[d0]=__builtin_amdgcn_mfma_f32_32x32x16_bf16(pa1,PK(1),o[d0],0,0,0);
    o[d0]=__builtin_amdgcn_mfma_f32_32x32x16_bf16(pa2,PK(2),o[d0],0,0,0);
    o[d0]=__builtin_amdgcn_mfma_f32_32x32x16_bf16(pa3,PK(3),o[d0],0,0,0);
    #undef PK
  }
}

#ifndef ATTN_STORE16
#define ATTN_STORE16(p,v) (*(u32x4*)(p)=(v))
#endif
template<int THRL> __device__ __forceinline__ void attn_unit(const bf16*Qu,const bf16*Kh,const bf16*Vh,bf16*Ou,const int NT,char*shm){
  const int tid=opaque_tid(),lane=tid&63,r32=lane&31,hi=lane>>5; const int wid=__builtin_amdgcn_readfirstlane(tid>>6);
  const bf16*Qw=Qu+(long)(wid*QBLK)*QP;
  const unsigned lds0=(unsigned)(uintptr_t)shm;
  float*wsf=(float*)(shm+LDS_WS)+wid*64;
  const bf16*ksrc=Kh+(long)lane*KP+wid*8;
  const bf16*vsrc=Vh+(long)(16*(wid&3)+(lane>>2))*KP+(wid>>2)*32+(lane&3)*8;
  const unsigned kdst=lds0+LDS_K+wid*1024, vdst=lds0+LDS_V+wid*1024;
  #define DMA_K(t,slot) glds16(ksrc+(long)(t)*KVBLK*KP,(unsigned)__builtin_amdgcn_readfirstlane(kdst+(slot)))
  #define DMA_V(t,slot) glds16(vsrc+(long)(t)*KVBLK*KP,(unsigned)__builtin_amdgcn_readfirstlane(vdst+(slot)))
  const int vb0=(int)(lds0+LDS_V)+((lane>>4)&1)*32+(lane&3)*8+(4*hi+((lane&15)>>2))*64;
  const char*Kbase=shm+LDS_K; bf16x8 kf[8];
  const lds_cptr shm3=(lds_cptr)shm; const lds_cptr kp0=shm3+LDS_K+hi*1024+r32*16; const lds_cptr vp0=shm3+LDS_V+((lane>>4)&1)*32+(lane&3)*8+(4*hi+((lane&15)>>2))*64;
  DMA_K(0,0);DMA_V(0,0);DMA_K(1,SLOTB);
  bf16x8 qr[4];
  #pragma unroll
  for(int d0=0;d0<4;++d0)qr[d0]=*reinterpret_cast<const bf16x8*>(&Qw[(long)r32*QP+d0*16+hi*8]);
  float mhat=0.f,l_reg=0.f;f32x16 o[2];o[0]=f32x16{};o[1]=f32x16{};f32x16 negm=f32x16{};asm volatile("":"+v"(negm));
  #define CMASK(P0,P1,t) do{}while(0)
  bool resc=false;
  #define START(P0,P1) do{ const float rm=rowmax(P0,P1); resc=false; \
    { const float dl=rm; mhat=fadd_s(mhat,dl); \
      _Pragma("unroll") for(int r=0;r<16;++r){P0[r]=fsub_s(P0[r],dl);P1[r]=fsub_s(P1[r],dl);} \
      _Pragma("unroll") for(int r=0;r<16;++r)negm[r]=-mhat; asm volatile("":"+v"(negm)); } \
    _Pragma("unroll") for(int r=0;r<16;++r)P0[r]=__builtin_amdgcn_exp2f(P0[r]); }while(0)
  #define RESC() do{ if(resc){ asm volatile("s_waitcnt lgkmcnt(0)":::"memory"); \
      _Pragma("unroll") for(int d_=0;d_<2;++d_) _Pragma("unroll") for(int r=0;r<16;++r)o[d_][r]*=wsf[crow(r,hi)]; } }while(0)
  f32x16 pA0,pA1,pB0,pB1;
  int sl_prev=0,sl_cur=0,sl_next=SLOTB;
  #define ROT() do{sl_prev=sl_cur;sl_cur=sl_next;sl_next=(sl_next==(NSLOT-1)*SLOTB)?0:sl_next+SLOTB;}while(0)
  DMA_K(2,2*SLOTB);
  WAIT_BAR(3);
  qkt(pA0,pA1,Kbase,qr,negm,r32,hi);asm volatile("s_nop 15\n\ts_nop 7":"+v"(pA0),"+v"(pA1));CMASK(pA0,pA1,0);
  START(pA0,pA1);
  _Pragma("unroll") for(int r=0;r<16;++r)pA1[r]=__builtin_amdgcn_exp2f(pA1[r]);
  WAIT_BAR(0);
  DMA_K(3,0);DMA_V(1,SLOTB);
  ROT();
  kload8(kf,kp0+sl_cur);
  WAIT_BAR(2);
  s16x4 vlo[8],vhi[8]; u32x4 pw0,pw1,pw2,pw3;
  #define PKW(P,B) cvtpk_s(P[B],P[B+1])
  #define PAF(k) __builtin_bit_cast(bf16x8,pw##k)
  #define VFR(i) (bf16x8){vlo[i][0],vlo[i][1],vlo[i][2],vlo[i][3],vhi[i][0],vhi[i][1],vhi[i][2],vhi[i][3]}
  #define PIN(x) asm volatile("":"+v"(x))
  #define MX3(a,b,c) __builtin_fmaxf(__builtin_fmaxf((a),(b)),(c))
  #define GAPA(MF,A0,A1,A2,A3,W0,W1,PW) do{ MF; sacc+=A0; sacc+=A1; sacc+=A2; sacc+=A3; PIN(sacc); W0; W1; PIN(PW); SBAR(); }while(0)
  #define EX(v) __builtin_amdgcn_exp2f(v)
  #define GAPB(MF,X,B) do{ MF; X[B]=EX(X[B]); X[B+1]=EX(X[B+1]); X[B+2]=EX(X[B+2]); X[B+3]=EX(X[B+3]); PIN(X); SBAR(); }while(0)
  #define VRD(i) do{ vlo[i]=vtr(vp_+(((i)>>2)*4096+((i)&3)*1024)); vhi[i]=vtr(vp_+(((i)>>2)*4096+((i)&3)*1024+512)); }while(0)
  #define KRD(G,j) do{ if(G){ kload2(kf,kp0+sl_next,j); SBAR(); } }while(0)
  #define STEP(C0,C1,P0,P1,t,GK,GV,GL) do{ SBAR(); \
    const lds_cptr vp_=vp0+sl_prev; \
    VRD(0); SBAR(); float sacc=(P0[0]+P0[1]); \
    GAPA(C0=__builtin_amdgcn_mfma_f32_32x32x16_bf16(kf[0],qr[0],negm,0,0,0), P0[2],P0[3],P0[4],P0[5],     pw0[0]=PKW(P0,0), pw0[1]=PKW(P0,2), pw0); \
    VRD(4); SBAR(); GAPA(C1=__builtin_amdgcn_mfma_f32_32x32x16_bf16(kf[1],qr[0],negm,0,0,0), P0[6],P0[7],P0[8],P0[9],     pw0[2]=PKW(P0,4), pw0[3]=PKW(P0,6), pw0); \
    VRD(1); SBAR(); GAPA(C0=__builtin_amdgcn_mfma_f32_32x32x16_bf16(kf[2],qr[1],C0,0,0,0),   P0[10],P0[11],P0[12],P0[13], pw1[0]=PKW(P0,8), pw1[1]=PKW(P0,10), pw1); \
    VRD(5); SBAR(); GAPA(C1=__builtin_amdgcn_mfma_f32_32x32x16_bf16(kf[3],qr[1],C1,0,0,0),   P0[14],P0[15],P1[0],P1[1],   pw1[2]=PKW(P0,12),pw1[3]=PKW(P0,14), pw1); \
    VRD(2); SBAR(); GAPA(C0=__builtin_amdgcn_mfma_f32_32x32x16_bf16(kf[4],qr[2],C0,0,0,0),   P1[2],P1[3],P1[4],P1[5],     pw2[0]=PKW(P1,0), pw2[1]=PKW(P1,2), pw2); \
    VRD(6); SBAR(); GAPA(C1=__builtin_amdgcn_mfma_f32_32x32x16_bf16(kf[5],qr[2],C1,0,0,0),   P1[6],P1[7],P1[8],P1[9],     pw2[2]=PKW(P1,4), pw2[3]=PKW(P1,6), pw2); \
    VRD(3); SBAR(); GAPA(C0=__builtin_amdgcn_mfma_f32_32x32x16_bf16(kf[6],qr[3],C0,0,0,0),   P1[10],P1[11],P1[12],P1[13], pw3[0]=PKW(P1,8), pw3[1]=PKW(P1,10), pw3); \
    VRD(7); SBAR(); GAPA(C1=__builtin_amdgcn_mfma_f32_32x32x16_bf16(kf[7],qr[3],C1,0,0,0),   P1[14],P1[15],0.f,0.f,       pw3[2]=PKW(P1,12),pw3[3]=PKW(P1,14), pw3); \
    l_reg+=sacc; \
    if(GK){DMA_K((t)+3,sl_cur);} if(GV){DMA_V((t)+1,sl_next);} \
    CMASK(C0,C1,t); \
    { float a=MX3(C0[0],C0[1],C1[0]),b=MX3(C0[2],C0[3],C1[1]); a=MX3(a,C1[2],C1[3]); \
      _Pragma("unroll") for(int r=4;r<16;r+=4){a=MX3(a,C0[r],C0[r+1]);b=MX3(b,C0[r+2],C0[r+3]);a=MX3(a,C1[r],C1[r+1]);b=MX3(b,C1[r+2],C1[r+3]);} \
      float rm=__builtin_fmaxf(a,b); { auto rr=__builtin_amdgcn_permlane32_swap(__float_as_uint(rm),__float_as_uint(rm),false,false); rm=__builtin_fmaxf(__uint_as_float(rr[0]),__uint_as_float(rr[1])); } \
      resc=false; \
      if(__builtin_expect(__any(rm>(float)THRL),0)){ const float dl=__builtin_fmaxf(rm,0.f); mhat+=dl; \
        _Pragma("unroll") for(int r=0;r<16;++r){C0[r]-=dl;C1[r]-=dl;} \
        _Pragma("unroll") for(int r=0;r<16;++r)negm[r]=-mhat; asm volatile("":"+v"(negm)); \
        const float f=__builtin_amdgcn_exp2f(-dl); l_reg*=f; if(hi==0)wsf[r32]=f; resc=true; } } \
    SBAR(); \
    GAPB(o[0]=__builtin_amdgcn_mfma_f32_32x32x16_bf16(PAF(0),VFR(0),o[0],0,0,0), C0,0); \
    GAPB(o[1]=__builtin_amdgcn_mfma_f32_32x32x16_bf16(PAF(0),VFR(4),o[1],0,0,0), C0,4); \
    KRD(GL,0); GAPB(o[0]=__builtin_amdgcn_mfma_f32_32x32x16_bf16(PAF(1),VFR(1),o[0],0,0,0), C0,8); \
    KRD(GL,1); GAPB(o[1]=__builtin_amdgcn_mfma_f32_32x32x16_bf16(PAF(1),VFR(5),o[1],0,0,0), C0,12); \
    KRD(GL,2); GAPB(o[0]=__builtin_amdgcn_mfma_f32_32x32x16_bf16(PAF(2),VFR(2),o[0],0,0,0), C1,0); \
    KRD(GL,3); GAPB(o[1]=__builtin_amdgcn_mfma_f32_32x32x16_bf16(PAF(2),VFR(6),o[1],0,0,0), C1,4); \
    GAPB(o[0]=__builtin_amdgcn_mfma_f32_32x32x16_bf16(PAF(3),VFR(3),o[0],0,0,0), C1,8); \
    GAPB(o[1]=__builtin_amdgcn_mfma_f32_32x32x16_bf16(PAF(3),VFR(7),o[1],0,0,0), C1,12); \
    }while(0)
  int t=1;
  #undef CMASK
  #define CMASK(P0,P1,t) do{}while(0)
  for(;t+5<NT;t+=2){
    STEP(pB0,pB1,pA0,pA1,t,true,true,true);     WAIT_BAR(2); RESC(); ROT();
    STEP(pA0,pA1,pB0,pB1,t+1,true,true,true);   WAIT_BAR(2); RESC(); ROT();
  }
  #undef CMASK
  #define CMASK(P0,P1,t) do{}while(0)
  #define ENDW(tt) do{ if((tt)+3<NT){WAIT_BAR(2);} else if((tt)+2<NT){WAIT_BAR(1);} else {WAIT_BAR(0);} }while(0)
  for(;t+1<NT;t+=2){
    STEP(pB0,pB1,pA0,pA1,t,(t+3<NT),(t+1<NT),(t+1<NT));       ENDW(t);   RESC(); ROT();
    STEP(pA0,pA1,pB0,pB1,t+1,(t+4<NT),(t+2<NT),(t+2<NT));     ENDW(t+1); RESC(); ROT();
  }
  STEP(pB0,pB1,pA0,pA1,NT-1,false,false,false); RESC();
  { float sacc=pB0[0]+pB0[1]; _Pragma("unroll") for(int r=2;r<16;++r)sacc+=pB0[r]; _Pragma("unroll") for(int r=0;r<16;++r)sacc+=pB1[r]; l_reg+=sacc;
    pw0=(u32x4){PKW(pB0,0),PKW(pB0,2),PKW(pB0,4),PKW(pB0,6)};pw1=(u32x4){PKW(pB0,8),PKW(pB0,10),PKW(pB0,12),PKW(pB0,14)};pw2=(u32x4){PKW(pB1,0),PKW(pB1,2),PKW(pB1,4),PKW(pB1,6)};pw3=(u32x4){PKW(pB1,8),PKW(pB1,10),PKW(pB1,12),PKW(pB1,14)};
    SBAR(); pv(o,vb0+sl_cur,PAF(0),PAF(1),PAF(2),PAF(3)); }
  #undef PKW
  #undef PAF
  #undef VFR
  #undef PIN
  #undef MX3
  #undef GAPA
  #undef GAPB
  #undef EX
  #undef VRD
  #undef KRD
  #undef STEP
  #undef ENDW
  {auto rr=__builtin_amdgcn_permlane32_swap(__float_as_uint(l_reg),__float_as_uint(l_reg),false,false);l_reg=__uint_as_float(rr[0])+__uint_as_float(rr[1]);}
  if(hi==0)wsf[32+r32]=l_reg;asm volatile("s_waitcnt lgkmcnt(0)":::"memory");
  float rli[16];
  #pragma unroll
  for(int r=0;r<16;++r)rli[r]=__builtin_amdgcn_rcpf(wsf[32+crow(r,hi)]);
  bf16*Ow=Ou+(long)(wid*QBLK)*OP;
  { bf16*stg=(bf16*)(shm+LDS_OST)+wid*2048;
    #pragma unroll
    for(int r=0;r<16;++r){const int orow=crow(r,hi);
      #pragma unroll
      for(int d0=0;d0<2;++d0)stg[orow*64+d0*32+r32]=__float2bfloat16(o[d0][r]*rli[r]);}
    asm volatile("s_waitcnt lgkmcnt(0)":::"memory");
    #pragma unroll
    for(int i=0;i<4;++i){const int row=i*8+(lane>>3),ch=lane&7; const u32x4 v=*(const u32x4*)(stg+row*64+ch*8); ATTN_STORE16(Ow+(long)row*OP+ch*8,v);} }
  asm volatile("s_waitcnt lgkmcnt(0)\n\ts_barrier":::"memory");
  #undef DMA_K
  #undef DMA_V
  #undef CMASK
  #undef START
  #undef RESC
  #undef ROT
}
constexpr int ATTN_LDS_BYTES=LDS_BYTES;
#undef SBAR
#undef WAIT_BAR
}

constexpr int NWAVES = 8;
#ifndef MK_N_LAUNCHES
#define MK_N_LAUNCHES 1
#endif
constexpr int DM = 1024, NBATCH = 8, SEQL = 4096, CTXL = 256, DEPTH = 2;
constexpr int RCTX = NBATCH * CTXL, RLAT = NBATCH * SEQL, RTOT = RCTX + RLAT;
constexpr int INW = 2560, NEXP = 32, NKEY = CTXL + SEQL, NPF = 34, NMOD = 6 * DM;
constexpr int ZC_U = 0, ZC_B = 256, ZC_C = 512, ZC_RQ = 768, ZC_RK = 1024, ZC_RV = 1280, ZC_RG = 1536, ZC_AQ = 1792, ZC_AK = 2304, ZC_AV = 2432;
constexpr float LN_EPS = 1e-6f, ALPHA = 1.41421356237309505f;
constexpr int N_PRO = 3, N_PER_LAYER = 10, N_PHASES = N_PRO + DEPTH * N_PER_LAYER;
constexpr int N_LAUNCHES = MK_N_LAUNCHES;

constexpr size_t MiB = 1u << 20;
constexpr size_t WS_CTL = 0, CTL_ZERO_BYTES = 1 * MiB;
constexpr size_t WS_MODP = 2 * MiB, WS_MODV = 6 * MiB, WS_ROPE = 7 * MiB;
constexpr size_t WS_RE = 8 * MiB, WS_RP = 9 * MiB, WS_RW = 10 * MiB, WS_SLOT = 11 * MiB, WS_ROWW = 12 * MiB;
constexpr size_t WS_WIN = 14 * MiB, WS_WOUT = 24 * MiB, WS_KVS = 28 * MiB, WS_SS = 62 * MiB, WS_AK = 80 * MiB, WS_AV = 89 * MiB, WS_AQ = 98 * MiB;
constexpr size_t WS_RQ = 132 * MiB, WS_RK = 149 * MiB, WS_WGU = 166 * MiB, WS_WD = 422 * MiB, WS_XSA = 550 * MiB, WS_XH = 618 * MiB, WS_Z = 686 * MiB;
constexpr size_t WS_MIX = 856 * MiB, WS_Y = 924 * MiB, WS_H2 = 992 * MiB, WS_XS2 = 1060 * MiB, WS_ACT = 1348 * MiB, WS_END = 1636 * MiB;
constexpr size_t WS_YB = WS_XS2;
constexpr int MAXTILES = 576;
static_assert(WS_MODP + (size_t)DEPTH * 8 * 9 * NMOD * 4 <= WS_MODV && WS_MODV + (size_t)DEPTH * 9 * NMOD * 4 <= WS_ROPE, "ws map");
static_assert(WS_WIN + (size_t)DEPTH * INW * DM * 2 <= WS_WOUT && WS_WOUT + (size_t)DEPTH * DM * DM * 2 <= WS_KVS, "ws map");
static_assert(WS_KVS + (size_t)NBATCH * 4 * NPF * 2 * 4096 * 4 <= WS_SS && WS_SS + (size_t)NBATCH * 4 * NPF * 2 * 4096 * 2 <= WS_AK, "ws map");
static_assert(WS_AK + (size_t)NBATCH * 2 * NKEY * 64 * 2 <= WS_AV && WS_AV + (size_t)NBATCH * 2 * NKEY * 64 * 2 <= WS_AQ && WS_AQ + (size_t)RTOT * 512 * 2 <= WS_RQ, "ws map");
static_assert(WS_RQ + (size_t)RTOT * 256 * 2 <= WS_RK && WS_RK + (size_t)RTOT * 256 * 2 <= WS_WGU && WS_WGU + (size_t)DEPTH * NEXP * 2048 * DM * 2 <= WS_WD, "ws map");
static_assert(WS_WD + (size_t)DEPTH * NEXP * DM * DM * 2 <= WS_XSA && WS_XSA + (size_t)RTOT * DM * 2 <= WS_XH && WS_XH + (size_t)RTOT * DM * 2 <= WS_Z, "ws map");
static_assert(WS_Z + (size_t)RTOT * INW * 2 <= WS_MIX && WS_MIX + (size_t)RTOT * DM * 2 <= WS_Y && WS_Y + (size_t)RTOT * DM * 2 <= WS_H2 && WS_H2 + (size_t)RTOT * DM * 2 <= WS_XS2, "ws map");
static_assert(WS_XS2 + (size_t)MAXTILES * 256 * DM * 2 <= WS_ACT && WS_ACT + (size_t)MAXTILES * 256 * DM * 2 <= WS_END, "ws map");
constexpr int CW_TMO = 0, CW_CODE = 1, CW_BAR = 4096, CW_GCNT = 8192;

constexpr int RING_OFF = 0, RING_BYTES = 131072;
constexpr int LDSCTL_OFF = RING_BYTES, MISC_OFF = LDSCTL_OFF + 320;
constexpr int OFFT_OFF = LDSCTL_OFF + 512, LCNT_OFF = LDSCTL_OFF + 768, LBASE_OFF = LDSCTL_OFF + 896, ENT_OFF = LDSCTL_OFF + 1024;
constexpr int LDS_BYTES = 147456;
static_assert(ENT_OFF + 4096 <= LDS_BYTES, "LDS map");

#define GAS __attribute__((address_space(1)))
#define LAS __attribute__((address_space(3)))
typedef unsigned short bf16;
typedef unsigned v4u __attribute__((ext_vector_type(4)));
typedef float f32x4 __attribute__((ext_vector_type(4)));
typedef short bf16x8 __attribute__((ext_vector_type(8)));
typedef GAS unsigned gu32;
typedef GAS unsigned long long gu64;
#define RLX_AGENT __ATOMIC_RELAXED, __HIP_MEMORY_SCOPE_AGENT
#define LDS_WAIT() asm volatile("s_waitcnt lgkmcnt(0)" ::: "memory")
#define VM_WAIT() asm volatile("s_waitcnt vmcnt(0)" ::: "memory")
__device__ __forceinline__ unsigned long long rt() { return __builtin_amdgcn_s_memrealtime(); }
__device__ __forceinline__ unsigned f2bf(float f) { unsigned u = __builtin_bit_cast(unsigned, f); return (u + 0x7fffu + ((u >> 16) & 1u)) >> 16; }
__device__ __forceinline__ unsigned pk2(float lo, float hi) { return f2bf(lo) | (f2bf(hi) << 16); }

#define XB_TMO      128
#define XB_XCNT(j)  (256  + 64 * (j))
#define XB_XSUB(j)  (1280 + 64 * (j))
#define XB_XGEN(j)  (2304 + 64 * (j))
#define XB_TOP      3328
#define XB_TOPGEN   3392
#define XCD_BAR_WORDS 3456
#define XB_SPIN_CAP (1u << 18)

__device__ __forceinline__ unsigned xb_ld(unsigned* p)              { return __hip_atomic_load(p, __ATOMIC_RELAXED, __HIP_MEMORY_SCOPE_AGENT); }
__device__ __forceinline__ unsigned xb_add(unsigned* p, unsigned v) { return __hip_atomic_fetch_add(p, v, __ATOMIC_RELAXED, __HIP_MEMORY_SCOPE_AGENT); }
__device__ __forceinline__ unsigned xb_xcc_id() { return (unsigned)__builtin_amdgcn_s_getreg((3 << 11) | 20) & 0xFu; }
#define XB_SPIN(cond, bar) do { unsigned _sp = 0; while (cond) { __builtin_amdgcn_s_sleep(1); \
    if ((++_sp & 255u) == 0u) { if (xb_ld(&(bar)[XB_TMO])) break; if (_sp > XB_SPIN_CAP) { atomicAdd(&(bar)[XB_TMO], 1u); break; } } } } while (0)

struct XcdBarrier {
    unsigned* bar; unsigned x;
    volatile LAS unsigned* st;
};

__device__ __forceinline__ XcdBarrier xcd_barrier_post(unsigned* bar, volatile LAS unsigned* st) {
    XcdBarrier b; b.bar = bar; b.x = xb_xcc_id(); b.st = st;
    if (threadIdx.x == 0) (void)xb_add(&bar[XB_XCNT(b.x)], 1u);
    return b;
}
__device__ __forceinline__ void xcd_barrier_complete(unsigned* bar, unsigned x, unsigned& nloc, unsigned& nx) {
    const unsigned G = gridDim.x * gridDim.y * gridDim.z;
    unsigned sum, cnt, mine, sp = 0u;
    for (;;) {
        sum = 0u; cnt = 0u; mine = 0u;
#pragma unroll
        for (unsigned j = 0; j < 16; ++j) { const unsigned c = xb_ld(&bar[XB_XCNT(j)]); sum += c; cnt += (c > 0u) ? 1u : 0u; mine = (j == x) ? c : mine; }
        if (sum == G) break;
        __builtin_amdgcn_s_sleep(1);
        if ((++sp & 255u) == 0u) { if (xb_ld(&bar[XB_TMO])) break; if (sp > XB_SPIN_CAP) { atomicAdd(&bar[XB_TMO], 1u); break; } }
    }
    nloc = mine > 0u ? mine : 1u; nx = cnt > 0u ? cnt : 1u;
}

__device__ __forceinline__ void xcd_barrier(const XcdBarrier& b) {
    asm volatile("s_waitcnt vmcnt(0)" ::: "memory");
    __syncthreads();
    if (threadIdx.x == 0) {
        unsigned* bar = b.bar;
        __builtin_amdgcn_s_waitcnt(0);
        unsigned nloc = b.st[0], nx = b.st[1];
        if (nloc == 0u) { xcd_barrier_complete(bar, b.x, nloc, nx); b.st[0] = nloc; b.st[1] = nx; }
        const unsigned old = xb_add(&bar[XB_XSUB(b.x)], 1u);
        const unsigned gen = old / nloc;
        if (old + 1u == (gen + 1u) * nloc) {
            __builtin_amdgcn_fence(__ATOMIC_RELEASE, "agent");
            asm volatile("s_waitcnt vmcnt(0)" ::: "memory");
            const unsigned og = xb_add(&bar[XB_TOP], 1u);
            const unsigned tg = og / nx;
            if (og + 1u == (tg + 1u) * nx) xb_add(&bar[XB_TOPGEN], 1u);
            else XB_SPIN(xb_ld(&bar[XB_TOPGEN]) == tg, bar);
            __builtin_amdgcn_fence(__ATOMIC_ACQUIRE, "agent");
            xb_add(&bar[XB_XGEN(b.x)], 1u);
            asm volatile("s_waitcnt vmcnt(0)" ::: "memory");
        } else {
            XB_SPIN(xb_ld(&bar[XB_XGEN(b.x)]) == gen, bar);
            __builtin_amdgcn_fence(__ATOMIC_ACQUIRE, "agent");
            asm volatile("s_waitcnt vmcnt(0)" ::: "memory");
        }
    }
    __syncthreads();
}

struct Args { const float* in[21]; float* out; unsigned char* ws; int ph_lo, ph_hi, li, pad; };
template <int OFF> __device__ __forceinline__ const float* karg_ptr() {
    const float* p;
    asm volatile("s_load_dwordx2 %0, %1, %2\n\ts_waitcnt lgkmcnt(0)\n\ts_nop 4" : "=s"(p) : "s"(__builtin_amdgcn_kernarg_segment_ptr()), "i"(OFF) : "memory");
    return p;
}
#define KIN(i) karg_ptr<8 * (i)>()
#define KOUT() ((float*)karg_ptr<8 * 21>())
#define KWS() ((unsigned char*)karg_ptr<8 * 22>())
typedef float f32x16 __attribute__((ext_vector_type(16)));
typedef unsigned v2u __attribute__((ext_vector_type(2)));
__device__ __forceinline__ float bflo(unsigned u) { return __builtin_bit_cast(float, u << 16); }
__device__ __forceinline__ float bfhi(unsigned u) { return __builtin_bit_cast(float, u & 0xffff0000u); }
__device__ __forceinline__ float bf1(unsigned short h) { return __builtin_bit_cast(float, (unsigned)h << 16); }
__device__ __forceinline__ float wave_sum(float v) {
#pragma unroll
    for (int o = 1; o < 64; o <<= 1) v += __shfl_xor(v, o);
    return v;
}
__device__ __forceinline__ int mod_row(int r) { return r < RCTX ? 8 : ((r - RCTX) >> 12); }
__device__ __forceinline__ void load_row_f32(const float* p, int lane, f32x4 (&v)[4]) {
#pragma unroll
    for (int j = 0; j < 4; ++j) v[j] = *(const f32x4*)(p + 256 * j + 4 * lane);
}
__device__ __forceinline__ void load_row_bf16(const bf16* p, int lane, f32x4 (&v)[4]) {
#pragma unroll
    for (int j = 0; j < 4; ++j) { const uint2 u = *(const uint2*)(p + 256 * j + 4 * lane); v[j] = (f32x4){bflo(u.x), bfhi(u.x), bflo(u.y), bfhi(u.y)}; }
}
__device__ __forceinline__ void store_row_bf16(bf16* p, int lane, const f32x4 (&v)[4]) {
#pragma unroll
    for (int j = 0; j < 4; ++j) { uint2 u; u.x = pk2(v[j][0], v[j][1]); u.y = pk2(v[j][2], v[j][3]); *(uint2*)(p + 256 * j + 4 * lane) = u; }
}
__device__ __forceinline__ void store_row_f32(float* p, int lane, const f32x4 (&v)[4]) {
#pragma unroll
    for (int j = 0; j < 4; ++j) *(f32x4*)(p + 256 * j + 4 * lane) = v[j];
}
__device__ __forceinline__ void ln_row(f32x4 (&v)[4], const float* g, const float* b, int lane) {
    float s = 0.f;
#pragma unroll
    for (int j = 0; j < 4; ++j) s += (v[j][0] + v[j][1]) + (v[j][2] + v[j][3]);
    const float mean = wave_sum(s) * (1.0f / DM); float s2 = 0.f;
#pragma unroll
    for (int j = 0; j < 4; ++j) { v[j] = v[j] - mean; s2 += (v[j][0] * v[j][0] + v[j][1] * v[j][1]) + (v[j][2] * v[j][2] + v[j][3] * v[j][3]); }
    const float rstd = 1.0f / sqrtf(wave_sum(s2) * (1.0f / DM) + LN_EPS);
#pragma unroll
    for (int j = 0; j < 4; ++j) { const f32x4 gg = *(const f32x4*)(g + 256 * j + 4 * lane), bb = *(const f32x4*)(b + 256 * j + 4 * lane); v[j] = v[j] * rstd * gg + bb; }
}
__device__ __forceinline__ void modulate(const f32x4 (&v)[4], const float* sc, const float* sh, int lane, f32x4 (&o)[4]) {
#pragma unroll
    for (int j = 0; j < 4; ++j) { const f32x4 s = *(const f32x4*)(sc + 256 * j + 4 * lane), h = *(const f32x4*)(sh + 256 * j + 4 * lane); o[j] = v[j] * (1.0f + s) + h; }
}
__device__ __forceinline__ float log2_gamma(float dexp) { return log1pf(-exp2f(-dexp)) * 1.4426950408889634f; }

__device__ __forceinline__ void p0_transpose_item(const float* W, int K, int N, bf16* WT, int dest_row0, int k0, int n0, LAS unsigned* T, int lane) {
    const float* src = W + (size_t)k0 * N + n0 + lane;
    float v[64];
#pragma unroll
    for (int k = 0; k < 64; ++k) v[k] = src[(size_t)k * N];
#pragma unroll
    for (int kp = 0; kp < 32; ++kp) T[lane * 36 + kp] = pk2(v[2 * kp], v[2 * kp + 1]);
    LDS_WAIT(); asm volatile("" ::: "memory");
    const int c = lane & 7, nr = lane >> 3;
#pragma unroll
    for (int j = 0; j < 8; ++j) { const int n = nr + 8 * j; const v4u o = *(const LAS v4u*)(T + n * 36 + 4 * c);
        *(GAS v4u*)(WT + (size_t)(dest_row0 + n) * K + k0 + 8 * c) = o; }
    LDS_WAIT(); asm volatile("" ::: "memory");
}
__device__ __forceinline__ void p0_transpose_item_f8(const float* W, int K, int N, unsigned char* WT, int dest_row0, int k0, int n0, float scale, LAS unsigned* T, int lane) {
    const float* src = W + (size_t)k0 * N + n0 + lane;
    float v[64];
#pragma unroll
    for (int k = 0; k < 64; ++k) v[k] = src[(size_t)k * N];
#pragma unroll
    for (int kq = 0; kq < 16; ++kq) T[lane * 20 + kq] = (unsigned)__builtin_amdgcn_cvt_pk_fp8_f32(v[4 * kq + 2] * scale, v[4 * kq + 3] * scale, __builtin_amdgcn_cvt_pk_fp8_f32(v[4 * kq] * scale, v[4 * kq + 1] * scale, 0, false), true);
    LDS_WAIT(); asm volatile("" ::: "memory");
    const int c = lane & 3, nr = lane >> 2;
#pragma unroll
    for (int j = 0; j < 4; ++j) { const int n = nr + 16 * j; const v4u o = *(const LAS v4u*)(T + n * 20 + 4 * c);
        *(GAS v4u*)(WT + (size_t)(dest_row0 + n) * K + k0 + 16 * c) = o; }
    LDS_WAIT(); asm volatile("" ::: "memory");
}
__device__ __forceinline__ void p0a(const Args& A, LAS unsigned char* lds, int tid, int lane, int wave) {
    unsigned char* ws = KWS();
    const int G = gridDim.x, wg = opaque_bid();
    const float* in_c = KIN(1); const float* in_cctx = KIN(3); const float* in_wmod = KIN(4); const float* in_bmod = KIN(5);
    {
        LAS float* sl = (LAS float*)(lds + RING_OFF);
        float* MODP = (float*)(ws + WS_MODP);
        for (int u = wg; u < DEPTH * 8 * 12; u += G) {
            const int l = u / 96, rem = u % 96, kp = rem / 12, cb = rem % 12;
            for (int i = tid; i < 9 * 128; i += NWAVES * 64) { const int r = i >> 7, k = i & 127;
                const float cv = (r < 8) ? in_c[r * DM + kp * 128 + k] : in_cctx[kp * 128 + k];
                sl[i] = cv / (1.0f + expf(-cv)); }
            __syncthreads();
            const int col = cb * 512 + tid;
            float acc[9];
#pragma unroll
            for (int r = 0; r < 9; ++r) acc[r] = (kp == 0) ? in_bmod[l * NMOD + col] : 0.f;
            const float* wp = in_wmod + ((size_t)l * DM + kp * 128) * NMOD + col;
#pragma unroll 8
            for (int k = 0; k < 128; ++k) { const float w = wp[(size_t)k * NMOD];
#pragma unroll
                for (int r = 0; r < 9; ++r) acc[r] += sl[r * 128 + k] * w; }
#pragma unroll
            for (int r = 0; r < 9; ++r) MODP[((size_t)(l * 8 + kp) * 9 + r) * NMOD + col] = acc[r];
            __syncthreads();
        }
    }
    if (wg == G - 1) {
        const float invf[16] = {1.0f, 0.5623413251903491f, 0.31622776601683794f, 0.1778279410038923f, 0.1f, 0.05623413251903491f, 0.03162277660168379f, 0.01778279410038923f,
                                0.01f, 0.005623413251903491f, 0.0031622776601683794f, 0.0017782794100389228f, 0.001f, 0.0005623413251903491f, 0.00031622776601683794f, 0.00017782794100389227f};
        float2* rope = (float2*)(ws + WS_ROPE);
        for (int i = tid; i < 1024; i += NWAVES * 64) { const int f = i & 15; float fr = invf[0];
#pragma unroll
            for (int q = 1; q < 16; ++q) fr = (f == q) ? invf[q] : fr;
            const float ang = (float)(i >> 4) * fr; rope[i] = make_float2(cosf(ang), sinf(ang)); }
    }
    {
        LAS unsigned* scr = (LAS unsigned*)(lds + RING_OFF + wave * 16384);
        const float* in_win = KIN(6); const float* in_wout = KIN(12); const float* in_wgu = KIN(17); const float* in_wd = KIN(19);
        const int gw = wg * NWAVES + wave, NGW = G * NWAVES;
        constexpr int I_IN = 16 * 40, I_OUT = 16 * 16, I_GU = 16 * 32, I_DN = 16 * 16;
        constexpr int T_IN = DEPTH * I_IN, T_OUT = DEPTH * I_OUT, T_GU = DEPTH * NEXP * I_GU, T_DN = DEPTH * NEXP * I_DN;
        for (int it = gw; it < T_IN + T_OUT + T_GU + T_DN; it += NGW) {
            int r = it;
            if (r < T_IN) { const int l = r / I_IN, q = r % I_IN, kb = q / 40, nb = q % 40;
                p0_transpose_item(in_win + (size_t)l * DM * INW, DM, INW, (bf16*)(ws + WS_WIN) + (size_t)l * INW * DM, 64 * nb, 64 * kb, 64 * nb, scr, lane); continue; }
            r -= T_IN;
            if (r < T_OUT) { const int l = r / I_OUT, q = r % I_OUT, kb = q / 16, nb = q % 16;
                p0_transpose_item(in_wout + (size_t)l * DM * DM, DM, DM, (bf16*)(ws + WS_WOUT) + (size_t)l * DM * DM, 64 * nb, 64 * kb, 64 * nb, scr, lane); continue; }
            r -= T_OUT;
            if (r < T_GU) { const int le = r / I_GU, q = r % I_GU, kb = q / 32, nb = q % 32; const int n0 = 64 * nb;
                const int dest = (n0 < 1024) ? ((n0 >> 7) * 256 + (n0 & 127)) : ((((n0 - 1024) >> 7) * 256) + 128 + ((n0 - 1024) & 127));
                p0_transpose_item_f8(in_wgu + (size_t)le * DM * 2048, DM, 2048, ws + WS_WGU + (size_t)le * 2048 * DM, dest, 64 * kb, n0, 32.0f, scr, lane); continue; }
            r -= T_GU;
            { const int le = r / I_DN, q = r % I_DN, kb = q / 16, nb = q % 16;
                p0_transpose_item_f8(in_wd + (size_t)le * DM * DM, DM, DM, ws + WS_WD + (size_t)le * DM * DM, 64 * nb, 64 * kb, 64 * nb, 64.0f, scr, lane); }
        }
    }
    __syncthreads();
}
__device__ __forceinline__ void p0b(const Args& A, int tid) {
    const float* MODP = (const float*)(KWS() + WS_MODP); float* MODV = (float*)(KWS() + WS_MODV);
    for (int i = opaque_bid() * (NWAVES * 64) + tid; i < DEPTH * 9 * NMOD; i += gridDim.x * NWAVES * 64) {
        const int l = i / (9 * NMOD), rc = i % (9 * NMOD); float s = 0.f;
#pragma unroll
        for (int kp = 0; kp < 8; ++kp) s += MODP[(size_t)(l * 8 + kp) * 9 * NMOD + rc];
        MODV[i] = s;
    }
}
__device__ __forceinline__ void p0c(const Args& A, int lane, int wave) {
    const float* MODV = (const float*)(KWS() + WS_MODV); bf16* XH = (bf16*)(KWS() + WS_XH);
    const int gw = opaque_bid() * NWAVES + wave, NGW = gridDim.x * NWAVES, RPW = (RTOT + NGW - 1) / NGW;
    for (int r = gw * RPW; r < (gw + 1) * RPW && r < RTOT; ++r) {
        const float* src = (r < RCTX) ? KIN(2) + (size_t)r * DM : KIN(0) + (size_t)(r - RCTX) * DM;
        const float* mv = MODV + (size_t)mod_row(r) * NMOD;
        f32x4 v[4], o[4]; load_row_f32(src, lane, v); modulate(v, mv + 1 * DM, mv + 0 * DM, lane, o); store_row_bf16(XH + (size_t)r * DM, lane, o);
    }
}

__device__ __forceinline__ void unpack4(uint2 u, float (&x)[4]) { x[0] = bflo(u.x); x[1] = bfhi(u.x); x[2] = bflo(u.y); x[3] = bfhi(u.y); }
__device__ __forceinline__ uint2 pack4(const float (&x)[4]) { uint2 u; u.x = pk2(x[0], x[1]); u.y = pk2(x[2], x[3]); return u; }
__device__ __forceinline__ void rope4(float (&x1)[4], float (&x2)[4], const float2* rope, int pos, int f0, bool apply, float scale) {
    if (apply) { const f32x4 a = *(const f32x4*)(rope + pos * 16 + f0), b = *(const f32x4*)(rope + pos * 16 + f0 + 2);
        const float cs[4] = {a[0], a[2], b[0], b[2]}, sn[4] = {a[1], a[3], b[1], b[3]};
#pragma unroll
        for (int i = 0; i < 4; ++i) { const float p = x1[i] * cs[i] - x2[i] * sn[i], q = x1[i] * sn[i] + x2[i] * cs[i]; x1[i] = p; x2[i] = q; } }
#pragma unroll
    for (int i = 0; i < 4; ++i) { x1[i] *= scale; x2[i] *= scale; }
}
struct P2Raw { uint2 bb, r1, r2, q1, q2, k1, k2, vv; };
__device__ __forceinline__ void p2_load(const bf16* Z, int r, int lane, P2Raw& R) {
    const bf16* zr = Z + (size_t)r * INW; const int j4 = 4 * (lane & 3);
    R.bb = *(const uint2*)(zr + ZC_B + 4 * lane);
    { const bf16* s = zr + ((lane >> 5) ? ZC_RK : ZC_RQ) + ((lane >> 2) & 7) * 32 + j4; R.r1 = *(const uint2*)s; R.r2 = *(const uint2*)(s + 16); }
    { const bf16* s = zr + ZC_AQ + (lane >> 2) * 32 + j4; R.q1 = *(const uint2*)s; R.q2 = *(const uint2*)(s + 16); }
    { const bf16* s = zr + ZC_AK + ((lane & 15) >> 2) * 32 + j4; R.k1 = *(const uint2*)s; R.k2 = *(const uint2*)(s + 16); }
    R.vv = *(const uint2*)(zr + ZC_AV + (lane & 31) * 4);
}
__device__ __forceinline__ void p2_load_uc(const bf16* Z, int r, int lane, uint2& u, uint2& c) { const bf16* zr = Z + (size_t)r * INW; u = *(const uint2*)(zr + ZC_U + 4 * lane); c = *(const uint2*)(zr + ZC_C + 4 * lane); }
__device__ __forceinline__ void p2_prod(uint2 u, uint2 c, float (&v)[4]) { float a[4], d[4]; unpack4(u, a); unpack4(c, d);
#pragma unroll
    for (int i = 0; i < 4; ++i) v[i] = a[i] * d[i]; }
__device__ __forceinline__ void p2_norm_rope(float (&x1)[4], float (&x2)[4], float rn, const f32x4& g1, const f32x4& g2, const float (&cs)[4], const float (&sn)[4], float scale) {
#pragma unroll
    for (int i = 0; i < 4; ++i) { const float a = x1[i] * rn * g1[i], d = x2[i] * rn * g2[i]; x1[i] = (a * cs[i] - d * sn[i]) * scale; x2[i] = (a * sn[i] + d * cs[i]) * scale; }
}
__device__ __forceinline__ void p2_rows(const Args& A, int l, int r0, int n, bool last, int lane) {
    unsigned char* ws = KWS();
    const bf16* Z = (const bf16*)(ws + WS_Z); const float2* rope = (const float2*)(ws + WS_ROPE);
    bf16* MIX = (bf16*)(ws + WS_MIX); bf16* RQK = (bf16*)(ws + ((lane >> 5) ? WS_RK : WS_RQ)); bf16* AQ = (bf16*)(ws + WS_AQ); bf16* AK = (bf16*)(ws + WS_AK); bf16* AV = (bf16*)(ws + WS_AV);
    const int j = lane & 3, axis = (lane >> 2) & 1, c0 = 4 * lane;
    const float* cw = KIN(7) + (size_t)l * 256 * 3 + c0 * 3; const f32x4 w0 = *(const f32x4*)cw, w1 = *(const f32x4*)(cw + 4), w2 = *(const f32x4*)(cw + 8);
    const float wf[12] = {w0[0], w0[1], w0[2], w0[3], w1[0], w1[1], w1[2], w1[3], w2[0], w2[1], w2[2], w2[3]};
    const float* qg = KIN(10) + l * 64 + axis * 32 + 4 * j; const f32x4 qg1 = *(const f32x4*)qg, qg2 = *(const f32x4*)(qg + 16);
    const float* kg = KIN(11) + l * 64 + axis * 32 + 4 * j; const f32x4 kg1 = *(const f32x4*)kg, kg2 = *(const f32x4*)(kg + 16);
    const f32x4 one4 = {1.f, 1.f, 1.f, 1.f};
    if (n <= 0) return;
    float vp[4], vc[4]; uint2 un, cn;
    { uint2 u, c; p2_load_uc(Z, r0 > 0 ? r0 - 1 : 0, lane, u, c); p2_prod(u, c, vp); p2_load_uc(Z, r0, lane, u, c); p2_prod(u, c, vc); p2_load_uc(Z, r0 + 1 < RTOT ? r0 + 1 : RTOT - 1, lane, un, cn); }
    P2Raw cur, nxt; p2_load(Z, r0, lane, cur);
    for (int i = 0; i < n; ++i) {
        const int r = r0 + i;
        const bool isctx = r < RCTX; const int b = isctx ? (r >> 8) : ((r - RCTX) >> 12), t = isctx ? (r & 255) : ((r - RCTX) & 4095), tlen = isctx ? CTXL : SEQL;
        const bool need_out = !(isctx && last);
        float cs[4] = {1.f, 1.f, 1.f, 1.f}, sn[4] = {0.f, 0.f, 0.f, 0.f};
        if (!isctx) { const int pos = axis ? (t & 63) : (t >> 6); const f32x4 a = *(const f32x4*)(rope + pos * 16 + 4 * j), d = *(const f32x4*)(rope + pos * 16 + 4 * j + 2);
            cs[0] = a[0]; sn[0] = a[1]; cs[1] = a[2]; sn[1] = a[3]; cs[2] = d[0]; sn[2] = d[1]; cs[3] = d[2]; sn[3] = d[3]; }
        p2_load(Z, (i + 1 < n) ? r + 1 : r, lane, nxt);
        uint2 un2, cn2; p2_load_uc(Z, r + 2 < RTOT ? r + 2 : RTOT - 1, lane, un2, cn2);
        float vn[4]; p2_prod(un, cn, vn);
        if (need_out) { float bb[4], y[4]; unpack4(cur.bb, bb); const float mp = (t > 0) ? 1.f : 0.f, mn = (t < tlen - 1) ? 1.f : 0.f;
#pragma unroll
            for (int q = 0; q < 4; ++q) y[q] = bb[q] * (wf[3 * q] * (vp[q] * mp) + wf[3 * q + 1] * vc[q] + wf[3 * q + 2] * (vn[q] * mn));
            *(uint2*)(MIX + (size_t)r * DM + c0) = pack4(y); }
        { float x1[4], x2[4]; unpack4(cur.r1, x1); unpack4(cur.r2, x2);
            p2_norm_rope(x1, x2, 1.0f, one4, one4, cs, sn, (lane >> 5) ? 0.125f : 1.0f);
            bf16* dst = RQK + (size_t)r * 256 + ((lane >> 2) & 7) * 32 + 4 * j; *(uint2*)dst = pack4(x1); *(uint2*)(dst + 16) = pack4(x2); }
        { float x1[4], x2[4]; unpack4(cur.q1, x1); unpack4(cur.q2, x2); float ss = 0.f;
#pragma unroll
            for (int q = 0; q < 4; ++q) ss += x1[q] * x1[q] + x2[q] * x2[q];
            ss += __shfl_xor(ss, 1); ss += __shfl_xor(ss, 2); ss += __shfl_xor(ss, 4);
            p2_norm_rope(x1, x2, 1.0f / sqrtf(ss * (1.0f / 64.0f) + LN_EPS), qg1, qg2, cs, sn, attn_body::C2);
            if (need_out) { bf16* dst = AQ + (size_t)r * 512 + (lane >> 2) * 32 + 4 * j; *(uint2*)dst = pack4(x1); *(uint2*)(dst + 16) = pack4(x2); } }
        { float x1[4], x2[4]; unpack4(cur.k1, x1); unpack4(cur.k2, x2); float ss = 0.f;
#pragma unroll
            for (int q = 0; q < 4; ++q) ss += x1[q] * x1[q] + x2[q] * x2[q];
            ss += __shfl_xor(ss, 1); ss += __shfl_xor(ss, 2); ss += __shfl_xor(ss, 4);
            p2_norm_rope(x1, x2, 1.0f / sqrtf(ss * (1.0f / 64.0f) + LN_EPS), kg1, kg2, cs, sn, 1.0f);
            const int key = isctx ? t : CTXL + t, blk = (lane & 15) >> 2;
            if (lane < 16) { bf16* dst = AK + ((size_t)(b * 2 + (blk >> 1)) * NKEY + key) * 64 + (blk & 1) * 32 + 4 * j; *(uint2*)dst = pack4(x1); *(uint2*)(dst + 16) = pack4(x2); }
            if (lane >= 32) { const int c = (lane - 32) * 4; *(uint2*)(AV + ((size_t)(b * 2 + (c >> 6)) * NKEY + key) * 64 + (c & 63)) = cur.vv; } }
#pragma unroll
        for (int q = 0; q < 4; ++q) { vp[q] = vc[q]; vc[q] = vn[q]; }
        un = un2; cn = cn2; cur = nxt;
    }
}
constexpr int RT_PITCH = 136;
__device__ __forceinline__ void p2_kv_job(const Args& A, int l, int u, LAS unsigned char* lds, int tid, int lane, int wave) {
    unsigned char* ws = KWS();
    const int h = u & 3, pf = (u >> 2) % NPF, b = (u >> 2) / NPF;
    const bool isctx = pf < 2; const int row0 = isctx ? (b * CTXL + pf * 128) : (RCTX + b * SEQL + (pf - 2) * 128);
    const bf16* Z = (const bf16*)(ws + WS_Z); const float2* rope = (const float2*)(ws + WS_ROPE);
    LAS unsigned short* VT = (LAS unsigned short*)(lds + RING_OFF); LAS unsigned short* KFT = VT + 64 * RT_PITCH; LAS unsigned short* KBT = KFT + 64 * RT_PITCH;
    const float lgf = log2_gamma(KIN(8)[(l * 2 + 0) * 4 + h]), lgb = log2_gamma(KIN(8)[(l * 2 + 1) * 4 + h]);
#pragma unroll
    for (int i = 0; i < 2; ++i) { const int idx = tid + 512 * i, t = idx >> 3, eg = idx & 7;
        const v4u v = *(const v4u*)(Z + (size_t)(row0 + t) * INW + ZC_RV + h * 64 + eg * 8);
        LAS unsigned short* d = VT + (eg * 8) * RT_PITCH + t;
        d[0 * RT_PITCH] = (unsigned short)(v.x & 0xffffu); d[1 * RT_PITCH] = (unsigned short)(v.x >> 16); d[2 * RT_PITCH] = (unsigned short)(v.y & 0xffffu); d[3 * RT_PITCH] = (unsigned short)(v.y >> 16);
        d[4 * RT_PITCH] = (unsigned short)(v.z & 0xffffu); d[5 * RT_PITCH] = (unsigned short)(v.z >> 16); d[6 * RT_PITCH] = (unsigned short)(v.w & 0xffffu); d[7 * RT_PITCH] = (unsigned short)(v.w >> 16); }
    { const int t = tid >> 2, axis = (tid >> 1) & 1, fg = tid & 1;
        const bf16* src = Z + (size_t)(row0 + t) * INW + ZC_RK + h * 64 + axis * 32 + 8 * fg;
        const v4u a = *(const v4u*)src, c = *(const v4u*)(src + 16);
        float x1[8] = {bflo(a.x), bfhi(a.x), bflo(a.y), bfhi(a.y), bflo(a.z), bfhi(a.z), bflo(a.w), bfhi(a.w)};
        float x2[8] = {bflo(c.x), bfhi(c.x), bflo(c.y), bfhi(c.y), bflo(c.z), bfhi(c.z), bflo(c.w), bfhi(c.w)};
        if (!isctx) { const int tt = (pf - 2) * 128 + t, pos = axis ? (tt & 63) : (tt >> 6); const float2* rp = rope + pos * 16 + 8 * fg;
#pragma unroll
            for (int i = 0; i < 8; ++i) { const float2 cs = rp[i]; const float p = x1[i] * cs.x - x2[i] * cs.y, q = x1[i] * cs.y + x2[i] * cs.x; x1[i] = p; x2[i] = q; } }
        const float wf = exp2f((float)(127 - t) * lgf) * 0.125f, wb = exp2f((float)t * lgb) * 0.125f;
        const int d0 = axis * 32 + 8 * fg;
#pragma unroll
        for (int i = 0; i < 8; ++i) {
            KFT[(d0 + i) * RT_PITCH + t] = (unsigned short)f2bf(x1[i] * wf); KFT[(d0 + 16 + i) * RT_PITCH + t] = (unsigned short)f2bf(x2[i] * wf);
            KBT[(d0 + i) * RT_PITCH + t] = (unsigned short)f2bf(x1[i] * wb); KBT[(d0 + 16 + i) * RT_PITCH + t] = (unsigned short)f2bf(x2[i] * wb); }
    }
    __syncthreads();
    { const int dir = wave >> 2, te = (wave >> 1) & 1, td = wave & 1, r32 = lane & 31, hh = lane >> 5;
        const LAS unsigned short* KT = dir ? KBT : KFT;
        f32x16 acc = {};
#pragma unroll
        for (int s = 0; s < 8; ++s) {
            const bf16x8 a = *(const LAS bf16x8*)(VT + (te * 32 + r32) * RT_PITCH + s * 16 + hh * 8);
            const bf16x8 bq = *(const LAS bf16x8*)(KT + (td * 32 + r32) * RT_PITCH + s * 16 + hh * 8);
            acc = __builtin_amdgcn_mfma_f32_32x32x16_bf16(a, bq, acc, 0, 0, 0);
        }
        float* out = (float*)(ws + WS_KVS) + ((size_t)((b * 4 + h) * NPF + pf) * 2 + dir) * 4096;
#pragma unroll
        for (int q = 0; q < 16; ++q) { const int e = te * 32 + (q & 3) + 8 * (q >> 2) + 4 * hh; out[e * 64 + td * 32 + r32] = acc[q]; }
    }
    __syncthreads();
}
__device__ __forceinline__ void p2(const Args& A, int l, LAS unsigned char* lds, int tid, int lane, int wave) {
    const bool last = (l == DEPTH - 1);
    for (int u = opaque_bid(); u < NBATCH * NPF * 4; u += gridDim.x) p2_kv_job(A, l, u, lds, tid, lane, wave);
    const int gw = opaque_bid() * NWAVES + wave, NGW = gridDim.x * NWAVES, RPW = (RTOT + NGW - 1) / NGW;
    { const int r0 = gw * RPW; p2_rows(A, l, r0, (r0 + RPW <= RTOT) ? RPW : ((RTOT > r0) ? RTOT - r0 : 0), last, lane); }
}

__device__ __forceinline__ void p4_scan(const Args& A, int l, int tid) {
    const float* KVS = (const float*)(KWS() + WS_KVS); bf16* SS = (bf16*)(KWS() + WS_SS);
    for (int gid = opaque_bid() * (NWAVES * 64) + tid; gid < NBATCH * 4 * 4096; gid += gridDim.x * NWAVES * 64) {
        const int bh = gid >> 12, ed = gid & 4095, h = bh & 3;
        const float gf = exp2f(128.0f * log2_gamma(KIN(8)[(l * 2 + 0) * 4 + h])), gb = exp2f(128.0f * log2_gamma(KIN(8)[(l * 2 + 1) * 4 + h]));
        const size_t base = (size_t)bh * NPF * 2 * 4096 + ed;
        float S = 0.f;
        for (int pf = 0; pf < NPF; ++pf) { const size_t o = base + (size_t)(pf * 2 + 0) * 4096; SS[o] = (bf16)f2bf(S); S = gf * S + KVS[o]; }
        S = 0.f;
        for (int q = 0; q < NPF; ++q) { const int pf = (q == 0) ? 1 : (q == 1) ? 0 : (NPF + 1 - q);
            const size_t o = base + (size_t)(pf * 2 + 1) * 4096; SS[o] = (bf16)f2bf(S); S = gb * S + KVS[o]; }
    }
}
__device__ __forceinline__ void p4_attention(const Args& A, int l, char* lds_ring) {
    using abf = attn_body::bf16;
    const abf* AQ = (const abf*)(KWS() + WS_AQ); const abf* AK = (const abf*)(KWS() + WS_AK); const abf* AV = (const abf*)(KWS() + WS_AV); abf* MIX = (abf*)(KWS() + WS_MIX);
    const int c = opaque_bid(), G = gridDim.x;
    const int x = c & 7, m = c >> 3, per = G >> 3, b = x;
    for (int i = 0; i < 5; ++i) {
        const bool isctx = (i == 4);
        if (isctx && (l == DEPTH - 1 || m >= 8)) break;
        const int uu = m + per * i; if (!isctx && uu >= 128) break;
        const int h = isctx ? m : (uu >> 4), kvh = h >> 2, NT = isctx ? (CTXL / 64) : (NKEY / 64);
        const size_t qrow = isctx ? (size_t)b * CTXL : (size_t)RCTX + (size_t)b * SEQL + (size_t)(uu & 15) * 256;
        attn_body::attn_unit<8>(AQ + qrow * 512 + h * 64, AK + (size_t)(b * 2 + kvh) * NKEY * 64, AV + (size_t)(b * 2 + kvh) * NKEY * 64, MIX + qrow * DM + 512 + h * 64, NT, lds_ring);
    }
}

__device__ __forceinline__ void p5_unit(const Args& A, int l, int g, int hp, LAS unsigned char* lds, int tid, int lane, int wave) {
    unsigned char* ws = KWS();
    const bf16* Z = (const bf16*)(ws + WS_Z); const bf16* RQ = (const bf16*)(ws + WS_RQ); const bf16* RK = (const bf16*)(ws + WS_RK); const bf16* SS = (const bf16*)(ws + WS_SS);
    bf16* MIX = (bf16*)(ws + WS_MIX);
    const int row0 = g * 128;
    int b, pf; if (g < 16) { b = g >> 1; pf = g & 1; } else { b = (g - 16) >> 5; pf = 2 + ((g - 16) & 31); }
    LAS unsigned short* VT = (LAS unsigned short*)(lds + RING_OFF);
#pragma unroll
    for (int i = 0; i < 4; ++i) { const int idx = tid + 512 * i, hl = idx >> 10, t = (idx >> 3) & 127, eg = idx & 7;
        const v4u v = *(const v4u*)(Z + (size_t)(row0 + t) * INW + ZC_RV + (2 * hp + hl) * 64 + eg * 8);
        LAS unsigned short* d = VT + (hl * 64 + eg * 8) * RT_PITCH + t;
        d[0 * RT_PITCH] = (unsigned short)(v.x & 0xffffu); d[1 * RT_PITCH] = (unsigned short)(v.x >> 16); d[2 * RT_PITCH] = (unsigned short)(v.y & 0xffffu); d[3 * RT_PITCH] = (unsigned short)(v.y >> 16);
        d[4 * RT_PITCH] = (unsigned short)(v.z & 0xffffu); d[5 * RT_PITCH] = (unsigned short)(v.z >> 16); d[6 * RT_PITCH] = (unsigned short)(v.w & 0xffffu); d[7 * RT_PITCH] = (unsigned short)(v.w >> 16); }
    __syncthreads();
    {
        const int hl = wave >> 2, h = 2 * hp + hl, ib = wave & 3, r32 = lane & 31, hh = lane >> 5;
        const float lgf = log2_gamma(KIN(8)[(l * 2 + 0) * 4 + h]), lgb = log2_gamma(KIN(8)[(l * 2 + 1) * 4 + h]);
        const int iloc = ib * 32 + r32;
        bf16x8 qf[4];
#pragma unroll
        for (int s = 0; s < 4; ++s) qf[s] = *(const bf16x8*)(RQ + (size_t)(row0 + iloc) * 256 + h * 64 + s * 16 + hh * 8);
        const bf16* Sf = SS + ((size_t)((b * 4 + h) * NPF + pf) * 2 + 0) * 4096; const bf16* Sb = Sf + 4096;
        f32x16 Y[2];
        {
            const float af = exp2f((float)(iloc + 1) * lgf), ab = exp2f((float)(128 - iloc) * lgb);
#pragma unroll
            for (int et = 0; et < 2; ++et) {
                f32x16 cf = {}, cb = {};
#pragma unroll
                for (int s = 0; s < 4; ++s) {
                    const bf16x8 a0 = *(const bf16x8*)(Sf + (et * 32 + r32) * 64 + s * 16 + hh * 8), a1 = *(const bf16x8*)(Sb + (et * 32 + r32) * 64 + s * 16 + hh * 8);
                    cf = __builtin_amdgcn_mfma_f32_32x32x16_bf16(a0, qf[s], cf, 0, 0, 0); cb = __builtin_amdgcn_mfma_f32_32x32x16_bf16(a1, qf[s], cb, 0, 0, 0);
                }
#pragma unroll
                for (int q = 0; q < 16; ++q) Y[et][q] = af * cf[q] + ab * cb[q];
            }
        }
        const LAS unsigned short* VTh = VT + hl * 64 * RT_PITCH;
#pragma unroll 1
        for (int jt = 0; jt < 4; ++jt) {
            f32x16 X = {};
#pragma unroll
            for (int s = 0; s < 4; ++s) { const bf16x8 a = *(const bf16x8*)(RK + (size_t)(row0 + jt * 32 + r32) * 256 + h * 64 + s * 16 + hh * 8);
                X = __builtin_amdgcn_mfma_f32_32x32x16_bf16(a, qf[s], X, 0, 0, 0); }
#pragma unroll
            for (int q = 0; q < 16; ++q) { const int jloc = jt * 32 + (q & 3) + 8 * (q >> 2) + 4 * hh; const int dl = iloc - jloc;
                X[q] *= (dl >= 0) ? exp2f((float)dl * lgf) : exp2f((float)(-dl) * lgb); }
#pragma unroll
            for (int s = 0; s < 2; ++s) {
                v4u pw; pw.x = pk2(X[8 * s + 0], X[8 * s + 1]); pw.y = pk2(X[8 * s + 2], X[8 * s + 3]); pw.z = pk2(X[8 * s + 4], X[8 * s + 5]); pw.w = pk2(X[8 * s + 6], X[8 * s + 7]);
                const bf16x8 bfrag = __builtin_bit_cast(bf16x8, pw);
#pragma unroll
                for (int et = 0; et < 2; ++et) {
                    const LAS unsigned short* vp = VTh + (et * 32 + r32) * RT_PITCH + jt * 32 + 16 * s + 4 * hh;
                    const v2u lo = *(const LAS v2u*)vp, hi2 = *(const LAS v2u*)(vp + 8);
                    v4u aw; aw.x = lo.x; aw.y = lo.y; aw.z = hi2.x; aw.w = hi2.y;
                    Y[et] = __builtin_amdgcn_mfma_f32_32x32x16_bf16(__builtin_bit_cast(bf16x8, aw), bfrag, Y[et], 0, 0, 0);
                }
            }
        }
        float s1 = 0.f;
#pragma unroll
        for (int q = 0; q < 16; ++q) s1 += Y[0][q] + Y[1][q];
        s1 += __shfl_xor(s1, 32); const float mu = s1 * (1.0f / 64.0f); float s2 = 0.f;
#pragma unroll
        for (int q = 0; q < 16; ++q) { const float d0 = Y[0][q] - mu, d1 = Y[1][q] - mu; s2 += d0 * d0 + d1 * d1; }
        s2 += __shfl_xor(s2, 32); const float rstd = 1.0f / sqrtf(s2 * (1.0f / 64.0f) + LN_EPS);
        const size_t row = (size_t)(row0 + iloc);
#pragma unroll
        for (int et = 0; et < 2; ++et)
#pragma unroll
            for (int q4 = 0; q4 < 4; ++q4) { const int e0 = et * 32 + 8 * q4 + 4 * hh;
                float gz[4]; unpack4(*(const uint2*)(Z + row * INW + ZC_RG + h * 64 + e0), gz);
                const f32x4 gn = *(const f32x4*)(KIN(9) + l * 256 + h * 64 + e0);
                float o[4];
#pragma unroll
                for (int i = 0; i < 4; ++i) { const float yn = (Y[et][4 * q4 + i] - mu) * rstd * gn[i]; o[i] = yn * (gz[i] / (1.0f + expf(-gz[i]))); }
                *(uint2*)(MIX + row * DM + 256 + h * 64 + e0) = pack4(o); }
    }
    __syncthreads();
}
__device__ __forceinline__ void p5(const Args& A, int l, LAS unsigned char* lds, int tid, int lane, int wave) {
    const int g0 = (l == DEPTH - 1) ? 16 : 0;
    for (int u = opaque_bid(); u < (272 - g0) * 2; u += gridDim.x) p5_unit(A, l, g0 + (u >> 1), u & 1, lds, tid, lane, wave);
}

__device__ __forceinline__ float reduce32(float (&v)[32], int lane) {
#pragma unroll
    for (int i = 0; i < 16; ++i) { const bool up = lane & 32; const float send = up ? v[i] : v[i + 16], keep = up ? v[i + 16] : v[i]; v[i] = keep + __shfl_xor(send, 32); }
#pragma unroll
    for (int i = 0; i < 8; ++i) { const bool up = lane & 16; const float send = up ? v[i] : v[i + 8], keep = up ? v[i + 8] : v[i]; v[i] = keep + __shfl_xor(send, 16); }
#pragma unroll
    for (int i = 0; i < 4; ++i) { const bool up = lane & 8; const float send = up ? v[i] : v[i + 4], keep = up ? v[i + 4] : v[i]; v[i] = keep + __shfl_xor(send, 8); }
#pragma unroll
    for (int i = 0; i < 2; ++i) { const bool up = lane & 4; const float send = up ? v[i] : v[i + 2], keep = up ? v[i + 2] : v[i]; v[i] = keep + __shfl_xor(send, 4); }
    { const bool up = lane & 2; const float send = up ? v[0] : v[1], keep = up ? v[1] : v[0]; v[0] = keep + __shfl_xor(send, 2); }
    return v[0] + __shfl_xor(v[0], 1);
}
struct P7Raw { v4u x[4]; uint2 y[4]; };
__device__ __forceinline__ void p7_load(int l, int r, int lane, const float* xin_lat, const float* xin_ctx, const bf16* XSA, const bf16* Y, P7Raw& R) {
    if (l == 0) { const float* p = (r < RCTX) ? xin_ctx + (size_t)r * DM : xin_lat + (size_t)(r - RCTX) * DM;
#pragma unroll
        for (int j = 0; j < 4; ++j) R.x[j] = *(const v4u*)(p + 256 * j + 4 * lane); }
    else { const bf16* p = XSA + (size_t)r * DM;
#pragma unroll
        for (int j = 0; j < 4; ++j) { const uint2 u = *(const uint2*)(p + 256 * j + 4 * lane); R.x[j] = (v4u){u.x, u.y, 0u, 0u}; } }
    const bf16* q = Y + (size_t)r * DM;
#pragma unroll
    for (int j = 0; j < 4; ++j) R.y[j] = *(const uint2*)(q + 256 * j + 4 * lane);
}
__device__ __forceinline__ void p7_ln(int l, int r, int lane, const P7Raw& R, const float* mv, const float* lng, const float* lnb, bf16* XSA, unsigned char* H2, f32x4 (&hv)[4]) {
    f32x4 v[4];
#pragma unroll
    for (int j = 0; j < 4; ++j) {
        f32x4 x;
        if (l == 0) x = __builtin_bit_cast(f32x4, R.x[j]);
        else { const unsigned a = R.x[j][0], b = R.x[j][1]; x = (f32x4){bflo(a), bfhi(a), bflo(b), bfhi(b)}; }
        const f32x4 y = (f32x4){bflo(R.y[j].x), bfhi(R.y[j].x), bflo(R.y[j].y), bfhi(R.y[j].y)};
        const f32x4 g1 = *(const f32x4*)(mv + 2 * DM + 256 * j + 4 * lane); v[j] = ALPHA * x + g1 * y; }
    ln_row(v, lng, lnb, lane);
    store_row_bf16(XSA + (size_t)r * DM, lane, v);
    modulate(v, mv + 4 * DM, mv + 3 * DM, lane, hv);
#pragma unroll
    for (int j = 0; j < 4; ++j) *(unsigned*)(H2 + (size_t)r * DM + 256 * j + 4 * lane) = (unsigned)__builtin_amdgcn_cvt_pk_fp8_f32(hv[j][2], hv[j][3], __builtin_amdgcn_cvt_pk_fp8_f32(hv[j][0], hv[j][1], 0, false), true);
}
__device__ __forceinline__ void p7_route(const Args& A, float logit, int r, int rloc, int lane, LAS int* lcnt, LAS int* ent) {
    float val = logit; const int idx = lane >> 1; float tv[4]; int te[4];
#pragma unroll
    for (int k = 0; k < 4; ++k) {
        float bv = val; int bi = idx;
#pragma unroll
        for (int o = 1; o < 64; o <<= 1) { const float ov = __shfl_xor(bv, o); const int oi = __shfl_xor(bi, o); const bool take = (ov > bv) || (ov == bv && oi < bi); bv = take ? ov : bv; bi = take ? oi : bi; }
        tv[k] = bv; te[k] = bi; val = (idx == bi) ? -INFINITY : val;
    }
    const float p1 = expf(tv[1] - tv[0]), p2 = expf(tv[2] - tv[0]), p3 = expf(tv[3] - tv[0]); const float inv = 1.0f / (1.0f + p1 + p2 + p3);
    if (lane < 4) {
        const int e = (lane == 0) ? te[0] : (lane == 1) ? te[1] : (lane == 2) ? te[2] : te[3];
        const float w = ((lane == 0) ? 1.0f : (lane == 1) ? p1 : (lane == 2) ? p2 : p3) * inv;
        const int lp = __hip_atomic_fetch_add(lcnt + e, 1, __ATOMIC_RELAXED, __HIP_MEMORY_SCOPE_WORKGROUP);
        ent[rloc * 4 + lane] = e | (lp << 8);
        ((float*)(KWS() + WS_RW))[(size_t)r * 4 + lane] = w;
    }
}
__device__ __forceinline__ void p7(const Args& A, int l, LAS unsigned char* lds, int tid, int lane, int wave) {
    unsigned char* ws = KWS();
    const int row_lo = (l == DEPTH - 1) ? RCTX : 0, nrows = RTOT - row_lo;
    const int NGW = gridDim.x * NWAVES, RPW = (nrows + NGW - 1) / NGW, wg_row0 = row_lo + opaque_bid() * NWAVES * RPW;
    LAS f32x4* WL = (LAS f32x4*)(lds + RING_OFF);
    LAS int* lcnt = (LAS int*)(lds + LCNT_OFF); LAS int* lbase = (LAS int*)(lds + LBASE_OFF); LAS int* ent = (LAS int*)(lds + ENT_OFF);
    const float* wr = KIN(15) + (size_t)l * DM * NEXP;
    for (int s = tid; s < 8192; s += NWAVES * 64) { const int ln = s & 63, eg = (s >> 6) & 7, jc = s >> 9; const int k = 256 * (jc >> 2) + 4 * ln + (jc & 3);
        WL[s] = *(const f32x4*)(wr + (size_t)k * NEXP + 4 * eg); }
    if (tid < 32) lcnt[tid] = 0;
    __syncthreads();
    const float bias_e = KIN(16)[l * NEXP + (lane >> 1)];
    const int w_row0 = wg_row0 + wave * RPW;
    const float* xin_lat = KIN(0); const float* xin_ctx = KIN(2); const float* lng = KIN(13) + (size_t)(l * 2 + 0) * DM; const float* lnb = KIN(14) + (size_t)(l * 2 + 0) * DM;
    bf16* XSA = (bf16*)(ws + WS_XSA); const bf16* Yb = (const bf16*)(ws + WS_Y); unsigned char* H2 = ws + WS_H2; const float* MODV = (const float*)(ws + WS_MODV);
    const int nmy = (w_row0 + RPW <= RTOT) ? RPW : ((RTOT > w_row0) ? RTOT - w_row0 : 0);
    P7Raw cur, nxt;
    if (nmy > 0) p7_load(l, w_row0, lane, xin_lat, xin_ctx, XSA, Yb, cur);
    for (int i = 0; i < nmy; ++i) {
        const int r0 = w_row0 + i;
        p7_load(l, (i + 1 < nmy) ? r0 + 1 : r0, lane, xin_lat, xin_ctx, XSA, Yb, nxt);
        f32x4 h0[4];
        p7_ln(l, r0, lane, cur, MODV + (size_t)(l * 9 + mod_row(r0)) * NMOD, lng, lnb, XSA, H2, h0);
        cur = nxt;
        f32x4 acc[8];
#pragma unroll
        for (int eg = 0; eg < 8; ++eg) acc[eg] = (f32x4){0.f, 0.f, 0.f, 0.f};
#pragma unroll
        for (int j = 0; j < 4; ++j)
#pragma unroll
            for (int c = 0; c < 4; ++c) { const float xa = h0[j][c];
#pragma unroll
                for (int eg = 0; eg < 8; ++eg) acc[eg] = WL[((j * 4 + c) * 8 + eg) * 64 + lane] * xa + acc[eg]; }
        float a0[32];
#pragma unroll
        for (int e = 0; e < 32; ++e) a0[e] = acc[e >> 2][e & 3];
        const float lg0 = reduce32(a0, lane) + bias_e;
        p7_route(A, lg0, r0, r0 - wg_row0, lane, lcnt, ent);
    }
    __syncthreads();
    if (tid < 32) lbase[tid] = (int)__hip_atomic_fetch_add((unsigned*)(ws + WS_CTL) + CW_GCNT + (l * 32 + tid) * 16, (unsigned)lcnt[tid], __ATOMIC_RELAXED, __HIP_MEMORY_SCOPE_AGENT);
    __syncthreads();
    { const int nent = NWAVES * RPW * 4; int* RE = (int*)(ws + WS_RE); int* RP = (int*)(ws + WS_RP);
        for (int i = tid; i < nent; i += NWAVES * 64) { const int row = wg_row0 + (i >> 2); if (row < RTOT) { const int v = ent[i], e = v & 255, lp = v >> 8;
            RE[(size_t)row * 4 + (i & 3)] = e; RP[(size_t)row * 4 + (i & 3)] = lbase[e] + lp; } } }
    __syncthreads();
}
__device__ __forceinline__ void moe_offsets(const Args& A, int l, LAS unsigned char* lds, int tid) {
    volatile LAS int* offt = (volatile LAS int*)(lds + OFFT_OFF);
    if (tid < 64) {
        const unsigned c = __hip_atomic_load((unsigned*)(KWS() + WS_CTL) + CW_GCNT + (l * 32 + (tid & 31)) * 16, __ATOMIC_RELAXED, __HIP_MEMORY_SCOPE_AGENT);
        int x = (int)((c + 255u) >> 8);
#pragma unroll
        for (int o = 1; o < 32; o <<= 1) { const int v = __shfl_up(x, o); if ((tid & 31) >= o) x += v; }
        if (tid < 32) offt[tid + 1] = x;
        if (tid == 0) offt[0] = 0;
    }
    __syncthreads();
}
__device__ __forceinline__ void p8(const Args& A, int l, LAS unsigned char* lds, int tid, int lane, int wave) {
    unsigned char* ws = KWS();
    moe_offsets(A, l, lds, tid);
    volatile LAS int* offt = (volatile LAS int*)(lds + OFFT_OFF);
    const int row_lo = (l == DEPTH - 1) ? RCTX : 0, nrows = RTOT - row_lo;
    const int NGW = gridDim.x * NWAVES, RPW = (nrows + NGW - 1) / NGW, w_row0 = row_lo + (opaque_bid() * NWAVES + wave) * RPW;
    const int* RE = (const int*)(ws + WS_RE); const int* RP = (const int*)(ws + WS_RP); const float* RW = (const float*)(ws + WS_RW);
    int* SLOT = (int*)(ws + WS_SLOT); float* ROWW = (float*)(ws + WS_ROWW); const unsigned char* H2 = ws + WS_H2; unsigned char* XS2 = ws + WS_XS2;
    const int nmy = (w_row0 + RPW <= RTOT) ? RPW : ((RTOT > w_row0) ? RTOT - w_row0 : 0);
    int sa = 0, sb = 0; float wa = 0.f, wb = 0.f;
    if (lane < nmy * 4) { const size_t q = (size_t)w_row0 * 4 + lane; sa = offt[RE[q] & 31] * 256 + RP[q]; wa = RW[q]; SLOT[q] = sa; ROWW[sa] = wa; }
    if (64 + lane < nmy * 4) { const size_t q = (size_t)w_row0 * 4 + 64 + lane; sb = offt[RE[q] & 31] * 256 + RP[q]; wb = RW[q]; SLOT[q] = sb; ROWW[sb] = wb; }
    v4u cur = {0u, 0u, 0u, 0u}, nxt;
    if (nmy > 0) cur = *(const v4u*)(H2 + (size_t)w_row0 * DM + 16 * lane);
    for (int i = 0; i < nmy; ++i) {
        const int r = w_row0 + i;
        nxt = *(const v4u*)(H2 + (size_t)((i + 1 < nmy) ? r + 1 : r) * DM + 16 * lane);
#pragma unroll
        for (int k = 0; k < 4; ++k) { const int idx = 4 * i + k; const int slot = (idx < 64) ? __builtin_amdgcn_readlane(sa, idx & 63) : __builtin_amdgcn_readlane(sb, idx & 63);
            *(v4u*)(XS2 + (size_t)slot * DM + 16 * lane) = cur; }
        cur = nxt;
    }
}
__device__ __forceinline__ void moe_order(pg8::MoeOrder& S, LAS unsigned char* lds, int sh) {
    volatile LAS int* offt = (volatile LAS int*)(lds + OFFT_OFF);
#pragma unroll
    for (int j = 0; j < 11; ++j) { unsigned w = 0;
#pragma unroll
        for (int q = 0; q < 3; ++q) { const int k = 3 * j + q + 1; if (k <= 32) w |= ((unsigned)offt[k] & 1023u) << (10 * q); }
        S.pk[j] = (unsigned)__builtin_amdgcn_readfirstlane((int)w); }
    S.nt = __builtin_amdgcn_readfirstlane(offt[32]); S.sh = sh; S.G = gridDim.x; S.c = opaque_bid();
}
struct P11Raw { unsigned y[4][4]; uint2 x[4]; };
__device__ __forceinline__ void p11_load(int r, int lane, int s0, int s1, int s2, int s3, const unsigned char* YB, const bf16* XSA, P11Raw& R) {
    const int sl[4] = {s0, s1, s2, s3};
#pragma unroll
    for (int k = 0; k < 4; ++k) { const unsigned char* p = YB + (size_t)sl[k] * DM;
#pragma unroll
        for (int j = 0; j < 4; ++j) R.y[k][j] = *(const unsigned*)(p + 256 * j + 4 * lane); }
    const bf16* q = XSA + (size_t)r * DM;
#pragma unroll
    for (int j = 0; j < 4; ++j) R.x[j] = *(const uint2*)(q + 256 * j + 4 * lane);
}
__device__ __forceinline__ void p11(const Args& A, int l, int lane, int wave) {
    unsigned char* ws = KWS();
    const bool last = (l == DEPTH - 1);
    const int row_lo = last ? RCTX : 0, nrows = RTOT - row_lo;
    const int NGW = gridDim.x * NWAVES, RPW = (nrows + NGW - 1) / NGW, w_row0 = row_lo + (opaque_bid() * NWAVES + wave) * RPW;
    const int* SLOT = (const int*)(ws + WS_SLOT); const unsigned char* YB = ws + WS_YB; bf16* XSA = (bf16*)(ws + WS_XSA); bf16* XH = (bf16*)(ws + WS_XH);
    const float* MODV = (const float*)(ws + WS_MODV); float* outp = KOUT();
    const float* lng = KIN(13) + (size_t)(l * 2 + 1) * DM; const float* lnb = KIN(14) + (size_t)(l * 2 + 1) * DM;
    const int nmy = (w_row0 + RPW <= RTOT) ? RPW : ((RTOT > w_row0) ? RTOT - w_row0 : 0);
    const int sa = (lane < nmy * 4) ? SLOT[(size_t)w_row0 * 4 + lane] : 0, sb = (64 + lane < nmy * 4) ? SLOT[(size_t)w_row0 * 4 + 64 + lane] : 0;
#define P11_SLOT(idx) (((idx) < 64) ? __builtin_amdgcn_readlane(sa, (idx) & 63) : __builtin_amdgcn_readlane(sb, (idx) & 63))
    P11Raw cur, nxt;
    if (nmy > 0) p11_load(w_row0, lane, P11_SLOT(0), P11_SLOT(1), P11_SLOT(2), P11_SLOT(3), YB, XSA, cur);
    for (int i = 0; i < nmy; ++i) {
        const int r = w_row0 + i;
        { const int in = (i + 1 < nmy) ? i + 1 : i, q = 4 * in; p11_load(w_row0 + in, lane, P11_SLOT(q), P11_SLOT(q + 1), P11_SLOT(q + 2), P11_SLOT(q + 3), YB, XSA, nxt); }
        const float* mv = MODV + (size_t)(l * 9 + mod_row(r)) * NMOD;
        f32x4 v[4];
#pragma unroll
        for (int j = 0; j < 4; ++j) {
            f32x4 f = {0.f, 0.f, 0.f, 0.f};
#pragma unroll
            for (int k = 0; k < 4; ++k) { typedef float f32x2_ __attribute__((ext_vector_type(2))); const f32x2_ lo = __builtin_amdgcn_cvt_pk_f32_fp8((int)cur.y[k][j], false), hi = __builtin_amdgcn_cvt_pk_f32_fp8((int)cur.y[k][j], true); f += (f32x4){lo[0], lo[1], hi[0], hi[1]}; }
            const f32x4 x = (f32x4){bflo(cur.x[j].x), bfhi(cur.x[j].x), bflo(cur.x[j].y), bfhi(cur.x[j].y)};
            const f32x4 g2 = *(const f32x4*)(mv + 5 * DM + 256 * j + 4 * lane); v[j] = ALPHA * x + g2 * f; }
        ln_row(v, lng, lnb, lane);
        if (last) store_row_f32(outp + (size_t)(r - RCTX) * DM, lane, v);
        else { store_row_bf16(XSA + (size_t)r * DM, lane, v);
            const float* mn = MODV + (size_t)((l + 1) * 9 + mod_row(r)) * NMOD; f32x4 o[4]; modulate(v, mn + 1 * DM, mn + 0 * DM, lane, o);
            store_row_bf16(XH + (size_t)r * DM, lane, o); }
        cur = nxt;
    }
#undef P11_SLOT
}

#define GRID_BAR() do { if (N_LAUNCHES == 1) { xcd_barrier(bar); } } while (0)
#define IN(k) (lo <= (k) && (k) < hi)
#define SEAM(k) do { if (IN(k) && IN((k) + 1)) GRID_BAR(); } while (0)
#ifndef PROBE_MASK
#define PROBE_MASK 0
#endif
#define REP(p) for (int rep_ = 0; rep_ < (((PROBE_MASK) >> (p)) & 1) + 1; ++rep_)
#define IDS() const int tid = opaque_tid(), lane = tid & 63, wave = __builtin_amdgcn_readfirstlane(tid >> 6); (void)lane; (void)wave
template <int L> __device__ __forceinline__ void layer_phases(const Args& args, LAS unsigned char* lds, unsigned char* lds_raw, const XcdBarrier& bar, int lo, int hi) {
        constexpr int l = L;
        const int pb = N_PRO + l * N_PER_LAYER; const bool last = (l == DEPTH - 1);
        if (IN(pb + 0)) REP(0) { unsigned char* ws = KWS();
            pg8::Gemm g{(const bf16*)(ws + WS_XH), (const bf16*)(ws + WS_WIN) + (size_t)l * INW * DM, RTOT, INW, DM}; pg8::StaticOrder S; S.init(RTOT, INW, (int)gridDim.x, opaque_bid());
            pg8::EpiBf16 E{(bf16*)(ws + WS_Z), INW};
            pg8::gemm_phase<pg8::EpiBf16, pg8::StaticOrder, true, true>(lds + RING_OFF, g, S, E);
        } SEAM(pb + 0);
        if (IN(pb + 1)) REP(1) { IDS(); p2(args, l, lds, tid, lane, wave); } SEAM(pb + 1);
        if (IN(pb + 2)) REP(2) { IDS(); p4_scan(args, l, tid); p4_attention(args, l, (char*)lds_raw + RING_OFF); } SEAM(pb + 2);
        if (IN(pb + 3)) REP(3) { IDS(); p5(args, l, lds, tid, lane, wave); } SEAM(pb + 3);
        if (IN(pb + 4)) REP(4) { unsigned char* ws = KWS();
            const int r0 = last ? RCTX : 0, M = RTOT - r0;
            pg8::Gemm g{(const bf16*)(ws + WS_MIX) + (size_t)r0 * DM, (const bf16*)(ws + WS_WOUT) + (size_t)l * DM * DM, M, DM, DM}; pg8::StaticOrder S; S.init(M, DM, (int)gridDim.x, opaque_bid());
            pg8::EpiBf16 E{(bf16*)(ws + WS_Y) + (size_t)r0 * DM, DM};
            pg8::gemm_phase<pg8::EpiBf16, pg8::StaticOrder, true, true>(lds + RING_OFF, g, S, E);
        } SEAM(pb + 4);
        if (IN(pb + 5)) { IDS(); p7(args, l, lds, tid, lane, wave); } SEAM(pb + 5);
        if (IN(pb + 6)) REP(6) { IDS(); p8(args, l, lds, tid, lane, wave); } SEAM(pb + 6);
        if (IN(pb + 7)) REP(7) { IDS(); unsigned char* ws = KWS();
            moe_offsets(args, l, lds, tid);
            pg8::MoeOrder S; moe_order(S, lds, 3);
            pg8::Gemm g{(const bf16*)(ws + WS_XS2), (const bf16*)(ws + WS_WGU + (size_t)l * NEXP * 2048 * DM), MAXTILES * 256, NEXP * 2048, DM / 2};
            pg8::EpiSwiglu E{ws + WS_ACT, KIN(18) + (size_t)l * NEXP * 2048};
            pg8::gemm_phase<pg8::EpiSwiglu, pg8::MoeOrder, true, true, true>(lds + RING_OFF, g, S, E);
        } SEAM(pb + 7);
        if (IN(pb + 8)) REP(8) { IDS(); unsigned char* ws = KWS();
            moe_offsets(args, l, lds, tid);
            pg8::MoeOrder S; moe_order(S, lds, 2);
            pg8::Gemm g{(const bf16*)(ws + WS_ACT), (const bf16*)(ws + WS_WD + (size_t)l * NEXP * DM * DM), MAXTILES * 256, NEXP * DM, DM / 2};
            pg8::EpiDown E{ws + WS_YB, KIN(20) + (size_t)l * NEXP * DM, (const float*)(ws + WS_ROWW)};
            pg8::gemm_phase<pg8::EpiDown, pg8::MoeOrder, true, true, true>(lds + RING_OFF, g, S, E);
        } SEAM(pb + 8);
        if (IN(pb + 9)) { IDS(); p11(args, l, lane, wave); } SEAM(pb + 9);
}

__global__ void __launch_bounds__(NWAVES * 64, 2) mk_fwd(Args args) {
    extern __shared__ __attribute__((aligned(16))) unsigned char lds_raw[];
    LAS unsigned char* lds = (LAS unsigned char*)lds_raw;
    volatile LAS unsigned* MISC = (volatile LAS unsigned*)(lds + MISC_OFF);
    gu32* ctl = (gu32*)(KWS() + WS_CTL);
    for (int u = threadIdx.x; u < (LDS_BYTES - LDSCTL_OFF) / 4; u += NWAVES * 64) ((LAS unsigned*)(lds + LDSCTL_OFF))[u] = 0u;
    __syncthreads();
    XcdBarrier bar; bar.bar = (unsigned*)(ctl + CW_BAR); bar.x = 0; bar.st = nullptr;
    if (N_LAUNCHES == 1) bar = xcd_barrier_post((unsigned*)(ctl + CW_BAR), MISC + 8);
    const int lo = args.ph_lo, hi = args.ph_hi;

    if (IN(0)) REP(10) { IDS(); p0a(args, lds, tid, lane, wave); } SEAM(0);
    if (IN(1)) REP(11) { IDS(); p0b(args, tid); } SEAM(1);
    if (IN(2)) REP(12) { IDS(); p0c(args, lane, wave); } SEAM(2);

    layer_phases<0>(args, lds, lds_raw, bar, lo, hi);
    layer_phases<1>(args, lds, lds_raw, bar, lo, hi);
    static_assert(DEPTH == 2, "two layer instances");
}
#undef IN
#undef IDS
#undef SEAM
#undef GRID_BAR

extern "C" void kernel_launch(void* const* d_in, const int* in_sizes, int n_in, void* d_out, int out_size, void* d_ws, size_t ws_size, hipStream_t stream) {
    static int grid = 0;
    if (grid == 0) {
        if (n_in != 21 || in_sizes[0] != RLAT * DM || out_size != RLAT * DM || ws_size < WS_END) { fprintf(stderr, "kernel_launch: unexpected shapes / workspace (n_in %d, ws %zu < %zu); nothing launched\n", n_in, ws_size, (size_t)WS_END); grid = -1; return; }
        int dev = 0, cus = 0, per_cu = 0;
        if (hipGetDevice(&dev) != hipSuccess || hipDeviceGetAttribute(&cus, hipDeviceAttributeMultiprocessorCount, dev) != hipSuccess) { grid = -1; return; }
        if (hipFuncSetAttribute((const void*)mk_fwd, hipFuncAttributeMaxDynamicSharedMemorySize, LDS_BYTES) != hipSuccess) { fprintf(stderr, "kernel_launch: hipFuncSetAttribute failed\n"); grid = -1; return; }
        if (hipOccupancyMaxActiveBlocksPerMultiprocessor(&per_cu, (const void*)mk_fwd, NWAVES * 64, LDS_BYTES) != hipSuccess || per_cu < 1) fprintf(stderr, "kernel_launch: occupancy query reports %d\n", per_cu);
        (void)hipGetLastError();
        grid = cus;
        if (grid != 256) { fprintf(stderr, "kernel_launch: built for 256 CUs, found %d; nothing launched\n", grid); grid = -1; return; }
    }
    if (grid < 0) return;
    if (hipMemsetAsync((char*)d_ws + WS_CTL, 0, CTL_ZERO_BYTES, stream) != hipSuccess) return;
    Args a{};
    for (int i = 0; i < 21; ++i) a.in[i] = (const float*)d_in[i];
    a.out = (float*)d_out; a.ws = (unsigned char*)d_ws; a.pad = 0;
    for (int li = 0; li < N_LAUNCHES; ++li) {
        a.ph_lo = (N_LAUNCHES == 1) ? 0 : li; a.ph_hi = (N_LAUNCHES == 1) ? N_PHASES : li + 1; a.li = li;
        hipLaunchKernelGGL(mk_fwd, dim3(grid), dim3(NWAVES * 64), LDS_BYTES, stream, a);
        const hipError_t le = hipPeekAtLastError();
        if (le != hipSuccess) { fprintf(stderr, "kernel_launch: launch %d failed: %s\n", li, hipGetErrorName(le)); break; }
    }
}
```

```cpp
#include <hip/hip_runtime.h>
#include <cstdio>
#include <cstdint>
__device__ __forceinline__ int opaque_tid() { int t = (int)threadIdx.x; asm volatile("" : "+v"(t)); return t; }
__device__ __forceinline__ int opaque_bid() { int b = (int)blockIdx.x; asm volatile("" : "+s"(b)); return b; }
namespace pg8 {
#define PG8_LAS __attribute__((address_space(3)))
typedef unsigned short bf16_t;
typedef short bf16x8 __attribute__((ext_vector_type(8)));
typedef float f32x4 __attribute__((ext_vector_type(4)));
typedef unsigned u32x4 __attribute__((ext_vector_type(4)));
constexpr int BM = 256, BK = 64, HALF = 128, HTB = HALF * BK * 2  , STAGE_BYTES = 8 * HTB, NXCD = 8, WGM = 8;

__host__ __device__ __forceinline__ int lds_byte(int r, int c) { const int st = (r >> 4) * 2 + (c >> 5), rr = r & 15, cc = c & 31, ob = rr * 64 + cc * 2; return st * 1024 + (ob ^ (((ob >> 9) & 1) << 5)); }
__host__ __device__ __forceinline__ void stage_rc(int b, int& R, int& C) { const int st = b / 1024, sb = b % 1024, swz = sb ^ (((sb >> 9) & 1) << 5); R = (st >> 1) * 16 + swz / 64; C = (st & 1) * 32 + (swz % 64) / 2; }
__host__ __device__ __forceinline__ int perm32(int rho) { const int n = rho >> 4, i = rho & 15; return 8 * (i >> 2) + 4 * n + (i & 3); }

struct Unit { int pm, pn; };
struct Gemm { const bf16_t* A; const bf16_t* Bt; int M, N, K; };

struct StaticOrder {
    int nM, nN, nwg, G, c;
    __host__ __device__ void init(int M, int N, int G_, int c_) { nM = M / BM; nN = N / BM; nwg = nM * nN; G = G_; c = c_; }
    __host__ __device__ bool next(int i, Unit& u) const {
        const long L = (long)i * G + c; if (L >= nwg) return false;
        int wgid = (int)L; { const int q = nwg / NXCD, r = nwg % NXCD, xcd = wgid % NXCD, off = wgid / NXCD; wgid = (xcd < r ? xcd * (q + 1) : r * (q + 1) + (xcd - r) * q) + off; }
        const int nig = WGM * nN, gid = wgid / nig, fm = gid * WGM, gsz = (nM - fm) < WGM ? (nM - fm) : WGM;
        u.pm = fm + ((wgid % nig) % gsz); u.pn = (wgid % nig) / gsz; return true;
    }
    __device__ __forceinline__ void a_ready(const Unit&) const {}
    __device__ __forceinline__ void done(const Unit&) const {}
};

__device__ __forceinline__ unsigned cvt_pk_bf16(float lo, float hi) { unsigned r; asm volatile("v_cvt_pk_bf16_f32 %0, %1, %2" : "=v"(r) : "v"(lo), "v"(hi)); return r; }
typedef float f32x2 __attribute__((ext_vector_type(2)));
struct EpiBf16 {
    static constexpr bool PERM = true, AFTER_DRAIN = false;
    bf16_t* O; int ldc;
    __device__ __forceinline__ void operator()(const f32x4 (&acc)[2][2][4][2], const Unit& u, int wr, int wc, int fr, int fq) const {
        const int row0 = u.pm * BM + wr * 64 + fr; const int col0 = u.pn * BM + wc * 32 + 8 * fq;
#pragma unroll
        for (int ai = 0; ai < 2; ++ai)
#pragma unroll
            for (int m = 0; m < 4; ++m) { bf16_t* rowp = O + (size_t)(row0 + ai * HALF + m * 16) * ldc + col0;
#pragma unroll
                for (int bj = 0; bj < 2; ++bj) { const f32x4 v0 = acc[ai][bj][m][0], v1 = acc[ai][bj][m][1];
                    u32x4 w; w.x = cvt_pk_bf16(v0[0], v0[1]); w.y = cvt_pk_bf16(v0[2], v0[3]); w.z = cvt_pk_bf16(v1[0], v1[1]); w.w = cvt_pk_bf16(v1[2], v1[3]);
                    *(u32x4*)(rowp + bj * HALF) = w; } }
    }
};
struct EpiSwiglu {
    static constexpr bool PERM = true, AFTER_DRAIN = false;
    unsigned char* O; const float* bias;
    static __device__ __forceinline__ f32x2 act2(f32x2 g, f32x2 up) {
        g = __builtin_elementwise_min(g, (f32x2){7.0f, 7.0f}); up = __builtin_elementwise_min(__builtin_elementwise_max(up, (f32x2){-7.0f, -7.0f}), (f32x2){7.0f, 7.0f});
        const f32x2 z = g * (-1.702f * 1.4426950408889634f); f32x2 d; d.x = __builtin_amdgcn_exp2f(z.x); d.y = __builtin_amdgcn_exp2f(z.y); d = d + 1.0f;
        f32x2 s; s.x = __builtin_amdgcn_rcpf(d.x); s.y = __builtin_amdgcn_rcpf(d.y);
        return (up + 1.0f) * (g * s);
    }
    __device__ __forceinline__ void operator()(const f32x4 (&acc)[2][2][4][2], const Unit& u, int wr, int wc, int fr, int fq) const {
        const int e = u.pn >> 3, pnl = u.pn & 7;
        const int row0 = u.pm * BM + wr * 64 + fr; const int j0 = pnl * HALF + wc * 32 + 8 * fq;
        const float* bg = bias + (size_t)e * 2048 + j0; const float* bu = bg + 1024;
        f32x4 bgv[2], buv[2];
#pragma unroll
        for (int n = 0; n < 2; ++n) { bgv[n] = *(const f32x4*)(bg + 4 * n); buv[n] = *(const f32x4*)(bu + 4 * n); }
#pragma unroll
        for (int ai = 0; ai < 2; ++ai)
#pragma unroll
            for (int m = 0; m < 4; ++m) { unsigned char* rowp = O + (size_t)(row0 + ai * HALF + m * 16) * 1024 + j0;
                typedef unsigned u32x2 __attribute__((ext_vector_type(2))); u32x2 w;
#pragma unroll
                for (int n = 0; n < 2; ++n) { const f32x4 g = acc[ai][0][m][n] * 0.03125f + bgv[n], up = acc[ai][1][m][n] * 0.03125f + buv[n];
                    const f32x2 r0 = act2((f32x2){g[0], g[1]}, (f32x2){up[0], up[1]}), r1 = act2((f32x2){g[2], g[3]}, (f32x2){up[2], up[3]});
                    const unsigned pk = (unsigned)__builtin_amdgcn_cvt_pk_fp8_f32(r1.x, r1.y, __builtin_amdgcn_cvt_pk_fp8_f32(r0.x, r0.y, 0, false), true);
                    if (n == 0) w.x = pk; else w.y = pk; }
                *(u32x2*)rowp = w; }
    }
};
struct EpiDown {
    static constexpr bool PERM = true, AFTER_DRAIN = false;
    unsigned char* O; const float* bias; const float* roww;
    __device__ __forceinline__ void operator()(const f32x4 (&acc)[2][2][4][2], const Unit& u, int wr, int wc, int fr, int fq) const {
        const int e = u.pn >> 2, pnl = u.pn & 3;
        const int row0 = u.pm * BM + wr * 64 + fr; const int col0 = pnl * BM + wc * 32 + 8 * fq;
        const float* bp = bias + (size_t)e * 1024 + col0;
        f32x4 bv[2][2];
#pragma unroll
        for (int bj = 0; bj < 2; ++bj)
#pragma unroll
            for (int n = 0; n < 2; ++n) bv[bj][n] = *(const f32x4*)(bp + bj * HALF + 4 * n);
#pragma unroll
        for (int ai = 0; ai < 2; ++ai)
#pragma unroll
            for (int m = 0; m < 4; ++m) { const int row = row0 + ai * HALF + m * 16; unsigned char* rowp = O + (size_t)row * 1024 + col0;
                const float wt = roww[row];
#pragma unroll
                for (int bj = 0; bj < 2; ++bj) { const f32x4 v0 = (acc[ai][bj][m][0] * 0.015625f + bv[bj][0]) * wt, v1 = (acc[ai][bj][m][1] * 0.015625f + bv[bj][1]) * wt;
                    typedef unsigned u32x2 __attribute__((ext_vector_type(2))); u32x2 w;
                    w.x = (unsigned)__builtin_amdgcn_cvt_pk_fp8_f32(v0[2], v0[3], __builtin_amdgcn_cvt_pk_fp8_f32(v0[0], v0[1], 0, false), true);
                    w.y = (unsigned)__builtin_amdgcn_cvt_pk_fp8_f32(v1[2], v1[3], __builtin_amdgcn_cvt_pk_fp8_f32(v1[0], v1[1], 0, false), true);
                    *(u32x2*)(rowp + bj * HALF) = w; } }
    }
};
struct MoeOrder {
    unsigned pk[11]; int nt, sh, G, c;
    __device__ __forceinline__ bool next(int i, Unit& u) const {
        const int L = i * G + c;
        if (L >= (nt << sh)) return false;
        const int tile = L >> sh, pnl = L & ((1 << sh) - 1); int e = 0;
#pragma unroll
        for (int k = 1; k < 32; ++k) { const int off = (int)((pk[(k - 1) / 3] >> (10 * ((k - 1) % 3))) & 1023u); e += (off <= tile) ? 1 : 0; }
        u.pm = __builtin_amdgcn_readfirstlane(tile); u.pn = __builtin_amdgcn_readfirstlane((e << sh) + pnl); return true;
    }
    __device__ __forceinline__ void a_ready(const Unit&) const {}
    __device__ __forceinline__ void done(const Unit&) const {}
};

template <class Epi, class Sched, bool ALIGN_EPI = false, bool SP2 = false, bool F8 = false>
__device__ __forceinline__ void gemm_phase(PG8_LAS unsigned char* lds, const Gemm g, const Sched& S, const Epi& E) {
    const int tid = opaque_tid(), wid = __builtin_amdgcn_readfirstlane(tid >> 6), lane = tid & 63, wr = wid >> 2, wc = wid & 3, fr = lane & 15, fq = lane >> 4;
    const int K = g.K, nt = K / BK;
    unsigned voffA[2], voffB[2];
#pragma unroll
    for (int i = 0; i < 2; ++i) { int R, C; stage_rc(tid * 16 + i * 8192, R, C); const int Rb = Epi::PERM ? ((R & ~31) + perm32(R & 31)) : R;
        voffA[i] = (unsigned)(R * K + C) * 2u; voffB[i] = (unsigned)(Rb * K + C) * 2u; }
    const size_t kstep = (size_t)(BK * 2);
    const size_t hstep = (size_t)HALF * K * 2;
    const size_t tstep = 2 * hstep;
    const unsigned ldsw = (unsigned)wid * 1024u;
    const int aoff = lds_byte(wr * 64 + fr, fq * 8), boff = lds_byte(wc * 32 + fr, fq * 8);
#define PG8_SA(b, h) (((b) * 2 + (h)) * HTB)
#define PG8_SB(b, h) ((4 + (b) * 2 + (h)) * HTB)
#define PG8_STAGE(bufoff, gbase, voff) do { _Pragma("unroll") for (int _i = 0; _i < 2; ++_i) { unsigned vo_ = (voff)[_i]; asm volatile("" : "+v"(vo_));     \
        __builtin_amdgcn_global_load_lds((const unsigned*)((const char*)(gbase) + vo_), (PG8_LAS unsigned*)(lds + (bufoff) + ldsw + _i * 8192), 16, 0, 0); } } while (0)
#define PG8_LDA(dst, b, h) do { _Pragma("unroll") for (int m = 0; m < 4; ++m) { if constexpr (F8) { \
            const i32x4_t lo_ = *(const PG8_LAS i32x4_t*)(lds + PG8_SA(b, h) + aoff + m * 2048), hi_ = *(const PG8_LAS i32x4_t*)(lds + PG8_SA(b, h) + aoff + m * 2048 + 1024); \
            dst##8[m] = __builtin_shufflevector(lo_, hi_, 0, 1, 2, 3, 4, 5, 6, 7); \
        } else { _Pragma("unroll") for (int k = 0; k < 2; ++k) dst[m][k] = *(const PG8_LAS bf16x8*)(lds + PG8_SA(b, h) + aoff + m * 2048 + k * 1024); } } } while (0)
#define PG8_LDB(dst, b, h) do { _Pragma("unroll") for (int n = 0; n < 2; ++n) { if constexpr (F8) { \
            const i32x4_t lo_ = *(const PG8_LAS i32x4_t*)(lds + PG8_SB(b, h) + boff + n * 2048), hi_ = *(const PG8_LAS i32x4_t*)(lds + PG8_SB(b, h) + boff + n * 2048 + 1024); \
            dst##8[n] = __builtin_shufflevector(lo_, hi_, 0, 1, 2, 3, 4, 5, 6, 7); \
        } else { _Pragma("unroll") for (int k = 0; k < 2; ++k) dst[n][k] = *(const PG8_LAS bf16x8*)(lds + PG8_SB(b, h) + boff + n * 2048 + k * 1024); } } } while (0)
#define PG8_MMA(ai, bj, At, Bt) do { __builtin_amdgcn_s_setprio(1); _Pragma("unroll") for (int m = 0; m < 4; ++m) _Pragma("unroll") for (int n = 0; n < 2; ++n) { \
        if constexpr (F8) {   \
            acc[ai][bj][m][n] = __builtin_amdgcn_mfma_scale_f32_16x16x128_f8f6f4(Bt##8[n], At##8[m], acc[ai][bj][m][n], 0, 0, 0, 0, 0, 0); \
        } else { _Pragma("unroll") for (int k = 0; k < 2; ++k) acc[ai][bj][m][n] = __builtin_amdgcn_mfma_f32_16x16x32_bf16(Bt[n][k], At[m][k], acc[ai][bj][m][n], 0, 0, 0); } } \
        __builtin_amdgcn_s_setprio(0); } while (0)
#define PG8_WAIT_V(n) asm volatile("s_waitcnt vmcnt(" #n ")" ::: "memory")
#define PG8_WAIT_L(n) asm volatile("s_waitcnt lgkmcnt(" #n ")" ::: "memory")
#define PG8_BAR __builtin_amdgcn_s_barrier()
#define PG8_SCHED __builtin_amdgcn_sched_barrier(0)
    Unit cur, nxt; int ui = 0;
    if (!S.next(0, cur)) return;
    f32x4 acc[2][2][4][2];
#pragma unroll
    for (int a = 0; a < 2; ++a)
#pragma unroll
        for (int b = 0; b < 2; ++b)
#pragma unroll
            for (int m = 0; m < 4; ++m)
#pragma unroll
                for (int n = 0; n < 2; ++n) acc[a][b][m][n] = (f32x4){0.f, 0.f, 0.f, 0.f};
    typedef int i32x4_t __attribute__((ext_vector_type(4))); typedef int i32x8_t __attribute__((ext_vector_type(8)));
    bf16x8 At[4][2], B0[2][2], B1[2][2];
    i32x8_t At8[4], B08[2], B18[2];
    const char* cA = (const char*)g.A + (size_t)cur.pm * tstep; const char* cB = (const char*)g.Bt + (size_t)cur.pn * tstep;
    S.a_ready(cur);
    if constexpr (SP2) {
        PG8_STAGE(PG8_SB(0, 0), cB, voffB); PG8_STAGE(PG8_SB(0, 1), cB + hstep, voffB); PG8_STAGE(PG8_SA(0, 0), cA, voffA); PG8_STAGE(PG8_SA(0, 1), cA + hstep, voffA);
        if (wr == 1) PG8_BAR;
        PG8_WAIT_V(2); PG8_BAR;
        PG8_STAGE(PG8_SB(1, 0), cB + kstep, voffB); PG8_STAGE(PG8_SA(1, 0), cA + kstep, voffA); PG8_STAGE(PG8_SB(1, 1), cB + hstep + kstep, voffB);
        PG8_WAIT_V(6); PG8_BAR;
    } else {
        PG8_STAGE(PG8_SB(0, 0), cB, voffB); PG8_STAGE(PG8_SA(0, 0), cA, voffA); PG8_STAGE(PG8_SB(0, 1), cB + hstep, voffB); PG8_STAGE(PG8_SA(0, 1), cA + hstep, voffA);
        if (wr == 1) PG8_BAR;
        PG8_WAIT_V(4); PG8_BAR;
        PG8_STAGE(PG8_SB(1, 0), cB + kstep, voffB); PG8_STAGE(PG8_SA(1, 0), cA + kstep, voffA); PG8_STAGE(PG8_SB(1, 1), cB + hstep + kstep, voffB);
        PG8_WAIT_V(6); PG8_BAR;
    }
    for (;;) {
        const bool has_next = S.next(ui + 1, nxt);
        const char* nA = has_next ? (const char*)g.A + (size_t)nxt.pm * tstep : cA; const char* nB = has_next ? (const char*)g.Bt + (size_t)nxt.pn * tstep : cB;
#pragma unroll 1
        for (int t = 0; t < nt; t += 2) {
            const bool last = (t == nt - 2);
            const char* a1 = cA + (size_t)(t + 1) * kstep;
            const char* a2 = last ? nA : cA + (size_t)(t + 2) * kstep; const char* b2 = last ? nB : cB + (size_t)(t + 2) * kstep;
            const char* a3 = a2 + kstep; const char* b3 = b2 + kstep;
            const char* a1h = a1 + hstep; const char* a2h = a2 + hstep; const char* b2h = b2 + hstep; const char* a3h = a3 + hstep; const char* b3h = b3 + hstep;
            asm volatile("" : "+s"(a1h), "+s"(a2), "+s"(a2h), "+s"(b2), "+s"(b2h), "+s"(a3), "+s"(a3h), "+s"(b3), "+s"(b3h));
            if (last && has_next) S.a_ready(nxt);
            if constexpr (SP2) {
            PG8_LDB(B0, 0, 0); PG8_LDB(B1, 0, 1); PG8_SCHED; PG8_LDA(At, 0, 0); PG8_STAGE(PG8_SA(1, 1), a1h, voffA);
            PG8_WAIT_V(8); PG8_WAIT_L(0); PG8_BAR; PG8_MMA(0, 0, At, B0); PG8_MMA(0, 1, At, B1); PG8_BAR; PG8_SCHED;
            PG8_LDA(At, 0, 1); PG8_STAGE(PG8_SB(0, 0), b2, voffB); PG8_STAGE(PG8_SB(0, 1), b2h, voffB); PG8_STAGE(PG8_SA(0, 0), a2, voffA);
            PG8_WAIT_V(8); PG8_WAIT_L(0); PG8_BAR; PG8_MMA(1, 0, At, B0); PG8_MMA(1, 1, At, B1); PG8_BAR; PG8_SCHED;
            PG8_LDB(B0, 1, 0); PG8_LDB(B1, 1, 1); PG8_SCHED; PG8_LDA(At, 1, 0); PG8_STAGE(PG8_SA(0, 1), a2h, voffA);
            PG8_WAIT_V(8); PG8_WAIT_L(0); PG8_BAR; PG8_MMA(0, 0, At, B0); PG8_MMA(0, 1, At, B1); PG8_BAR; PG8_SCHED;
            PG8_LDA(At, 1, 1); PG8_STAGE(PG8_SB(1, 0), b3, voffB); PG8_STAGE(PG8_SB(1, 1), b3h, voffB); PG8_STAGE(PG8_SA(1, 0), a3, voffA);
            PG8_WAIT_V(8); PG8_WAIT_L(0); PG8_BAR; PG8_MMA(1, 0, At, B0); PG8_MMA(1, 1, At, B1); PG8_BAR; PG8_SCHED;
            } else {
            PG8_LDB(B0, 0, 0); PG8_SCHED; PG8_LDA(At, 0, 0); PG8_STAGE(PG8_SA(1, 1), a1h, voffA);
            PG8_WAIT_L(8); PG8_BAR; PG8_WAIT_L(0); PG8_MMA(0, 0, At, B0); PG8_BAR; PG8_SCHED;
            PG8_LDB(B1, 0, 1); PG8_STAGE(PG8_SB(0, 0), b2, voffB);
            PG8_BAR; PG8_WAIT_L(0); PG8_MMA(0, 1, At, B1); PG8_BAR;
            PG8_LDA(At, 0, 1); PG8_STAGE(PG8_SA(0, 0), a2, voffA);
            PG8_BAR; PG8_WAIT_L(0); PG8_MMA(1, 0, At, B0); PG8_BAR; PG8_SCHED;
            PG8_STAGE(PG8_SB(0, 1), b2h, voffB);
            PG8_WAIT_V(6); PG8_BAR; PG8_MMA(1, 1, At, B1); PG8_BAR;
            PG8_LDB(B0, 1, 0); PG8_SCHED; PG8_LDA(At, 1, 0); PG8_STAGE(PG8_SA(0, 1), a2h, voffA);
            PG8_WAIT_L(8); PG8_BAR; PG8_WAIT_L(0); PG8_MMA(0, 0, At, B0); PG8_BAR; PG8_SCHED;
            PG8_LDB(B1, 1, 1); PG8_STAGE(PG8_SB(1, 0), b3, voffB);
            PG8_BAR; PG8_WAIT_L(0); PG8_MMA(0, 1, At, B1); PG8_BAR;
            PG8_LDA(At, 1, 1); PG8_STAGE(PG8_SA(1, 0), a3, voffA);
            PG8_BAR; PG8_WAIT_L(0); PG8_MMA(1, 0, At, B0); PG8_BAR; PG8_SCHED;
            PG8_STAGE(PG8_SB(1, 1), b3h, voffB);
            PG8_WAIT_V(6); PG8_BAR; PG8_MMA(1, 1, At, B1); PG8_BAR;
            }
        }
        if constexpr (ALIGN_EPI) { if (wr == 0) PG8_BAR; }
        if constexpr (!Epi::AFTER_DRAIN) { unsigned ones_ = ~0u; asm volatile("" : "+s"(ones_)); const int ln_ = (int)__builtin_amdgcn_mbcnt_hi(ones_, __builtin_amdgcn_mbcnt_lo(ones_, 0u)); const int fr_ = ln_ & 15, fq_ = ln_ >> 4;
            E(acc, cur, wr, wc, fr_, fq_); S.done(cur); }
        if (!has_next) break;
#pragma unroll
        for (int a = 0; a < 2; ++a)
#pragma unroll
            for (int b = 0; b < 2; ++b)
#pragma unroll
                for (int m = 0; m < 4; ++m)
#pragma unroll
                    for (int n = 0; n < 2; ++n) acc[a][b][m][n] = (f32x4){0.f, 0.f, 0.f, 0.f};
        cur = nxt; cA = nA; cB = nB; ++ui;
        if constexpr (ALIGN_EPI) { if (wr == 1) PG8_BAR; }
    }
    PG8_WAIT_V(0);
    if constexpr (!ALIGN_EPI) { if (wr == 0) PG8_BAR; }
    PG8_BAR;
    if constexpr (Epi::AFTER_DRAIN) { E.fused(acc, cur, wr, wc, fr, fq, lds, wid, lane); S.done(cur); }
#undef PG8_SA
#undef PG8_SB
#undef PG8_STAGE
#undef PG8_LDA
#undef PG8_LDB
#undef PG8_MMA
#undef PG8_WAIT_V
#undef PG8_WAIT_L
#undef PG8_BAR
#undef PG8_SCHED
}
}

#include <hip/hip_bf16.h>
#include <cmath>
namespace attn_body {
using bf16=__hip_bfloat16;
using bf16x8=__attribute__((ext_vector_type(8)))short;
using s16x4=__attribute__((ext_vector_type(4)))short;
using f32x16=__attribute__((ext_vector_type(16)))float;
using u32x4=__attribute__((ext_vector_type(4)))unsigned;
constexpr int D=64,QP=512,KP=64,OP=1024;
constexpr int NW=8,QBLK=32,QB=QBLK*NW,KVBLK=64;
constexpr int ATTN_UNIT_ROWS=QB;
__device__ __forceinline__ int crow(int r,int hi){return (r&3)+8*(r>>2)+4*hi;}
#define SBAR() __builtin_amdgcn_sched_barrier(0)
__device__ __forceinline__ void cmask(f32x16&p0,f32x16&p1,int jb,int qrel,int hi){
  const float NEG=-INFINITY; int kb=64*jb+4*hi;
  #pragma unroll
  for(int r=0;r<16;++r){int kv=kb+(r&3)+8*(r>>2); if(kv>qrel)p0[r]=NEG; if(kv+32>qrel)p1[r]=NEG;}
}

constexpr int NSLOT=3, SLOTB=8192;
constexpr int LDS_K=0, LDS_V=NSLOT*SLOTB, LDS_WS=2*NSLOT*SLOTB, LDS_OST=LDS_WS+NW*64*4, LDS_BYTES=LDS_OST+NW*4096;
constexpr float C2=0.125f*1.4426950408889634f;
__device__ __forceinline__ void glds16(const void*gsrc,unsigned lds_dst){unsigned keep;
  asm volatile("s_mov_b32 %0, m0\n\ts_mov_b32 m0, %2\n\ts_nop 0\n\tglobal_load_lds_dwordx4 %1, off\n\ts_mov_b32 m0, %0":"=&s"(keep):"v"(gsrc),"s"(lds_dst):"memory");}
__device__ __forceinline__ float max3f(float a,float b,float c){float r;asm("v_max3_f32 %0, %1, %2, %3":"=v"(r):"v"(a),"v"(b),"v"(c));return r;}
__device__ __forceinline__ float max2f(float a,float b){float r;asm("v_max_f32_e32 %0, %1, %2":"=v"(r):"v"(a),"v"(b));return r;}
__device__ __forceinline__ float fadd_s(float a,float b){float r;asm("v_add_f32_e32 %0, %1, %2":"=v"(r):"v"(a),"v"(b));return r;}
__device__ __forceinline__ float fsub_s(float a,float b){float r;asm("v_sub_f32_e32 %0, %1, %2":"=v"(r):"v"(a),"v"(b));return r;}
typedef float f32x2_t __attribute__((ext_vector_type(2))); typedef __bf16 bf16x2_t __attribute__((ext_vector_type(2)));
__device__ __forceinline__ unsigned cvtpk_s(float lo,float hi){f32x2_t v={lo,hi};bf16x2_t b=__builtin_convertvector(v,bf16x2_t);return __builtin_bit_cast(unsigned,b);}
#define WAIT_BAR(N) asm volatile("s_waitcnt vmcnt(" #N ") lgkmcnt(0)\n\ts_barrier":::"memory")

__device__ __forceinline__ void qkt(f32x16&p0,f32x16&p1,const char*Kslot,const bf16x8*qr,const f32x16&negm,int r32,int hi){
  const char*kb=Kslot+hi*1024+r32*16;
  #pragma unroll
  for(int d0=0;d0<4;++d0){
    const bf16x8 b0=*reinterpret_cast<const bf16x8*>(kb+d0*2048);
    const bf16x8 b1=*reinterpret_cast<const bf16x8*>(kb+d0*2048+512);
    if(d0==0){p0=__builtin_amdgcn_mfma_f32_32x32x16_bf16(b0,qr[0],negm,0,0,0);p1=__builtin_amdgcn_mfma_f32_32x32x16_bf16(b1,qr[0],negm,0,0,0);}
    else{p0=__builtin_amdgcn_mfma_f32_32x32x16_bf16(b0,qr[d0],p0,0,0,0);p1=__builtin_amdgcn_mfma_f32_32x32x16_bf16(b1,qr[d0],p1,0,0,0);}}
}
typedef __attribute__((address_space(3))) const char* lds_cptr;
typedef short v4i16_t __attribute__((ext_vector_type(4)));
__device__ __forceinline__ void kload8(bf16x8*kf,lds_cptr kp){
  kf[0]=*(const __attribute__((address_space(3))) bf16x8*)(kp);      kf[1]=*(const __attribute__((address_space(3))) bf16x8*)(kp+512);
  kf[2]=*(const __attribute__((address_space(3))) bf16x8*)(kp+2048); kf[3]=*(const __attribute__((address_space(3))) bf16x8*)(kp+2560);
  kf[4]=*(const __attribute__((address_space(3))) bf16x8*)(kp+4096); kf[5]=*(const __attribute__((address_space(3))) bf16x8*)(kp+4608);
  kf[6]=*(const __attribute__((address_space(3))) bf16x8*)(kp+6144); kf[7]=*(const __attribute__((address_space(3))) bf16x8*)(kp+6656);
}
__device__ __forceinline__ void kload2(bf16x8*kf,lds_cptr kp,int j){ kf[2*j]=*(const __attribute__((address_space(3))) bf16x8*)(kp+j*2048); kf[2*j+1]=*(const __attribute__((address_space(3))) bf16x8*)(kp+j*2048+512); }
__device__ __forceinline__ s16x4 vtr(lds_cptr p){ return __builtin_bit_cast(s16x4,__builtin_amdgcn_ds_read_tr16_b64_v4i16((__attribute__((address_space(3))) v4i16_t*)p)); }
__device__ __forceinline__ float rowmax(const f32x16&p0,const f32x16&p1){
  float a=max3f(p0[0],p0[1],p1[0]),b=max3f(p0[2],p0[3],p1[1]);a=max3f(a,p1[2],p1[3]);
  #pragma unroll
  for(int r=4;r<16;r+=4){a=max3f(a,p0[r],p0[r+1]);b=max3f(b,p0[r+2],p0[r+3]);a=max3f(a,p1[r],p1[r+1]);b=max3f(b,p1[r+2],p1[r+3]);}
  const float m=max2f(a,b);
  auto rr=__builtin_amdgcn_permlane32_swap(__float_as_uint(m),__float_as_uint(m),false,false);
  return max2f(__uint_as_float(rr[0]),__uint_as_float(rr[1]));
}
__device__ __forceinline__ void pv(f32x16*o,int vb,bf16x8 pa0,bf16x8 pa1,bf16x8 pa2,bf16x8 pa3){
  #pragma unroll
  for(int d0=0;d0<2;++d0){s16x4 lo[4],hi[4];
    #pragma unroll
    for(int ks=0;ks<4;++ks){
      asm volatile("ds_read_b64_tr_b16 %0,%1 offset:%c2":"=&v"(lo[ks]):"v"(vb),"i"(d0*4096+ks*1024):"memory");
      asm volatile("ds_read_b64_tr_b16 %0,%1 offset:%c2":"=&v"(hi[ks]):"v"(vb),"i"(d0*4096+ks*1024+512):"memory");}
    asm volatile("s_waitcnt lgkmcnt(0)":::"memory");SBAR();
    #define PK(k) (bf16x8){lo[k][0],lo[k][1],lo[k][2],lo[k][3],hi[k][0],hi[k][1],hi[k][2],hi[k][3]}
    o[d0]=__builtin_amdgcn_mfma_f32_32x32x16_bf16(pa0,PK(0),o[d0],0,0,0);
    o[d0]=__builtin_amdgcn_mfma_f32_32x32x16_bf16(pa1,PK(1),o[d0],0,0,0);
    o[d0]=__builtin_amdgcn_mfma_f32_32x32x16_bf16(pa2,PK(2),o[d0],0,0,0);
    o[d0]=__builtin_amdgcn_mfma_f32_32x32x16_bf16(pa3,PK(3),o[d0],0,0,0);
    #undef PK
  }
}

#ifndef ATTN_STORE16
#define ATTN_STORE16(p,v) (*(u32x4*)(p)=(v))
#endif
template<int THRL> __device__ __forceinline__ void attn_unit(const bf16*Qu,const bf16*Kh,const bf16*Vh,bf16*Ou,const int NT,char*shm){
  const int tid=opaque_tid(),lane=tid&63,r32=lane&31,hi=lane>>5; const int wid=__builtin_amdgcn_readfirstlane(tid>>6);
  const bf16*Qw=Qu+(long)(wid*QBLK)*QP;
  const unsigned lds0=(unsigned)(uintptr_t)shm;
  float*wsf=(float*)(shm+LDS_WS)+wid*64;
  const bf16*ksrc=Kh+(long)lane*KP+wid*8;
  const bf16*vsrc=Vh+(long)(16*(wid&3)+(lane>>2))*KP+(wid>>2)*32+(lane&3)*8;
  const unsigned kdst=lds0+LDS_K+wid*1024, vdst=lds0+LDS_V+wid*1024;
  #define DMA_K(t,slot) glds16(ksrc+(long)(t)*KVBLK*KP,(unsigned)__builtin_amdgcn_readfirstlane(kdst+(slot)))
  #define DMA_V(t,slot) glds16(vsrc+(long)(t)*KVBLK*KP,(unsigned)__builtin_amdgcn_readfirstlane(vdst+(slot)))
  const int vb0=(int)(lds0+LDS_V)+((lane>>4)&1)*32+(lane&3)*8+(4*hi+((lane&15)>>2))*64;
  const char*Kbase=shm+LDS_K; bf16x8 kf[8];
  const lds_cptr shm3=(lds_cptr)shm; const lds_cptr kp0=shm3+LDS_K+hi*1024+r32*16; const lds_cptr vp0=shm3+LDS_V+((lane>>4)&1)*32+(lane&3)*8+(4*hi+((lane&15)>>2))*64;
  DMA_K(0,0);DMA_V(0,0);DMA_K(1,SLOTB);
  bf16x8 qr[4];
  #pragma unroll
  for(int d0=0;d0<4;++d0)qr[d0]=*reinterpret_cast<const bf16x8*>(&Qw[(long)r32*QP+d0*16+hi*8]);
  float mhat=0.f,l_reg=0.f;f32x16 o[2];o[0]=f32x16{};o[1]=f32x16{};f32x16 negm=f32x16{};asm volatile("":"+v"(negm));
  #define CMASK(P0,P1,t) do{}while(0)
  bool resc=false;
  #define START(P0,P1) do{ const float rm=rowmax(P0,P1); resc=false; \
    { const float dl=rm; mhat=fadd_s(mhat,dl); \
      _Pragma("unroll") for(int r=0;r<16;++r){P0[r]=fsub_s(P0[r],dl);P1[r]=fsub_s(P1[r],dl);} \
      _Pragma("unroll") for(int r=0;r<16;++r)negm[r]=-mhat; asm volatile("":"+v"(negm)); } \
    _Pragma("unroll") for(int r=0;r<16;++r)P0[r]=__builtin_amdgcn_exp2f(P0[r]); }while(0)
  #define RESC() do{ if(resc){ asm volatile("s_waitcnt lgkmcnt(0)":::"memory"); \
      _Pragma("unroll") for(int d_=0;d_<2;++d_) _Pragma("unroll") for(int r=0;r<16;++r)o[d_][r]*=wsf[crow(r,hi)]; } }while(0)
  f32x16 pA0,pA1,pB0,pB1;
  int sl_prev=0,sl_cur=0,sl_next=SLOTB;
  #define ROT() do{sl_prev=sl_cur;sl_cur=sl_next;sl_next=(sl_next==(NSLOT-1)*SLOTB)?0:sl_next+SLOTB;}while(0)
  DMA_K(2,2*SLOTB);
  WAIT_BAR(3);
  qkt(pA0,pA1,Kbase,qr,negm,r32,hi);asm volatile("s_nop 15\n\ts_nop 7":"+v"(pA0),"+v"(pA1));CMASK(pA0,pA1,0);
  START(pA0,pA1);
  _Pragma("unroll") for(int r=0;r<16;++r)pA1[r]=__builtin_amdgcn_exp2f(pA1[r]);
  WAIT_BAR(0);
  DMA_K(3,0);DMA_V(1,SLOTB);
  ROT();
  kload8(kf,kp0+sl_cur);
  WAIT_BAR(2);
  s16x4 vlo[8],vhi[8]; u32x4 pw0,pw1,pw2,pw3;
  #define PKW(P,B) cvtpk_s(P[B],P[B+1])
  #define PAF(k) __builtin_bit_cast(bf16x8,pw##k)
  #define VFR(i) (bf16x8){vlo[i][0],vlo[i][1],vlo[i][2],vlo[i][3],vhi[i][0],vhi[i][1],vhi[i][2],vhi[i][3]}
  #define PIN(x) asm volatile("":"+v"(x))
  #define MX3(a,b,c) __builtin_fmaxf(__builtin_fmaxf((a),(b)),(c))
  #define GAPA(MF,A0,A1,A2,A3,W0,W1,PW) do{ MF; sacc+=A0; sacc+=A1; sacc+=A2; sacc+=A3; PIN(sacc); W0; W1; PIN(PW); SBAR(); }while(0)
  #define EX(v) __builtin_amdgcn_exp2f(v)
  #define GAPB(MF,X,B) do{ MF; X[B]=EX(X[B]); X[B+1]=EX(X[B+1]); X[B+2]=EX(X[B+2]); X[B+3]=EX(X[B+3]); PIN(X); SBAR(); }while(0)
  #define VRD(i) do{ vlo[i]=vtr(vp_+(((i)>>2)*4096+((i)&3)*1024)); vhi[i]=vtr(vp_+(((i)>>2)*4096+((i)&3)*1024+512)); }while(0)
  #define KRD(G,j) do{ if(G){ kload2(kf,kp0+sl_next,j); SBAR(); } }while(0)
  #define STEP(C0,C1,P0,P1,t,GK,GV,GL) do{ SBAR(); \
    const lds_cptr vp_=vp0+sl_prev; \
    VRD(0); SBAR(); float sacc=(P0[0]+P0[1]); \
    GAPA(C0=__builtin_amdgcn_mfma_f32_32x32x16_bf16(kf[0],qr[0],negm,0,0,0), P0[2],P0[3],P0[4],P0[5],     pw0[0]=PKW(P0,0), pw0[1]=PKW(P0,2), pw0); \
    VRD(4); SBAR(); GAPA(C1=__builtin_amdgcn_mfma_f32_32x32x16_bf16(kf[1],qr[0],negm,0,0,0), P0[6],P0[7],P0[8],P0[9],     pw0[2]=PKW(P0,4), pw0[3]=PKW(P0,6), pw0); \
    VRD(1); SBAR(); GAPA(C0=__builtin_amdgcn_mfma_f32_32x32x16_bf16(kf[2],qr[1],C0,0,0,0),   P0[10],P0[11],P0[12],P0[13], pw1[0]=PKW(P0,8), pw1[1]=PKW(P0,10), pw1); \
    VRD(5); SBAR(); GAPA(C1=__builtin_amdgcn_mfma_f32_32x32x16_bf16(kf[3],qr[1],C1,0,0,0),   P0[14],P0[15],P1[0],P1[1],   pw1[2]=PKW(P0,12),pw1[3]=PKW(P0,14), pw1); \
    VRD(2); SBAR(); GAPA(C0=__builtin_amdgcn_mfma_f32_32x32x16_bf16(kf[4],qr[2],C0,0,0,0),   P1[2],P1[3],P1[4],P1[5],     pw2[0]=PKW(P1,0), pw2[1]=PKW(P1,2), pw2); \
    VRD(6); SBAR(); GAPA(C1=__builtin_amdgcn_mfma_f32_32x32x16_bf16(kf[5],qr[2],C1,0,0,0),   P1[6],P1[7],P1[8],P1[9],     pw2[2]=PKW(P1,4), pw2[3]=PKW(P1,6), pw2); \
    VRD(3); SBAR(); GAPA(C0=__builtin_amdgcn_mfma_f32_32x32x16_bf16(kf[6],qr[3],C0,0,0,0),   P1[10],P1[11],P1[12],P1[13], pw3[0]=PKW(P1,8), pw3[1]=PKW(P1,10), pw3); \
    VRD(7); SBAR(); GAPA(C1=__builtin_amdgcn_mfma_f32_32x32x16_bf16(kf[7],qr[3],C1,0,0,0),   P1[14],P1[15],0.f,0.f,       pw3[2]=PKW(P1,12),pw3[3]=PKW(P1,14), pw3); \
    l_reg+=sacc; \
    if(GK){DMA_K((t)+3,sl_cur);} if(GV){DMA_V((t)+1,sl_next);} \
    CMASK(C0,C1,t); \
    { float a=MX3(C0[0],C0[1],C1[0]),b=MX3(C0[2],C0[3],C1[1]); a=MX3(a,C1[2],C1[3]); \
      _Pragma("unroll") for(int r=4;r<16;r+=4){a=MX3(a,C0[r],C0[r+1]);b=MX3(b,C0[r+2],C0[r+3]);a=MX3(a,C1[r],C1[r+1]);b=MX3(b,C1[r+2],C1[r+3]);} \
      float rm=__builtin_fmaxf(a,b); { auto rr=__builtin_amdgcn_permlane32_swap(__float_as_uint(rm),__float_as_uint(rm),false,false); rm=__builtin_fmaxf(__uint_as_float(rr[0]),__uint_as_float(rr[1])); } \
      resc=false; \
      if(__builtin_expect(__any(rm>(float)THRL),0)){ const float dl=__builtin_fmaxf(rm,0.f); mhat+=dl; \
        _Pragma("unroll") for(int r=0;r<16;++r){C0[r]-=dl;C1[r]-=dl;} \
        _Pragma("unroll") for(int r=0;r<16;++r)negm[r]=-mhat; asm volatile("":"+v"(negm)); \
        const float f=__builtin_amdgcn_exp2f(-dl); l_reg*=f; if(hi==0)wsf[r32]=f; resc=true; } } \
    SBAR(); \
    GAPB(o[0]=__builtin_amdgcn_mfma_f32_32x32x16_bf16(PAF(0),VFR(0),o[0],0,0,0), C0,0); \
    GAPB(o[1]=__builtin_amdgcn_mfma_f32_32x32x16_bf16(PAF(0),VFR(4),o[1],0,0,0), C0,4); \
    KRD(GL,0); GAPB(o[0]=__builtin_amdgcn_mfma_f32_32x32x16_bf16(PAF(1),VFR(1),o[0],0,0,0), C0,8); \
    KRD(GL,1); GAPB(o[1]=__builtin_amdgcn_mfma_f32_32x32x16_bf16(PAF(1),VFR(5),o[1],0,0,0), C0,12); \
    KRD(GL,2); GAPB(o[0]=__builtin_amdgcn_mfma_f32_32x32x16_bf16(PAF(2),VFR(2),o[0],0,0,0), C1,0); \
    KRD(GL,3); GAPB(o[1]=__builtin_amdgcn_mfma_f32_32x32x16_bf16(PAF(2),VFR(6),o[1],0,0,0), C1,4); \
    GAPB(o[0]=__builtin_amdgcn_mfma_f32_32x32x16_bf16(PAF(3),VFR(3),o[0],0,0,0), C1,8); \
    GAPB(o[1]=__builtin_amdgcn_mfma_f32_32x32x16_bf16(PAF(3),VFR(7),o[1],0,0,0), C1,12); \
    }while(0)
  int t=1;
  #undef CMASK
  #define CMASK(P0,P1,t) do{}while(0)
  for(;t+5<NT;t+=2){
    STEP(pB0,pB1,pA0,pA1,t,true,true,true);     WAIT_BAR(2); RESC(); ROT();
    STEP(pA0,pA1,pB0,pB1,t+1,true,true,true);   WAIT_BAR(2); RESC(); ROT();
  }
  #undef CMASK
  #define CMASK(P0,P1,t) do{}while(0)
  #define ENDW(tt) do{ if((tt)+3<NT){WAIT_BAR(2);} else if((tt)+2<NT){WAIT_BAR(1);} else {WAIT_BAR(0);} }while(0)
  for(;t+1<NT;t+=2){
    STEP(pB0,pB1,pA0,pA1,t,(t+3<NT),(t+1<NT),(t+1<NT));       ENDW(t);   RESC(); ROT();
    STEP(pA0,pA1,pB0,pB1,t+1,(t+4<NT),(t+2<NT),(t+2<NT));     ENDW(t+1); RESC(); ROT();
  }
  STEP(pB0,pB1,pA0,pA1,NT-1,false,false,false); RESC();
  { float sacc=pB0[0]+pB0[1]; _Pragma("unroll") for(int r=2;r<16;++r)sacc+=pB0[r]; _Pragma("unroll") for(int r=0;r<16;++r)sacc+=pB1[r]; l_reg+=sacc;
    pw0=(u32x4){PKW(pB0,0),PKW(pB0,2),PKW(pB0,4),PKW(pB0,6)};pw1=(u32x4){PKW(pB0,8),PKW(pB0,10),PKW(pB0,12),PKW(pB0,14)};pw2=(u32x4){PKW(pB1,0),PKW(pB1,2),PKW(pB1,4),PKW(pB1,6)};pw3=(u32x4){PKW(pB1,8),PKW(pB1,10),PKW(pB1,12),PKW(pB1,14)};
    SBAR(); pv(o,vb0+sl_cur,PAF(0),PAF(1),PAF(2),PAF(3)); }
  #undef PKW
  #undef PAF
  #undef VFR
  #undef PIN
  #undef MX3
  #undef GAPA
  #undef GAPB
  #undef EX
  #undef VRD
  #undef KRD
  #undef STEP
  #undef ENDW
  {auto rr=__builtin_amdgcn_permlane32_swap(__float_as_uint(l_reg),__float_as_uint(l_reg),false,false);l_reg=__uint_as_float(rr[0])+__uint_as_float(rr[1]);}
  if(hi==0)wsf[32+r32]=l_reg;asm volatile("s_waitcnt lgkmcnt(0)":::"memory");
  float rli[16];
  #pragma unroll
  for(int r=0;r<16;++r)rli[r]=__builtin_amdgcn_rcpf(wsf[32+crow(r,hi)]);
  bf16*Ow=Ou+(long)(wid*QBLK)*OP;
  { bf16*stg=(bf16*)(shm+LDS_OST)+wid*2048;
    #pragma unroll
    for(int r=0;r<16;++r){const int orow=crow(r,hi);
      #pragma unroll
      for(int d0=0;d0<2;++d0)stg[orow*64+d0*32+r32]=__float2bfloat16(o[d0][r]*rli[r]);}
    asm volatile("s_waitcnt lgkmcnt(0)":::"memory");
    #pragma unroll
    for(int i=0;i<4;++i){const int row=i*8+(lane>>3),ch=lane&7; const u32x4 v=*(const u32x4*)(stg+row*64+ch*8); ATTN_STORE16(Ow+(long)row*OP+ch*8,v);} }
  asm volatile("s_waitcnt lgkmcnt(0)\n\ts_barrier":::"memory");
  #undef DMA_K
  #undef DMA_V
  #undef CMASK
  #undef START
  #undef RESC
  #undef ROT
}
constexpr int ATTN_LDS_BYTES=LDS_BYTES;
#undef SBAR
#undef WAIT_BAR
}

constexpr int NWAVES = 8;
#ifndef MK_N_LAUNCHES
#define MK_N_LAUNCHES 1
#endif
constexpr int DM = 1024, NBATCH = 8, SEQL = 4096, CTXL = 256, DEPTH = 2;
constexpr int RCTX = NBATCH * CTXL, RLAT = NBATCH * SEQL, RTOT = RCTX + RLAT;
constexpr int INW = 2560, NEXP = 32, NKEY = CTXL + SEQL, NPF = 34, NMOD = 6 * DM;
constexpr int ZC_U = 0, ZC_B = 256, ZC_C = 512, ZC_RQ = 768, ZC_RK = 1024, ZC_RV = 1280, ZC_RG = 1536, ZC_AQ = 1792, ZC_AK = 2304, ZC_AV = 2432;
constexpr float LN_EPS = 1e-6f, ALPHA = 1.41421356237309505f;
constexpr int N_PRO = 3, N_PER_LAYER = 10, N_PHASES = N_PRO + DEPTH * N_PER_LAYER;
constexpr int N_LAUNCHES = MK_N_LAUNCHES;

constexpr size_t MiB = 1u << 20;
constexpr size_t WS_CTL = 0, CTL_ZERO_BYTES = 1 * MiB;
constexpr size_t WS_MODP = 2 * MiB, WS_MODV = 6 * MiB, WS_ROPE = 7 * MiB;
constexpr size_t WS_RE = 8 * MiB, WS_RP = 9 * MiB, WS_RW = 10 * MiB, WS_SLOT = 11 * MiB, WS_ROWW = 12 * MiB;
constexpr size_t WS_WIN = 14 * MiB, WS_WOUT = 24 * MiB, WS_KVS = 28 * MiB, WS_SS = 62 * MiB, WS_AK = 80 * MiB, WS_AV = 89 * MiB, WS_AQ = 98 * MiB;
constexpr size_t WS_RQ = 132 * MiB, WS_RK = 149 * MiB, WS_WGU = 166 * MiB, WS_WD = 422 * MiB, WS_XSA = 550 * MiB, WS_XH = 618 * MiB, WS_Z = 686 * MiB;
constexpr size_t WS_MIX = 856 * MiB, WS_Y = 924 * MiB, WS_H2 = 992 * MiB, WS_XS2 = 1060 * MiB, WS_ACT = 1348 * MiB, WS_END = 1636 * MiB;
constexpr size_t WS_YB = WS_XS2;
constexpr int MAXTILES = 576;
static_assert(WS_MODP + (size_t)DEPTH * 8 * 9 * NMOD * 4 <= WS_MODV && WS_MODV + (size_t)DEPTH * 9 * NMOD * 4 <= WS_ROPE, "ws map");
static_assert(WS_WIN + (size_t)DEPTH * INW * DM * 2 <= WS_WOUT && WS_WOUT + (size_t)DEPTH * DM * DM * 2 <= WS_KVS, "ws map");
static_assert(WS_KVS + (size_t)NBATCH * 4 * NPF * 2 * 4096 * 4 <= WS_SS && WS_SS + (size_t)NBATCH * 4 * NPF * 2 * 4096 * 2 <= WS_AK, "ws map");
static_assert(WS_AK + (size_t)NBATCH * 2 * NKEY * 64 * 2 <= WS_AV && WS_AV + (size_t)NBATCH * 2 * NKEY * 64 * 2 <= WS_AQ && WS_AQ + (size_t)RTOT * 512 * 2 <= WS_RQ, "ws map");
static_assert(WS_RQ + (size_t)RTOT * 256 * 2 <= WS_RK && WS_RK + (size_t)RTOT * 256 * 2 <= WS_WGU && WS_WGU + (size_t)DEPTH * NEXP * 2048 * DM * 2 <= WS_WD, "ws map");
static_assert(WS_WD + (size_t)DEPTH * NEXP * DM * DM * 2 <= WS_XSA && WS_XSA + (size_t)RTOT * DM * 2 <= WS_XH && WS_XH + (size_t)RTOT * DM * 2 <= WS_Z, "ws map");
static_assert(WS_Z + (size_t)RTOT * INW * 2 <= WS_MIX && WS_MIX + (size_t)RTOT * DM * 2 <= WS_Y && WS_Y + (size_t)RTOT * DM * 2 <= WS_H2 && WS_H2 + (size_t)RTOT * DM * 2 <= WS_XS2, "ws map");
static_assert(WS_XS2 + (size_t)MAXTILES * 256 * DM * 2 <= WS_ACT && WS_ACT + (size_t)MAXTILES * 256 * DM * 2 <= WS_END, "ws map");
constexpr int CW_TMO = 0, CW_CODE = 1, CW_BAR = 4096, CW_GCNT = 8192;

constexpr int RING_OFF = 0, RING_BYTES = 131072;
constexpr int LDSCTL_OFF = RING_BYTES, MISC_OFF = LDSCTL_OFF + 320;
constexpr int OFFT_OFF = LDSCTL_OFF + 512, LCNT_OFF = LDSCTL_OFF + 768, LBASE_OFF = LDSCTL_OFF + 896, ENT_OFF = LDSCTL_OFF + 1024;
constexpr int LDS_BYTES = 147456;
static_assert(ENT_OFF + 4096 <= LDS_BYTES, "LDS map");

#define GAS __attribute__((address_space(1)))
#define LAS __attribute__((address_space(3)))
typedef unsigned short bf16;
typedef unsigned v4u __attribute__((ext_vector_type(4)));
typedef float f32x4 __attribute__((ext_vector_type(4)));
typedef short bf16x8 __attribute__((ext_vector_type(8)));
typedef GAS unsigned gu32;
typedef GAS unsigned long long gu64;
#define RLX_AGENT __ATOMIC_RELAXED, __HIP_MEMORY_SCOPE_AGENT
#define LDS_WAIT() asm volatile("s_waitcnt lgkmcnt(0)" ::: "memory")
#define VM_WAIT() asm volatile("s_waitcnt vmcnt(0)" ::: "memory")
__device__ __forceinline__ unsigned long long rt() { return __builtin_amdgcn_s_memrealtime(); }
__device__ __forceinline__ unsigned f2bf(float f) { unsigned u = __builtin_bit_cast(unsigned, f); return (u + 0x7fffu + ((u >> 16) & 1u)) >> 16; }
__device__ __forceinline__ unsigned pk2(float lo, float hi) { return f2bf(lo) | (f2bf(hi) << 16); }

#define XB_TMO      128
#define XB_XCNT(j)  (256  + 64 * (j))
#define XB_XSUB(j)  (1280 + 64 * (j))
#define XB_XGEN(j)  (2304 + 64 * (j))
#define XB_TOP      3328
#define XB_TOPGEN   3392
#define XCD_BAR_WORDS 3456
#define XB_SPIN_CAP (1u << 18)

__device__ __forceinline__ unsigned xb_ld(unsigned* p)              { return __hip_atomic_load(p, __ATOMIC_RELAXED, __HIP_MEMORY_SCOPE_AGENT); }
__device__ __forceinline__ unsigned xb_add(unsigned* p, unsigned v) { return __hip_atomic_fetch_add(p, v, __ATOMIC_RELAXED, __HIP_MEMORY_SCOPE_AGENT); }
__device__ __forceinline__ unsigned xb_xcc_id() { return (unsigned)__builtin_amdgcn_s_getreg((3 << 11) | 20) & 0xFu; }
#define XB_SPIN(cond, bar) do { unsigned _sp = 0; while (cond) { __builtin_amdgcn_s_sleep(1); \
    if ((++_sp & 255u) == 0u) { if (xb_ld(&(bar)[XB_TMO])) break; if (_sp > XB_SPIN_CAP) { atomicAdd(&(bar)[XB_TMO], 1u); break; } } } } while (0)

struct XcdBarrier {
    unsigned* bar; unsigned x;
    volatile LAS unsigned* st;
};

__device__ __forceinline__ XcdBarrier xcd_barrier_post(unsigned* bar, volatile LAS unsigned* st) {
    XcdBarrier b; b.bar = bar; b.x = xb_xcc_id(); b.st = st;
    if (threadIdx.x == 0) (void)xb_add(&bar[XB_XCNT(b.x)], 1u);
    return b;
}
__device__ __forceinline__ void xcd_barrier_complete(unsigned* bar, unsigned x, unsigned& nloc, unsigned& nx) {
    const unsigned G = gridDim.x * gridDim.y * gridDim.z;
    unsigned sum, cnt, mine, sp = 0u;
    for (;;) {
        sum = 0u; cnt = 0u; mine = 0u;
#pragma unroll
        for (unsigned j = 0; j < 16; ++j) { const unsigned c = xb_ld(&bar[XB_XCNT(j)]); sum += c; cnt += (c > 0u) ? 1u : 0u; mine = (j == x) ? c : mine; }
        if (sum == G) break;
        __builtin_amdgcn_s_sleep(1);
        if ((++sp & 255u) == 0u) { if (xb_ld(&bar[XB_TMO])) break; if (sp > XB_SPIN_CAP) { atomicAdd(&bar[XB_TMO], 1u); break; } }
    }
    nloc = mine > 0u ? mine : 1u; nx = cnt > 0u ? cnt : 1u;
}

__device__ __forceinline__ void xcd_barrier(const XcdBarrier& b) {
    asm volatile("s_waitcnt vmcnt(0)" ::: "memory");
    __syncthreads();
    if (threadIdx.x == 0) {
        unsigned* bar = b.bar;
        __builtin_amdgcn_s_waitcnt(0);
        unsigned nloc = b.st[0], nx = b.st[1];
        if (nloc == 0u) { xcd_barrier_complete(bar, b.x, nloc, nx); b.st[0] = nloc; b.st[1] = nx; }
        const unsigned old = xb_add(&bar[XB_XSUB(b.x)], 1u);
        const unsigned gen = old / nloc;
        if (old + 1u == (gen + 1u) * nloc) {
            __builtin_amdgcn_fence(__ATOMIC_RELEASE, "agent");
            asm volatile("s_waitcnt vmcnt(0)" ::: "memory");
            const unsigned og = xb_add(&bar[XB_TOP], 1u);
            const unsigned tg = og / nx;
            if (og + 1u == (tg + 1u) * nx) xb_add(&bar[XB_TOPGEN], 1u);
            else XB_SPIN(xb_ld(&bar[XB_TOPGEN]) == tg, bar);
            __builtin_amdgcn_fence(__ATOMIC_ACQUIRE, "agent");
            xb_add(&bar[XB_XGEN(b.x)], 1u);
            asm volatile("s_waitcnt vmcnt(0)" ::: "memory");
        } else {
            XB_SPIN(xb_ld(&bar[XB_XGEN(b.x)]) == gen, bar);
            __builtin_amdgcn_fence(__ATOMIC_ACQUIRE, "agent");
            asm volatile("s_waitcnt vmcnt(0)" ::: "memory");
        }
    }
    __syncthreads();
}

struct Args { const float* in[21]; float* out; unsigned char* ws; int ph_lo, ph_hi, li, pad; };
template <int OFF> __device__ __forceinline__ const float* karg_ptr() {
    const float* p;
    asm volatile("s_load_dwordx2 %0, %1, %2\n\ts_waitcnt lgkmcnt(0)\n\ts_nop 4" : "=s"(p) : "s"(__builtin_amdgcn_kernarg_segment_ptr()), "i"(OFF) : "memory");
    return p;
}
#define KIN(i) karg_ptr<8 * (i)>()
#define KOUT() ((float*)karg_ptr<8 * 21>())
#define KWS() ((unsigned char*)karg_ptr<8 * 22>())
typedef float f32x16 __attribute__((ext_vector_type(16)));
typedef unsigned v2u __attribute__((ext_vector_type(2)));
__device__ __forceinline__ float bflo(unsigned u) { return __builtin_bit_cast(float, u << 16); }
__device__ __forceinline__ float bfhi(unsigned u) { return __builtin_bit_cast(float, u & 0xffff0000u); }
__device__ __forceinline__ float bf1(unsigned short h) { return __builtin_bit_cast(float, (unsigned)h << 16); }
__device__ __forceinline__ float wave_sum(float v) {
#pragma unroll
    for (int o = 1; o < 64; o <<= 1) v += __shfl_xor(v, o);
    return v;
}
__device__ __forceinline__ int mod_row(int r) { return r < RCTX ? 8 : ((r - RCTX) >> 12); }
__device__ __forceinline__ void load_row_f32(const float* p, int lane, f32x4 (&v)[4]) {
#pragma unroll
    for (int j = 0; j < 4; ++j) v[j] = *(const f32x4*)(p + 256 * j + 4 * lane);
}
__device__ __forceinline__ void load_row_bf16(const bf16* p, int lane, f32x4 (&v)[4]) {
#pragma unroll
    for (int j = 0; j < 4; ++j) { const uint2 u = *(const uint2*)(p + 256 * j + 4 * lane); v[j] = (f32x4){bflo(u.x), bfhi(u.x), bflo(u.y), bfhi(u.y)}; }
}
__device__ __forceinline__ void store_row_bf16(bf16* p, int lane, const f32x4 (&v)[4]) {
#pragma unroll
    for (int j = 0; j < 4; ++j) { uint2 u; u.x = pk2(v[j][0], v[j][1]); u.y = pk2(v[j][2], v[j][3]); *(uint2*)(p + 256 * j + 4 * lane) = u; }
}
__device__ __forceinline__ void store_row_f32(float* p, int lane, const f32x4 (&v)[4]) {
#pragma unroll
    for (int j = 0; j < 4; ++j) *(f32x4*)(p + 256 * j + 4 * lane) = v[j];
}
__device__ __forceinline__ void ln_row(f32x4 (&v)[4], const float* g, const float* b, int lane) {
    float s = 0.f;
#pragma unroll
    for (int j = 0; j < 4; ++j) s += (v[j][0] + v[j][1]) + (v[j][2] + v[j][3]);
    const float mean = wave_sum(s) * (1.0f / DM); float s2 = 0.f;
#pragma unroll
    for (int j = 0; j < 4; ++j) { v[j] = v[j] - mean; s2 += (v[j][0] * v[j][0] + v[j][1] * v[j][1]) + (v[j][2] * v[j][2] + v[j][3] * v[j][3]); }
    const float rstd = 1.0f / sqrtf(wave_sum(s2) * (1.0f / DM) + LN_EPS);
#pragma unroll
    for (int j = 0; j < 4; ++j) { const f32x4 gg = *(const f32x4*)(g + 256 * j + 4 * lane), bb = *(const f32x4*)(b + 256 * j + 4 * lane); v[j] = v[j] * rstd * gg + bb; }
}
__device__ __forceinline__ void modulate(const f32x4 (&v)[4], const float* sc, const float* sh, int lane, f32x4 (&o)[4]) {
#pragma unroll
    for (int j = 0; j < 4; ++j) { const f32x4 s = *(const f32x4*)(sc + 256 * j + 4 * lane), h = *(const f32x4*)(sh + 256 * j + 4 * lane); o[j] = v[j] * (1.0f + s) + h; }
}
__device__ __forceinline__ float log2_gamma(float dexp) { return log1pf(-exp2f(-dexp)) * 1.4426950408889634f; }

struct P0Item { const float* src; unsigned char* dst; int N, f8; float scale; };
__device__ __forceinline__ bool p0_item(int it, int lane, const float* in_win, const float* in_wout, const float* in_wgu, const float* in_wd, unsigned char* ws, P0Item& I) {
    constexpr int I_IN = 16 * 40, I_OUT = 16 * 16, I_GU = 16 * 32, I_DN = 16 * 16;
    constexpr int T_IN = DEPTH * I_IN, T_OUT = DEPTH * I_OUT, T_GU = DEPTH * NEXP * I_GU, T_DN = DEPTH * NEXP * I_DN;
    if (it >= T_IN + T_OUT + T_GU + T_DN) return false;
    int r = it;
    if (r < T_IN) { const int l = r / I_IN, q = r % I_IN, kb = q / 40, nb = q % 40;
        I.src = in_win + (size_t)l * DM * INW + (size_t)(64 * kb) * INW + 64 * nb + lane; I.N = INW; I.f8 = 0; I.scale = 1.f;
        I.dst = ws + WS_WIN + ((size_t)l * INW * DM + (size_t)(64 * nb) * DM + 64 * kb) * 2; return true; }
    r -= T_IN;
    if (r < T_OUT) { const int l = r / I_OUT, q = r % I_OUT, kb = q / 16, nb = q % 16;
        I.src = in_wout + (size_t)l * DM * DM + (size_t)(64 * kb) * DM + 64 * nb + lane; I.N = DM; I.f8 = 0; I.scale = 1.f;
        I.dst = ws + WS_WOUT + ((size_t)l * DM * DM + (size_t)(64 * nb) * DM + 64 * kb) * 2; return true; }
    r -= T_OUT;
    if (r < T_GU) { const int le = r / I_GU, q = r % I_GU, kb = q / 32, nb = q % 32; const int n0 = 64 * nb;
        const int dest = (n0 < 1024) ? ((n0 >> 7) * 256 + (n0 & 127)) : ((((n0 - 1024) >> 7) * 256) + 128 + ((n0 - 1024) & 127));
        I.src = in_wgu + (size_t)le * DM * 2048 + (size_t)(64 * kb) * 2048 + n0 + lane; I.N = 2048; I.f8 = 1; I.scale = 32.f;
        I.dst = ws + WS_WGU + (size_t)le * 2048 * DM + (size_t)dest * DM + 64 * kb; return true; }
    r -= T_GU;
    { const int le = r / I_DN, q = r % I_DN, kb = q / 16, nb = q % 16;
        I.src = in_wd + (size_t)le * DM * DM + (size_t)(64 * kb) * DM + 64 * nb + lane; I.N = DM; I.f8 = 1; I.scale = 64.f;
        I.dst = ws + WS_WD + (size_t)le * DM * DM + (size_t)(64 * nb) * DM + 64 * kb; return true; }
}
__device__ __forceinline__ void p0_item_load(const P0Item& I, float (&v)[64]) {
#pragma unroll
    for (int k = 0; k < 64; ++k) v[k] = I.src[(size_t)k * I.N];
}
__device__ __forceinline__ void p0_item_store(const P0Item& I, const float (&v)[64], LAS unsigned* T, int lane) {
    if (I.f8) {
#pragma unroll
        for (int kq = 0; kq < 16; ++kq) T[lane * 20 + kq] = (unsigned)__builtin_amdgcn_cvt_pk_fp8_f32(v[4 * kq + 2] * I.scale, v[4 * kq + 3] * I.scale, __builtin_amdgcn_cvt_pk_fp8_f32(v[4 * kq] * I.scale, v[4 * kq + 1] * I.scale, 0, false), true);
        LDS_WAIT(); asm volatile("" ::: "memory");
        const int c = lane & 3, nr = lane >> 2;
#pragma unroll
        for (int j = 0; j < 4; ++j) { const int n = nr + 16 * j; const v4u o = *(const LAS v4u*)(T + n * 20 + 4 * c); *(GAS v4u*)(I.dst + (size_t)n * DM + 16 * c) = o; }
    } else {
#pragma unroll
        for (int kp = 0; kp < 32; ++kp) T[lane * 36 + kp] = pk2(v[2 * kp], v[2 * kp + 1]);
        LDS_WAIT(); asm volatile("" ::: "memory");
        const int c = lane & 7, nr = lane >> 3;
#pragma unroll
        for (int j = 0; j < 8; ++j) { const int n = nr + 8 * j; const v4u o = *(const LAS v4u*)(T + n * 36 + 4 * c); *(GAS v4u*)(I.dst + (size_t)n * DM * 2 + 16 * c) = o; }
    }
    LDS_WAIT(); asm volatile("" ::: "memory");
}
__device__ __forceinline__ void p0a(const Args& A, LAS unsigned char* lds, int tid, int lane, int wave) {
    unsigned char* ws = KWS();
    const int G = gridDim.x, wg = opaque_bid();
    const float* in_c = KIN(1); const float* in_cctx = KIN(3); const float* in_wmod = KIN(4); const float* in_bmod = KIN(5);
    {
        LAS float* sl = (LAS float*)(lds + RING_OFF);
        float* MODP = (float*)(ws + WS_MODP);
        for (int u = wg; u < DEPTH * 8 * 12; u += G) {
            const int l = u / 96, rem = u % 96, kp = rem / 12, cb = rem % 12;
            for (int i = tid; i < 9 * 128; i += NWAVES * 64) { const int r = i >> 7, k = i & 127;
                const float cv = (r < 8) ? in_c[r * DM + kp * 128 + k] : in_cctx[kp * 128 + k];
                sl[i] = cv / (1.0f + expf(-cv)); }
            __syncthreads();
            const int col = cb * 512 + tid;
            float acc[9];
#pragma unroll
            for (int r = 0; r < 9; ++r) acc[r] = (kp == 0) ? in_bmod[l * NMOD + col] : 0.f;
            const float* wp = in_wmod + ((size_t)l * DM + kp * 128) * NMOD + col;
#pragma unroll 8
            for (int k = 0; k < 128; ++k) { const float w = wp[(size_t)k * NMOD];
#pragma unroll
                for (int r = 0; r < 9; ++r) acc[r] += sl[r * 128 + k] * w; }
#pragma unroll
            for (int r = 0; r < 9; ++r) MODP[((size_t)(l * 8 + kp) * 9 + r) * NMOD + col] = acc[r];
            __syncthreads();
        }
    }
    if (wg == G - 1) {
        const float invf[16] = {1.0f, 0.5623413251903491f, 0.31622776601683794f, 0.1778279410038923f, 0.1f, 0.05623413251903491f, 0.03162277660168379f, 0.01778279410038923f,
                                0.01f, 0.005623413251903491f, 0.0031622776601683794f, 0.0017782794100389228f, 0.001f, 0.0005623413251903491f, 0.00031622776601683794f, 0.00017782794100389227f};
        float2* rope = (float2*)(ws + WS_ROPE);
        for (int i = tid; i < 1024; i += NWAVES * 64) { const int f = i & 15; float fr = invf[0];
#pragma unroll
            for (int q = 1; q < 16; ++q) fr = (f == q) ? invf[q] : fr;
            const float ang = (float)(i >> 4) * fr; rope[i] = make_float2(cosf(ang), sinf(ang)); }
    }
    {
        LAS unsigned* scr = (LAS unsigned*)(lds + RING_OFF + wave * 16384);
        const float* in_win = KIN(6); const float* in_wout = KIN(12); const float* in_wgu = KIN(17); const float* in_wd = KIN(19);
        const int gw = wg * NWAVES + wave, NGW = G * NWAVES;
        P0Item Ia, Ib; float va[64], vb[64];
        bool ha = p0_item(gw, lane, in_win, in_wout, in_wgu, in_wd, ws, Ia), hb = false;
        if (ha) p0_item_load(Ia, va);
        for (int it = gw; ha; it += 2 * NGW) {
            hb = p0_item(it + NGW, lane, in_win, in_wout, in_wgu, in_wd, ws, Ib);
            if (hb) p0_item_load(Ib, vb);
            p0_item_store(Ia, va, scr, lane);
            if (!hb) break;
            ha = p0_item(it + 2 * NGW, lane, in_win, in_wout, in_wgu, in_wd, ws, Ia);
            if (ha) p0_item_load(Ia, va);
            p0_item_store(Ib, vb, scr, lane);
        }
    }
    __syncthreads();
}
__device__ __forceinline__ void p0b(const Args& A, int tid) {
    const float* MODP = (const float*)(KWS() + WS_MODP); float* MODV = (float*)(KWS() + WS_MODV);
    for (int i = opaque_bid() * (NWAVES * 64) + tid; i < DEPTH * 9 * NMOD; i += gridDim.x * NWAVES * 64) {
        const int l = i / (9 * NMOD), rc = i % (9 * NMOD); float s = 0.f;
#pragma unroll
        for (int kp = 0; kp < 8; ++kp) s += MODP[(size_t)(l * 8 + kp) * 9 * NMOD + rc];
        MODV[i] = s;
    }
}
__device__ __forceinline__ void p0c(const Args& A, int lane, int wave) {
    const float* MODV = (const float*)(KWS() + WS_MODV); bf16* XH = (bf16*)(KWS() + WS_XH);
    const int gw = opaque_bid() * NWAVES + wave, NGW = gridDim.x * NWAVES, RPW = (RTOT + NGW - 1) / NGW;
    for (int r = gw * RPW; r < (gw + 1) * RPW && r < RTOT; ++r) {
        const float* src = (r < RCTX) ? KIN(2) + (size_t)r * DM : KIN(0) + (size_t)(r - RCTX) * DM;
        const float* mv = MODV + (size_t)mod_row(r) * NMOD;
        f32x4 v[4], o[4]; load_row_f32(src, lane, v); modulate(v, mv + 1 * DM, mv + 0 * DM, lane, o); store_row_bf16(XH + (size_t)r * DM, lane, o);
    }
}

__device__ __forceinline__ void unpack4(uint2 u, float (&x)[4]) { x[0] = bflo(u.x); x[1] = bfhi(u.x); x[2] = bflo(u.y); x[3] = bfhi(u.y); }
__device__ __forceinline__ uint2 pack4(const float (&x)[4]) { uint2 u; u.x = pk2(x[0], x[1]); u.y = pk2(x[2], x[3]); return u; }
__device__ __forceinline__ void rope4(float (&x1)[4], float (&x2)[4], const float2* rope, int pos, int f0, bool apply, float scale) {
    if (apply) { const f32x4 a = *(const f32x4*)(rope + pos * 16 + f0), b = *(const f32x4*)(rope + pos * 16 + f0 + 2);
        const float cs[4] = {a[0], a[2], b[0], b[2]}, sn[4] = {a[1], a[3], b[1], b[3]};
#pragma unroll
        for (int i = 0; i < 4; ++i) { const float p = x1[i] * cs[i] - x2[i] * sn[i], q = x1[i] * sn[i] + x2[i] * cs[i]; x1[i] = p; x2[i] = q; } }
#pragma unroll
    for (int i = 0; i < 4; ++i) { x1[i] *= scale; x2[i] *= scale; }
}
struct P2Raw { uint2 bb, r1, r2, q1, q2, k1, k2, vv; };
__device__ __forceinline__ void p2_load(const bf16* Z, int r, int lane, P2Raw& R) {
    const bf16* zr = Z + (size_t)r * INW; const int j4 = 4 * (lane & 3);
    R.bb = *(const uint2*)(zr + ZC_B + 4 * lane);
    { const bf16* s = zr + ((lane >> 5) ? ZC_RK : ZC_RQ) + ((lane >> 2) & 7) * 32 + j4; R.r1 = *(const uint2*)s; R.r2 = *(const uint2*)(s + 16); }
    { const bf16* s = zr + ZC_AQ + (lane >> 2) * 32 + j4; R.q1 = *(const uint2*)s; R.q2 = *(const uint2*)(s + 16); }
    { const bf16* s = zr + ZC_AK + ((lane & 15) >> 2) * 32 + j4; R.k1 = *(const uint2*)s; R.k2 = *(const uint2*)(s + 16); }
    R.vv = *(const uint2*)(zr + ZC_AV + (lane & 31) * 4);
}
__device__ __forceinline__ void p2_load_uc(const bf16* Z, int r, int lane, uint2& u, uint2& c) { const bf16* zr = Z + (size_t)r * INW; u = *(const uint2*)(zr + ZC_U + 4 * lane); c = *(const uint2*)(zr + ZC_C + 4 * lane); }
__device__ __forceinline__ void p2_prod(uint2 u, uint2 c, float (&v)[4]) { float a[4], d[4]; unpack4(u, a); unpack4(c, d);
#pragma unroll
    for (int i = 0; i < 4; ++i) v[i] = a[i] * d[i]; }
__device__ __forceinline__ void p2_norm_rope(float (&x1)[4], float (&x2)[4], float rn, const f32x4& g1, const f32x4& g2, const float (&cs)[4], const float (&sn)[4], float scale) {
#pragma unroll
    for (int i = 0; i < 4; ++i) { const float a = x1[i] * rn * g1[i], d = x2[i] * rn * g2[i]; x1[i] = (a * cs[i] - d * sn[i]) * scale; x2[i] = (a * sn[i] + d * cs[i]) * scale; }
}
__device__ __forceinline__ void p2_rows(const Args& A, int l, int r0, int n, bool last, int lane) {
    unsigned char* ws = KWS();
    const bf16* Z = (const bf16*)(ws + WS_Z); const float2* rope = (const float2*)(ws + WS_ROPE);
    bf16* MIX = (bf16*)(ws + WS_MIX); bf16* RQK = (bf16*)(ws + ((lane >> 5) ? WS_RK : WS_RQ)); bf16* AQ = (bf16*)(ws + WS_AQ); bf16* AK = (bf16*)(ws + WS_AK); bf16* AV = (bf16*)(ws + WS_AV);
    const int j = lane & 3, axis = (lane >> 2) & 1, c0 = 4 * lane;
    const float* cw = KIN(7) + (size_t)l * 256 * 3 + c0 * 3; const f32x4 w0 = *(const f32x4*)cw, w1 = *(const f32x4*)(cw + 4), w2 = *(const f32x4*)(cw + 8);
    const float wf[12] = {w0[0], w0[1], w0[2], w0[3], w1[0], w1[1], w1[2], w1[3], w2[0], w2[1], w2[2], w2[3]};
    const float* qg = KIN(10) + l * 64 + axis * 32 + 4 * j; const f32x4 qg1 = *(const f32x4*)qg, qg2 = *(const f32x4*)(qg + 16);
    const float* kg = KIN(11) + l * 64 + axis * 32 + 4 * j; const f32x4 kg1 = *(const f32x4*)kg, kg2 = *(const f32x4*)(kg + 16);
    const f32x4 one4 = {1.f, 1.f, 1.f, 1.f};
    if (n <= 0) return;
    float vp[4], vc[4]; uint2 un, cn;
    { uint2 u, c; p2_load_uc(Z, r0 > 0 ? r0 - 1 : 0, lane, u, c); p2_prod(u, c, vp); p2_load_uc(Z, r0, lane, u, c); p2_prod(u, c, vc); p2_load_uc(Z, r0 + 1 < RTOT ? r0 + 1 : RTOT - 1, lane, un, cn); }
    P2Raw cur, nxt; p2_load(Z, r0, lane, cur);
    for (int i = 0; i < n; ++i) {
        const int r = r0 + i;
        const bool isctx = r < RCTX; const int b = isctx ? (r >> 8) : ((r - RCTX) >> 12), t = isctx ? (r & 255) : ((r - RCTX) & 4095), tlen = isctx ? CTXL : SEQL;
        const bool need_out = !(isctx && last);
        float cs[4] = {1.f, 1.f, 1.f, 1.f}, sn[4] = {0.f, 0.f, 0.f, 0.f};
        if (!isctx) { const int pos = axis ? (t & 63) : (t >> 6); const f32x4 a = *(const f32x4*)(rope + pos * 16 + 4 * j), d = *(const f32x4*)(rope + pos * 16 + 4 * j + 2);
            cs[0] = a[0]; sn[0] = a[1]; cs[1] = a[2]; sn[1] = a[3]; cs[2] = d[0]; sn[2] = d[1]; cs[3] = d[2]; sn[3] = d[3]; }
        p2_load(Z, (i + 1 < n) ? r + 1 : r, lane, nxt);
        uint2 un2, cn2; p2_load_uc(Z, r + 2 < RTOT ? r + 2 : RTOT - 1, lane, un2, cn2);
        float vn[4]; p2_prod(un, cn, vn);
        if (need_out) { float bb[4], y[4]; unpack4(cur.bb, bb); const float mp = (t > 0) ? 1.f : 0.f, mn = (t < tlen - 1) ? 1.f : 0.f;
#pragma unroll
            for (int q = 0; q < 4; ++q) y[q] = bb[q] * (wf[3 * q] * (vp[q] * mp) + wf[3 * q + 1] * vc[q] + wf[3 * q + 2] * (vn[q] * mn));
            *(uint2*)(MIX + (size_t)r * DM + c0) = pack4(y); }
        { float x1[4], x2[4]; unpack4(cur.r1, x1); unpack4(cur.r2, x2);
            p2_norm_rope(x1, x2, 1.0f, one4, one4, cs, sn, (lane >> 5) ? 0.125f : 1.0f);
            bf16* dst = RQK + (size_t)r * 256 + ((lane >> 2) & 7) * 32 + 4 * j; *(uint2*)dst = pack4(x1); *(uint2*)(dst + 16) = pack4(x2); }
        { float x1[4], x2[4]; unpack4(cur.q1, x1); unpack4(cur.q2, x2); float ss = 0.f;
#pragma unroll
            for (int q = 0; q < 4; ++q) ss += x1[q] * x1[q] + x2[q] * x2[q];
            ss += __shfl_xor(ss, 1); ss += __shfl_xor(ss, 2); ss += __shfl_xor(ss, 4);
            p2_norm_rope(x1, x2, 1.0f / sqrtf(ss * (1.0f / 64.0f) + LN_EPS), qg1, qg2, cs, sn, attn_body::C2);
            if (need_out) { bf16* dst = AQ + (size_t)r * 512 + (lane >> 2) * 32 + 4 * j; *(uint2*)dst = pack4(x1); *(uint2*)(dst + 16) = pack4(x2); } }
        { float x1[4], x2[4]; unpack4(cur.k1, x1); unpack4(cur.k2, x2); float ss = 0.f;
#pragma unroll
            for (int q = 0; q < 4; ++q) ss += x1[q] * x1[q] + x2[q] * x2[q];
            ss += __shfl_xor(ss, 1); ss += __shfl_xor(ss, 2); ss += __shfl_xor(ss, 4);
            p2_norm_rope(x1, x2, 1.0f / sqrtf(ss * (1.0f / 64.0f) + LN_EPS), kg1, kg2, cs, sn, 1.0f);
            const int key = isctx ? t : CTXL + t, blk = (lane & 15) >> 2;
            if (lane < 16) { bf16* dst = AK + ((size_t)(b * 2 + (blk >> 1)) * NKEY + key) * 64 + (blk & 1) * 32 + 4 * j; *(uint2*)dst = pack4(x1); *(uint2*)(dst + 16) = pack4(x2); }
            if (lane >= 32) { const int c = (lane - 32) * 4; *(uint2*)(AV + ((size_t)(b * 2 + (c >> 6)) * NKEY + key) * 64 + (c & 63)) = cur.vv; } }
#pragma unroll
        for (int q = 0; q < 4; ++q) { vp[q] = vc[q]; vc[q] = vn[q]; }
        un = un2; cn = cn2; cur = nxt;
    }
}
constexpr int RT_PITCH = 136;
__device__ __forceinline__ void p2_kv_job(const Args& A, int l, int u, LAS unsigned char* lds, int tid, int lane, int wave) {
    unsigned char* ws = KWS();
    const int h = u & 3, pf = (u >> 2) % NPF, b = (u >> 2) / NPF;
    const bool isctx = pf < 2; const int row0 = isctx ? (b * CTXL + pf * 128) : (RCTX + b * SEQL + (pf - 2) * 128);
    const bf16* Z = (const bf16*)(ws + WS_Z); const float2* rope = (const float2*)(ws + WS_ROPE);
    LAS unsigned short* VT = (LAS unsigned short*)(lds + RING_OFF); LAS unsigned short* KFT = VT + 64 * RT_PITCH; LAS unsigned short* KBT = KFT + 64 * RT_PITCH;
    const float lgf = log2_gamma(KIN(8)[(l * 2 + 0) * 4 + h]), lgb = log2_gamma(KIN(8)[(l * 2 + 1) * 4 + h]);
#pragma unroll
    for (int i = 0; i < 2; ++i) { const int idx = tid + 512 * i, t = idx >> 3, eg = idx & 7;
        const v4u v = *(const v4u*)(Z + (size_t)(row0 + t) * INW + ZC_RV + h * 64 + eg * 8);
        LAS unsigned short* d = VT + (eg * 8) * RT_PITCH + t;
        d[0 * RT_PITCH] = (unsigned short)(v.x & 0xffffu); d[1 * RT_PITCH] = (unsigned short)(v.x >> 16); d[2 * RT_PITCH] = (unsigned short)(v.y & 0xffffu); d[3 * RT_PITCH] = (unsigned short)(v.y >> 16);
        d[4 * RT_PITCH] = (unsigned short)(v.z & 0xffffu); d[5 * RT_PITCH] = (unsigned short)(v.z >> 16); d[6 * RT_PITCH] = (unsigned short)(v.w & 0xffffu); d[7 * RT_PITCH] = (unsigned short)(v.w >> 16); }
    { const int t = tid >> 2, axis = (tid >> 1) & 1, fg = tid & 1;
        const bf16* src = Z + (size_t)(row0 + t) * INW + ZC_RK + h * 64 + axis * 32 + 8 * fg;
        const v4u a = *(const v4u*)src, c = *(const v4u*)(src + 16);
        float x1[8] = {bflo(a.x), bfhi(a.x), bflo(a.y), bfhi(a.y), bflo(a.z), bfhi(a.z), bflo(a.w), bfhi(a.w)};
        float x2[8] = {bflo(c.x), bfhi(c.x), bflo(c.y), bfhi(c.y), bflo(c.z), bfhi(c.z), bflo(c.w), bfhi(c.w)};
        if (!isctx) { const int tt = (pf - 2) * 128 + t, pos = axis ? (tt & 63) : (tt >> 6); const float2* rp = rope + pos * 16 + 8 * fg;
#pragma unroll
            for (int i = 0; i < 8; ++i) { const float2 cs = rp[i]; const float p = x1[i] * cs.x - x2[i] * cs.y, q = x1[i] * cs.y + x2[i] * cs.x; x1[i] = p; x2[i] = q; } }
        const float wf = exp2f((float)(127 - t) * lgf) * 0.125f, wb = exp2f((float)t * lgb) * 0.125f;
        const int d0 = axis * 32 + 8 * fg;
#pragma unroll
        for (int i = 0; i < 8; ++i) {
            KFT[(d0 + i) * RT_PITCH + t] = (unsigned short)f2bf(x1[i] * wf); KFT[(d0 + 16 + i) * RT_PITCH + t] = (unsigned short)f2bf(x2[i] * wf);
            KBT[(d0 + i) * RT_PITCH + t] = (unsigned short)f2bf(x1[i] * wb); KBT[(d0 + 16 + i) * RT_PITCH + t] = (unsigned short)f2bf(x2[i] * wb); }
    }
    __syncthreads();
    { const int dir = wave >> 2, te = (wave >> 1) & 1, td = wave & 1, r32 = lane & 31, hh = lane >> 5;
        const LAS unsigned short* KT = dir ? KBT : KFT;
        f32x16 acc = {};
#pragma unroll
        for (int s = 0; s < 8; ++s) {
            const bf16x8 a = *(const LAS bf16x8*)(VT + (te * 32 + r32) * RT_PITCH + s * 16 + hh * 8);
            const bf16x8 bq = *(const LAS bf16x8*)(KT + (td * 32 + r32) * RT_PITCH + s * 16 + hh * 8);
            acc = __builtin_amdgcn_mfma_f32_32x32x16_bf16(a, bq, acc, 0, 0, 0);
        }
        float* out = (float*)(ws + WS_KVS) + ((size_t)((b * 4 + h) * NPF + pf) * 2 + dir) * 4096;
#pragma unroll
        for (int q = 0; q < 16; ++q) { const int e = te * 32 + (q & 3) + 8 * (q >> 2) + 4 * hh; out[e * 64 + td * 32 + r32] = acc[q]; }
    }
    __syncthreads();
}
__device__ __forceinline__ void p2(const Args& A, int l, LAS unsigned char* lds, int tid, int lane, int wave) {
    const bool last = (l == DEPTH - 1);
    for (int u = opaque_bid(); u < NBATCH * NPF * 4; u += gridDim.x) p2_kv_job(A, l, u, lds, tid, lane, wave);
    const int gw = opaque_bid() * NWAVES + wave, NGW = gridDim.x * NWAVES, RPW = (RTOT + NGW - 1) / NGW;
    { const int r0 = gw * RPW; p2_rows(A, l, r0, (r0 + RPW <= RTOT) ? RPW : ((RTOT > r0) ? RTOT - r0 : 0), last, lane); }
}

__device__ __forceinline__ void p4_scan(const Args& A, int l, int tid) {
    const float* KVS = (const float*)(KWS() + WS_KVS); bf16* SS = (bf16*)(KWS() + WS_SS);
    for (int gid = opaque_bid() * (NWAVES * 64) + tid; gid < NBATCH * 4 * 4096; gid += gridDim.x * NWAVES * 64) {
        const int bh = gid >> 12, ed = gid & 4095, h = bh & 3;
        const float gf = exp2f(128.0f * log2_gamma(KIN(8)[(l * 2 + 0) * 4 + h])), gb = exp2f(128.0f * log2_gamma(KIN(8)[(l * 2 + 1) * 4 + h]));
        const size_t base = (size_t)bh * NPF * 2 * 4096 + ed;
        float S = 0.f;
        for (int pf = 0; pf < NPF; ++pf) { const size_t o = base + (size_t)(pf * 2 + 0) * 4096; SS[o] = (bf16)f2bf(S); S = gf * S + KVS[o]; }
        S = 0.f;
        for (int q = 0; q < NPF; ++q) { const int pf = (q == 0) ? 1 : (q == 1) ? 0 : (NPF + 1 - q);
            const size_t o = base + (size_t)(pf * 2 + 1) * 4096; SS[o] = (bf16)f2bf(S); S = gb * S + KVS[o]; }
    }
}
__device__ __forceinline__ void p4_attention(const Args& A, int l, char* lds_ring) {
    using abf = attn_body::bf16;
    const abf* AQ = (const abf*)(KWS() + WS_AQ); const abf* AK = (const abf*)(KWS() + WS_AK); const abf* AV = (const abf*)(KWS() + WS_AV); abf* MIX = (abf*)(KWS() + WS_MIX);
    const int c = opaque_bid(), G = gridDim.x;
    const int x = c & 7, m = c >> 3, per = G >> 3, b = x;
    for (int i = 0; i < 5; ++i) {
        const bool isctx = (i == 4);
        if (isctx && (l == DEPTH - 1 || m >= 8)) break;
        const int uu = m + per * i; if (!isctx && uu >= 128) break;
        const int h = isctx ? m : (uu >> 4), kvh = h >> 2, NT = isctx ? (CTXL / 64) : (NKEY / 64);
        const size_t qrow = isctx ? (size_t)b * CTXL : (size_t)RCTX + (size_t)b * SEQL + (size_t)(uu & 15) * 256;
        attn_body::attn_unit<8>(AQ + qrow * 512 + h * 64, AK + (size_t)(b * 2 + kvh) * NKEY * 64, AV + (size_t)(b * 2 + kvh) * NKEY * 64, MIX + qrow * DM + 512 + h * 64, NT, lds_ring);
    }
}

__device__ __forceinline__ void p5_unit(const Args& A, int l, int g, int hp, LAS unsigned char* lds, int tid, int lane, int wave) {
    unsigned char* ws = KWS();
    const bf16* Z = (const bf16*)(ws + WS_Z); const bf16* RQ = (const bf16*)(ws + WS_RQ); const bf16* RK = (const bf16*)(ws + WS_RK); const bf16* SS = (const bf16*)(ws + WS_SS);
    bf16* MIX = (bf16*)(ws + WS_MIX);
    const int row0 = g * 128;
    int b, pf; if (g < 16) { b = g >> 1; pf = g & 1; } else { b = (g - 16) >> 5; pf = 2 + ((g - 16) & 31); }
    LAS unsigned short* VT = (LAS unsigned short*)(lds + RING_OFF);
#pragma unroll
    for (int i = 0; i < 4; ++i) { const int idx = tid + 512 * i, hl = idx >> 10, t = (idx >> 3) & 127, eg = idx & 7;
        const v4u v = *(const v4u*)(Z + (size_t)(row0 + t) * INW + ZC_RV + (2 * hp + hl) * 64 + eg * 8);
        LAS unsigned short* d = VT + (hl * 64 + eg * 8) * RT_PITCH + t;
        d[0 * RT_PITCH] = (unsigned short)(v.x & 0xffffu); d[1 * RT_PITCH] = (unsigned short)(v.x >> 16); d[2 * RT_PITCH] = (unsigned short)(v.y & 0xffffu); d[3 * RT_PITCH] = (unsigned short)(v.y >> 16);
        d[4 * RT_PITCH] = (unsigned short)(v.z & 0xffffu); d[5 * RT_PITCH] = (unsigned short)(v.z >> 16); d[6 * RT_PITCH] = (unsigned short)(v.w & 0xffffu); d[7 * RT_PITCH] = (unsigned short)(v.w >> 16); }
    __syncthreads();
    {
        const int hl = wave >> 2, h = 2 * hp + hl, ib = wave & 3, r32 = lane & 31, hh = lane >> 5;
        const float lgf = log2_gamma(KIN(8)[(l * 2 + 0) * 4 + h]), lgb = log2_gamma(KIN(8)[(l * 2 + 1) * 4 + h]);
        const int iloc = ib * 32 + r32;
        bf16x8 qf[4];
#pragma unroll
        for (int s = 0; s < 4; ++s) qf[s] = *(const bf16x8*)(RQ + (size_t)(row0 + iloc) * 256 + h * 64 + s * 16 + hh * 8);
        const bf16* Sf = SS + ((size_t)((b * 4 + h) * NPF + pf) * 2 + 0) * 4096; const bf16* Sb = Sf + 4096;
        f32x16 Y[2];
        {
            const float af = exp2f((float)(iloc + 1) * lgf), ab = exp2f((float)(128 - iloc) * lgb);
#pragma unroll
            for (int et = 0; et < 2; ++et) {
                f32x16 cf = {}, cb = {};
#pragma unroll
                for (int s = 0; s < 4; ++s) {
                    const bf16x8 a0 = *(const bf16x8*)(Sf + (et * 32 + r32) * 64 + s * 16 + hh * 8), a1 = *(const bf16x8*)(Sb + (et * 32 + r32) * 64 + s * 16 + hh * 8);
                    cf = __builtin_amdgcn_mfma_f32_32x32x16_bf16(a0, qf[s], cf, 0, 0, 0); cb = __builtin_amdgcn_mfma_f32_32x32x16_bf16(a1, qf[s], cb, 0, 0, 0);
                }
#pragma unroll
                for (int q = 0; q < 16; ++q) Y[et][q] = af * cf[q] + ab * cb[q];
            }
        }
        const LAS unsigned short* VTh = VT + hl * 64 * RT_PITCH;
#pragma unroll 1
        for (int jt = 0; jt < 4; ++jt) {
            f32x16 X = {};
#pragma unroll
            for (int s = 0; s < 4; ++s) { const bf16x8 a = *(const bf16x8*)(RK + (size_t)(row0 + jt * 32 + r32) * 256 + h * 64 + s * 16 + hh * 8);
                X = __builtin_amdgcn_mfma_f32_32x32x16_bf16(a, qf[s], X, 0, 0, 0); }
#pragma unroll
            for (int q = 0; q < 16; ++q) { const int jloc = jt * 32 + (q & 3) + 8 * (q >> 2) + 4 * hh; const int dl = iloc - jloc;
                X[q] *= (dl >= 0) ? exp2f((float)dl * lgf) : exp2f((float)(-dl) * lgb); }
#pragma unroll
            for (int s = 0; s < 2; ++s) {
                v4u pw; pw.x = pk2(X[8 * s + 0], X[8 * s + 1]); pw.y = pk2(X[8 * s + 2], X[8 * s + 3]); pw.z = pk2(X[8 * s + 4], X[8 * s + 5]); pw.w = pk2(X[8 * s + 6], X[8 * s + 7]);
                const bf16x8 bfrag = __builtin_bit_cast(bf16x8, pw);
#pragma unroll
                for (int et = 0; et < 2; ++et) {
                    const LAS unsigned short* vp = VTh + (et * 32 + r32) * RT_PITCH + jt * 32 + 16 * s + 4 * hh;
                    const v2u lo = *(const LAS v2u*)vp, hi2 = *(const LAS v2u*)(vp + 8);
                    v4u aw; aw.x = lo.x; aw.y = lo.y; aw.z = hi2.x; aw.w = hi2.y;
                    Y[et] = __builtin_amdgcn_mfma_f32_32x32x16_bf16(__builtin_bit_cast(bf16x8, aw), bfrag, Y[et], 0, 0, 0);
                }
            }
        }
        float s1 = 0.f;
#pragma unroll
        for (int q = 0; q < 16; ++q) s1 += Y[0][q] + Y[1][q];
        s1 += __shfl_xor(s1, 32); const float mu = s1 * (1.0f / 64.0f); float s2 = 0.f;
#pragma unroll
        for (int q = 0; q < 16; ++q) { const float d0 = Y[0][q] - mu, d1 = Y[1][q] - mu; s2 += d0 * d0 + d1 * d1; }
        s2 += __shfl_xor(s2, 32); const float rstd = 1.0f / sqrtf(s2 * (1.0f / 64.0f) + LN_EPS);
        const size_t row = (size_t)(row0 + iloc);
#pragma unroll
        for (int et = 0; et < 2; ++et)
#pragma unroll
            for (int q4 = 0; q4 < 4; ++q4) { const int e0 = et * 32 + 8 * q4 + 4 * hh;
                float gz[4]; unpack4(*(const uint2*)(Z + row * INW + ZC_RG + h * 64 + e0), gz);
                const f32x4 gn = *(const f32x4*)(KIN(9) + l * 256 + h * 64 + e0);
                float o[4];
#pragma unroll
                for (int i = 0; i < 4; ++i) { const float yn = (Y[et][4 * q4 + i] - mu) * rstd * gn[i]; o[i] = yn * (gz[i] / (1.0f + expf(-gz[i]))); }
                *(uint2*)(MIX + row * DM + 256 + h * 64 + e0) = pack4(o); }
    }
    __syncthreads();
}
__device__ __forceinline__ void p5(const Args& A, int l, LAS unsigned char* lds, int tid, int lane, int wave) {
    const int g0 = (l == DEPTH - 1) ? 16 : 0;
    for (int u = opaque_bid(); u < (272 - g0) * 2; u += gridDim.x) p5_unit(A, l, g0 + (u >> 1), u & 1, lds, tid, lane, wave);
}

__device__ __forceinline__ float reduce32(float (&v)[32], int lane) {
#pragma unroll
    for (int i = 0; i < 16; ++i) { const bool up = lane & 32; const float send = up ? v[i] : v[i + 16], keep = up ? v[i + 16] : v[i]; v[i] = keep + __shfl_xor(send, 32); }
#pragma unroll
    for (int i = 0; i < 8; ++i) { const bool up = lane & 16; const float send = up ? v[i] : v[i + 8], keep = up ? v[i + 8] : v[i]; v[i] = keep + __shfl_xor(send, 16); }
#pragma unroll
    for (int i = 0; i < 4; ++i) { const bool up = lane & 8; const float send = up ? v[i] : v[i + 4], keep = up ? v[i + 4] : v[i]; v[i] = keep + __shfl_xor(send, 8); }
#pragma unroll
    for (int i = 0; i < 2; ++i) { const bool up = lane & 4; const float send = up ? v[i] : v[i + 2], keep = up ? v[i + 2] : v[i]; v[i] = keep + __shfl_xor(send, 4); }
    { const bool up = lane & 2; const float send = up ? v[0] : v[1], keep = up ? v[1] : v[0]; v[0] = keep + __shfl_xor(send, 2); }
    return v[0] + __shfl_xor(v[0], 1);
}
struct P7Raw { v4u x[4]; uint2 y[4]; };
__device__ __forceinline__ void p7_load(int l, int r, int lane, const float* xin_lat, const float* xin_ctx, const bf16* XSA, const bf16* Y, P7Raw& R) {
    if (l == 0) { const float* p = (r < RCTX) ? xin_ctx + (size_t)r * DM : xin_lat + (size_t)(r - RCTX) * DM;
#pragma unroll
        for (int j = 0; j < 4; ++j) R.x[j] = *(const v4u*)(p + 256 * j + 4 * lane); }
    else { const bf16* p = XSA + (size_t)r * DM;
#pragma unroll
        for (int j = 0; j < 4; ++j) { const uint2 u = *(const uint2*)(p + 256 * j + 4 * lane); R.x[j] = (v4u){u.x, u.y, 0u, 0u}; } }
    const bf16* q = Y + (size_t)r * DM;
#pragma unroll
    for (int j = 0; j < 4; ++j) R.y[j] = *(const uint2*)(q + 256 * j + 4 * lane);
}
__device__ __forceinline__ void p7_ln(int l, int r, int lane, const P7Raw& R, const float* mv, const float* lng, const float* lnb, bf16* XSA, unsigned char* H2, f32x4 (&hv)[4], bool doit) {
    f32x4 v[4];
#pragma unroll
    for (int j = 0; j < 4; ++j) {
        f32x4 x;
        if (l == 0) x = __builtin_bit_cast(f32x4, R.x[j]);
        else { const unsigned a = R.x[j][0], b = R.x[j][1]; x = (f32x4){bflo(a), bfhi(a), bflo(b), bfhi(b)}; }
        const f32x4 y = (f32x4){bflo(R.y[j].x), bfhi(R.y[j].x), bflo(R.y[j].y), bfhi(R.y[j].y)};
        const f32x4 g1 = *(const f32x4*)(mv + 2 * DM + 256 * j + 4 * lane); v[j] = ALPHA * x + g1 * y; }
    ln_row(v, lng, lnb, lane);
    if (doit) store_row_bf16(XSA + (size_t)r * DM, lane, v);
    modulate(v, mv + 4 * DM, mv + 3 * DM, lane, hv);
    if (doit)
#pragma unroll
    for (int j = 0; j < 4; ++j) *(unsigned*)(H2 + (size_t)r * DM + 256 * j + 4 * lane) = (unsigned)__builtin_amdgcn_cvt_pk_fp8_f32(hv[j][2], hv[j][3], __builtin_amdgcn_cvt_pk_fp8_f32(hv[j][0], hv[j][1], 0, false), true);
}
__device__ __forceinline__ void p7_route(const Args& A, float logit, int r, int rloc, int lane, LAS int* lcnt, LAS int* ent, float* RWout) {
    float val = logit; const int idx = lane >> 1; float tv[4]; int te[4];
#pragma unroll
    for (int k = 0; k < 4; ++k) {
        float bv = val; int bi = idx;
#pragma unroll
        for (int o = 1; o < 64; o <<= 1) { const float ov = __shfl_xor(bv, o); const int oi = __shfl_xor(bi, o); const bool take = (ov > bv) || (ov == bv && oi < bi); bv = take ? ov : bv; bi = take ? oi : bi; }
        tv[k] = bv; te[k] = bi; val = (idx == bi) ? -INFINITY : val;
    }
    const float p1 = expf(tv[1] - tv[0]), p2 = expf(tv[2] - tv[0]), p3 = expf(tv[3] - tv[0]); const float inv = 1.0f / (1.0f + p1 + p2 + p3);
    if (lane < 4) {
        const int e = (lane == 0) ? te[0] : (lane == 1) ? te[1] : (lane == 2) ? te[2] : te[3];
        const float w = ((lane == 0) ? 1.0f : (lane == 1) ? p1 : (lane == 2) ? p2 : p3) * inv;
        const int lp = __hip_atomic_fetch_add(lcnt + e, 1, __ATOMIC_RELAXED, __HIP_MEMORY_SCOPE_WORKGROUP);
        ent[rloc * 4 + lane] = e | (lp << 8);
        RWout[(size_t)r * 4 + lane] = w;
    }
}
template <bool DRY> __device__ __forceinline__ void p7(const Args& A, int l, LAS unsigned char* lds, int tid, int lane, int wave) {
    unsigned char* ws = KWS();
    const int row_lo = (l == DEPTH - 1) ? RCTX : 0, nrows = RTOT - row_lo;
    const int NGW = gridDim.x * NWAVES, RPW = (nrows + NGW - 1) / NGW, wg_row0 = row_lo + opaque_bid() * NWAVES * RPW;
    LAS f32x4* WL = (LAS f32x4*)(lds + RING_OFF);
    LAS int* lcnt = (LAS int*)(lds + LCNT_OFF); LAS int* lbase = (LAS int*)(lds + LBASE_OFF); LAS int* ent = (LAS int*)(lds + ENT_OFF);
    const float* wr = KIN(15) + (size_t)l * DM * NEXP;
    for (int s = tid; s < 8192; s += NWAVES * 64) { const int ln = s & 63, eg = (s >> 6) & 7, jc = s >> 9; const int k = 256 * (jc >> 2) + 4 * ln + (jc & 3);
        WL[s] = *(const f32x4*)(wr + (size_t)k * NEXP + 4 * eg); }
    if (tid < 32) lcnt[tid] = 0;
    __syncthreads();
    const float bias_e = KIN(16)[l * NEXP + (lane >> 1)];
    const int w_row0 = wg_row0 + wave * RPW;
    const float* xin_lat = KIN(0); const float* xin_ctx = KIN(2); const float* lng = KIN(13) + (size_t)(l * 2 + 0) * DM; const float* lnb = KIN(14) + (size_t)(l * 2 + 0) * DM;
    bf16* XSA = (bf16*)(ws + WS_XSA); const bf16* Yb = (const bf16*)(ws + WS_Y); unsigned char* H2 = ws + (DRY ? WS_XS2 + 128 * MiB : WS_H2); const float* MODV = (const float*)(ws + WS_MODV);
    bf16* XSAo = DRY ? (bf16*)(ws + WS_XS2) : XSA; float* RWo = (float*)(ws + (DRY ? WS_XS2 + 256 * MiB : WS_RW));
    const int nmy = (w_row0 + RPW <= RTOT) ? RPW : ((RTOT > w_row0) ? RTOT - w_row0 : 0);
    P7Raw cur, nxt;
    if (nmy > 0) p7_load(l, w_row0, lane, xin_lat, xin_ctx, XSA, Yb, cur);
    for (int i = 0; i < nmy; i += 2) {
        const int rA = w_row0 + i; const bool okB = (i + 1 < nmy); const int rB = okB ? rA + 1 : rA;
        f32x4 hA[4], hB[4];
        p7_load(l, rB, lane, xin_lat, xin_ctx, XSA, Yb, nxt);
        p7_ln(l, rA, lane, cur, MODV + (size_t)(l * 9 + mod_row(rA)) * NMOD, lng, lnb, XSAo, H2, hA, true);
        cur = nxt;
        p7_load(l, (i + 2 < nmy) ? rA + 2 : rB, lane, xin_lat, xin_ctx, XSA, Yb, nxt);
        p7_ln(l, rB, lane, cur, MODV + (size_t)(l * 9 + mod_row(rB)) * NMOD, lng, lnb, XSAo, H2, hB, okB);
        cur = nxt;
        f32x4 accA[8], accB[8];
#pragma unroll
        for (int eg = 0; eg < 8; ++eg) { accA[eg] = (f32x4){0.f, 0.f, 0.f, 0.f}; accB[eg] = (f32x4){0.f, 0.f, 0.f, 0.f}; }
#pragma unroll
        for (int j = 0; j < 4; ++j)
#pragma unroll
            for (int c = 0; c < 4; ++c) { const float xa = hA[j][c], xb = hB[j][c];
#pragma unroll
                for (int eg = 0; eg < 8; ++eg) { const f32x4 w = WL[((j * 4 + c) * 8 + eg) * 64 + lane]; accA[eg] = w * xa + accA[eg]; accB[eg] = w * xb + accB[eg]; } }
        float a0[32];
#pragma unroll
        for (int e = 0; e < 32; ++e) a0[e] = accA[e >> 2][e & 3];
        const float lgA = reduce32(a0, lane) + bias_e;
#pragma unroll
        for (int e = 0; e < 32; ++e) a0[e] = accB[e >> 2][e & 3];
        const float lgB = reduce32(a0, lane) + bias_e;
        p7_route(A, lgA, rA, rA - wg_row0, lane, lcnt, ent, RWo);
        if (okB) p7_route(A, lgB, rB, rB - wg_row0, lane, lcnt, ent, RWo);
    }
    __syncthreads();
    if (DRY) return;
    if (tid < 32) lbase[tid] = (int)__hip_atomic_fetch_add((unsigned*)(ws + WS_CTL) + CW_GCNT + (l * 32 + tid) * 16, (unsigned)lcnt[tid], __ATOMIC_RELAXED, __HIP_MEMORY_SCOPE_AGENT);
    __syncthreads();
    { const int nent = NWAVES * RPW * 4; int* RE = (int*)(ws + WS_RE); int* RP = (int*)(ws + WS_RP);
        for (int i = tid; i < nent; i += NWAVES * 64) { const int row = wg_row0 + (i >> 2); if (row < RTOT) { const int v = ent[i], e = v & 255, lp = v >> 8;
            RE[(size_t)row * 4 + (i & 3)] = e; RP[(size_t)row * 4 + (i & 3)] = lbase[e] + lp; } } }
    __syncthreads();
}
__device__ __forceinline__ void moe_offsets(const Args& A, int l, LAS unsigned char* lds, int tid) {
    volatile LAS int* offt = (volatile LAS int*)(lds + OFFT_OFF);
    if (tid < 64) {
        const unsigned c = __hip_atomic_load((unsigned*)(KWS() + WS_CTL) + CW_GCNT + (l * 32 + (tid & 31)) * 16, __ATOMIC_RELAXED, __HIP_MEMORY_SCOPE_AGENT);
        int x = (int)((c + 255u) >> 8);
#pragma unroll
        for (int o = 1; o < 32; o <<= 1) { const int v = __shfl_up(x, o); if ((tid & 31) >= o) x += v; }
        if (tid < 32) offt[tid + 1] = x;
        if (tid == 0) offt[0] = 0;
    }
    __syncthreads();
}
__device__ __forceinline__ void p8(const Args& A, int l, LAS unsigned char* lds, int tid, int lane, int wave) {
    unsigned char* ws = KWS();
    moe_offsets(A, l, lds, tid);
    volatile LAS int* offt = (volatile LAS int*)(lds + OFFT_OFF);
    const int row_lo = (l == DEPTH - 1) ? RCTX : 0, nrows = RTOT - row_lo;
    const int NGW = gridDim.x * NWAVES, RPW = (nrows + NGW - 1) / NGW, w_row0 = row_lo + (opaque_bid() * NWAVES + wave) * RPW;
    const int* RE = (const int*)(ws + WS_RE); const int* RP = (const int*)(ws + WS_RP); const float* RW = (const float*)(ws + WS_RW);
    int* SLOT = (int*)(ws + WS_SLOT); float* ROWW = (float*)(ws + WS_ROWW); const unsigned char* H2 = ws + WS_H2; unsigned char* XS2 = ws + WS_XS2;
    const int nmy = (w_row0 + RPW <= RTOT) ? RPW : ((RTOT > w_row0) ? RTOT - w_row0 : 0);
    int sa = 0, sb = 0; float wa = 0.f, wb = 0.f;
    if (lane < nmy * 4) { const size_t q = (size_t)w_row0 * 4 + lane; sa = offt[RE[q] & 31] * 256 + RP[q]; wa = RW[q]; SLOT[q] = sa; ROWW[sa] = wa; }
    if (64 + lane < nmy * 4) { const size_t q = (size_t)w_row0 * 4 + 64 + lane; sb = offt[RE[q] & 31] * 256 + RP[q]; wb = RW[q]; SLOT[q] = sb; ROWW[sb] = wb; }
    v4u cur = {0u, 0u, 0u, 0u}, nxt;
    if (nmy > 0) cur = *(const v4u*)(H2 + (size_t)w_row0 * DM + 16 * lane);
    for (int i = 0; i < nmy; ++i) {
        const int r = w_row0 + i;
        nxt = *(const v4u*)(H2 + (size_t)((i + 1 < nmy) ? r + 1 : r) * DM + 16 * lane);
#pragma unroll
        for (int k = 0; k < 4; ++k) { const int idx = 4 * i + k; const int slot = (idx < 64) ? __builtin_amdgcn_readlane(sa, idx & 63) : __builtin_amdgcn_readlane(sb, idx & 63);
            *(v4u*)(XS2 + (size_t)slot * DM + 16 * lane) = cur; }
        cur = nxt;
    }
}
__device__ __forceinline__ void moe_order(pg8::MoeOrder& S, LAS unsigned char* lds, int sh) {
    volatile LAS int* offt = (volatile LAS int*)(lds + OFFT_OFF);
#pragma unroll
    for (int j = 0; j < 11; ++j) { unsigned w = 0;
#pragma unroll
        for (int q = 0; q < 3; ++q) { const int k = 3 * j + q + 1; if (k <= 32) w |= ((unsigned)offt[k] & 1023u) << (10 * q); }
        S.pk[j] = (unsigned)__builtin_amdgcn_readfirstlane((int)w); }
    S.nt = __builtin_amdgcn_readfirstlane(offt[32]); S.sh = sh; S.G = gridDim.x; S.c = opaque_bid();
}
struct P11Raw { unsigned y[4][4]; uint2 x[4]; };
__device__ __forceinline__ void p11_load(int r, int lane, int s0, int s1, int s2, int s3, const unsigned char* YB, const bf16* XSA, P11Raw& R) {
    const int sl[4] = {s0, s1, s2, s3};
#pragma unroll
    for (int k = 0; k < 4; ++k) { const unsigned char* p = YB + (size_t)sl[k] * DM;
#pragma unroll
        for (int j = 0; j < 4; ++j) R.y[k][j] = *(const unsigned*)(p + 256 * j + 4 * lane); }
    const bf16* q = XSA + (size_t)r * DM;
#pragma unroll
    for (int j = 0; j < 4; ++j) R.x[j] = *(const uint2*)(q + 256 * j + 4 * lane);
}
template <bool DRY> __device__ __forceinline__ void p11(const Args& A, int l, int lane, int wave) {
    unsigned char* ws = KWS();
    const bool last = (l == DEPTH - 1);
    const int row_lo = last ? RCTX : 0, nrows = RTOT - row_lo;
    const int NGW = gridDim.x * NWAVES, RPW = (nrows + NGW - 1) / NGW, w_row0 = row_lo + (opaque_bid() * NWAVES + wave) * RPW;
    const int* SLOT = (const int*)(ws + WS_SLOT); const unsigned char* YB = ws + WS_YB; bf16* XSA = (bf16*)(ws + WS_XSA); bf16* XH = (bf16*)(ws + WS_XH);
    const float* MODV = (const float*)(ws + WS_MODV); float* outp = DRY ? (float*)(ws + WS_ACT) : KOUT();
    bf16* XSAo = DRY ? (bf16*)(ws + WS_ACT) : XSA; if (DRY) XH = (bf16*)(ws + WS_ACT + 128 * MiB);
    const float* lng = KIN(13) + (size_t)(l * 2 + 1) * DM; const float* lnb = KIN(14) + (size_t)(l * 2 + 1) * DM;
    const int nmy = (w_row0 + RPW <= RTOT) ? RPW : ((RTOT > w_row0) ? RTOT - w_row0 : 0);
    const int sa = (lane < nmy * 4) ? SLOT[(size_t)w_row0 * 4 + lane] : 0, sb = (64 + lane < nmy * 4) ? SLOT[(size_t)w_row0 * 4 + 64 + lane] : 0;
#define P11_SLOT(idx) (((idx) < 64) ? __builtin_amdgcn_readlane(sa, (idx) & 63) : __builtin_amdgcn_readlane(sb, (idx) & 63))
    P11Raw cur, nxt;
    if (nmy > 0) p11_load(w_row0, lane, P11_SLOT(0), P11_SLOT(1), P11_SLOT(2), P11_SLOT(3), YB, XSA, cur);
    for (int i = 0; i < nmy; ++i) {
        const int r = w_row0 + i;
        { const int in = (i + 1 < nmy) ? i + 1 : i, q = 4 * in; p11_load(w_row0 + in, lane, P11_SLOT(q), P11_SLOT(q + 1), P11_SLOT(q + 2), P11_SLOT(q + 3), YB, XSA, nxt); }
        const float* mv = MODV + (size_t)(l * 9 + mod_row(r)) * NMOD;
        f32x4 v[4];
#pragma unroll
        for (int j = 0; j < 4; ++j) {
            f32x4 f = {0.f, 0.f, 0.f, 0.f};
#pragma unroll
            for (int k = 0; k < 4; ++k) { typedef float f32x2_ __attribute__((ext_vector_type(2))); const f32x2_ lo = __builtin_amdgcn_cvt_pk_f32_fp8((int)cur.y[k][j], false), hi = __builtin_amdgcn_cvt_pk_f32_fp8((int)cur.y[k][j], true); f += (f32x4){lo[0], lo[1], hi[0], hi[1]}; }
            const f32x4 x = (f32x4){bflo(cur.x[j].x), bfhi(cur.x[j].x), bflo(cur.x[j].y), bfhi(cur.x[j].y)};
            const f32x4 g2 = *(const f32x4*)(mv + 5 * DM + 256 * j + 4 * lane); v[j] = ALPHA * x + g2 * f; }
        ln_row(v, lng, lnb, lane);
        if (last) store_row_f32(outp + (size_t)(r - RCTX) * DM, lane, v);
        else { store_row_bf16(XSAo + (size_t)r * DM, lane, v);
            const float* mn = MODV + (size_t)((l + 1) * 9 + mod_row(r)) * NMOD; f32x4 o[4]; modulate(v, mn + 1 * DM, mn + 0 * DM, lane, o);
            store_row_bf16(XH + (size_t)r * DM, lane, o); }
        cur = nxt;
    }
#undef P11_SLOT
}

#define GRID_BAR() do { if (N_LAUNCHES == 1) { xcd_barrier(bar); } } while (0)
#define IN(k) (lo <= (k) && (k) < hi)
#define SEAM(k) do { if (IN(k) && IN((k) + 1)) { GRID_BAR(); if (((PROBE_MASK) >> 15) & 1) GRID_BAR(); } } while (0)
#ifndef PROBE_MASK
#define PROBE_MASK 0
#endif
#define REP(p) for (int rep_ = 0; rep_ < (((PROBE_MASK) >> (p)) & 1) + 1; ++rep_)
#define IDS() const int tid = opaque_tid(), lane = tid & 63, wave = __builtin_amdgcn_readfirstlane(tid >> 6); (void)lane; (void)wave
template <int L> __device__ __forceinline__ void layer_phases(const Args& args, LAS unsigned char* lds, unsigned char* lds_raw, const XcdBarrier& bar, int lo, int hi) {
        constexpr int l = L;
        const int pb = N_PRO + l * N_PER_LAYER; const bool last = (l == DEPTH - 1);
        if (IN(pb + 0)) REP(0) { unsigned char* ws = KWS();
            pg8::Gemm g{(const bf16*)(ws + WS_XH), (const bf16*)(ws + WS_WIN) + (size_t)l * INW * DM, RTOT, INW, DM}; pg8::StaticOrder S; S.init(RTOT, INW, (int)gridDim.x, opaque_bid());
            pg8::EpiBf16 E{(bf16*)(ws + WS_Z), INW};
            pg8::gemm_phase<pg8::EpiBf16, pg8::StaticOrder, true, true>(lds + RING_OFF, g, S, E);
        } SEAM(pb + 0);
        if (IN(pb + 1)) REP(1) { IDS(); p2(args, l, lds, tid, lane, wave); } SEAM(pb + 1);
        if (IN(pb + 2)) REP(2) { IDS(); p4_scan(args, l, tid); p4_attention(args, l, (char*)lds_raw + RING_OFF); } SEAM(pb + 2);
        if (IN(pb + 3)) REP(3) { IDS(); p5(args, l, lds, tid, lane, wave); } SEAM(pb + 3);
        if (IN(pb + 4)) REP(4) { unsigned char* ws = KWS();
            const int r0 = last ? RCTX : 0, M = RTOT - r0;
            pg8::Gemm g{(const bf16*)(ws + WS_MIX) + (size_t)r0 * DM, (const bf16*)(ws + WS_WOUT) + (size_t)l * DM * DM, M, DM, DM}; pg8::StaticOrder S; S.init(M, DM, (int)gridDim.x, opaque_bid());
            pg8::EpiBf16 E{(bf16*)(ws + WS_Y) + (size_t)r0 * DM, DM};
            pg8::gemm_phase<pg8::EpiBf16, pg8::StaticOrder, true, true>(lds + RING_OFF, g, S, E);
        } SEAM(pb + 4);
        if (IN(pb + 5)) { IDS(); if (((PROBE_MASK) >> 13) & 1) p7<true>(args, l, lds, tid, lane, wave); p7<false>(args, l, lds, tid, lane, wave); } SEAM(pb + 5);
        if (IN(pb + 6)) REP(6) { IDS(); p8(args, l, lds, tid, lane, wave); } SEAM(pb + 6);
        if (IN(pb + 7)) REP(7) { IDS(); unsigned char* ws = KWS();
            moe_offsets(args, l, lds, tid);
            pg8::MoeOrder S; moe_order(S, lds, 3);
            pg8::Gemm g{(const bf16*)(ws + WS_XS2), (const bf16*)(ws + WS_WGU + (size_t)l * NEXP * 2048 * DM), MAXTILES * 256, NEXP * 2048, DM / 2};
            pg8::EpiSwiglu E{ws + WS_ACT, KIN(18) + (size_t)l * NEXP * 2048};
            pg8::gemm_phase<pg8::EpiSwiglu, pg8::MoeOrder, true, true, true>(lds + RING_OFF, g, S, E);
        } SEAM(pb + 7);
        if (IN(pb + 8)) REP(8) { IDS(); unsigned char* ws = KWS();
            moe_offsets(args, l, lds, tid);
            pg8::MoeOrder S; moe_order(S, lds, 2);
            pg8::Gemm g{(const bf16*)(ws + WS_ACT), (const bf16*)(ws + WS_WD + (size_t)l * NEXP * DM * DM), MAXTILES * 256, NEXP * DM, DM / 2};
            pg8::EpiDown E{ws + WS_YB, KIN(20) + (size_t)l * NEXP * DM, (const float*)(ws + WS_ROWW)};
            pg8::gemm_phase<pg8::EpiDown, pg8::MoeOrder, true, true, true>(lds + RING_OFF, g, S, E);
        } SEAM(pb + 8);
        if (IN(pb + 9)) { IDS(); if (((PROBE_MASK) >> 14) & 1) p11<true>(args, l, lane, wave); p11<false>(args, l, lane, wave); } SEAM(pb + 9);
}

__global__ void __launch_bounds__(NWAVES * 64, 2) mk_fwd(Args args) {
    extern __shared__ __attribute__((aligned(16))) unsigned char lds_raw[];
    LAS unsigned char* lds = (LAS unsigned char*)lds_raw;
    volatile LAS unsigned* MISC = (volatile LAS unsigned*)(lds + MISC_OFF);
    gu32* ctl = (gu32*)(KWS() + WS_CTL);
    for (int u = threadIdx.x; u < (LDS_BYTES - LDSCTL_OFF) / 4; u += NWAVES * 64) ((LAS unsigned*)(lds + LDSCTL_OFF))[u] = 0u;
    __syncthreads();
    XcdBarrier bar; bar.bar = (unsigned*)(ctl + CW_BAR); bar.x = 0; bar.st = nullptr;
    if (N_LAUNCHES == 1) bar = xcd_barrier_post((unsigned*)(ctl + CW_BAR), MISC + 8);
    const int lo = args.ph_lo, hi = args.ph_hi;

    if (IN(0)) REP(10) { IDS(); p0a(args, lds, tid, lane, wave); } SEAM(0);
    if (IN(1)) REP(11) { IDS(); p0b(args, tid); } SEAM(1);
    if (IN(2)) REP(12) { IDS(); p0c(args, lane, wave); } SEAM(2);

    layer_phases<0>(args, lds, lds_raw, bar, lo, hi);
    layer_phases<1>(args, lds, lds_raw, bar, lo, hi);
    static_assert(DEPTH == 2, "two layer instances");
}
#undef IN
#undef IDS
#undef SEAM
#undef GRID_BAR

extern "C" void kernel_launch(void* const* d_in, const int* in_sizes, int n_in, void* d_out, int out_size, void* d_ws, size_t ws_size, hipStream_t stream) {
    static int grid = 0;
    if (grid == 0) {
        if (n_in != 21 || in_sizes[0] != RLAT * DM || out_size != RLAT * DM || ws_size < WS_END) { fprintf(stderr, "kernel_launch: unexpected shapes / workspace (n_in %d, ws %zu < %zu); nothing launched\n", n_in, ws_size, (size_t)WS_END); grid = -1; return; }
        int dev = 0, cus = 0, per_cu = 0;
        if (hipGetDevice(&dev) != hipSuccess || hipDeviceGetAttribute(&cus, hipDeviceAttributeMultiprocessorCount, dev) != hipSuccess) { grid = -1; return; }
        if (hipFuncSetAttribute((const void*)mk_fwd, hipFuncAttributeMaxDynamicSharedMemorySize, LDS_BYTES) != hipSuccess) { fprintf(stderr, "kernel_launch: hipFuncSetAttribute failed\n"); grid = -1; return; }
        if (hipOccupancyMaxActiveBlocksPerMultiprocessor(&per_cu, (const void*)mk_fwd, NWAVES * 64, LDS_BYTES) != hipSuccess || per_cu < 1) fprintf(stderr, "kernel_launch: occupancy query reports %d\n", per_cu);
        (void)hipGetLastError();
        grid = cus;
        if (grid != 256) { fprintf(stderr, "kernel_launch: built for 256 CUs, found %d; nothing launched\n", grid); grid = -1; return; }
    }
    if (grid < 0) return;
    if (hipMemsetAsync((char*)d_ws + WS_CTL, 0, CTL_ZERO_BYTES, stream) != hipSuccess) return;
    Args a{};
    for (int i = 0; i < 21; ++i) a.in[i] = (const float*)d_in[i];
    a.out = (float*)d_out; a.ws = (unsigned char*)d_ws; a.pad = 0;
    for (int li = 0; li < N_LAUNCHES; ++li) {
        a.ph_lo = (N_LAUNCHES == 1) ? 0 : li; a.ph_hi = (N_LAUNCHES == 1) ? N_PHASES : li + 1; a.li = li;
        hipLaunchKernelGGL(mk_fwd, dim3(grid), dim3(NWAVES * 64), LDS_BYTES, stream, a);
        const hipError_t le = hipPeekAtLastError();
        if (le != hipSuccess) { fprintf(stderr, "kernel_launch: launch %d failed: %s\n", li, hipGetErrorName(le)); break; }
    }
}
```

```cpp
#include <hip/hip_runtime.h>
#include <cstdio>
#include <cstdint>
__device__ __forceinline__ int opaque_tid() { int t = (int)threadIdx.x; asm volatile("" : "+v"(t)); return t; }
__device__ __forceinline__ int opaque_bid() { int b = (int)blockIdx.x; asm volatile("" : "+s"(b)); return b; }
namespace pg8 {
#define PG8_LAS __attribute__((address_space(3)))
typedef unsigned short bf16_t;
typedef short bf16x8 __attribute__((ext_vector_type(8)));
typedef float f32x4 __attribute__((ext_vector_type(4)));
typedef unsigned u32x4 __attribute__((ext_vector_type(4)));
constexpr int BM = 256, BK = 64, HALF = 128, HTB = HALF * BK * 2  , STAGE_BYTES = 8 * HTB, NXCD = 8, WGM = 8;

__host__ __device__ __forceinline__ int lds_byte(int r, int c) { const int st = (r >> 4) * 2 + (c >> 5), rr = r & 15, cc = c & 31, ob = rr * 64 + cc * 2; return st * 1024 + (ob ^ (((ob >> 9) & 1) << 5)); }
__host__ __device__ __forceinline__ void stage_rc(int b, int& R, int& C) { const int st = b / 1024, sb = b % 1024, swz = sb ^ (((sb >> 9) & 1) << 5); R = (st >> 1) * 16 + swz / 64; C = (st & 1) * 32 + (swz % 64) / 2; }
__host__ __device__ __forceinline__ int perm32(int rho) { const int n = rho >> 4, i = rho & 15; return 8 * (i >> 2) + 4 * n + (i & 3); }

struct Unit { int pm, pn; };
struct Gemm { const bf16_t* A; const bf16_t* Bt; int M, N, K; };

struct StaticOrder {
    int nM, nN, nwg, G, c;
    __host__ __device__ void init(int M, int N, int G_, int c_) { nM = M / BM; nN = N / BM; nwg = nM * nN; G = G_; c = c_; }
    __host__ __device__ bool next(int i, Unit& u) const {
        const long L = (long)i * G + c; if (L >= nwg) return false;
        int wgid = (int)L; { const int q = nwg / NXCD, r = nwg % NXCD, xcd = wgid % NXCD, off = wgid / NXCD; wgid = (xcd < r ? xcd * (q + 1) : r * (q + 1) + (xcd - r) * q) + off; }
        const int nig = WGM * nN, gid = wgid / nig, fm = gid * WGM, gsz = (nM - fm) < WGM ? (nM - fm) : WGM;
        u.pm = fm + ((wgid % nig) % gsz); u.pn = (wgid % nig) / gsz; return true;
    }
    __device__ __forceinline__ void a_ready(const Unit&) const {}
    __device__ __forceinline__ void done(const Unit&) const {}
};

__device__ __forceinline__ unsigned cvt_pk_bf16(float lo, float hi) { unsigned r; asm volatile("v_cvt_pk_bf16_f32 %0, %1, %2" : "=v"(r) : "v"(lo), "v"(hi)); return r; }
typedef float f32x2 __attribute__((ext_vector_type(2)));
struct EpiBf16 {
    static constexpr bool PERM = true, AFTER_DRAIN = false;
    bf16_t* O; int ldc;
    __device__ __forceinline__ void init(f32x4 (&acc)[2][2][4][2], const Unit&, int, int) const {
#pragma unroll
        for (int a = 0; a < 2; ++a)
#pragma unroll
            for (int b = 0; b < 2; ++b)
#pragma unroll
                for (int m = 0; m < 4; ++m)
#pragma unroll
                    for (int n = 0; n < 2; ++n) acc[a][b][m][n] = (f32x4){0.f, 0.f, 0.f, 0.f};
    }
    __device__ __forceinline__ void operator()(const f32x4 (&acc)[2][2][4][2], const Unit& u, int wr, int wc, int fr, int fq) const {
        const int row0 = u.pm * BM + wr * 64 + fr; const int col0 = u.pn * BM + wc * 32 + 8 * fq;
#pragma unroll
        for (int ai = 0; ai < 2; ++ai)
#pragma unroll
            for (int m = 0; m < 4; ++m) { bf16_t* rowp = O + (size_t)(row0 + ai * HALF + m * 16) * ldc + col0;
#pragma unroll
                for (int bj = 0; bj < 2; ++bj) { const f32x4 v0 = acc[ai][bj][m][0], v1 = acc[ai][bj][m][1];
                    u32x4 w; w.x = cvt_pk_bf16(v0[0], v0[1]); w.y = cvt_pk_bf16(v0[2], v0[3]); w.z = cvt_pk_bf16(v1[0], v1[1]); w.w = cvt_pk_bf16(v1[2], v1[3]);
                    *(u32x4*)(rowp + bj * HALF) = w; } }
    }
};
struct EpiSwiglu {
    static constexpr bool PERM = true, AFTER_DRAIN = false;
    unsigned char* O; const float* bias;
    static __device__ __forceinline__ f32x2 act2(f32x2 g, f32x2 up) {
        g = __builtin_elementwise_min(g, (f32x2){7.0f, 7.0f}); up = __builtin_elementwise_min(__builtin_elementwise_max(up, (f32x2){-7.0f, -7.0f}), (f32x2){7.0f, 7.0f});
        const f32x2 z = g * (-1.702f * 1.4426950408889634f); f32x2 d; d.x = __builtin_amdgcn_exp2f(z.x); d.y = __builtin_amdgcn_exp2f(z.y); d = d + 1.0f;
        f32x2 s; s.x = __builtin_amdgcn_rcpf(d.x); s.y = __builtin_amdgcn_rcpf(d.y);
        return (up + 1.0f) * (g * s);
    }
    __device__ __forceinline__ void init(f32x4 (&acc)[2][2][4][2], const Unit& u, int wc, int fq) const {
        const int e = u.pn >> 3, pnl = u.pn & 7; const int j0 = pnl * HALF + wc * 32 + 8 * fq;
        const float* bg = bias + (size_t)e * 2048 + j0; const float* bu = bg + 1024;
#pragma unroll
        for (int n = 0; n < 2; ++n) { const f32x4 g = *(const f32x4*)(bg + 4 * n) * 32.0f, up = *(const f32x4*)(bu + 4 * n) * 32.0f;
#pragma unroll
            for (int a = 0; a < 2; ++a)
#pragma unroll
                for (int m = 0; m < 4; ++m) { acc[a][0][m][n] = g; acc[a][1][m][n] = up; } }
    }
    __device__ __forceinline__ void operator()(const f32x4 (&acc)[2][2][4][2], const Unit& u, int wr, int wc, int fr, int fq) const {
        const int pnl = u.pn & 7;
        const int row0 = u.pm * BM + wr * 64 + fr; const int j0 = pnl * HALF + wc * 32 + 8 * fq;
#pragma unroll
        for (int ai = 0; ai < 2; ++ai)
#pragma unroll
            for (int m = 0; m < 4; ++m) { unsigned char* rowp = O + (size_t)(row0 + ai * HALF + m * 16) * 1024 + j0;
                typedef unsigned u32x2 __attribute__((ext_vector_type(2))); u32x2 w;
#pragma unroll
                for (int n = 0; n < 2; ++n) { const f32x4 g = acc[ai][0][m][n] * 0.03125f, up = acc[ai][1][m][n] * 0.03125f;
                    const f32x2 r0 = act2((f32x2){g[0], g[1]}, (f32x2){up[0], up[1]}), r1 = act2((f32x2){g[2], g[3]}, (f32x2){up[2], up[3]});
                    const unsigned pk = (unsigned)__builtin_amdgcn_cvt_pk_fp8_f32(r1.x, r1.y, __builtin_amdgcn_cvt_pk_fp8_f32(r0.x, r0.y, 0, false), true);
                    if (n == 0) w.x = pk; else w.y = pk; }
                *(u32x2*)rowp = w; }
    }
};
struct EpiDown {
    static constexpr bool PERM = true, AFTER_DRAIN = false;
    unsigned char* O; const float* bias;
    __device__ __forceinline__ void init(f32x4 (&acc)[2][2][4][2], const Unit& u, int wc, int fq) const {
        const int e = u.pn >> 2, pnl = u.pn & 3; const float* bp = bias + (size_t)e * 1024 + pnl * BM + wc * 32 + 8 * fq;
#pragma unroll
        for (int bj = 0; bj < 2; ++bj)
#pragma unroll
            for (int n = 0; n < 2; ++n) { const f32x4 b = *(const f32x4*)(bp + bj * HALF + 4 * n) * 64.0f;
#pragma unroll
                for (int a = 0; a < 2; ++a)
#pragma unroll
                    for (int m = 0; m < 4; ++m) acc[a][bj][m][n] = b; }
    }
    __device__ __forceinline__ void operator()(const f32x4 (&acc)[2][2][4][2], const Unit& u, int wr, int wc, int fr, int fq) const {
        const int pnl = u.pn & 3;
        const int row0 = u.pm * BM + wr * 64 + fr; const int col0 = pnl * BM + wc * 32 + 8 * fq;
#pragma unroll
        for (int ai = 0; ai < 2; ++ai)
#pragma unroll
            for (int m = 0; m < 4; ++m) { unsigned char* rowp = O + (size_t)(row0 + ai * HALF + m * 16) * 1024 + col0;
#pragma unroll
                for (int bj = 0; bj < 2; ++bj) { const f32x4 v0 = acc[ai][bj][m][0] * 0.015625f, v1 = acc[ai][bj][m][1] * 0.015625f;
                    typedef unsigned u32x2 __attribute__((ext_vector_type(2))); u32x2 w;
                    w.x = (unsigned)__builtin_amdgcn_cvt_pk_fp8_f32(v0[2], v0[3], __builtin_amdgcn_cvt_pk_fp8_f32(v0[0], v0[1], 0, false), true);
                    w.y = (unsigned)__builtin_amdgcn_cvt_pk_fp8_f32(v1[2], v1[3], __builtin_amdgcn_cvt_pk_fp8_f32(v1[0], v1[1], 0, false), true);
                    *(u32x2*)(rowp + bj * HALF) = w; } }
    }
};
struct MoeOrder {
    unsigned pk[11]; int nt, sh, G, c;
    __device__ __forceinline__ bool next(int i, Unit& u) const {
        const int x = c & 7, m = c >> 3, per = G >> 3;
        const int t0 = (nt * x) >> 3, t1 = (nt * (x + 1)) >> 3;
        const int v = m + i * per, tile = t0 + (v >> sh), pnl = v & ((1 << sh) - 1);
        if (tile >= t1) return false;
        int e = 0;
#pragma unroll
        for (int k = 1; k < 32; ++k) { const int off = (int)((pk[(k - 1) / 3] >> (10 * ((k - 1) % 3))) & 1023u); e += (off <= tile) ? 1 : 0; }
        u.pm = __builtin_amdgcn_readfirstlane(tile); u.pn = __builtin_amdgcn_readfirstlane((e << sh) + pnl); return true;
    }
    __device__ __forceinline__ void a_ready(const Unit&) const {}
    __device__ __forceinline__ void done(const Unit&) const {}
};

template <class Epi, class Sched, bool ALIGN_EPI = false, bool SP2 = false, bool F8 = false>
__device__ __forceinline__ void gemm_phase(PG8_LAS unsigned char* lds, const Gemm g, const Sched& S, const Epi& E) {
    const int tid = opaque_tid(), wid = __builtin_amdgcn_readfirstlane(tid >> 6), lane = tid & 63, wr = wid >> 2, wc = wid & 3, fr = lane & 15, fq = lane >> 4;
    const int K = g.K, nt = K / BK;
    unsigned voffA[2], voffB[2];
#pragma unroll
    for (int i = 0; i < 2; ++i) { int R, C; stage_rc(tid * 16 + i * 8192, R, C); const int Rb = Epi::PERM ? ((R & ~31) + perm32(R & 31)) : R;
        voffA[i] = (unsigned)(R * K + C) * 2u; voffB[i] = (unsigned)(Rb * K + C) * 2u; }
    const size_t kstep = (size_t)(BK * 2);
    const size_t hstep = (size_t)HALF * K * 2;
    const size_t tstep = 2 * hstep;
    const unsigned ldsw = (unsigned)wid * 1024u;
    const int aoff = lds_byte(wr * 64 + fr, fq * 8), boff = lds_byte(wc * 32 + fr, fq * 8);
#define PG8_SA(b, h) (((b) * 2 + (h)) * HTB)
#define PG8_SB(b, h) ((4 + (b) * 2 + (h)) * HTB)
#define PG8_STAGE(bufoff, gbase, voff) do { _Pragma("unroll") for (int _i = 0; _i < 2; ++_i) { unsigned vo_ = (voff)[_i]; asm volatile("" : "+v"(vo_));     \
        __builtin_amdgcn_global_load_lds((const unsigned*)((const char*)(gbase) + vo_), (PG8_LAS unsigned*)(lds + (bufoff) + ldsw + _i * 8192), 16, 0, 0); } } while (0)
#define PG8_LDA(dst, b, h) do { _Pragma("unroll") for (int m = 0; m < 4; ++m) { if constexpr (F8) { \
            const i32x4_t lo_ = *(const PG8_LAS i32x4_t*)(lds + PG8_SA(b, h) + aoff + m * 2048), hi_ = *(const PG8_LAS i32x4_t*)(lds + PG8_SA(b, h) + aoff + m * 2048 + 1024); \
            dst##8[m] = __builtin_shufflevector(lo_, hi_, 0, 1, 2, 3, 4, 5, 6, 7); \
        } else { _Pragma("unroll") for (int k = 0; k < 2; ++k) dst[m][k] = *(const PG8_LAS bf16x8*)(lds + PG8_SA(b, h) + aoff + m * 2048 + k * 1024); } } } while (0)
#define PG8_LDB(dst, b, h) do { _Pragma("unroll") for (int n = 0; n < 2; ++n) { if constexpr (F8) { \
            const i32x4_t lo_ = *(const PG8_LAS i32x4_t*)(lds + PG8_SB(b, h) + boff + n * 2048), hi_ = *(const PG8_LAS i32x4_t*)(lds + PG8_SB(b, h) + boff + n * 2048 + 1024); \
            dst##8[n] = __builtin_shufflevector(lo_, hi_, 0, 1, 2, 3, 4, 5, 6, 7); \
        } else { _Pragma("unroll") for (int k = 0; k < 2; ++k) dst[n][k] = *(const PG8_LAS bf16x8*)(lds + PG8_SB(b, h) + boff + n * 2048 + k * 1024); } } } while (0)
#define PG8_MMA(ai, bj, At, Bt) do { __builtin_amdgcn_s_setprio(1); _Pragma("unroll") for (int m = 0; m < 4; ++m) _Pragma("unroll") for (int n = 0; n < 2; ++n) { \
        if constexpr (F8) {   \
            acc[ai][bj][m][n] = __builtin_amdgcn_mfma_scale_f32_16x16x128_f8f6f4(Bt##8[n], At##8[m], acc[ai][bj][m][n], 0, 0, 0, 0, 0, 0); \
        } else { _Pragma("unroll") for (int k = 0; k < 2; ++k) acc[ai][bj][m][n] = __builtin_amdgcn_mfma_f32_16x16x32_bf16(Bt[n][k], At[m][k], acc[ai][bj][m][n], 0, 0, 0); } } \
        __builtin_amdgcn_s_setprio(0); } while (0)
#define PG8_WAIT_V(n) asm volatile("s_waitcnt vmcnt(" #n ")" ::: "memory")
#define PG8_WAIT_L(n) asm volatile("s_waitcnt lgkmcnt(" #n ")" ::: "memory")
#define PG8_BAR __builtin_amdgcn_s_barrier()
#define PG8_SCHED __builtin_amdgcn_sched_barrier(0)
    Unit cur, nxt; int ui = 0;
    if (!S.next(0, cur)) return;
    f32x4 acc[2][2][4][2];
    E.init(acc, cur, wc, fq);
    typedef int i32x4_t __attribute__((ext_vector_type(4))); typedef int i32x8_t __attribute__((ext_vector_type(8)));
    bf16x8 At[4][2], B0[2][2], B1[2][2];
    i32x8_t At8[4], B08[2], B18[2];
    const char* cA = (const char*)g.A + (size_t)cur.pm * tstep; const char* cB = (const char*)g.Bt + (size_t)cur.pn * tstep;
    S.a_ready(cur);
    if constexpr (SP2) {
        PG8_STAGE(PG8_SB(0, 0), cB, voffB); PG8_STAGE(PG8_SB(0, 1), cB + hstep, voffB); PG8_STAGE(PG8_SA(0, 0), cA, voffA); PG8_STAGE(PG8_SA(0, 1), cA + hstep, voffA);
        if (wr == 1) PG8_BAR;
        PG8_WAIT_V(2); PG8_BAR;
        PG8_STAGE(PG8_SB(1, 0), cB + kstep, voffB); PG8_STAGE(PG8_SA(1, 0), cA + kstep, voffA); PG8_STAGE(PG8_SB(1, 1), cB + hstep + kstep, voffB);
        PG8_WAIT_V(6); PG8_BAR;
    } else {
        PG8_STAGE(PG8_SB(0, 0), cB, voffB); PG8_STAGE(PG8_SA(0, 0), cA, voffA); PG8_STAGE(PG8_SB(0, 1), cB + hstep, voffB); PG8_STAGE(PG8_SA(0, 1), cA + hstep, voffA);
        if (wr == 1) PG8_BAR;
        PG8_WAIT_V(4); PG8_BAR;
        PG8_STAGE(PG8_SB(1, 0), cB + kstep, voffB); PG8_STAGE(PG8_SA(1, 0), cA + kstep, voffA); PG8_STAGE(PG8_SB(1, 1), cB + hstep + kstep, voffB);
        PG8_WAIT_V(6); PG8_BAR;
    }
    for (;;) {
        const bool has_next = S.next(ui + 1, nxt);
        const char* nA = has_next ? (const char*)g.A + (size_t)nxt.pm * tstep : cA; const char* nB = has_next ? (const char*)g.Bt + (size_t)nxt.pn * tstep : cB;
#pragma unroll 1
        for (int t = 0; t < nt; t += 2) {
            const bool last = (t == nt - 2);
            const char* a1 = cA + (size_t)(t + 1) * kstep;
            const char* a2 = last ? nA : cA + (size_t)(t + 2) * kstep; const char* b2 = last ? nB : cB + (size_t)(t + 2) * kstep;
            const char* a3 = a2 + kstep; const char* b3 = b2 + kstep;
            const char* a1h = a1 + hstep; const char* a2h = a2 + hstep; const char* b2h = b2 + hstep; const char* a3h = a3 + hstep; const char* b3h = b3 + hstep;
            asm volatile("" : "+s"(a1h), "+s"(a2), "+s"(a2h), "+s"(b2), "+s"(b2h), "+s"(a3), "+s"(a3h), "+s"(b3), "+s"(b3h));
            if (last && has_next) S.a_ready(nxt);
            if constexpr (SP2) {
            PG8_LDB(B0, 0, 0); PG8_LDB(B1, 0, 1); PG8_SCHED; PG8_LDA(At, 0, 0); PG8_STAGE(PG8_SA(1, 1), a1h, voffA);
            PG8_WAIT_V(8); PG8_WAIT_L(0); PG8_BAR; PG8_MMA(0, 0, At, B0); PG8_MMA(0, 1, At, B1); PG8_BAR; PG8_SCHED;
            PG8_LDA(At, 0, 1); PG8_STAGE(PG8_SB(0, 0), b2, voffB); PG8_STAGE(PG8_SB(0, 1), b2h, voffB); PG8_STAGE(PG8_SA(0, 0), a2, voffA);
            PG8_WAIT_V(8); PG8_WAIT_L(0); PG8_BAR; PG8_MMA(1, 0, At, B0); PG8_MMA(1, 1, At, B1); PG8_BAR; PG8_SCHED;
            PG8_LDB(B0, 1, 0); PG8_LDB(B1, 1, 1); PG8_SCHED; PG8_LDA(At, 1, 0); PG8_STAGE(PG8_SA(0, 1), a2h, voffA);
            PG8_WAIT_V(8); PG8_WAIT_L(0); PG8_BAR; PG8_MMA(0, 0, At, B0); PG8_MMA(0, 1, At, B1); PG8_BAR; PG8_SCHED;
            PG8_LDA(At, 1, 1); PG8_STAGE(PG8_SB(1, 0), b3, voffB); PG8_STAGE(PG8_SB(1, 1), b3h, voffB); PG8_STAGE(PG8_SA(1, 0), a3, voffA);
            PG8_WAIT_V(8); PG8_WAIT_L(0); PG8_BAR; PG8_MMA(1, 0, At, B0); PG8_MMA(1, 1, At, B1); PG8_BAR; PG8_SCHED;
            } else {
            PG8_LDB(B0, 0, 0); PG8_SCHED; PG8_LDA(At, 0, 0); PG8_STAGE(PG8_SA(1, 1), a1h, voffA);
            PG8_WAIT_L(8); PG8_BAR; PG8_WAIT_L(0); PG8_MMA(0, 0, At, B0); PG8_BAR; PG8_SCHED;
            PG8_LDB(B1, 0, 1); PG8_STAGE(PG8_SB(0, 0), b2, voffB);
            PG8_BAR; PG8_WAIT_L(0); PG8_MMA(0, 1, At, B1); PG8_BAR;
            PG8_LDA(At, 0, 1); PG8_STAGE(PG8_SA(0, 0), a2, voffA);
            PG8_BAR; PG8_WAIT_L(0); PG8_MMA(1, 0, At, B0); PG8_BAR; PG8_SCHED;
            PG8_STAGE(PG8_SB(0, 1), b2h, voffB);
            PG8_WAIT_V(6); PG8_BAR; PG8_MMA(1, 1, At, B1); PG8_BAR;
            PG8_LDB(B0, 1, 0); PG8_SCHED; PG8_LDA(At, 1, 0); PG8_STAGE(PG8_SA(0, 1), a2h, voffA);
            PG8_WAIT_L(8); PG8_BAR; PG8_WAIT_L(0); PG8_MMA(0, 0, At, B0); PG8_BAR; PG8_SCHED;
            PG8_LDB(B1, 1, 1); PG8_STAGE(PG8_SB(1, 0), b3, voffB);
            PG8_BAR; PG8_WAIT_L(0); PG8_MMA(0, 1, At, B1); PG8_BAR;
            PG8_LDA(At, 1, 1); PG8_STAGE(PG8_SA(1, 0), a3, voffA);
            PG8_BAR; PG8_WAIT_L(0); PG8_MMA(1, 0, At, B0); PG8_BAR; PG8_SCHED;
            PG8_STAGE(PG8_SB(1, 1), b3h, voffB);
            PG8_WAIT_V(6); PG8_BAR; PG8_MMA(1, 1, At, B1); PG8_BAR;
            }
        }
        if constexpr (ALIGN_EPI) { if (wr == 0) PG8_BAR; }
        if constexpr (!Epi::AFTER_DRAIN) { unsigned ones_ = ~0u; asm volatile("" : "+s"(ones_)); const int ln_ = (int)__builtin_amdgcn_mbcnt_hi(ones_, __builtin_amdgcn_mbcnt_lo(ones_, 0u)); const int fr_ = ln_ & 15, fq_ = ln_ >> 4;
            E(acc, cur, wr, wc, fr_, fq_);
#if defined(PROBE_MASK)
            if constexpr ((F8 && (((PROBE_MASK) >> 18) & 1)) || (!F8 && (((PROBE_MASK) >> 19) & 1))) { asm volatile("" ::: "memory"); E(acc, cur, wr, wc, fr_, fq_); }
#endif
            S.done(cur); }
        if (!has_next) break;
        cur = nxt; cA = nA; cB = nB; ++ui;
        E.init(acc, cur, wc, fq);
        if constexpr (ALIGN_EPI) { if (wr == 1) PG8_BAR; }
    }
    PG8_WAIT_V(0);
    if constexpr (!ALIGN_EPI) { if (wr == 0) PG8_BAR; }
    PG8_BAR;
    if constexpr (Epi::AFTER_DRAIN) { E.fused(acc, cur, wr, wc, fr, fq, lds, wid, lane); S.done(cur); }
#undef PG8_SA
#undef PG8_SB
#undef PG8_STAGE
#undef PG8_LDA
#undef PG8_LDB
#undef PG8_MMA
#undef PG8_WAIT_V
#undef PG8_WAIT_L
#undef PG8_BAR
#undef PG8_SCHED
}
}

#include <hip/hip_bf16.h>
#include <cmath>
namespace attn_body {
using bf16=__hip_bfloat16;
using bf16x8=__attribute__((ext_vector_type(8)))short;
using s16x4=__attribute__((ext_vector_type(4)))short;
using f32x16=__attribute__((ext_vector_type(16)))float;
using u32x4=__attribute__((ext_vector_type(4)))unsigned;
constexpr int D=64,QP=512,KP=64,OP=1024;
constexpr int NW=8,QBLK=32,QB=QBLK*NW,KVBLK=64;
constexpr int ATTN_UNIT_ROWS=QB;
__device__ __forceinline__ int crow(int r,int hi){return (r&3)+8*(r>>2)+4*hi;}
#define SBAR() __builtin_amdgcn_sched_barrier(0)
__device__ __forceinline__ void cmask(f32x16&p0,f32x16&p1,int jb,int qrel,int hi){
  const float NEG=-INFINITY; int kb=64*jb+4*hi;
  #pragma unroll
  for(int r=0;r<16;++r){int kv=kb+(r&3)+8*(r>>2); if(kv>qrel)p0[r]=NEG; if(kv+32>qrel)p1[r]=NEG;}
}

constexpr int NSLOT=3, SLOTB=8192;
constexpr int LDS_K=0, LDS_V=NSLOT*SLOTB, LDS_WS=2*NSLOT*SLOTB, LDS_OST=LDS_WS+NW*64*4, LDS_BYTES=LDS_OST+NW*4096;
constexpr float C2=0.125f*1.4426950408889634f;
__device__ __forceinline__ void glds16(const void*gsrc,unsigned lds_dst){unsigned keep;
  asm volatile("s_mov_b32 %0, m0\n\ts_mov_b32 m0, %2\n\ts_nop 0\n\tglobal_load_lds_dwordx4 %1, off\n\ts_mov_b32 m0, %0":"=&s"(keep):"v"(gsrc),"s"(lds_dst):"memory");}
__device__ __forceinline__ float max3f(float a,float b,float c){float r;asm("v_max3_f32 %0, %1, %2, %3":"=v"(r):"v"(a),"v"(b),"v"(c));return r;}
__device__ __forceinline__ float max2f(float a,float b){float r;asm("v_max_f32_e32 %0, %1, %2":"=v"(r):"v"(a),"v"(b));return r;}
__device__ __forceinline__ float fadd_s(float a,float b){float r;asm("v_add_f32_e32 %0, %1, %2":"=v"(r):"v"(a),"v"(b));return r;}
__device__ __forceinline__ float fsub_s(float a,float b){float r;asm("v_sub_f32_e32 %0, %1, %2":"=v"(r):"v"(a),"v"(b));return r;}
typedef float f32x2_t __attribute__((ext_vector_type(2))); typedef __bf16 bf16x2_t __attribute__((ext_vector_type(2)));
__device__ __forceinline__ unsigned cvtpk_s(float lo,float hi){f32x2_t v={lo,hi};bf16x2_t b=__builtin_convertvector(v,bf16x2_t);return __builtin_bit_cast(unsigned,b);}
#define WAIT_BAR(N) asm volatile("s_waitcnt vmcnt(" #N ") lgkmcnt(0)\n\ts_barrier":::"memory")

__device__ __forceinline__ void qkt(f32x16&p0,f32x16&p1,const char*Kslot,const bf16x8*qr,const f32x16&negm,int r32,int hi){
  const char*kb=Kslot+hi*1024+r32*16;
  #pragma unroll
  for(int d0=0;d0<4;++d0){
    const bf16x8 b0=*reinterpret_cast<const bf16x8*>(kb+d0*2048);
    const bf16x8 b1=*reinterpret_cast<const bf16x8*>(kb+d0*2048+512);
    if(d0==0){p0=__builtin_amdgcn_mfma_f32_32x32x16_bf16(b0,qr[0],negm,0,0,0);p1=__builtin_amdgcn_mfma_f32_32x32x16_bf16(b1,qr[0],negm,0,0,0);}
    else{p0=__builtin_amdgcn_mfma_f32_32x32x16_bf16(b0,qr[d0],p0,0,0,0);p1=__builtin_amdgcn_mfma_f32_32x32x16_bf16(b1,qr[d0],p1,0,0,0);}}
}
typedef __attribute__((address_space(3))) const char* lds_cptr;
typedef short v4i16_t __attribute__((ext_vector_type(4)));
__device__ __forceinline__ void kload8(bf16x8*kf,lds_cptr kp){
  kf[0]=*(const __attribute__((address_space(3))) bf16x8*)(kp);      kf[1]=*(const __attribute__((address_space(3))) bf16x8*)(kp+512);
  kf[2]=*(const __attribute__((address_space(3))) bf16x8*)(kp+2048); kf[3]=*(const __attribute__((address_space(3))) bf16x8*)(kp+2560);
  kf[4]=*(const __attribute__((address_space(3))) bf16x8*)(kp+4096); kf[5]=*(const __attribute__((address_space(3))) bf16x8*)(kp+4608);
  kf[6]=*(const __attribute__((address_space(3))) bf16x8*)(kp+6144); kf[7]=*(const __attribute__((address_space(3))) bf16x8*)(kp+6656);
}
__device__ __forceinline__ void kload2(bf16x8*kf,lds_cptr kp,int j){ kf[2*j]=*(const __attribute__((address_space(3))) bf16x8*)(kp+j*2048); kf[2*j+1]=*(const __attribute__((address_space(3))) bf16x8*)(kp+j*2048+512); }
__device__ __forceinline__ s16x4 vtr(lds_cptr p){ return __builtin_bit_cast(s16x4,__builtin_amdgcn_ds_read_tr16_b64_v4i16((__attribute__((address_space(3))) v4i16_t*)p)); }
__device__ __forceinline__ float rowmax(const f32x16&p0,const f32x16&p1){
  float a=max3f(p0[0],p0[1],p1[0]),b=max3f(p0[2],p0[3],p1[1]);a=max3f(a,p1[2],p1[3]);
  #pragma unroll
  for(int r=4;r<16;r+=4){a=max3f(a,p0[r],p0[r+1]);b=max3f(b,p0[r+2],p0[r+3]);a=max3f(a,p1[r],p1[r+1]);b=max3f(b,p1[r+2],p1[r+3]);}
  const float m=max2f(a,b);
  auto rr=__builtin_amdgcn_permlane32_swap(__float_as_uint(m),__float_as_uint(m),false,false);
  return max2f(__uint_as_float(rr[0]),__uint_as_float(rr[1]));
}
__device__ __forceinline__ void pv(f32x16*o,int vb,bf16x8 pa0,bf16x8 pa1,bf16x8 pa2,bf16x8 pa3){
  #pragma unroll
  for(int d0=0;d0<2;++d0){s16x4 lo[4],hi[4];
    #pragma unroll
    for(int ks=0;ks<4;++ks){
      asm volatile("ds_read_b64_tr_b16 %0,%1 offset:%c2":"=&v"(lo[ks]):"v"(vb),"i"(d0*4096+ks*1024):"memory");
      asm volatile("ds_read_b64_tr_b16 %0,%1 offset:%c2":"=&v"(hi[ks]):"v"(vb),"i"(d0*4096+ks*1024+512):"memory");}
    asm volatile("s_waitcnt lgkmcnt(0)":::"memory");SBAR();
    #define PK(k) (bf16x8){lo[k][0],lo[k][1],lo[k][2],lo[k][3],hi[k][0],hi[k][1],hi[k][2],hi[k][3]}
    o[d0]=__builtin_amdgcn_mfma_f32_32x32x16_bf16(pa0,PK(0),o[d0],0,0,0);
    o[d0]=__builtin_amdgcn_mfma_f32_32x32x16_bf16(pa1,PK(1),o[d0],0,0,0);
    o[d0]=__builtin_amdgcn_mfma_f32_32x32x16_bf16(pa2,PK(2),o[d0],0,0,0);
    o[d0]=__builtin_amdgcn_mfma_f32_32x32x16_bf16(pa3,PK(3),o[d0],0,0,0);
    #undef PK
  }
}

#ifndef ATTN_STORE16
#define ATTN_STORE16(p,v) (*(u32x4*)(p)=(v))
#endif
template<int THRL> __device__ __forceinline__ void attn_unit(const bf16*Qu,const bf16*Kh,const bf16*Vh,bf16*Ou,const int NT,char*shm){
  const int tid=opaque_tid(),lane=tid&63,r32=lane&31,hi=lane>>5; const int wid=__builtin_amdgcn_readfirstlane(tid>>6);
  const bf16*Qw=Qu+(long)(wid*QBLK)*QP;
  const unsigned lds0=(unsigned)(uintptr_t)shm;
  float*wsf=(float*)(shm+LDS_WS)+wid*64;
  const bf16*ksrc=Kh+(long)lane*KP+wid*8;
  const bf16*vsrc=Vh+(long)(16*(wid&3)+(lane>>2))*KP+(wid>>2)*32+(lane&3)*8;
  const unsigned kdst=lds0+LDS_K+wid*1024, vdst=lds0+LDS_V+wid*1024;
  #define DMA_K(t,slot) glds16(ksrc+(long)(t)*KVBLK*KP,(unsigned)__builtin_amdgcn_readfirstlane(kdst+(slot)))
  #define DMA_V(t,slot) glds16(vsrc+(long)(t)*KVBLK*KP,(unsigned)__builtin_amdgcn_readfirstlane(vdst+(slot)))
  const int vb0=(int)(lds0+LDS_V)+((lane>>4)&1)*32+(lane&3)*8+(4*hi+((lane&15)>>2))*64;
  const char*Kbase=shm+LDS_K; bf16x8 kf[8];
  const lds_cptr shm3=(lds_cptr)shm; const lds_cptr kp0=shm3+LDS_K+hi*1024+r32*16; const lds_cptr vp0=shm3+LDS_V+((lane>>4)&1)*32+(lane&3)*8+(4*hi+((lane&15)>>2))*64;
  DMA_K(0,0);DMA_V(0,0);DMA_K(1,SLOTB);
  bf16x8 qr[4];
  #pragma unroll
  for(int d0=0;d0<4;++d0)qr[d0]=*reinterpret_cast<const bf16x8*>(&Qw[(long)r32*QP+d0*16+hi*8]);
  float mhat=0.f,l_reg=0.f;f32x16 o[2];o[0]=f32x16{};o[1]=f32x16{};f32x16 negm=f32x16{};asm volatile("":"+v"(negm));
  #define CMASK(P0,P1,t) do{}while(0)
  bool resc=false;
  #define START(P0,P1) do{ const float rm=rowmax(P0,P1); resc=false; \
    { const float dl=rm; mhat=fadd_s(mhat,dl); \
      _Pragma("unroll") for(int r=0;r<16;++r){P0[r]=fsub_s(P0[r],dl);P1[r]=fsub_s(P1[r],dl);} \
      _Pragma("unroll") for(int r=0;r<16;++r)negm[r]=-mhat; asm volatile("":"+v"(negm)); } \
    _Pragma("unroll") for(int r=0;r<16;++r)P0[r]=__builtin_amdgcn_exp2f(P0[r]); }while(0)
  #define RESC() do{ if(resc){ asm volatile("s_waitcnt lgkmcnt(0)":::"memory"); \
      _Pragma("unroll") for(int d_=0;d_<2;++d_) _Pragma("unroll") for(int r=0;r<16;++r)o[d_][r]*=wsf[crow(r,hi)]; } }while(0)
  f32x16 pA0,pA1,pB0,pB1;
  int sl_prev=0,sl_cur=0,sl_next=SLOTB;
  #define ROT() do{sl_prev=sl_cur;sl_cur=sl_next;sl_next=(sl_next==(NSLOT-1)*SLOTB)?0:sl_next+SLOTB;}while(0)
  DMA_K(2,2*SLOTB);
  WAIT_BAR(3);
  qkt(pA0,pA1,Kbase,qr,negm,r32,hi);asm volatile("s_nop 15\n\ts_nop 7":"+v"(pA0),"+v"(pA1));CMASK(pA0,pA1,0);
  START(pA0,pA1);
  _Pragma("unroll") for(int r=0;r<16;++r)pA1[r]=__builtin_amdgcn_exp2f(pA1[r]);
  WAIT_BAR(0);
  DMA_K(3,0);DMA_V(1,SLOTB);
  ROT();
  kload8(kf,kp0+sl_cur);
  WAIT_BAR(2);
  s16x4 vlo[8],vhi[8]; u32x4 pw0,pw1,pw2,pw3;
  #define PKW(P,B) cvtpk_s(P[B],P[B+1])
  #define PAF(k) __builtin_bit_cast(bf16x8,pw##k)
  #define VFR(i) (bf16x8){vlo[i][0],vlo[i][1],vlo[i][2],vlo[i][3],vhi[i][0],vhi[i][1],vhi[i][2],vhi[i][3]}
  #define PIN(x) asm volatile("":"+v"(x))
  #define MX3(a,b,c) __builtin_fmaxf(__builtin_fmaxf((a),(b)),(c))
  #define GAPA(MF,A0,A1,A2,A3,W0,W1,PW) do{ MF; sacc+=A0; sacc+=A1; sacc+=A2; sacc+=A3; PIN(sacc); W0; W1; PIN(PW); SBAR(); }while(0)
  #define EX(v) __builtin_amdgcn_exp2f(v)
  #define GAPB(MF,X,B) do{ MF; X[B]=EX(X[B]); X[B+1]=EX(X[B+1]); X[B+2]=EX(X[B+2]); X[B+3]=EX(X[B+3]); PIN(X); SBAR(); }while(0)
  #define VRD(i) do{ vlo[i]=vtr(vp_+(((i)>>2)*4096+((i)&3)*1024)); vhi[i]=vtr(vp_+(((i)>>2)*4096+((i)&3)*1024+512)); }while(0)
  #define KRD(G,j) do{ if(G){ kload2(kf,kp0+sl_next,j); SBAR(); } }while(0)
  #define STEP(C0,C1,P0,P1,t,GK,GV,GL) do{ SBAR(); \
    const lds_cptr vp_=vp0+sl_prev; \
    VRD(0); SBAR(); float sacc=(P0[0]+P0[1]); \
    GAPA(C0=__builtin_amdgcn_mfma_f32_32x32x16_bf16(kf[0],qr[0],negm,0,0,0), P0[2],P0[3],P0[4],P0[5],     pw0[0]=PKW(P0,0), pw0[1]=PKW(P0,2), pw0); \
    VRD(4); SBAR(); GAPA(C1=__builtin_amdgcn_mfma_f32_32x32x16_bf16(kf[1],qr[0],negm,0,0,0), P0[6],P0[7],P0[8],P0[9],     pw0[2]=PKW(P0,4), pw0[3]=PKW(P0,6), pw0); \
    VRD(1); SBAR(); GAPA(C0=__builtin_amdgcn_mfma_f32_32x32x16_bf16(kf[2],qr[1],C0,0,0,0),   P0[10],P0[11],P0[12],P0[13], pw1[0]=PKW(P0,8), pw1[1]=PKW(P0,10), pw1); \
    VRD(5); SBAR(); GAPA(C1=__builtin_amdgcn_mfma_f32_32x32x16_bf16(kf[3],qr[1],C1,0,0,0),   P0[14],P0[15],P1[0],P1[1],   pw1[2]=PKW(P0,12),pw1[3]=PKW(P0,14), pw1); \
    VRD(2); SBAR(); GAPA(C0=__builtin_amdgcn_mfma_f32_32x32x16_bf16(kf[4],qr[2],C0,0,0,0),   P1[2],P1[3],P1[4],P1[5],     pw2[0]=PKW(P1,0), pw2[1]=PKW(P1,2), pw2); \
    VRD(6); SBAR(); GAPA(C1=__builtin_amdgcn_mfma_f32_32x32x16_bf16(kf[5],qr[2],C1,0,0,0),   P1[6],P1[7],P1[8],P1[9],     pw2[2]=PKW(P1,4), pw2[3]=PKW(P1,6), pw2); \
    VRD(3); SBAR(); GAPA(C0=__builtin_amdgcn_mfma_f32_32x32x16_bf16(kf[6],qr[3],C0,0,0,0),   P1[10],P1[11],P1[12],P1[13], pw3[0]=PKW(P1,8), pw3[1]=PKW(P1,10), pw3); \
    VRD(7); SBAR(); GAPA(C1=__builtin_amdgcn_mfma_f32_32x32x16_bf16(kf[7],qr[3],C1,0,0,0),   P1[14],P1[15],0.f,0.f,       pw3[2]=PKW(P1,12),pw3[3]=PKW(P1,14), pw3); \
    l_reg+=sacc; \
    if(GK){DMA_K((t)+3,sl_cur);} if(GV){DMA_V((t)+1,sl_next);} \
    CMASK(C0,C1,t); \
    { float a=MX3(C0[0],C0[1],C1[0]),b=MX3(C0[2],C0[3],C1[1]); a=MX3(a,C1[2],C1[3]); \
      _Pragma("unroll") for(int r=4;r<16;r+=4){a=MX3(a,C0[r],C0[r+1]);b=MX3(b,C0[r+2],C0[r+3]);a=MX3(a,C1[r],C1[r+1]);b=MX3(b,C1[r+2],C1[r+3]);} \
      float rm=__builtin_fmaxf(a,b); { auto rr=__builtin_amdgcn_permlane32_swap(__float_as_uint(rm),__float_as_uint(rm),false,false); rm=__builtin_fmaxf(__uint_as_float(rr[0]),__uint_as_float(rr[1])); } \
      resc=false; \
      if(__builtin_expect(__any(rm>(float)THRL),0)){ const float dl=__builtin_fmaxf(rm,0.f); mhat+=dl; \
        _Pragma("unroll") for(int r=0;r<16;++r){C0[r]-=dl;C1[r]-=dl;} \
        _Pragma("unroll") for(int r=0;r<16;++r)negm[r]=-mhat; asm volatile("":"+v"(negm)); \
        const float f=__builtin_amdgcn_exp2f(-dl); l_reg*=f; if(hi==0)wsf[r32]=f; resc=true; } } \
    SBAR(); \
    GAPB(o[0]=__builtin_amdgcn_mfma_f32_32x32x16_bf16(PAF(0),VFR(0),o[0],0,0,0), C0,0); \
    GAPB(o[1]=__builtin_amdgcn_mfma_f32_32x32x16_bf16(PAF(0),VFR(4),o[1],0,0,0), C0,4); \
    KRD(GL,0); GAPB(o[0]=__builtin_amdgcn_mfma_f32_32x32x16_bf16(PAF(1),VFR(1),o[0],0,0,0), C0,8); \
    KRD(GL,1); GAPB(o[1]=__builtin_amdgcn_mfma_f32_32x32x16_bf16(PAF(1),VFR(5),o[1],0,0,0), C0,12); \
    KRD(GL,2); GAPB(o[0]=__builtin_amdgcn_mfma_f32_32x32x16_bf16(PAF(2),VFR(2),o[0],0,0,0), C1,0); \
    KRD(GL,3); GAPB(o[1]=__builtin_amdgcn_mfma_f32_32x32x16_bf16(PAF(2),VFR(6),o[1],0,0,0), C1,4); \
    GAPB(o[0]=__builtin_amdgcn_mfma_f32_32x32x16_bf16(PAF(3),VFR(3),o[0],0,0,0), C1,8); \
    GAPB(o[1]=__builtin_amdgcn_mfma_f32_32x32x16_bf16(PAF(3),VFR(7),o[1],0,0,0), C1,12); \
    }while(0)
  int t=1;
  #undef CMASK
  #define CMASK(P0,P1,t) do{}while(0)
  for(;t+5<NT;t+=2){
    STEP(pB0,pB1,pA0,pA1,t,true,true,true);     WAIT_BAR(2); RESC(); ROT();
    STEP(pA0,pA1,pB0,pB1,t+1,true,true,true);   WAIT_BAR(2); RESC(); ROT();
  }
  #undef CMASK
  #define CMASK(P0,P1,t) do{}while(0)
  #define ENDW(tt) do{ if((tt)+3<NT){WAIT_BAR(2);} else if((tt)+2<NT){WAIT_BAR(1);} else {WAIT_BAR(0);} }while(0)
  for(;t+1<NT;t+=2){
    STEP(pB0,pB1,pA0,pA1,t,(t+3<NT),(t+1<NT),(t+1<NT));       ENDW(t);   RESC(); ROT();
    STEP(pA0,pA1,pB0,pB1,t+1,(t+4<NT),(t+2<NT),(t+2<NT));     ENDW(t+1); RESC(); ROT();
  }
  STEP(pB0,pB1,pA0,pA1,NT-1,false,false,false); RESC();
  { float sacc=pB0[0]+pB0[1]; _Pragma("unroll") for(int r=2;r<16;++r)sacc+=pB0[r]; _Pragma("unroll") for(int r=0;r<16;++r)sacc+=pB1[r]; l_reg+=sacc;
    pw0=(u32x4){PKW(pB0,0),PKW(pB0,2),PKW(pB0,4),PKW(pB0,6)};pw1=(u32x4){PKW(pB0,8),PKW(pB0,10),PKW(pB0,12),PKW(pB0,14)};pw2=(u32x4){PKW(pB1,0),PKW(pB1,2),PKW(pB1,4),PKW(pB1,6)};pw3=(u32x4){PKW(pB1,8),PKW(pB1,10),PKW(pB1,12),PKW(pB1,14)};
    SBAR(); pv(o,vb0+sl_cur,PAF(0),PAF(1),PAF(2),PAF(3)); }
  #undef PKW
  #undef PAF
  #undef VFR
  #undef PIN
  #undef MX3
  #undef GAPA
  #undef GAPB
  #undef EX
  #undef VRD
  #undef KRD
  #undef STEP
  #undef ENDW
  {auto rr=__builtin_amdgcn_permlane32_swap(__float_as_uint(l_reg),__float_as_uint(l_reg),false,false);l_reg=__uint_as_float(rr[0])+__uint_as_float(rr[1]);}
  if(hi==0)wsf[32+r32]=l_reg;asm volatile("s_waitcnt lgkmcnt(0)":::"memory");
  float rli[16];
  #pragma unroll
  for(int r=0;r<16;++r)rli[r]=__builtin_amdgcn_rcpf(wsf[32+crow(r,hi)]);
  bf16*Ow=Ou+(long)(wid*QBLK)*OP;
  { bf16*stg=(bf16*)(shm+LDS_OST)+wid*2048;
    #pragma unroll
    for(int r=0;r<16;++r){const int orow=crow(r,hi);
      #pragma unroll
      for(int d0=0;d0<2;++d0)stg[orow*64+d0*32+r32]=__float2bfloat16(o[d0][r]*rli[r]);}
    asm volatile("s_waitcnt lgkmcnt(0)":::"memory");
    #pragma unroll
    for(int i=0;i<4;++i){const int row=i*8+(lane>>3),ch=lane&7; const u32x4 v=*(const u32x4*)(stg+row*64+ch*8); ATTN_STORE16(Ow+(long)row*OP+ch*8,v);} }
  asm volatile("s_waitcnt lgkmcnt(0)\n\ts_barrier":::"memory");
  #undef DMA_K
  #undef DMA_V
  #undef CMASK
  #undef START
  #undef RESC
  #undef ROT
}
constexpr int ATTN_LDS_BYTES=LDS_BYTES;
#undef SBAR
#undef WAIT_BAR
}

constexpr int NWAVES = 8;
#ifndef MK_N_LAUNCHES
#define MK_N_LAUNCHES 1
#endif
constexpr int DM = 1024, NBATCH = 8, SEQL = 4096, CTXL = 256, DEPTH = 2;
constexpr int RCTX = NBATCH * CTXL, RLAT = NBATCH * SEQL, RTOT = RCTX + RLAT;
constexpr int INW = 2560, NEXP = 32, NKEY = CTXL + SEQL, NPF = 34, NMOD = 6 * DM;
constexpr int ZC_U = 0, ZC_B = 256, ZC_C = 512, ZC_RQ = 768, ZC_RK = 1024, ZC_RV = 1280, ZC_RG = 1536, ZC_AQ = 1792, ZC_AK = 2304, ZC_AV = 2432;
constexpr float LN_EPS = 1e-6f, ALPHA = 1.41421356237309505f;
constexpr int N_PRO = 3, N_PER_LAYER = 10, N_PHASES = N_PRO + DEPTH * N_PER_LAYER;
constexpr int N_LAUNCHES = MK_N_LAUNCHES;

constexpr size_t MiB = 1u << 20;
constexpr size_t WS_CTL = 0, CTL_ZERO_BYTES = 1 * MiB;
constexpr size_t WS_MODP = 2 * MiB, WS_MODV = 6 * MiB, WS_ROPE = 7 * MiB;
constexpr size_t WS_RE = 8 * MiB, WS_RP = 9 * MiB, WS_RW = 10 * MiB, WS_SLOT = 11 * MiB, WS_ROWW = 12 * MiB;
constexpr size_t WS_WIN = 14 * MiB, WS_WOUT = 24 * MiB, WS_KVS = 28 * MiB, WS_SS = 62 * MiB, WS_AK = 80 * MiB, WS_AV = 89 * MiB, WS_AQ = 98 * MiB;
constexpr size_t WS_RQ = 132 * MiB, WS_RK = 149 * MiB, WS_WGU = 166 * MiB, WS_WD = 422 * MiB, WS_XSA = 550 * MiB, WS_XH = 618 * MiB, WS_Z = 686 * MiB;
constexpr size_t WS_MIX = 856 * MiB, WS_Y = 924 * MiB, WS_H2 = 992 * MiB, WS_XS2 = 1060 * MiB, WS_ACT = 1348 * MiB, WS_END = 1636 * MiB;
constexpr size_t WS_YB = WS_XS2;
constexpr int MAXTILES = 576;
static_assert(WS_MODP + (size_t)DEPTH * 8 * 9 * NMOD * 4 <= WS_MODV && WS_MODV + (size_t)DEPTH * 9 * NMOD * 4 <= WS_ROPE, "ws map");
static_assert(WS_WIN + (size_t)DEPTH * INW * DM * 2 <= WS_WOUT && WS_WOUT + (size_t)DEPTH * DM * DM * 2 <= WS_KVS, "ws map");
static_assert(WS_KVS + (size_t)NBATCH * 4 * NPF * 2 * 4096 * 4 <= WS_SS && WS_SS + (size_t)NBATCH * 4 * NPF * 2 * 4096 * 2 <= WS_AK, "ws map");
static_assert(WS_AK + (size_t)NBATCH * 2 * NKEY * 64 * 2 <= WS_AV && WS_AV + (size_t)NBATCH * 2 * NKEY * 64 * 2 <= WS_AQ && WS_AQ + (size_t)RTOT * 512 * 2 <= WS_RQ, "ws map");
static_assert(WS_RQ + (size_t)RTOT * 256 * 2 <= WS_RK && WS_RK + (size_t)RTOT * 256 * 2 <= WS_WGU && WS_WGU + (size_t)DEPTH * NEXP * 2048 * DM * 2 <= WS_WD, "ws map");
static_assert(WS_WD + (size_t)DEPTH * NEXP * DM * DM * 2 <= WS_XSA && WS_XSA + (size_t)RTOT * DM * 2 <= WS_XH && WS_XH + (size_t)RTOT * DM * 2 <= WS_Z, "ws map");
static_assert(WS_Z + (size_t)RTOT * INW * 2 <= WS_MIX && WS_MIX + (size_t)RTOT * DM * 2 <= WS_Y && WS_Y + (size_t)RTOT * DM * 2 <= WS_H2 && WS_H2 + (size_t)RTOT * DM * 2 <= WS_XS2, "ws map");
static_assert(WS_XS2 + (size_t)MAXTILES * 256 * DM * 2 <= WS_ACT && WS_ACT + (size_t)MAXTILES * 256 * DM * 2 <= WS_END, "ws map");
constexpr int CW_TMO = 0, CW_CODE = 1, CW_BAR = 4096, CW_GCNT = 8192;

constexpr int RING_OFF = 0, RING_BYTES = 131072;
constexpr int LDSCTL_OFF = RING_BYTES, MISC_OFF = LDSCTL_OFF + 320;
constexpr int OFFT_OFF = LDSCTL_OFF + 512, LCNT_OFF = LDSCTL_OFF + 768, LBASE_OFF = LDSCTL_OFF + 896, ENT_OFF = LDSCTL_OFF + 1024;
constexpr int LDS_BYTES = 147456;
static_assert(ENT_OFF + 4096 <= LDS_BYTES, "LDS map");

#define GAS __attribute__((address_space(1)))
#define LAS __attribute__((address_space(3)))
typedef unsigned short bf16;
typedef unsigned v4u __attribute__((ext_vector_type(4)));
typedef float f32x4 __attribute__((ext_vector_type(4)));
typedef short bf16x8 __attribute__((ext_vector_type(8)));
typedef GAS unsigned gu32;
typedef GAS unsigned long long gu64;
#define RLX_AGENT __ATOMIC_RELAXED, __HIP_MEMORY_SCOPE_AGENT
#define LDS_WAIT() asm volatile("s_waitcnt lgkmcnt(0)" ::: "memory")
#define VM_WAIT() asm volatile("s_waitcnt vmcnt(0)" ::: "memory")
__device__ __forceinline__ unsigned long long rt() { return __builtin_amdgcn_s_memrealtime(); }
__device__ __forceinline__ unsigned f2bf(float f) { unsigned u = __builtin_bit_cast(unsigned, f); return (u + 0x7fffu + ((u >> 16) & 1u)) >> 16; }
__device__ __forceinline__ unsigned pk2(float lo, float hi) { return f2bf(lo) | (f2bf(hi) << 16); }

#define XB_TMO      128
#define XB_XCNT(j)  (256  + 64 * (j))
#define XB_XSUB(j)  (1280 + 64 * (j))
#define XB_XGEN(j)  (2304 + 64 * (j))
#define XB_TOP      3328
#define XB_TOPGEN   3392
#define XCD_BAR_WORDS 3456
#define XB_SPIN_CAP (1u << 18)

__device__ __forceinline__ unsigned xb_ld(unsigned* p)              { return __hip_atomic_load(p, __ATOMIC_RELAXED, __HIP_MEMORY_SCOPE_AGENT); }
__device__ __forceinline__ unsigned xb_add(unsigned* p, unsigned v) { return __hip_atomic_fetch_add(p, v, __ATOMIC_RELAXED, __HIP_MEMORY_SCOPE_AGENT); }
__device__ __forceinline__ unsigned xb_xcc_id() { return (unsigned)__builtin_amdgcn_s_getreg((3 << 11) | 20) & 0xFu; }
#define XB_SPIN(cond, bar) do { unsigned _sp = 0; while (cond) { __builtin_amdgcn_s_sleep(1); \
    if ((++_sp & 255u) == 0u) { if (xb_ld(&(bar)[XB_TMO])) break; if (_sp > XB_SPIN_CAP) { atomicAdd(&(bar)[XB_TMO], 1u); break; } } } } while (0)

struct XcdBarrier {
    unsigned* bar; unsigned x;
    volatile LAS unsigned* st;
};

__device__ __forceinline__ XcdBarrier xcd_barrier_post(unsigned* bar, volatile LAS unsigned* st) {
    XcdBarrier b; b.bar = bar; b.x = xb_xcc_id(); b.st = st;
    if (threadIdx.x == 0) (void)xb_add(&bar[XB_XCNT(b.x)], 1u);
    return b;
}
__device__ __forceinline__ void xcd_barrier_complete(unsigned* bar, unsigned x, unsigned& nloc, unsigned& nx) {
    const unsigned G = gridDim.x * gridDim.y * gridDim.z;
    unsigned sum, cnt, mine, sp = 0u;
    for (;;) {
        sum = 0u; cnt = 0u; mine = 0u;
#pragma unroll
        for (unsigned j = 0; j < 16; ++j) { const unsigned c = xb_ld(&bar[XB_XCNT(j)]); sum += c; cnt += (c > 0u) ? 1u : 0u; mine = (j == x) ? c : mine; }
        if (sum == G) break;
        __builtin_amdgcn_s_sleep(1);
        if ((++sp & 255u) == 0u) { if (xb_ld(&bar[XB_TMO])) break; if (sp > XB_SPIN_CAP) { atomicAdd(&bar[XB_TMO], 1u); break; } }
    }
    nloc = mine > 0u ? mine : 1u; nx = cnt > 0u ? cnt : 1u;
}

__device__ __forceinline__ void xcd_barrier(const XcdBarrier& b) {
    asm volatile("s_waitcnt vmcnt(0)" ::: "memory");
    __syncthreads();
    if (threadIdx.x == 0) {
        unsigned* bar = b.bar;
        __builtin_amdgcn_s_waitcnt(0);
        unsigned nloc = b.st[0], nx = b.st[1];
        if (nloc == 0u) { xcd_barrier_complete(bar, b.x, nloc, nx); b.st[0] = nloc; b.st[1] = nx; }
        const unsigned old = xb_add(&bar[XB_XSUB(b.x)], 1u);
        const unsigned gen = old / nloc;
        if (old + 1u == (gen + 1u) * nloc) {
            __builtin_amdgcn_fence(__ATOMIC_RELEASE, "agent");
            asm volatile("s_waitcnt vmcnt(0)" ::: "memory");
            const unsigned og = xb_add(&bar[XB_TOP], 1u);
            const unsigned tg = og / nx;
            if (og + 1u == (tg + 1u) * nx) xb_add(&bar[XB_TOPGEN], 1u);
            else XB_SPIN(xb_ld(&bar[XB_TOPGEN]) == tg, bar);
            __builtin_amdgcn_fence(__ATOMIC_ACQUIRE, "agent");
            xb_add(&bar[XB_XGEN(b.x)], 1u);
            asm volatile("s_waitcnt vmcnt(0)" ::: "memory");
        } else {
            XB_SPIN(xb_ld(&bar[XB_XGEN(b.x)]) == gen, bar);
            __builtin_amdgcn_fence(__ATOMIC_ACQUIRE, "agent");
            asm volatile("s_waitcnt vmcnt(0)" ::: "memory");
        }
    }
    __syncthreads();
}

struct Args { const float* in[21]; float* out; unsigned char* ws; int ph_lo, ph_hi, li, pad; };
template <int OFF> __device__ __forceinline__ const float* karg_ptr() {
    const float* p;
    asm volatile("s_load_dwordx2 %0, %1, %2\n\ts_waitcnt lgkmcnt(0)\n\ts_nop 4" : "=s"(p) : "s"(__builtin_amdgcn_kernarg_segment_ptr()), "i"(OFF) : "memory");
    return p;
}
#define KIN(i) karg_ptr<8 * (i)>()
#define KOUT() ((float*)karg_ptr<8 * 21>())
#define KWS() ((unsigned char*)karg_ptr<8 * 22>())
typedef float f32x16 __attribute__((ext_vector_type(16)));
typedef unsigned v2u __attribute__((ext_vector_type(2)));
__device__ __forceinline__ float bflo(unsigned u) { return __builtin_bit_cast(float, u << 16); }
__device__ __forceinline__ float bfhi(unsigned u) { return __builtin_bit_cast(float, u & 0xffff0000u); }
__device__ __forceinline__ float bf1(unsigned short h) { return __builtin_bit_cast(float, (unsigned)h << 16); }
__device__ __forceinline__ float wave_sum(float v) {
#pragma unroll
    for (int o = 1; o < 64; o <<= 1) v += __shfl_xor(v, o);
    return v;
}
__device__ __forceinline__ int mod_row(int r) { return r < RCTX ? 8 : ((r - RCTX) >> 12); }
__device__ __forceinline__ void load_row_f32(const float* p, int lane, f32x4 (&v)[4]) {
#pragma unroll
    for (int j = 0; j < 4; ++j) v[j] = *(const f32x4*)(p + 256 * j + 4 * lane);
}
__device__ __forceinline__ void load_row_bf16(const bf16* p, int lane, f32x4 (&v)[4]) {
#pragma unroll
    for (int j = 0; j < 4; ++j) { const uint2 u = *(const uint2*)(p + 256 * j + 4 * lane); v[j] = (f32x4){bflo(u.x), bfhi(u.x), bflo(u.y), bfhi(u.y)}; }
}
__device__ __forceinline__ void store_row_bf16(bf16* p, int lane, const f32x4 (&v)[4]) {
#pragma unroll
    for (int j = 0; j < 4; ++j) { uint2 u; u.x = pk2(v[j][0], v[j][1]); u.y = pk2(v[j][2], v[j][3]); *(uint2*)(p + 256 * j + 4 * lane) = u; }
}
__device__ __forceinline__ void store_row_f32(float* p, int lane, const f32x4 (&v)[4]) {
#pragma unroll
    for (int j = 0; j < 4; ++j) *(f32x4*)(p + 256 * j + 4 * lane) = v[j];
}
__device__ __forceinline__ void ln_row(f32x4 (&v)[4], const float* g, const float* b, int lane) {
    float s = 0.f;
#pragma unroll
    for (int j = 0; j < 4; ++j) s += (v[j][0] + v[j][1]) + (v[j][2] + v[j][3]);
    const float mean = wave_sum(s) * (1.0f / DM); float s2 = 0.f;
#pragma unroll
    for (int j = 0; j < 4; ++j) { v[j] = v[j] - mean; s2 += (v[j][0] * v[j][0] + v[j][1] * v[j][1]) + (v[j][2] * v[j][2] + v[j][3] * v[j][3]); }
    const float rstd = 1.0f / sqrtf(wave_sum(s2) * (1.0f / DM) + LN_EPS);
#pragma unroll
    for (int j = 0; j < 4; ++j) { const f32x4 gg = *(const f32x4*)(g + 256 * j + 4 * lane), bb = *(const f32x4*)(b + 256 * j + 4 * lane); v[j] = v[j] * rstd * gg + bb; }
}
__device__ __forceinline__ void modulate(const f32x4 (&v)[4], const float* sc, const float* sh, int lane, f32x4 (&o)[4]) {
#pragma unroll
    for (int j = 0; j < 4; ++j) { const f32x4 s = *(const f32x4*)(sc + 256 * j + 4 * lane), h = *(const f32x4*)(sh + 256 * j + 4 * lane); o[j] = v[j] * (1.0f + s) + h; }
}
__device__ __forceinline__ float log2_gamma(float dexp) { return log1pf(-exp2f(-dexp)) * 1.4426950408889634f; }

struct P0Item { const float* src; unsigned char* dst; int N, f8; float scale; };
__device__ __forceinline__ bool p0_item(int it, int lane, const float* in_win, const float* in_wout, const float* in_wgu, const float* in_wd, unsigned char* ws, P0Item& I) {
    constexpr int I_IN = 16 * 40, I_OUT = 16 * 16, I_GU = 16 * 32, I_DN = 16 * 16;
    constexpr int T_IN = DEPTH * I_IN, T_OUT = DEPTH * I_OUT, T_GU = DEPTH * NEXP * I_GU, T_DN = DEPTH * NEXP * I_DN;
    if (it >= T_IN + T_OUT + T_GU + T_DN) return false;
    int r = it;
    if (r < T_IN) { const int l = r / I_IN, q = r % I_IN, kb = q / 40, nb = q % 40;
        I.src = in_win + (size_t)l * DM * INW + (size_t)(64 * kb) * INW + 64 * nb + lane; I.N = INW; I.f8 = 0; I.scale = 1.f;
        I.dst = ws + WS_WIN + ((size_t)l * INW * DM + (size_t)(64 * nb) * DM + 64 * kb) * 2; return true; }
    r -= T_IN;
    if (r < T_OUT) { const int l = r / I_OUT, q = r % I_OUT, kb = q / 16, nb = q % 16;
        I.src = in_wout + (size_t)l * DM * DM + (size_t)(64 * kb) * DM + 64 * nb + lane; I.N = DM; I.f8 = 0; I.scale = 1.f;
        I.dst = ws + WS_WOUT + ((size_t)l * DM * DM + (size_t)(64 * nb) * DM + 64 * kb) * 2; return true; }
    r -= T_OUT;
    if (r < T_GU) { const int le = r / I_GU, q = r % I_GU, kb = q / 32, nb = q % 32; const int n0 = 64 * nb;
        const int dest = (n0 < 1024) ? ((n0 >> 7) * 256 + (n0 & 127)) : ((((n0 - 1024) >> 7) * 256) + 128 + ((n0 - 1024) & 127));
        I.src = in_wgu + (size_t)le * DM * 2048 + (size_t)(64 * kb) * 2048 + n0 + lane; I.N = 2048; I.f8 = 1; I.scale = 32.f;
        I.dst = ws + WS_WGU + (size_t)le * 2048 * DM + (size_t)dest * DM + 64 * kb; return true; }
    r -= T_GU;
    { const int le = r / I_DN, q = r % I_DN, kb = q / 16, nb = q % 16;
        I.src = in_wd + (size_t)le * DM * DM + (size_t)(64 * kb) * DM + 64 * nb + lane; I.N = DM; I.f8 = 1; I.scale = 64.f;
        I.dst = ws + WS_WD + (size_t)le * DM * DM + (size_t)(64 * nb) * DM + 64 * kb; return true; }
}
__device__ __forceinline__ void p0_item_load(const P0Item& I, float (&v)[64]) {
#pragma unroll
    for (int k = 0; k < 64; ++k) v[k] = I.src[(size_t)k * I.N];
}
__device__ __forceinline__ void p0_item_store(const P0Item& I, const float (&v)[64], LAS unsigned* T, int lane) {
    if (I.f8) {
#pragma unroll
        for (int kq = 0; kq < 16; ++kq) T[lane * 20 + kq] = (unsigned)__builtin_amdgcn_cvt_pk_fp8_f32(v[4 * kq + 2] * I.scale, v[4 * kq + 3] * I.scale, __builtin_amdgcn_cvt_pk_fp8_f32(v[4 * kq] * I.scale, v[4 * kq + 1] * I.scale, 0, false), true);
        LDS_WAIT(); asm volatile("" ::: "memory");
        const int c = lane & 3, nr = lane >> 2;
#pragma unroll
        for (int j = 0; j < 4; ++j) { const int n = nr + 16 * j; const v4u o = *(const LAS v4u*)(T + n * 20 + 4 * c); *(GAS v4u*)(I.dst + (size_t)n * DM + 16 * c) = o; }
    } else {
#pragma unroll
        for (int kp = 0; kp < 32; ++kp) T[lane * 36 + kp] = pk2(v[2 * kp], v[2 * kp + 1]);
        LDS_WAIT(); asm volatile("" ::: "memory");
        const int c = lane & 7, nr = lane >> 3;
#pragma unroll
        for (int j = 0; j < 8; ++j) { const int n = nr + 8 * j; const v4u o = *(const LAS v4u*)(T + n * 36 + 4 * c); *(GAS v4u*)(I.dst + (size_t)n * DM * 2 + 16 * c) = o; }
    }
    LDS_WAIT(); asm volatile("" ::: "memory");
}
__device__ __forceinline__ void p0a(const Args& A, LAS unsigned char* lds, int tid, int lane, int wave) {
    unsigned char* ws = KWS();
    const int G = gridDim.x, wg = opaque_bid();
    const float* in_c = KIN(1); const float* in_cctx = KIN(3); const float* in_wmod = KIN(4); const float* in_bmod = KIN(5);
    {
        LAS float* sl = (LAS float*)(lds + RING_OFF);
        float* MODP = (float*)(ws + WS_MODP);
        for (int u = wg; u < DEPTH * 8 * 12; u += G) {
            const int l = u / 96, rem = u % 96, kp = rem / 12, cb = rem % 12;
            for (int i = tid; i < 9 * 128; i += NWAVES * 64) { const int r = i >> 7, k = i & 127;
                const float cv = (r < 8) ? in_c[r * DM + kp * 128 + k] : in_cctx[kp * 128 + k];
                sl[i] = cv / (1.0f + expf(-cv)); }
            __syncthreads();
            const int col = cb * 512 + tid;
            float acc[9];
#pragma unroll
            for (int r = 0; r < 9; ++r) acc[r] = (kp == 0) ? in_bmod[l * NMOD + col] : 0.f;
            const float* wp = in_wmod + ((size_t)l * DM + kp * 128) * NMOD + col;
#pragma unroll 8
            for (int k = 0; k < 128; ++k) { const float w = wp[(size_t)k * NMOD];
#pragma unroll
                for (int r = 0; r < 9; ++r) acc[r] += sl[r * 128 + k] * w; }
#pragma unroll
            for (int r = 0; r < 9; ++r) MODP[((size_t)(l * 8 + kp) * 9 + r) * NMOD + col] = acc[r];
            __syncthreads();
        }
    }
    if (wg == G - 1) {
        const float invf[16] = {1.0f, 0.5623413251903491f, 0.31622776601683794f, 0.1778279410038923f, 0.1f, 0.05623413251903491f, 0.03162277660168379f, 0.01778279410038923f,
                                0.01f, 0.005623413251903491f, 0.0031622776601683794f, 0.0017782794100389228f, 0.001f, 0.0005623413251903491f, 0.00031622776601683794f, 0.00017782794100389227f};
        float2* rope = (float2*)(ws + WS_ROPE);
        for (int i = tid; i < 1024; i += NWAVES * 64) { const int f = i & 15; float fr = invf[0];
#pragma unroll
            for (int q = 1; q < 16; ++q) fr = (f == q) ? invf[q] : fr;
            const float ang = (float)(i >> 4) * fr; rope[i] = make_float2(cosf(ang), sinf(ang)); }
    }
    {
        LAS unsigned* scr = (LAS unsigned*)(lds + RING_OFF + wave * 16384);
        const float* in_win = KIN(6); const float* in_wout = KIN(12); const float* in_wgu = KIN(17); const float* in_wd = KIN(19);
        const int gw = wg * NWAVES + wave, NGW = G * NWAVES;
        P0Item Ia, Ib; float va[64], vb[64];
        bool ha = p0_item(gw, lane, in_win, in_wout, in_wgu, in_wd, ws, Ia), hb = false;
        if (ha) p0_item_load(Ia, va);
        for (int it = gw; ha; it += 2 * NGW) {
            hb = p0_item(it + NGW, lane, in_win, in_wout, in_wgu, in_wd, ws, Ib);
            if (hb) p0_item_load(Ib, vb);
            p0_item_store(Ia, va, scr, lane);
            if (!hb) break;
            ha = p0_item(it + 2 * NGW, lane, in_win, in_wout, in_wgu, in_wd, ws, Ia);
            if (ha) p0_item_load(Ia, va);
            p0_item_store(Ib, vb, scr, lane);
        }
    }
    __syncthreads();
}
__device__ __forceinline__ void p0b(const Args& A, int tid) {
    const float* MODP = (const float*)(KWS() + WS_MODP); float* MODV = (float*)(KWS() + WS_MODV);
    for (int i = opaque_bid() * (NWAVES * 64) + tid; i < DEPTH * 9 * NMOD; i += gridDim.x * NWAVES * 64) {
        const int l = i / (9 * NMOD), rc = i % (9 * NMOD); float s = 0.f;
#pragma unroll
        for (int kp = 0; kp < 8; ++kp) s += MODP[(size_t)(l * 8 + kp) * 9 * NMOD + rc];
        MODV[i] = s;
    }
}
__device__ __forceinline__ void p0c(const Args& A, int lane, int wave) {
    const float* MODV = (const float*)(KWS() + WS_MODV); bf16* XH = (bf16*)(KWS() + WS_XH);
    const int gw = opaque_bid() * NWAVES + wave, NGW = gridDim.x * NWAVES, RPW = (RTOT + NGW - 1) / NGW;
    for (int r = gw * RPW; r < (gw + 1) * RPW && r < RTOT; ++r) {
        const float* src = (r < RCTX) ? KIN(2) + (size_t)r * DM : KIN(0) + (size_t)(r - RCTX) * DM;
        const float* mv = MODV + (size_t)mod_row(r) * NMOD;
        f32x4 v[4], o[4]; load_row_f32(src, lane, v); modulate(v, mv + 1 * DM, mv + 0 * DM, lane, o); store_row_bf16(XH + (size_t)r * DM, lane, o);
    }
}

__device__ __forceinline__ void unpack4(uint2 u, float (&x)[4]) { x[0] = bflo(u.x); x[1] = bfhi(u.x); x[2] = bflo(u.y); x[3] = bfhi(u.y); }
__device__ __forceinline__ uint2 pack4(const float (&x)[4]) { uint2 u; u.x = pk2(x[0], x[1]); u.y = pk2(x[2], x[3]); return u; }
__device__ __forceinline__ void rope4(float (&x1)[4], float (&x2)[4], const float2* rope, int pos, int f0, bool apply, float scale) {
    if (apply) { const f32x4 a = *(const f32x4*)(rope + pos * 16 + f0), b = *(const f32x4*)(rope + pos * 16 + f0 + 2);
        const float cs[4] = {a[0], a[2], b[0], b[2]}, sn[4] = {a[1], a[3], b[1], b[3]};
#pragma unroll
        for (int i = 0; i < 4; ++i) { const float p = x1[i] * cs[i] - x2[i] * sn[i], q = x1[i] * sn[i] + x2[i] * cs[i]; x1[i] = p; x2[i] = q; } }
#pragma unroll
    for (int i = 0; i < 4; ++i) { x1[i] *= scale; x2[i] *= scale; }
}
struct P2Raw { uint2 bb, r1, r2, q1, q2, k1, k2, vv; };
__device__ __forceinline__ void p2_load(const bf16* Z, int r, int lane, P2Raw& R) {
    const bf16* zr = Z + (size_t)r * INW; const int j4 = 4 * (lane & 3);
    R.bb = *(const uint2*)(zr + ZC_B + 4 * lane);
    { const bf16* s = zr + ((lane >> 5) ? ZC_RK : ZC_RQ) + ((lane >> 2) & 7) * 32 + j4; R.r1 = *(const uint2*)s; R.r2 = *(const uint2*)(s + 16); }
    { const bf16* s = zr + ZC_AQ + (lane >> 2) * 32 + j4; R.q1 = *(const uint2*)s; R.q2 = *(const uint2*)(s + 16); }
    { const bf16* s = zr + ZC_AK + ((lane & 15) >> 2) * 32 + j4; R.k1 = *(const uint2*)s; R.k2 = *(const uint2*)(s + 16); }
    R.vv = *(const uint2*)(zr + ZC_AV + (lane & 31) * 4);
}
__device__ __forceinline__ void p2_load_uc(const bf16* Z, int r, int lane, uint2& u, uint2& c) { const bf16* zr = Z + (size_t)r * INW; u = *(const uint2*)(zr + ZC_U + 4 * lane); c = *(const uint2*)(zr + ZC_C + 4 * lane); }
__device__ __forceinline__ void p2_prod(uint2 u, uint2 c, float (&v)[4]) { float a[4], d[4]; unpack4(u, a); unpack4(c, d);
#pragma unroll
    for (int i = 0; i < 4; ++i) v[i] = a[i] * d[i]; }
__device__ __forceinline__ void p2_norm_rope(float (&x1)[4], float (&x2)[4], float rn, const f32x4& g1, const f32x4& g2, const float (&cs)[4], const float (&sn)[4], float scale) {
#pragma unroll
    for (int i = 0; i < 4; ++i) { const float a = x1[i] * rn * g1[i], d = x2[i] * rn * g2[i]; x1[i] = (a * cs[i] - d * sn[i]) * scale; x2[i] = (a * sn[i] + d * cs[i]) * scale; }
}
__device__ __forceinline__ void p2_rows(const Args& A, int l, int r0, int n, bool last, int lane) {
    unsigned char* ws = KWS();
    const bf16* Z = (const bf16*)(ws + WS_Z); const float2* rope = (const float2*)(ws + WS_ROPE);
    bf16* MIX = (bf16*)(ws + WS_MIX); bf16* RQK = (bf16*)(ws + ((lane >> 5) ? WS_RK : WS_RQ)); bf16* AQ = (bf16*)(ws + WS_AQ); bf16* AK = (bf16*)(ws + WS_AK); bf16* AV = (bf16*)(ws + WS_AV);
    const int j = lane & 3, axis = (lane >> 2) & 1, c0 = 4 * lane;
    const float* cw = KIN(7) + (size_t)l * 256 * 3 + c0 * 3; const f32x4 w0 = *(const f32x4*)cw, w1 = *(const f32x4*)(cw + 4), w2 = *(const f32x4*)(cw + 8);
    const float wf[12] = {w0[0], w0[1], w0[2], w0[3], w1[0], w1[1], w1[2], w1[3], w2[0], w2[1], w2[2], w2[3]};
    const float* qg = KIN(10) + l * 64 + axis * 32 + 4 * j; const f32x4 qg1 = *(const f32x4*)qg, qg2 = *(const f32x4*)(qg + 16);
    const float* kg = KIN(11) + l * 64 + axis * 32 + 4 * j; const f32x4 kg1 = *(const f32x4*)kg, kg2 = *(const f32x4*)(kg + 16);
    const f32x4 one4 = {1.f, 1.f, 1.f, 1.f};
    if (n <= 0) return;
    float vp[4], vc[4]; uint2 un, cn;
    { uint2 u, c; p2_load_uc(Z, r0 > 0 ? r0 - 1 : 0, lane, u, c); p2_prod(u, c, vp); p2_load_uc(Z, r0, lane, u, c); p2_prod(u, c, vc); p2_load_uc(Z, r0 + 1 < RTOT ? r0 + 1 : RTOT - 1, lane, un, cn); }
    P2Raw cur, nxt; p2_load(Z, r0, lane, cur);
    for (int i = 0; i < n; ++i) {
        const int r = r0 + i;
        const bool isctx = r < RCTX; const int b = isctx ? (r >> 8) : ((r - RCTX) >> 12), t = isctx ? (r & 255) : ((r - RCTX) & 4095), tlen = isctx ? CTXL : SEQL;
        const bool need_out = !(isctx && last);
        float cs[4] = {1.f, 1.f, 1.f, 1.f}, sn[4] = {0.f, 0.f, 0.f, 0.f};
        if (!isctx) { const int pos = axis ? (t & 63) : (t >> 6); const f32x4 a = *(const f32x4*)(rope + pos * 16 + 4 * j), d = *(const f32x4*)(rope + pos * 16 + 4 * j + 2);
            cs[0] = a[0]; sn[0] = a[1]; cs[1] = a[2]; sn[1] = a[3]; cs[2] = d[0]; sn[2] = d[1]; cs[3] = d[2]; sn[3] = d[3]; }
        p2_load(Z, (i + 1 < n) ? r + 1 : r, lane, nxt);
        uint2 un2, cn2; p2_load_uc(Z, r + 2 < RTOT ? r + 2 : RTOT - 1, lane, un2, cn2);
        float vn[4]; p2_prod(un, cn, vn);
        if (need_out) { float bb[4], y[4]; unpack4(cur.bb, bb); const float mp = (t > 0) ? 1.f : 0.f, mn = (t < tlen - 1) ? 1.f : 0.f;
#pragma unroll
            for (int q = 0; q < 4; ++q) y[q] = bb[q] * (wf[3 * q] * (vp[q] * mp) + wf[3 * q + 1] * vc[q] + wf[3 * q + 2] * (vn[q] * mn));
            *(uint2*)(MIX + (size_t)r * DM + c0) = pack4(y); }
        { float x1[4], x2[4]; unpack4(cur.r1, x1); unpack4(cur.r2, x2);
            p2_norm_rope(x1, x2, 1.0f, one4, one4, cs, sn, (lane >> 5) ? 0.125f : 1.0f);
            bf16* dst = RQK + (size_t)r * 256 + ((lane >> 2) & 7) * 32 + 4 * j; *(uint2*)dst = pack4(x1); *(uint2*)(dst + 16) = pack4(x2); }
        { float x1[4], x2[4]; unpack4(cur.q1, x1); unpack4(cur.q2, x2); float ss = 0.f;
#pragma unroll
            for (int q = 0; q < 4; ++q) ss += x1[q] * x1[q] + x2[q] * x2[q];
            ss += __shfl_xor(ss, 1); ss += __shfl_xor(ss, 2); ss += __shfl_xor(ss, 4);
            p2_norm_rope(x1, x2, 1.0f / sqrtf(ss * (1.0f / 64.0f) + LN_EPS), qg1, qg2, cs, sn, attn_body::C2);
            if (need_out) { bf16* dst = AQ + (size_t)r * 512 + (lane >> 2) * 32 + 4 * j; *(uint2*)dst = pack4(x1); *(uint2*)(dst + 16) = pack4(x2); } }
        { float x1[4], x2[4]; unpack4(cur.k1, x1); unpack4(cur.k2, x2); float ss = 0.f;
#pragma unroll
            for (int q = 0; q < 4; ++q) ss += x1[q] * x1[q] + x2[q] * x2[q];
            ss += __shfl_xor(ss, 1); ss += __shfl_xor(ss, 2); ss += __shfl_xor(ss, 4);
            p2_norm_rope(x1, x2, 1.0f / sqrtf(ss * (1.0f / 64.0f) + LN_EPS), kg1, kg2, cs, sn, 1.0f);
            const int key = isctx ? t : CTXL + t, blk = (lane & 15) >> 2;
            if (lane < 16) { bf16* dst = AK + ((size_t)(b * 2 + (blk >> 1)) * NKEY + key) * 64 + (blk & 1) * 32 + 4 * j; *(uint2*)dst = pack4(x1); *(uint2*)(dst + 16) = pack4(x2); }
            if (lane >= 32) { const int c = (lane - 32) * 4; *(uint2*)(AV + ((size_t)(b * 2 + (c >> 6)) * NKEY + key) * 64 + (c & 63)) = cur.vv; } }
#pragma unroll
        for (int q = 0; q < 4; ++q) { vp[q] = vc[q]; vc[q] = vn[q]; }
        un = un2; cn = cn2; cur = nxt;
    }
}
constexpr int RT_PITCH = 136;
__device__ __forceinline__ void p2_kv_job(const Args& A, int l, int u, LAS unsigned char* lds, int tid, int lane, int wave) {
    unsigned char* ws = KWS();
    const int h = u & 3, pf = (u >> 2) % NPF, b = (u >> 2) / NPF;
    const bool isctx = pf < 2; const int row0 = isctx ? (b * CTXL + pf * 128) : (RCTX + b * SEQL + (pf - 2) * 128);
    const bf16* Z = (const bf16*)(ws + WS_Z); const float2* rope = (const float2*)(ws + WS_ROPE);
    LAS unsigned short* VT = (LAS unsigned short*)(lds + RING_OFF); LAS unsigned short* KFT = VT + 64 * RT_PITCH; LAS unsigned short* KBT = KFT + 64 * RT_PITCH;
    const float lgf = log2_gamma(KIN(8)[(l * 2 + 0) * 4 + h]), lgb = log2_gamma(KIN(8)[(l * 2 + 1) * 4 + h]);
#pragma unroll
    for (int i = 0; i < 2; ++i) { const int idx = tid + 512 * i, t = idx >> 3, eg = idx & 7;
        const v4u v = *(const v4u*)(Z + (size_t)(row0 + t) * INW + ZC_RV + h * 64 + eg * 8);
        LAS unsigned short* d = VT + (eg * 8) * RT_PITCH + t;
        d[0 * RT_PITCH] = (unsigned short)(v.x & 0xffffu); d[1 * RT_PITCH] = (unsigned short)(v.x >> 16); d[2 * RT_PITCH] = (unsigned short)(v.y & 0xffffu); d[3 * RT_PITCH] = (unsigned short)(v.y >> 16);
        d[4 * RT_PITCH] = (unsigned short)(v.z & 0xffffu); d[5 * RT_PITCH] = (unsigned short)(v.z >> 16); d[6 * RT_PITCH] = (unsigned short)(v.w & 0xffffu); d[7 * RT_PITCH] = (unsigned short)(v.w >> 16); }
    { const int t = tid >> 2, axis = (tid >> 1) & 1, fg = tid & 1;
        const bf16* src = Z + (size_t)(row0 + t) * INW + ZC_RK + h * 64 + axis * 32 + 8 * fg;
        const v4u a = *(const v4u*)src, c = *(const v4u*)(src + 16);
        float x1[8] = {bflo(a.x), bfhi(a.x), bflo(a.y), bfhi(a.y), bflo(a.z), bfhi(a.z), bflo(a.w), bfhi(a.w)};
        float x2[8] = {bflo(c.x), bfhi(c.x), bflo(c.y), bfhi(c.y), bflo(c.z), bfhi(c.z), bflo(c.w), bfhi(c.w)};
        if (!isctx) { const int tt = (pf - 2) * 128 + t, pos = axis ? (tt & 63) : (tt >> 6); const float2* rp = rope + pos * 16 + 8 * fg;
#pragma unroll
            for (int i = 0; i < 8; ++i) { const float2 cs = rp[i]; const float p = x1[i] * cs.x - x2[i] * cs.y, q = x1[i] * cs.y + x2[i] * cs.x; x1[i] = p; x2[i] = q; } }
        const float wf = exp2f((float)(127 - t) * lgf) * 0.125f, wb = exp2f((float)t * lgb) * 0.125f;
        const int d0 = axis * 32 + 8 * fg;
#pragma unroll
        for (int i = 0; i < 8; ++i) {
            KFT[(d0 + i) * RT_PITCH + t] = (unsigned short)f2bf(x1[i] * wf); KFT[(d0 + 16 + i) * RT_PITCH + t] = (unsigned short)f2bf(x2[i] * wf);
            KBT[(d0 + i) * RT_PITCH + t] = (unsigned short)f2bf(x1[i] * wb); KBT[(d0 + 16 + i) * RT_PITCH + t] = (unsigned short)f2bf(x2[i] * wb); }
    }
    __syncthreads();
    { const int dir = wave >> 2, te = (wave >> 1) & 1, td = wave & 1, r32 = lane & 31, hh = lane >> 5;
        const LAS unsigned short* KT = dir ? KBT : KFT;
        f32x16 acc = {};
#pragma unroll
        for (int s = 0; s < 8; ++s) {
            const bf16x8 a = *(const LAS bf16x8*)(VT + (te * 32 + r32) * RT_PITCH + s * 16 + hh * 8);
            const bf16x8 bq = *(const LAS bf16x8*)(KT + (td * 32 + r32) * RT_PITCH + s * 16 + hh * 8);
            acc = __builtin_amdgcn_mfma_f32_32x32x16_bf16(a, bq, acc, 0, 0, 0);
        }
        float* out = (float*)(ws + WS_KVS) + ((size_t)((b * 4 + h) * NPF + pf) * 2 + dir) * 4096;
#pragma unroll
        for (int q = 0; q < 16; ++q) { const int e = te * 32 + (q & 3) + 8 * (q >> 2) + 4 * hh; out[e * 64 + td * 32 + r32] = acc[q]; }
    }
    __syncthreads();
}
__device__ __forceinline__ void p2(const Args& A, int l, LAS unsigned char* lds, int tid, int lane, int wave) {
    const bool last = (l == DEPTH - 1);
    for (int u = opaque_bid(); u < NBATCH * NPF * 4; u += gridDim.x) p2_kv_job(A, l, u, lds, tid, lane, wave);
    const int gw = opaque_bid() * NWAVES + wave, NGW = gridDim.x * NWAVES, RPW = (RTOT + NGW - 1) / NGW;
    { const int r0 = gw * RPW; p2_rows(A, l, r0, (r0 + RPW <= RTOT) ? RPW : ((RTOT > r0) ? RTOT - r0 : 0), last, lane); }
}

__device__ __forceinline__ void p4_scan(const Args& A, int l, int tid) {
    const float* KVS = (const float*)(KWS() + WS_KVS); bf16* SS = (bf16*)(KWS() + WS_SS);
    for (int gid = opaque_bid() * (NWAVES * 64) + tid; gid < NBATCH * 4 * 4096; gid += gridDim.x * NWAVES * 64) {
        const int bh = gid >> 12, ed = gid & 4095, h = bh & 3;
        const float gf = exp2f(128.0f * log2_gamma(KIN(8)[(l * 2 + 0) * 4 + h])), gb = exp2f(128.0f * log2_gamma(KIN(8)[(l * 2 + 1) * 4 + h]));
        const size_t base = (size_t)bh * NPF * 2 * 4096 + ed;
        float S = 0.f;
        for (int pf = 0; pf < NPF; ++pf) { const size_t o = base + (size_t)(pf * 2 + 0) * 4096; SS[o] = (bf16)f2bf(S); S = gf * S + KVS[o]; }
        S = 0.f;
        for (int q = 0; q < NPF; ++q) { const int pf = (q == 0) ? 1 : (q == 1) ? 0 : (NPF + 1 - q);
            const size_t o = base + (size_t)(pf * 2 + 1) * 4096; SS[o] = (bf16)f2bf(S); S = gb * S + KVS[o]; }
    }
}
__device__ __forceinline__ void p4_attention(const Args& A, int l, char* lds_ring) {
    using abf = attn_body::bf16;
    const abf* AQ = (const abf*)(KWS() + WS_AQ); const abf* AK = (const abf*)(KWS() + WS_AK); const abf* AV = (const abf*)(KWS() + WS_AV); abf* MIX = (abf*)(KWS() + WS_MIX);
    const int c = opaque_bid(), G = gridDim.x;
    const int x = c & 7, m = c >> 3, per = G >> 3, b = x;
    for (int i = 0; i < 5; ++i) {
        const bool isctx = (i == 4);
        if (isctx && (l == DEPTH - 1 || m >= 8)) break;
        const int uu = m + per * i; if (!isctx && uu >= 128) break;
        const int h = isctx ? m : (uu >> 4), kvh = h >> 2, NT = isctx ? (CTXL / 64) : (NKEY / 64);
        const size_t qrow = isctx ? (size_t)b * CTXL : (size_t)RCTX + (size_t)b * SEQL + (size_t)(uu & 15) * 256;
        attn_body::attn_unit<8>(AQ + qrow * 512 + h * 64, AK + (size_t)(b * 2 + kvh) * NKEY * 64, AV + (size_t)(b * 2 + kvh) * NKEY * 64, MIX + qrow * DM + 512 + h * 64, NT, lds_ring);
    }
}

__device__ __forceinline__ void p5_unit(const Args& A, int l, int g, int hp, LAS unsigned char* lds, int tid, int lane, int wave) {
    unsigned char* ws = KWS();
    const bf16* Z = (const bf16*)(ws + WS_Z); const bf16* RQ = (const bf16*)(ws + WS_RQ); const bf16* RK = (const bf16*)(ws + WS_RK); const bf16* SS = (const bf16*)(ws + WS_SS);
    bf16* MIX = (bf16*)(ws + WS_MIX);
    const int row0 = g * 128;
    int b, pf; if (g < 16) { b = g >> 1; pf = g & 1; } else { b = (g - 16) >> 5; pf = 2 + ((g - 16) & 31); }
    LAS unsigned short* VT = (LAS unsigned short*)(lds + RING_OFF);
#pragma unroll
    for (int i = 0; i < 4; ++i) { const int idx = tid + 512 * i, hl = idx >> 10, t = (idx >> 3) & 127, eg = idx & 7;
        const v4u v = *(const v4u*)(Z + (size_t)(row0 + t) * INW + ZC_RV + (2 * hp + hl) * 64 + eg * 8);
        LAS unsigned short* d = VT + (hl * 64 + eg * 8) * RT_PITCH + t;
        d[0 * RT_PITCH] = (unsigned short)(v.x & 0xffffu); d[1 * RT_PITCH] = (unsigned short)(v.x >> 16); d[2 * RT_PITCH] = (unsigned short)(v.y & 0xffffu); d[3 * RT_PITCH] = (unsigned short)(v.y >> 16);
        d[4 * RT_PITCH] = (unsigned short)(v.z & 0xffffu); d[5 * RT_PITCH] = (unsigned short)(v.z >> 16); d[6 * RT_PITCH] = (unsigned short)(v.w & 0xffffu); d[7 * RT_PITCH] = (unsigned short)(v.w >> 16); }
    __syncthreads();
    {
        const int hl = wave >> 2, h = 2 * hp + hl, ib = wave & 3, r32 = lane & 31, hh = lane >> 5;
        const float lgf = log2_gamma(KIN(8)[(l * 2 + 0) * 4 + h]), lgb = log2_gamma(KIN(8)[(l * 2 + 1) * 4 + h]);
        const int iloc = ib * 32 + r32;
        bf16x8 qf[4];
#pragma unroll
        for (int s = 0; s < 4; ++s) qf[s] = *(const bf16x8*)(RQ + (size_t)(row0 + iloc) * 256 + h * 64 + s * 16 + hh * 8);
        const bf16* Sf = SS + ((size_t)((b * 4 + h) * NPF + pf) * 2 + 0) * 4096; const bf16* Sb = Sf + 4096;
        f32x16 Y[2];
        {
            const float af = exp2f((float)(iloc + 1) * lgf), ab = exp2f((float)(128 - iloc) * lgb);
#pragma unroll
            for (int et = 0; et < 2; ++et) {
                f32x16 cf = {}, cb = {};
#pragma unroll
                for (int s = 0; s < 4; ++s) {
                    const bf16x8 a0 = *(const bf16x8*)(Sf + (et * 32 + r32) * 64 + s * 16 + hh * 8), a1 = *(const bf16x8*)(Sb + (et * 32 + r32) * 64 + s * 16 + hh * 8);
                    cf = __builtin_amdgcn_mfma_f32_32x32x16_bf16(a0, qf[s], cf, 0, 0, 0); cb = __builtin_amdgcn_mfma_f32_32x32x16_bf16(a1, qf[s], cb, 0, 0, 0);
                }
#pragma unroll
                for (int q = 0; q < 16; ++q) Y[et][q] = af * cf[q] + ab * cb[q];
            }
        }
        const LAS unsigned short* VTh = VT + hl * 64 * RT_PITCH;
        bf16x8 ka[4], kn[4];
#pragma unroll
        for (int s = 0; s < 4; ++s) ka[s] = *(const bf16x8*)(RK + (size_t)(row0 + r32) * 256 + h * 64 + s * 16 + hh * 8);
#pragma unroll 1
        for (int jt = 0; jt < 4; ++jt) {
            f32x16 X = {};
            { const int jn = (jt < 3) ? jt + 1 : jt;
#pragma unroll
                for (int s = 0; s < 4; ++s) kn[s] = *(const bf16x8*)(RK + (size_t)(row0 + jn * 32 + r32) * 256 + h * 64 + s * 16 + hh * 8); }
#pragma unroll
            for (int s = 0; s < 4; ++s) X = __builtin_amdgcn_mfma_f32_32x32x16_bf16(ka[s], qf[s], X, 0, 0, 0);
#pragma unroll
            for (int q = 0; q < 16; ++q) { const int jloc = jt * 32 + (q & 3) + 8 * (q >> 2) + 4 * hh; const int dl = iloc - jloc;
                X[q] *= __builtin_amdgcn_exp2f((dl >= 0) ? (float)dl * lgf : (float)(-dl) * lgb); }
#pragma unroll
            for (int s = 0; s < 2; ++s) {
                v4u pw; pw.x = pk2(X[8 * s + 0], X[8 * s + 1]); pw.y = pk2(X[8 * s + 2], X[8 * s + 3]); pw.z = pk2(X[8 * s + 4], X[8 * s + 5]); pw.w = pk2(X[8 * s + 6], X[8 * s + 7]);
                const bf16x8 bfrag = __builtin_bit_cast(bf16x8, pw);
#pragma unroll
                for (int et = 0; et < 2; ++et) {
                    const LAS unsigned short* vp = VTh + (et * 32 + r32) * RT_PITCH + jt * 32 + 16 * s + 4 * hh;
                    const v2u lo = *(const LAS v2u*)vp, hi2 = *(const LAS v2u*)(vp + 8);
                    v4u aw; aw.x = lo.x; aw.y = lo.y; aw.z = hi2.x; aw.w = hi2.y;
                    Y[et] = __builtin_amdgcn_mfma_f32_32x32x16_bf16(__builtin_bit_cast(bf16x8, aw), bfrag, Y[et], 0, 0, 0);
                }
            }
#pragma unroll
            for (int s = 0; s < 4; ++s) ka[s] = kn[s];
        }
        float s1 = 0.f;
#pragma unroll
        for (int q = 0; q < 16; ++q) s1 += Y[0][q] + Y[1][q];
        s1 += __shfl_xor(s1, 32); const float mu = s1 * (1.0f / 64.0f); float s2 = 0.f;
#pragma unroll
        for (int q = 0; q < 16; ++q) { const float d0 = Y[0][q] - mu, d1 = Y[1][q] - mu; s2 += d0 * d0 + d1 * d1; }
        s2 += __shfl_xor(s2, 32); const float rstd = 1.0f / sqrtf(s2 * (1.0f / 64.0f) + LN_EPS);
        const size_t row = (size_t)(row0 + iloc); const float* gng = KIN(9) + l * 256 + h * 64;
#pragma unroll
        for (int et = 0; et < 2; ++et)
#pragma unroll
            for (int q4 = 0; q4 < 4; ++q4) { const int e0 = et * 32 + 8 * q4 + 4 * hh;
                float gz[4]; unpack4(*(const uint2*)(Z + row * INW + ZC_RG + h * 64 + e0), gz);
                const f32x4 gn = *(const f32x4*)(gng + e0);
                float o[4];
#pragma unroll
                for (int i = 0; i < 4; ++i) { const float yn = (Y[et][4 * q4 + i] - mu) * rstd * gn[i]; o[i] = yn * gz[i] * __builtin_amdgcn_rcpf(1.0f + __builtin_amdgcn_exp2f(gz[i] * -1.4426950408889634f)); }
                *(uint2*)(MIX + row * DM + 256 + h * 64 + e0) = pack4(o); }
    }
    __syncthreads();
}
__device__ __forceinline__ void p5(const Args& A, int l, LAS unsigned char* lds, int tid, int lane, int wave) {
    const int g0 = (l == DEPTH - 1) ? 16 : 0;
    for (int u = opaque_bid(); u < (272 - g0) * 2; u += gridDim.x) p5_unit(A, l, g0 + (u >> 1), u & 1, lds, tid, lane, wave);
}

__device__ __forceinline__ float reduce32(float (&v)[32], int lane) {
#pragma unroll
    for (int i = 0; i < 16; ++i) { const bool up = lane & 32; const float send = up ? v[i] : v[i + 16], keep = up ? v[i + 16] : v[i]; v[i] = keep + __shfl_xor(send, 32); }
#pragma unroll
    for (int i = 0; i < 8; ++i) { const bool up = lane & 16; const float send = up ? v[i] : v[i + 8], keep = up ? v[i + 8] : v[i]; v[i] = keep + __shfl_xor(send, 16); }
#pragma unroll
    for (int i = 0; i < 4; ++i) { const bool up = lane & 8; const float send = up ? v[i] : v[i + 4], keep = up ? v[i + 4] : v[i]; v[i] = keep + __shfl_xor(send, 8); }
#pragma unroll
    for (int i = 0; i < 2; ++i) { const bool up = lane & 4; const float send = up ? v[i] : v[i + 2], keep = up ? v[i + 2] : v[i]; v[i] = keep + __shfl_xor(send, 4); }
    { const bool up = lane & 2; const float send = up ? v[0] : v[1], keep = up ? v[1] : v[0]; v[0] = keep + __shfl_xor(send, 2); }
    return v[0] + __shfl_xor(v[0], 1);
}
struct P7Raw { v4u x[4]; uint2 y[4]; };
__device__ __forceinline__ void p7_load(int l, int r, int lane, const float* xin_lat, const float* xin_ctx, const bf16* XSA, const bf16* Y, P7Raw& R) {
    if (l == 0) { const float* p = (r < RCTX) ? xin_ctx + (size_t)r * DM : xin_lat + (size_t)(r - RCTX) * DM;
#pragma unroll
        for (int j = 0; j < 4; ++j) R.x[j] = *(const v4u*)(p + 256 * j + 4 * lane); }
    else { const bf16* p = XSA + (size_t)r * DM;
#pragma unroll
        for (int j = 0; j < 4; ++j) { const uint2 u = *(const uint2*)(p + 256 * j + 4 * lane); R.x[j] = (v4u){u.x, u.y, 0u, 0u}; } }
    const bf16* q = Y + (size_t)r * DM;
#pragma unroll
    for (int j = 0; j < 4; ++j) R.y[j] = *(const uint2*)(q + 256 * j + 4 * lane);
}
__device__ __forceinline__ void p7_ln(int l, int r, int lane, const P7Raw& R, const float* mv, const float* lng, const float* lnb, bf16* XSA, unsigned char* H2, f32x4 (&hv)[4], bool doit) {
    f32x4 v[4];
#pragma unroll
    for (int j = 0; j < 4; ++j) {
        f32x4 x;
        if (l == 0) x = __builtin_bit_cast(f32x4, R.x[j]);
        else { const unsigned a = R.x[j][0], b = R.x[j][1]; x = (f32x4){bflo(a), bfhi(a), bflo(b), bfhi(b)}; }
        const f32x4 y = (f32x4){bflo(R.y[j].x), bfhi(R.y[j].x), bflo(R.y[j].y), bfhi(R.y[j].y)};
        const f32x4 g1 = *(const f32x4*)(mv + 2 * DM + 256 * j + 4 * lane); v[j] = ALPHA * x + g1 * y; }
    ln_row(v, lng, lnb, lane);
    if (doit) store_row_bf16(XSA + (size_t)r * DM, lane, v);
    modulate(v, mv + 4 * DM, mv + 3 * DM, lane, hv);
    if (doit)
#pragma unroll
    for (int j = 0; j < 4; ++j) *(unsigned*)(H2 + (size_t)r * DM + 256 * j + 4 * lane) = (unsigned)__builtin_amdgcn_cvt_pk_fp8_f32(hv[j][2], hv[j][3], __builtin_amdgcn_cvt_pk_fp8_f32(hv[j][0], hv[j][1], 0, false), true);
}
__device__ __forceinline__ void p7_route(const Args& A, float logit, int r, int rloc, int lane, LAS int* lcnt, LAS int* ent, float* RWout) {
    float val = logit; const int idx = lane >> 1; float tv[4]; int te[4];
#pragma unroll
    for (int k = 0; k < 4; ++k) {
        float bv = val; int bi = idx;
#pragma unroll
        for (int o = 1; o < 64; o <<= 1) { const float ov = __shfl_xor(bv, o); const int oi = __shfl_xor(bi, o); const bool take = (ov > bv) || (ov == bv && oi < bi); bv = take ? ov : bv; bi = take ? oi : bi; }
        tv[k] = bv; te[k] = bi; val = (idx == bi) ? -INFINITY : val;
    }
    const float p1 = expf(tv[1] - tv[0]), p2 = expf(tv[2] - tv[0]), p3 = expf(tv[3] - tv[0]); const float inv = 1.0f / (1.0f + p1 + p2 + p3);
    if (lane < 4) {
        const int e = (lane == 0) ? te[0] : (lane == 1) ? te[1] : (lane == 2) ? te[2] : te[3];
        const float w = ((lane == 0) ? 1.0f : (lane == 1) ? p1 : (lane == 2) ? p2 : p3) * inv;
        const int lp = __hip_atomic_fetch_add(lcnt + e, 1, __ATOMIC_RELAXED, __HIP_MEMORY_SCOPE_WORKGROUP);
        ent[rloc * 4 + lane] = e | (lp << 8);
        RWout[(size_t)r * 4 + lane] = w;
    }
}
template <bool DRY> __device__ __forceinline__ void p7(const Args& A, int l, LAS unsigned char* lds, int tid, int lane, int wave) {
    unsigned char* ws = KWS();
    const int row_lo = (l == DEPTH - 1) ? RCTX : 0, nrows = RTOT - row_lo;
    const int NGW = gridDim.x * NWAVES, RPW = (nrows + NGW - 1) / NGW, wg_row0 = row_lo + opaque_bid() * NWAVES * RPW;
    LAS f32x4* WL = (LAS f32x4*)(lds + RING_OFF);
    LAS int* lcnt = (LAS int*)(lds + LCNT_OFF); LAS int* lbase = (LAS int*)(lds + LBASE_OFF); LAS int* ent = (LAS int*)(lds + ENT_OFF);
    const float* wr = KIN(15) + (size_t)l * DM * NEXP;
    for (int s = tid; s < 8192; s += NWAVES * 64) { const int ln = s & 63, eg = (s >> 6) & 7, jc = s >> 9; const int k = 256 * (jc >> 2) + 4 * ln + (jc & 3);
        WL[s] = *(const f32x4*)(wr + (size_t)k * NEXP + 4 * eg); }
    if (tid < 32) lcnt[tid] = 0;
    __syncthreads();
    const float bias_e = KIN(16)[l * NEXP + (lane >> 1)];
    const int w_row0 = wg_row0 + wave * RPW;
    const float* xin_lat = KIN(0); const float* xin_ctx = KIN(2); const float* lng = KIN(13) + (size_t)(l * 2 + 0) * DM; const float* lnb = KIN(14) + (size_t)(l * 2 + 0) * DM;
    bf16* XSA = (bf16*)(ws + WS_XSA); const bf16* Yb = (const bf16*)(ws + WS_Y); unsigned char* H2 = ws + (DRY ? WS_XS2 + 128 * MiB : WS_H2); const float* MODV = (const float*)(ws + WS_MODV);
    bf16* XSAo = DRY ? (bf16*)(ws + WS_XS2) : XSA; float* RWo = (float*)(ws + (DRY ? WS_XS2 + 256 * MiB : WS_RW));
    const int nmy = (w_row0 + RPW <= RTOT) ? RPW : ((RTOT > w_row0) ? RTOT - w_row0 : 0);
    P7Raw cur, nxt;
    if (nmy > 0) p7_load(l, w_row0, lane, xin_lat, xin_ctx, XSA, Yb, cur);
    for (int i = 0; i < nmy; i += 2) {
        const int rA = w_row0 + i; const bool okB = (i + 1 < nmy); const int rB = okB ? rA + 1 : rA;
        f32x4 hA[4], hB[4];
        p7_load(l, rB, lane, xin_lat, xin_ctx, XSA, Yb, nxt);
        p7_ln(l, rA, lane, cur, MODV + (size_t)(l * 9 + mod_row(rA)) * NMOD, lng, lnb, XSAo, H2, hA, true);
        cur = nxt;
        p7_load(l, (i + 2 < nmy) ? rA + 2 : rB, lane, xin_lat, xin_ctx, XSA, Yb, nxt);
        p7_ln(l, rB, lane, cur, MODV + (size_t)(l * 9 + mod_row(rB)) * NMOD, lng, lnb, XSAo, H2, hB, okB);
        cur = nxt;
        f32x4 accA[8], accB[8];
#pragma unroll
        for (int eg = 0; eg < 8; ++eg) { accA[eg] = (f32x4){0.f, 0.f, 0.f, 0.f}; accB[eg] = (f32x4){0.f, 0.f, 0.f, 0.f}; }
#pragma unroll
        for (int j = 0; j < 4; ++j)
#pragma unroll
            for (int c = 0; c < 4; ++c) { const float xa = hA[j][c], xb = hB[j][c];
#pragma unroll
                for (int eg = 0; eg < 8; ++eg) { const f32x4 w = WL[((j * 4 + c) * 8 + eg) * 64 + lane]; accA[eg] = w * xa + accA[eg]; accB[eg] = w * xb + accB[eg]; } }
        float a0[32];
#pragma unroll
        for (int e = 0; e < 32; ++e) a0[e] = accA[e >> 2][e & 3];
        const float lgA = reduce32(a0, lane) + bias_e;
#pragma unroll
        for (int e = 0; e < 32; ++e) a0[e] = accB[e >> 2][e & 3];
        const float lgB = reduce32(a0, lane) + bias_e;
        p7_route(A, lgA, rA, rA - wg_row0, lane, lcnt, ent, RWo);
        if (okB) p7_route(A, lgB, rB, rB - wg_row0, lane, lcnt, ent, RWo);
    }
    __syncthreads();
    if (DRY) return;
    if (tid < 32) lbase[tid] = (int)__hip_atomic_fetch_add((unsigned*)(ws + WS_CTL) + CW_GCNT + (l * 32 + tid) * 16, (unsigned)lcnt[tid], __ATOMIC_RELAXED, __HIP_MEMORY_SCOPE_AGENT);
    __syncthreads();
    { const int nent = NWAVES * RPW * 4; int* RE = (int*)(ws + WS_RE); int* RP = (int*)(ws + WS_RP);
        for (int i = tid; i < nent; i += NWAVES * 64) { const int row = wg_row0 + (i >> 2); if (row < RTOT) { const int v = ent[i], e = v & 255, lp = v >> 8;
            RE[(size_t)row * 4 + (i & 3)] = e; RP[(size_t)row * 4 + (i & 3)] = lbase[e] + lp; } } }
    __syncthreads();
}
__device__ __forceinline__ void moe_offsets(const Args& A, int l, LAS unsigned char* lds, int tid) {
    volatile LAS int* offt = (volatile LAS int*)(lds + OFFT_OFF);
    if (tid < 64) {
        const unsigned c = __hip_atomic_load((unsigned*)(KWS() + WS_CTL) + CW_GCNT + (l * 32 + (tid & 31)) * 16, __ATOMIC_RELAXED, __HIP_MEMORY_SCOPE_AGENT);
        int x = (int)((c + 255u) >> 8);
#pragma unroll
        for (int o = 1; o < 32; o <<= 1) { const int v = __shfl_up(x, o); if ((tid & 31) >= o) x += v; }
        if (tid < 32) offt[tid + 1] = x;
        if (tid == 0) offt[0] = 0;
    }
    __syncthreads();
}
__device__ __forceinline__ void p8(const Args& A, int l, LAS unsigned char* lds, int tid, int lane, int wave) {
    unsigned char* ws = KWS();
    moe_offsets(A, l, lds, tid);
    volatile LAS int* offt = (volatile LAS int*)(lds + OFFT_OFF);
    const int row_lo = (l == DEPTH - 1) ? RCTX : 0, nrows = RTOT - row_lo;
    const int NGW = gridDim.x * NWAVES, RPW = (nrows + NGW - 1) / NGW, w_row0 = row_lo + (opaque_bid() * NWAVES + wave) * RPW;
    const int* RE = (const int*)(ws + WS_RE); const int* RP = (const int*)(ws + WS_RP); const float* RW = (const float*)(ws + WS_RW);
    int* SLOT = (int*)(ws + WS_SLOT); float* ROWW = (float*)(ws + WS_ROWW); const unsigned char* H2 = ws + WS_H2; unsigned char* XS2 = ws + WS_XS2;
    const int nmy = (w_row0 + RPW <= RTOT) ? RPW : ((RTOT > w_row0) ? RTOT - w_row0 : 0);
    int sa = 0, sb = 0; float wa = 0.f, wb = 0.f;
    if (lane < nmy * 4) { const size_t q = (size_t)w_row0 * 4 + lane; sa = offt[RE[q] & 31] * 256 + RP[q]; wa = RW[q]; SLOT[q] = sa; ROWW[sa] = wa; }
    if (64 + lane < nmy * 4) { const size_t q = (size_t)w_row0 * 4 + 64 + lane; sb = offt[RE[q] & 31] * 256 + RP[q]; wb = RW[q]; SLOT[q] = sb; ROWW[sb] = wb; }
    v4u cur = {0u, 0u, 0u, 0u}, nxt;
    if (nmy > 0) cur = *(const v4u*)(H2 + (size_t)w_row0 * DM + 16 * lane);
    for (int i = 0; i < nmy; ++i) {
        const int r = w_row0 + i;
        nxt = *(const v4u*)(H2 + (size_t)((i + 1 < nmy) ? r + 1 : r) * DM + 16 * lane);
#pragma unroll
        for (int k = 0; k < 4; ++k) { const int idx = 4 * i + k; const int slot = (idx < 64) ? __builtin_amdgcn_readlane(sa, idx & 63) : __builtin_amdgcn_readlane(sb, idx & 63);
            *(v4u*)(XS2 + (size_t)slot * DM + 16 * lane) = cur; }
        cur = nxt;
    }
}
__device__ __forceinline__ void moe_order(pg8::MoeOrder& S, LAS unsigned char* lds, int sh) {
    volatile LAS int* offt = (volatile LAS int*)(lds + OFFT_OFF);
#pragma unroll
    for (int j = 0; j < 11; ++j) { unsigned w = 0;
#pragma unroll
        for (int q = 0; q < 3; ++q) { const int k = 3 * j + q + 1; if (k <= 32) w |= ((unsigned)offt[k] & 1023u) << (10 * q); }
        S.pk[j] = (unsigned)__builtin_amdgcn_readfirstlane((int)w); }
    S.nt = __builtin_amdgcn_readfirstlane(offt[32]); S.sh = sh; S.G = gridDim.x; S.c = opaque_bid();
}
struct P11Raw { unsigned y[4][4]; uint2 x[4]; };
__device__ __forceinline__ void p11_load(int r, int lane, int s0, int s1, int s2, int s3, const unsigned char* YB, const bf16* XSA, P11Raw& R) {
    const int sl[4] = {s0, s1, s2, s3};
#pragma unroll
    for (int k = 0; k < 4; ++k) { const unsigned char* p = YB + (size_t)sl[k] * DM;
#pragma unroll
        for (int j = 0; j < 4; ++j) R.y[k][j] = *(const unsigned*)(p + 256 * j + 4 * lane); }
    const bf16* q = XSA + (size_t)r * DM;
#pragma unroll
    for (int j = 0; j < 4; ++j) R.x[j] = *(const uint2*)(q + 256 * j + 4 * lane);
}
template <bool DRY> __device__ __forceinline__ void p11(const Args& A, int l, int lane, int wave) {
    unsigned char* ws = KWS();
    const bool last = (l == DEPTH - 1);
    const int row_lo = last ? RCTX : 0, nrows = RTOT - row_lo;
    const int NGW = gridDim.x * NWAVES, RPW = (nrows + NGW - 1) / NGW, w_row0 = row_lo + (opaque_bid() * NWAVES + wave) * RPW;
    const int* SLOT = (const int*)(ws + WS_SLOT); const unsigned char* YB = ws + WS_YB; bf16* XSA = (bf16*)(ws + WS_XSA); bf16* XH = (bf16*)(ws + WS_XH);
    const float* MODV = (const float*)(ws + WS_MODV); float* outp = DRY ? (float*)(ws + WS_ACT) : KOUT();
    bf16* XSAo = DRY ? (bf16*)(ws + WS_ACT) : XSA; if (DRY) XH = (bf16*)(ws + WS_ACT + 128 * MiB);
    const float* lng = KIN(13) + (size_t)(l * 2 + 1) * DM; const float* lnb = KIN(14) + (size_t)(l * 2 + 1) * DM;
    const int nmy = (w_row0 + RPW <= RTOT) ? RPW : ((RTOT > w_row0) ? RTOT - w_row0 : 0);
    const int sa = (lane < nmy * 4) ? SLOT[(size_t)w_row0 * 4 + lane] : 0, sb = (64 + lane < nmy * 4) ? SLOT[(size_t)w_row0 * 4 + 64 + lane] : 0;
    const float* RW = (const float*)(ws + WS_RW);
    const float wa = (lane < nmy * 4) ? RW[(size_t)w_row0 * 4 + lane] : 0.f, wb = (64 + lane < nmy * 4) ? RW[(size_t)w_row0 * 4 + 64 + lane] : 0.f;
#define P11_SLOT(idx) (((idx) < 64) ? __builtin_amdgcn_readlane(sa, (idx) & 63) : __builtin_amdgcn_readlane(sb, (idx) & 63))
    P11Raw cur, nxt;
    if (nmy > 0) p11_load(w_row0, lane, P11_SLOT(0), P11_SLOT(1), P11_SLOT(2), P11_SLOT(3), YB, XSA, cur);
    for (int i = 0; i < nmy; ++i) {
        const int r = w_row0 + i;
        { const int in = (i + 1 < nmy) ? i + 1 : i, q = 4 * in; p11_load(w_row0 + in, lane, P11_SLOT(q), P11_SLOT(q + 1), P11_SLOT(q + 2), P11_SLOT(q + 3), YB, XSA, nxt); }
        const float* mv = MODV + (size_t)(l * 9 + mod_row(r)) * NMOD;
        float wk[4];
#pragma unroll
        for (int k = 0; k < 4; ++k) { const int idx = 4 * i + k; wk[k] = __builtin_bit_cast(float, (idx < 64) ? __builtin_amdgcn_readlane(__builtin_bit_cast(int, wa), idx & 63) : __builtin_amdgcn_readlane(__builtin_bit_cast(int, wb), idx & 63)); }
        f32x4 v[4];
#pragma unroll
        for (int j = 0; j < 4; ++j) {
            f32x4 f = {0.f, 0.f, 0.f, 0.f};
#pragma unroll
            for (int k = 0; k < 4; ++k) { typedef float f32x2_ __attribute__((ext_vector_type(2))); const f32x2_ lo = __builtin_amdgcn_cvt_pk_f32_fp8((int)cur.y[k][j], false), hi = __builtin_amdgcn_cvt_pk_f32_fp8((int)cur.y[k][j], true); f += (f32x4){lo[0], lo[1], hi[0], hi[1]} * wk[k]; }
            const f32x4 x = (f32x4){bflo(cur.x[j].x), bfhi(cur.x[j].x), bflo(cur.x[j].y), bfhi(cur.x[j].y)};
            const f32x4 g2 = *(const f32x4*)(mv + 5 * DM + 256 * j + 4 * lane); v[j] = ALPHA * x + g2 * f; }
        ln_row(v, lng, lnb, lane);
        if (last) store_row_f32(outp + (size_t)(r - RCTX) * DM, lane, v);
        else { store_row_bf16(XSAo + (size_t)r * DM, lane, v);
            const float* mn = MODV + (size_t)((l + 1) * 9 + mod_row(r)) * NMOD; f32x4 o[4]; modulate(v, mn + 1 * DM, mn + 0 * DM, lane, o);
            store_row_bf16(XH + (size_t)r * DM, lane, o); }
        cur = nxt;
    }
#undef P11_SLOT
}

#define GRID_BAR() do { if (N_LAUNCHES == 1) { xcd_barrier(bar); } } while (0)
#define IN(k) (lo <= (k) && (k) < hi)
#define SEAM(k) do { if (IN(k) && IN((k) + 1)) { GRID_BAR(); if (((PROBE_MASK) >> 15) & 1) GRID_BAR(); } } while (0)
#ifndef PROBE_MASK
#define PROBE_MASK 0
#endif
#define REP(p) for (int rep_ = 0; rep_ < (((PROBE_MASK) >> (p)) & 1) + 1; ++rep_)
#define IDS() const int tid = opaque_tid(), lane = tid & 63, wave = __builtin_amdgcn_readfirstlane(tid >> 6); (void)lane; (void)wave
template <int L> __device__ __forceinline__ void layer_phases(const Args& args, LAS unsigned char* lds, unsigned char* lds_raw, const XcdBarrier& bar, int lo, int hi) {
        constexpr int l = L;
        const int pb = N_PRO + l * N_PER_LAYER; const bool last = (l == DEPTH - 1);
        if (IN(pb + 0)) REP(0) { unsigned char* ws = KWS();
            pg8::Gemm g{(const bf16*)(ws + WS_XH), (const bf16*)(ws + WS_WIN) + (size_t)l * INW * DM, RTOT, INW, DM}; pg8::StaticOrder S; S.init(RTOT, INW, (int)gridDim.x, opaque_bid());
            pg8::EpiBf16 E{(bf16*)(ws + WS_Z), INW};
            pg8::gemm_phase<pg8::EpiBf16, pg8::StaticOrder, true, true>(lds + RING_OFF, g, S, E);
        } SEAM(pb + 0);
        if (IN(pb + 1)) REP(1) { IDS(); p2(args, l, lds, tid, lane, wave); } SEAM(pb + 1);
        if (IN(pb + 2)) REP(2) { IDS(); p4_scan(args, l, tid); p4_attention(args, l, (char*)lds_raw + RING_OFF); } SEAM(pb + 2);
        if (IN(pb + 3)) REP(3) { IDS(); p5(args, l, lds, tid, lane, wave); } SEAM(pb + 3);
        if (IN(pb + 4)) REP(4) { unsigned char* ws = KWS();
            const int r0 = last ? RCTX : 0, M = RTOT - r0;
            pg8::Gemm g{(const bf16*)(ws + WS_MIX) + (size_t)r0 * DM, (const bf16*)(ws + WS_WOUT) + (size_t)l * DM * DM, M, DM, DM}; pg8::StaticOrder S; S.init(M, DM, (int)gridDim.x, opaque_bid());
            pg8::EpiBf16 E{(bf16*)(ws + WS_Y) + (size_t)r0 * DM, DM};
            pg8::gemm_phase<pg8::EpiBf16, pg8::StaticOrder, true, true>(lds + RING_OFF, g, S, E);
        } SEAM(pb + 4);
        if (IN(pb + 5)) { IDS(); if (((PROBE_MASK) >> 13) & 1) p7<true>(args, l, lds, tid, lane, wave); p7<false>(args, l, lds, tid, lane, wave); } SEAM(pb + 5);
        if (IN(pb + 6)) REP(6) { IDS(); p8(args, l, lds, tid, lane, wave); } SEAM(pb + 6);
        if (IN(pb + 7)) {
            { IDS(); unsigned char* ws = KWS();
            moe_offsets(args, l, lds, tid);
            pg8::MoeOrder S; moe_order(S, lds, 3);
            pg8::Gemm g{(const bf16*)(ws + WS_XS2), (const bf16*)(ws + WS_WGU + (size_t)l * NEXP * 2048 * DM), MAXTILES * 256, NEXP * 2048, DM / 2};
            pg8::EpiSwiglu E{ws + WS_ACT, KIN(18) + (size_t)l * NEXP * 2048};
            pg8::gemm_phase<pg8::EpiSwiglu, pg8::MoeOrder, true, true, true>(lds + RING_OFF, g, S, E);
        }
            if (((PROBE_MASK) >> 16) & 1) { IDS(); unsigned char* ws = KWS();
            moe_offsets(args, l, lds, tid);
            pg8::MoeOrder S; moe_order(S, lds, 3);
            pg8::Gemm g{(const bf16*)(ws + WS_XS2), (const bf16*)(ws + WS_WGU + (size_t)l * NEXP * 2048 * DM), MAXTILES * 256, NEXP * 2048, DM / 2};
            pg8::EpiSwiglu E{ws + WS_ACT, KIN(18) + (size_t)l * NEXP * 2048};
            pg8::gemm_phase<pg8::EpiSwiglu, pg8::MoeOrder, true, true, true>(lds + RING_OFF, g, S, E);
        }
        } SEAM(pb + 7);
        if (IN(pb + 8)) {
            { IDS(); unsigned char* ws = KWS();
            moe_offsets(args, l, lds, tid);
            pg8::MoeOrder S; moe_order(S, lds, 2);
            pg8::Gemm g{(const bf16*)(ws + WS_ACT), (const bf16*)(ws + WS_WD + (size_t)l * NEXP * DM * DM), MAXTILES * 256, NEXP * DM, DM / 2};
            pg8::EpiDown E{ws + WS_YB, KIN(20) + (size_t)l * NEXP * DM};
            pg8::gemm_phase<pg8::EpiDown, pg8::MoeOrder, true, true, true>(lds + RING_OFF, g, S, E);
        }
            if (((PROBE_MASK) >> 17) & 1) { IDS(); unsigned char* ws = KWS();
            moe_offsets(args, l, lds, tid);
            pg8::MoeOrder S; moe_order(S, lds, 2);
            pg8::Gemm g{(const bf16*)(ws + WS_ACT), (const bf16*)(ws + WS_WD + (size_t)l * NEXP * DM * DM), MAXTILES * 256, NEXP * DM, DM / 2};
            pg8::EpiDown E{ws + WS_YB, KIN(20) + (size_t)l * NEXP * DM};
            pg8::gemm_phase<pg8::EpiDown, pg8::MoeOrder, true, true, true>(lds + RING_OFF, g, S, E);
        }
        } SEAM(pb + 8);
        if (IN(pb + 9)) { IDS(); if (((PROBE_MASK) >> 14) & 1) p11<true>(args, l, lane, wave); p11<false>(args, l, lane, wave); } SEAM(pb + 9);
}

__global__ void __launch_bounds__(NWAVES * 64, 2) mk_fwd(Args args) {
    extern __shared__ __attribute__((aligned(16))) unsigned char lds_raw[];
    LAS unsigned char* lds = (LAS unsigned char*)lds_raw;
    volatile LAS unsigned* MISC = (volatile LAS unsigned*)(lds + MISC_OFF);
    gu32* ctl = (gu32*)(KWS() + WS_CTL);
    for (int u = threadIdx.x; u < (LDS_BYTES - LDSCTL_OFF) / 4; u += NWAVES * 64) ((LAS unsigned*)(lds + LDSCTL_OFF))[u] = 0u;
    __syncthreads();
    XcdBarrier bar; bar.bar = (unsigned*)(ctl + CW_BAR); bar.x = 0; bar.st = nullptr;
    if (N_LAUNCHES == 1) bar = xcd_barrier_post((unsigned*)(ctl + CW_BAR), MISC + 8);
    const int lo = args.ph_lo, hi = args.ph_hi;

    if (IN(0)) REP(10) { IDS(); p0a(args, lds, tid, lane, wave); } SEAM(0);
    if (IN(1)) REP(11) { IDS(); p0b(args, tid); } SEAM(1);
    if (IN(2)) REP(12) { IDS(); p0c(args, lane, wave); } SEAM(2);

    layer_phases<0>(args, lds, lds_raw, bar, lo, hi);
    layer_phases<1>(args, lds, lds_raw, bar, lo, hi);
    static_assert(DEPTH == 2, "two layer instances");
}
#undef IN
#undef IDS
#undef SEAM
#undef GRID_BAR

extern "C" void kernel_launch(void* const* d_in, const int* in_sizes, int n_in, void* d_out, int out_size, void* d_ws, size_t ws_size, hipStream_t stream) {
    static int grid = 0;
    if (grid == 0) {
        if (n_in != 21 || in_sizes[0] != RLAT * DM || out_size != RLAT * DM || ws_size < WS_END) { fprintf(stderr, "kernel_launch: unexpected shapes / workspace (n_in %d, ws %zu < %zu); nothing launched\n", n_in, ws_size, (size_t)WS_END); grid = -1; return; }
        int dev = 0, cus = 0, per_cu = 0;
        if (hipGetDevice(&dev) != hipSuccess || hipDeviceGetAttribute(&cus, hipDeviceAttributeMultiprocessorCount, dev) != hipSuccess) { grid = -1; return; }
        if (hipFuncSetAttribute((const void*)mk_fwd, hipFuncAttributeMaxDynamicSharedMemorySize, LDS_BYTES) != hipSuccess) { fprintf(stderr, "kernel_launch: hipFuncSetAttribute failed\n"); grid = -1; return; }
        if (hipOccupancyMaxActiveBlocksPerMultiprocessor(&per_cu, (const void*)mk_fwd, NWAVES * 64, LDS_BYTES) != hipSuccess || per_cu < 1) fprintf(stderr, "kernel_launch: occupancy query reports %d\n", per_cu);
        (void)hipGetLastError();
        grid = cus;
        if (grid != 256) { fprintf(stderr, "kernel_launch: built for 256 CUs, found %d; nothing launched\n", grid); grid = -1; return; }
    }
    if (grid < 0) return;
    if (hipMemsetAsync((char*)d_ws + WS_CTL, 0, CTL_ZERO_BYTES, stream) != hipSuccess) return;
    Args a{};
    for (int i = 0; i < 21; ++i) a.in[i] = (const float*)d_in[i];
    a.out = (float*)d_out; a.ws = (unsigned char*)d_ws; a.pad = 0;
    for (int li = 0; li < N_LAUNCHES; ++li) {
        a.ph_lo = (N_LAUNCHES == 1) ? 0 : li; a.ph_hi = (N_LAUNCHES == 1) ? N_PHASES : li + 1; a.li = li;
        hipLaunchKernelGGL(mk_fwd, dim3(grid), dim3(NWAVES * 64), LDS_BYTES, stream, a);
        const hipError_t le = hipPeekAtLastError();
        if (le != hipSuccess) { fprintf(stderr, "kernel_launch: launch %d failed: %s\n", li, hipGetErrorName(le)); break; }
    }
}
```

```cpp
#include <hip/hip_runtime.h>
#include <cstdio>
#include <cstdint>
__device__ __forceinline__ int opaque_tid() { int t = (int)threadIdx.x; asm volatile("" : "+v"(t)); return t; }
__device__ __forceinline__ int opaque_bid() { int b = (int)blockIdx.x; asm volatile("" : "+s"(b)); return b; }
namespace pg8 {
#define PG8_LAS __attribute__((address_space(3)))
typedef unsigned short bf16_t;
typedef short bf16x8 __attribute__((ext_vector_type(8)));
typedef float f32x4 __attribute__((ext_vector_type(4)));
typedef unsigned u32x4 __attribute__((ext_vector_type(4)));
constexpr int BM = 256, BK = 64, HALF = 128, HTB = HALF * BK * 2  , STAGE_BYTES = 8 * HTB, NXCD = 8, WGM = 8;

__host__ __device__ __forceinline__ int lds_byte(int r, int c) { const int st = (r >> 4) * 2 + (c >> 5), rr = r & 15, cc = c & 31, ob = rr * 64 + cc * 2; return st * 1024 + (ob ^ (((ob >> 9) & 1) << 5)); }
__host__ __device__ __forceinline__ void stage_rc(int b, int& R, int& C) { const int st = b / 1024, sb = b % 1024, swz = sb ^ (((sb >> 9) & 1) << 5); R = (st >> 1) * 16 + swz / 64; C = (st & 1) * 32 + (swz % 64) / 2; }
__host__ __device__ __forceinline__ int perm32(int rho) { const int n = rho >> 4, i = rho & 15; return 8 * (i >> 2) + 4 * n + (i & 3); }

struct Unit { int pm, pn; };
struct Gemm { const bf16_t* A; const bf16_t* Bt; int M, N, K; };

struct StaticOrder {
    int nM, nN, nwg, G, c;
    __host__ __device__ void init(int M, int N, int G_, int c_) { nM = M / BM; nN = N / BM; nwg = nM * nN; G = G_; c = c_; }
    __host__ __device__ bool next(int i, Unit& u) const {
        const long L = (long)i * G + c; if (L >= nwg) return false;
        int wgid = (int)L; { const int q = nwg / NXCD, r = nwg % NXCD, xcd = wgid % NXCD, off = wgid / NXCD; wgid = (xcd < r ? xcd * (q + 1) : r * (q + 1) + (xcd - r) * q) + off; }
        const int nig = WGM * nN, gid = wgid / nig, fm = gid * WGM, gsz = (nM - fm) < WGM ? (nM - fm) : WGM;
        u.pm = fm + ((wgid % nig) % gsz); u.pn = (wgid % nig) / gsz; return true;
    }
    __device__ __forceinline__ void a_ready(const Unit&) const {}
    __device__ __forceinline__ void done(const Unit&) const {}
};

__device__ __forceinline__ unsigned cvt_pk_bf16(float lo, float hi) { unsigned r; asm volatile("v_cvt_pk_bf16_f32 %0, %1, %2" : "=v"(r) : "v"(lo), "v"(hi)); return r; }
typedef float f32x2 __attribute__((ext_vector_type(2)));
struct EpiBf16 {
    static constexpr bool PERM = true, AFTER_DRAIN = false;
    bf16_t* O; int ldc;
    __device__ __forceinline__ void init(f32x4 (&acc)[2][2][4][2], const Unit&, int, int) const {
#pragma unroll
        for (int a = 0; a < 2; ++a)
#pragma unroll
            for (int b = 0; b < 2; ++b)
#pragma unroll
                for (int m = 0; m < 4; ++m)
#pragma unroll
                    for (int n = 0; n < 2; ++n) acc[a][b][m][n] = (f32x4){0.f, 0.f, 0.f, 0.f};
    }
    __device__ __forceinline__ void operator()(const f32x4 (&acc)[2][2][4][2], const Unit& u, int wr, int wc, int fr, int fq) const {
        const int row0 = u.pm * BM + wr * 64 + fr; const int col0 = u.pn * BM + wc * 32 + 8 * fq;
#pragma unroll
        for (int ai = 0; ai < 2; ++ai)
#pragma unroll
            for (int m = 0; m < 4; ++m) { bf16_t* rowp = O + (size_t)(row0 + ai * HALF + m * 16) * ldc + col0;
#pragma unroll
                for (int bj = 0; bj < 2; ++bj) { const f32x4 v0 = acc[ai][bj][m][0], v1 = acc[ai][bj][m][1];
                    u32x4 w; w.x = cvt_pk_bf16(v0[0], v0[1]); w.y = cvt_pk_bf16(v0[2], v0[3]); w.z = cvt_pk_bf16(v1[0], v1[1]); w.w = cvt_pk_bf16(v1[2], v1[3]);
                    *(u32x4*)(rowp + bj * HALF) = w; } }
    }
};
struct EpiSwiglu {
    static constexpr bool PERM = true, AFTER_DRAIN = false;
    unsigned char* O; const float* bias;
    static __device__ __forceinline__ f32x2 act2(f32x2 g, f32x2 up) {
        g = __builtin_elementwise_min(g, (f32x2){7.0f, 7.0f}); up = __builtin_elementwise_min(__builtin_elementwise_max(up, (f32x2){-7.0f, -7.0f}), (f32x2){7.0f, 7.0f});
        const f32x2 z = g * (-1.702f * 1.4426950408889634f); f32x2 d; d.x = __builtin_amdgcn_exp2f(z.x); d.y = __builtin_amdgcn_exp2f(z.y); d = d + 1.0f;
        f32x2 s; s.x = __builtin_amdgcn_rcpf(d.x); s.y = __builtin_amdgcn_rcpf(d.y);
        return (up + 1.0f) * (g * s);
    }
    __device__ __forceinline__ void init(f32x4 (&acc)[2][2][4][2], const Unit& u, int wc, int fq) const {
        const int e = u.pn >> 3, pnl = u.pn & 7; const int j0 = pnl * HALF + wc * 32 + 8 * fq;
        const float* bg = bias + (size_t)e * 2048 + j0; const float* bu = bg + 1024;
#pragma unroll
        for (int n = 0; n < 2; ++n) { const f32x4 g = *(const f32x4*)(bg + 4 * n) * 32.0f, up = *(const f32x4*)(bu + 4 * n) * 32.0f;
#pragma unroll
            for (int a = 0; a < 2; ++a)
#pragma unroll
                for (int m = 0; m < 4; ++m) { acc[a][0][m][n] = g; acc[a][1][m][n] = up; } }
    }
    __device__ __forceinline__ void operator()(const f32x4 (&acc)[2][2][4][2], const Unit& u, int wr, int wc, int fr, int fq) const {
        const int pnl = u.pn & 7;
        const int row0 = u.pm * BM + wr * 64 + fr; const int j0 = pnl * HALF + wc * 32 + 8 * fq;
#pragma unroll
        for (int ai = 0; ai < 2; ++ai)
#pragma unroll
            for (int m = 0; m < 4; ++m) { unsigned char* rowp = O + (size_t)(row0 + ai * HALF + m * 16) * 1024 + j0;
                typedef unsigned u32x2 __attribute__((ext_vector_type(2))); u32x2 w;
#pragma unroll
                for (int n = 0; n < 2; ++n) { const f32x4 g = acc[ai][0][m][n] * 0.03125f, up = acc[ai][1][m][n] * 0.03125f;
                    const f32x2 r0 = act2((f32x2){g[0], g[1]}, (f32x2){up[0], up[1]}), r1 = act2((f32x2){g[2], g[3]}, (f32x2){up[2], up[3]});
                    const unsigned pk = (unsigned)__builtin_amdgcn_cvt_pk_fp8_f32(r1.x, r1.y, __builtin_amdgcn_cvt_pk_fp8_f32(r0.x, r0.y, 0, false), true);
                    if (n == 0) w.x = pk; else w.y = pk; }
                *(u32x2*)rowp = w; }
    }
};
struct EpiDown {
    static constexpr bool PERM = true, AFTER_DRAIN = false;
    unsigned char* O; const float* bias;
    __device__ __forceinline__ void init(f32x4 (&acc)[2][2][4][2], const Unit& u, int wc, int fq) const {
        const int e = u.pn >> 2, pnl = u.pn & 3; const float* bp = bias + (size_t)e * 1024 + pnl * BM + wc * 32 + 8 * fq;
#pragma unroll
        for (int bj = 0; bj < 2; ++bj)
#pragma unroll
            for (int n = 0; n < 2; ++n) { const f32x4 b = *(const f32x4*)(bp + bj * HALF + 4 * n) * 64.0f;
#pragma unroll
                for (int a = 0; a < 2; ++a)
#pragma unroll
                    for (int m = 0; m < 4; ++m) acc[a][bj][m][n] = b; }
    }
    __device__ __forceinline__ void operator()(const f32x4 (&acc)[2][2][4][2], const Unit& u, int wr, int wc, int fr, int fq) const {
        const int pnl = u.pn & 3;
        const int row0 = u.pm * BM + wr * 64 + fr; const int col0 = pnl * BM + wc * 32 + 8 * fq;
#pragma unroll
        for (int ai = 0; ai < 2; ++ai)
#pragma unroll
            for (int m = 0; m < 4; ++m) { unsigned char* rowp = O + (size_t)(row0 + ai * HALF + m * 16) * 1024 + col0;
#pragma unroll
                for (int bj = 0; bj < 2; ++bj) { const f32x4 v0 = acc[ai][bj][m][0] * 0.015625f, v1 = acc[ai][bj][m][1] * 0.015625f;
                    typedef unsigned u32x2 __attribute__((ext_vector_type(2))); u32x2 w;
                    w.x = (unsigned)__builtin_amdgcn_cvt_pk_fp8_f32(v0[2], v0[3], __builtin_amdgcn_cvt_pk_fp8_f32(v0[0], v0[1], 0, false), true);
                    w.y = (unsigned)__builtin_amdgcn_cvt_pk_fp8_f32(v1[2], v1[3], __builtin_amdgcn_cvt_pk_fp8_f32(v1[0], v1[1], 0, false), true);
                    *(u32x2*)(rowp + bj * HALF) = w; } }
    }
};
struct MoeOrder {
    unsigned pk[11]; int nt, sh, G, c;
    __device__ __forceinline__ bool next(int i, Unit& u) const {
        const int x = c & 7, m = c >> 3, per = G >> 3;
        const int t0 = (nt * x) >> 3, t1 = (nt * (x + 1)) >> 3;
        const int v = m + i * per, tile = t0 + (v >> sh), pnl = v & ((1 << sh) - 1);
        if (tile >= t1) return false;
        int e = 0;
#pragma unroll
        for (int k = 1; k < 32; ++k) { const int off = (int)((pk[(k - 1) / 3] >> (10 * ((k - 1) % 3))) & 1023u); e += (off <= tile) ? 1 : 0; }
        u.pm = __builtin_amdgcn_readfirstlane(tile); u.pn = __builtin_amdgcn_readfirstlane((e << sh) + pnl); return true;
    }
    __device__ __forceinline__ void a_ready(const Unit&) const {}
    __device__ __forceinline__ void done(const Unit&) const {}
};

template <class Epi, class Sched, bool ALIGN_EPI = false, bool SP2 = false, bool F8 = false>
__device__ __forceinline__ void gemm_phase(PG8_LAS unsigned char* lds, const Gemm g, const Sched& S, const Epi& E) {
    const int tid = opaque_tid(), wid = __builtin_amdgcn_readfirstlane(tid >> 6), lane = tid & 63, wr = wid >> 2, wc = wid & 3, fr = lane & 15, fq = lane >> 4;
    const int K = g.K, nt = K / BK;
    unsigned voffA[2], voffB[2];
#pragma unroll
    for (int i = 0; i < 2; ++i) { int R, C; stage_rc(tid * 16 + i * 8192, R, C); const int Rb = Epi::PERM ? ((R & ~31) + perm32(R & 31)) : R;
        voffA[i] = (unsigned)(R * K + C) * 2u; voffB[i] = (unsigned)(Rb * K + C) * 2u; }
    const size_t kstep = (size_t)(BK * 2);
    const size_t hstep = (size_t)HALF * K * 2;
    const size_t tstep = 2 * hstep;
    const unsigned ldsw = (unsigned)wid * 1024u;
    const int aoff = lds_byte(wr * 64 + fr, fq * 8), boff = lds_byte(wc * 32 + fr, fq * 8);
#define PG8_SA(b, h) (((b) * 2 + (h)) * HTB)
#define PG8_SB(b, h) ((4 + (b) * 2 + (h)) * HTB)
#define PG8_STAGE(bufoff, gbase, voff) do { _Pragma("unroll") for (int _i = 0; _i < 2; ++_i) { unsigned vo_ = (voff)[_i]; asm volatile("" : "+v"(vo_));     \
        __builtin_amdgcn_global_load_lds((const unsigned*)((const char*)(gbase) + vo_), (PG8_LAS unsigned*)(lds + (bufoff) + ldsw + _i * 8192), 16, 0, 0); } } while (0)
#define PG8_LDA(dst, b, h) do { _Pragma("unroll") for (int m = 0; m < 4; ++m) { if constexpr (F8) { \
            const i32x4_t lo_ = *(const PG8_LAS i32x4_t*)(lds + PG8_SA(b, h) + aoff + m * 2048), hi_ = *(const PG8_LAS i32x4_t*)(lds + PG8_SA(b, h) + aoff + m * 2048 + 1024); \
            dst##8[m] = __builtin_shufflevector(lo_, hi_, 0, 1, 2, 3, 4, 5, 6, 7); \
        } else { _Pragma("unroll") for (int k = 0; k < 2; ++k) dst[m][k] = *(const PG8_LAS bf16x8*)(lds + PG8_SA(b, h) + aoff + m * 2048 + k * 1024); } } } while (0)
#define PG8_LDB(dst, b, h) do { _Pragma("unroll") for (int n = 0; n < 2; ++n) { if constexpr (F8) { \
            const i32x4_t lo_ = *(const PG8_LAS i32x4_t*)(lds + PG8_SB(b, h) + boff + n * 2048), hi_ = *(const PG8_LAS i32x4_t*)(lds + PG8_SB(b, h) + boff + n * 2048 + 1024); \
            dst##8[n] = __builtin_shufflevector(lo_, hi_, 0, 1, 2, 3, 4, 5, 6, 7); \
        } else { _Pragma("unroll") for (int k = 0; k < 2; ++k) dst[n][k] = *(const PG8_LAS bf16x8*)(lds + PG8_SB(b, h) + boff + n * 2048 + k * 1024); } } } while (0)
#define PG8_MMA(ai, bj, At, Bt) do { __builtin_amdgcn_s_setprio(1); _Pragma("unroll") for (int m = 0; m < 4; ++m) _Pragma("unroll") for (int n = 0; n < 2; ++n) { \
        if constexpr (F8) {   \
            acc[ai][bj][m][n] = __builtin_amdgcn_mfma_scale_f32_16x16x128_f8f6f4(Bt##8[n], At##8[m], acc[ai][bj][m][n], 0, 0, 0, 0, 0, 0); \
        } else { _Pragma("unroll") for (int k = 0; k < 2; ++k) acc[ai][bj][m][n] = __builtin_amdgcn_mfma_f32_16x16x32_bf16(Bt[n][k], At[m][k], acc[ai][bj][m][n], 0, 0, 0); } } \
        __builtin_amdgcn_s_setprio(0); } while (0)
#define PG8_WAIT_V(n) asm volatile("s_waitcnt vmcnt(" #n ")" ::: "memory")
#define PG8_WAIT_L(n) asm volatile("s_waitcnt lgkmcnt(" #n ")" ::: "memory")
#define PG8_BAR __builtin_amdgcn_s_barrier()
#define PG8_SCHED __builtin_amdgcn_sched_barrier(0)
    Unit cur, nxt; int ui = 0;
    if (!S.next(0, cur)) return;
    f32x4 acc[2][2][4][2];
    E.init(acc, cur, wc, fq);
    typedef int i32x4_t __attribute__((ext_vector_type(4))); typedef int i32x8_t __attribute__((ext_vector_type(8)));
    bf16x8 At[4][2], B0[2][2], B1[2][2];
    i32x8_t At8[4], B08[2], B18[2];
    const char* cA = (const char*)g.A + (size_t)cur.pm * tstep; const char* cB = (const char*)g.Bt + (size_t)cur.pn * tstep;
    S.a_ready(cur);
    if constexpr (SP2) {
        PG8_STAGE(PG8_SB(0, 0), cB, voffB); PG8_STAGE(PG8_SB(0, 1), cB + hstep, voffB); PG8_STAGE(PG8_SA(0, 0), cA, voffA); PG8_STAGE(PG8_SA(0, 1), cA + hstep, voffA);
        if (wr == 1) PG8_BAR;
        PG8_WAIT_V(2); PG8_BAR;
        PG8_STAGE(PG8_SB(1, 0), cB + kstep, voffB); PG8_STAGE(PG8_SA(1, 0), cA + kstep, voffA); PG8_STAGE(PG8_SB(1, 1), cB + hstep + kstep, voffB);
        PG8_WAIT_V(6); PG8_BAR;
    } else {
        PG8_STAGE(PG8_SB(0, 0), cB, voffB); PG8_STAGE(PG8_SA(0, 0), cA, voffA); PG8_STAGE(PG8_SB(0, 1), cB + hstep, voffB); PG8_STAGE(PG8_SA(0, 1), cA + hstep, voffA);
        if (wr == 1) PG8_BAR;
        PG8_WAIT_V(4); PG8_BAR;
        PG8_STAGE(PG8_SB(1, 0), cB + kstep, voffB); PG8_STAGE(PG8_SA(1, 0), cA + kstep, voffA); PG8_STAGE(PG8_SB(1, 1), cB + hstep + kstep, voffB);
        PG8_WAIT_V(6); PG8_BAR;
    }
    for (;;) {
        const bool has_next = S.next(ui + 1, nxt);
        const char* nA = has_next ? (const char*)g.A + (size_t)nxt.pm * tstep : cA; const char* nB = has_next ? (const char*)g.Bt + (size_t)nxt.pn * tstep : cB;
#pragma unroll 1
        for (int t = 0; t < nt; t += 2) {
            const bool last = (t == nt - 2);
            const char* a1 = cA + (size_t)(t + 1) * kstep;
            const char* a2 = last ? nA : cA + (size_t)(t + 2) * kstep; const char* b2 = last ? nB : cB + (size_t)(t + 2) * kstep;
            const char* a3 = a2 + kstep; const char* b3 = b2 + kstep;
            const char* a1h = a1 + hstep; const char* a2h = a2 + hstep; const char* b2h = b2 + hstep; const char* a3h = a3 + hstep; const char* b3h = b3 + hstep;
            asm volatile("" : "+s"(a1h), "+s"(a2), "+s"(a2h), "+s"(b2), "+s"(b2h), "+s"(a3), "+s"(a3h), "+s"(b3), "+s"(b3h));
            if (last && has_next) S.a_ready(nxt);
            if constexpr (SP2) {
            PG8_LDB(B0, 0, 0); PG8_LDB(B1, 0, 1); PG8_SCHED; PG8_LDA(At, 0, 0); PG8_STAGE(PG8_SA(1, 1), a1h, voffA);
            PG8_WAIT_V(8); PG8_WAIT_L(0); PG8_BAR; PG8_MMA(0, 0, At, B0); PG8_MMA(0, 1, At, B1); PG8_BAR; PG8_SCHED;
            PG8_LDA(At, 0, 1); PG8_STAGE(PG8_SB(0, 0), b2, voffB); PG8_STAGE(PG8_SB(0, 1), b2h, voffB); PG8_STAGE(PG8_SA(0, 0), a2, voffA);
            PG8_WAIT_V(8); PG8_WAIT_L(0); PG8_BAR; PG8_MMA(1, 0, At, B0); PG8_MMA(1, 1, At, B1); PG8_BAR; PG8_SCHED;
            PG8_LDB(B0, 1, 0); PG8_LDB(B1, 1, 1); PG8_SCHED; PG8_LDA(At, 1, 0); PG8_STAGE(PG8_SA(0, 1), a2h, voffA);
            PG8_WAIT_V(8); PG8_WAIT_L(0); PG8_BAR; PG8_MMA(0, 0, At, B0); PG8_MMA(0, 1, At, B1); PG8_BAR; PG8_SCHED;
            PG8_LDA(At, 1, 1); PG8_STAGE(PG8_SB(1, 0), b3, voffB); PG8_STAGE(PG8_SB(1, 1), b3h, voffB); PG8_STAGE(PG8_SA(1, 0), a3, voffA);
            PG8_WAIT_V(8); PG8_WAIT_L(0); PG8_BAR; PG8_MMA(1, 0, At, B0); PG8_MMA(1, 1, At, B1); PG8_BAR; PG8_SCHED;
            } else {
            PG8_LDB(B0, 0, 0); PG8_SCHED; PG8_LDA(At, 0, 0); PG8_STAGE(PG8_SA(1, 1), a1h, voffA);
            PG8_WAIT_L(8); PG8_BAR; PG8_WAIT_L(0); PG8_MMA(0, 0, At, B0); PG8_BAR; PG8_SCHED;
            PG8_LDB(B1, 0, 1); PG8_STAGE(PG8_SB(0, 0), b2, voffB);
            PG8_BAR; PG8_WAIT_L(0); PG8_MMA(0, 1, At, B1); PG8_BAR;
            PG8_LDA(At, 0, 1); PG8_STAGE(PG8_SA(0, 0), a2, voffA);
            PG8_BAR; PG8_WAIT_L(0); PG8_MMA(1, 0, At, B0); PG8_BAR; PG8_SCHED;
            PG8_STAGE(PG8_SB(0, 1), b2h, voffB);
            PG8_WAIT_V(6); PG8_BAR; PG8_MMA(1, 1, At, B1); PG8_BAR;
            PG8_LDB(B0, 1, 0); PG8_SCHED; PG8_LDA(At, 1, 0); PG8_STAGE(PG8_SA(0, 1), a2h, voffA);
            PG8_WAIT_L(8); PG8_BAR; PG8_WAIT_L(0); PG8_MMA(0, 0, At, B0); PG8_BAR; PG8_SCHED;
            PG8_LDB(B1, 1, 1); PG8_STAGE(PG8_SB(1, 0), b3, voffB);
            PG8_BAR; PG8_WAIT_L(0); PG8_MMA(0, 1, At, B1); PG8_BAR;
            PG8_LDA(At, 1, 1); PG8_STAGE(PG8_SA(1, 0), a3, voffA);
            PG8_BAR; PG8_WAIT_L(0); PG8_MMA(1, 0, At, B0); PG8_BAR; PG8_SCHED;
            PG8_STAGE(PG8_SB(1, 1), b3h, voffB);
            PG8_WAIT_V(6); PG8_BAR; PG8_MMA(1, 1, At, B1); PG8_BAR;
            }
        }
        if constexpr (ALIGN_EPI) { if (wr == 0) PG8_BAR; }
        if constexpr (!Epi::AFTER_DRAIN) { unsigned ones_ = ~0u; asm volatile("" : "+s"(ones_)); const int ln_ = (int)__builtin_amdgcn_mbcnt_hi(ones_, __builtin_amdgcn_mbcnt_lo(ones_, 0u)); const int fr_ = ln_ & 15, fq_ = ln_ >> 4;
            E(acc, cur, wr, wc, fr_, fq_);
#if defined(PROBE_MASK)
            if constexpr ((F8 && (((PROBE_MASK) >> 18) & 1)) || (!F8 && (((PROBE_MASK) >> 19) & 1))) { asm volatile("" ::: "memory"); E(acc, cur, wr, wc, fr_, fq_); }
#endif
            S.done(cur); }
        if (!has_next) break;
        cur = nxt; cA = nA; cB = nB; ++ui;
        E.init(acc, cur, wc, fq);
        if constexpr (ALIGN_EPI) { if (wr == 1) PG8_BAR; }
    }
    PG8_WAIT_V(0);
    if constexpr (!ALIGN_EPI) { if (wr == 0) PG8_BAR; }
    PG8_BAR;
    if constexpr (Epi::AFTER_DRAIN) { E.fused(acc, cur, wr, wc, fr, fq, lds, wid, lane); S.done(cur); }
#undef PG8_SA
#undef PG8_SB
#undef PG8_STAGE
#undef PG8_LDA
#undef PG8_LDB
#undef PG8_MMA
#undef PG8_WAIT_V
#undef PG8_WAIT_L
#undef PG8_BAR
#undef PG8_SCHED
}
}

#include <hip/hip_bf16.h>
#include <cmath>
namespace attn_body {
using bf16=__hip_bfloat16;
using bf16x8=__attribute__((ext_vector_type(8)))short;
using s16x4=__attribute__((ext_vector_type(4)))short;
using f32x16=__attribute__((ext_vector_type(16)))float;
using u32x4=__attribute__((ext_vector_type(4)))unsigned;
constexpr int D=64,QP=512,KP=64,OP=1024;
constexpr int NW=8,QBLK=32,QB=QBLK*NW,KVBLK=64;
constexpr int ATTN_UNIT_ROWS=QB;
__device__ __forceinline__ int crow(int r,int hi){return (r&3)+8*(r>>2)+4*hi;}
#define SBAR() __builtin_amdgcn_sched_barrier(0)
__device__ __forceinline__ void cmask(f32x16&p0,f32x16&p1,int jb,int qrel,int hi){
  const float NEG=-INFINITY; int kb=64*jb+4*hi;
  #pragma unroll
  for(int r=0;r<16;++r){int kv=kb+(r&3)+8*(r>>2); if(kv>qrel)p0[r]=NEG; if(kv+32>qrel)p1[r]=NEG;}
}

constexpr int NSLOT=3, SLOTB=8192;
constexpr int LDS_K=0, LDS_V=NSLOT*SLOTB, LDS_WS=2*NSLOT*SLOTB, LDS_OST=LDS_WS+NW*64*4, LDS_BYTES=LDS_OST+NW*4096;
constexpr float C2=0.125f*1.4426950408889634f;
__device__ __forceinline__ void glds16(const void*gsrc,unsigned lds_dst){unsigned keep;
  asm volatile("s_mov_b32 %0, m0\n\ts_mov_b32 m0, %2\n\ts_nop 0\n\tglobal_load_lds_dwordx4 %1, off\n\ts_mov_b32 m0, %0":"=&s"(keep):"v"(gsrc),"s"(lds_dst):"memory");}
__device__ __forceinline__ float max3f(float a,float b,float c){float r;asm("v_max3_f32 %0, %1, %2, %3":"=v"(r):"v"(a),"v"(b),"v"(c));return r;}
__device__ __forceinline__ float max2f(float a,float b){float r;asm("v_max_f32_e32 %0, %1, %2":"=v"(r):"v"(a),"v"(b));return r;}
__device__ __forceinline__ float fadd_s(float a,float b){float r;asm("v_add_f32_e32 %0, %1, %2":"=v"(r):"v"(a),"v"(b));return r;}
__device__ __forceinline__ float fsub_s(float a,float b){float r;asm("v_sub_f32_e32 %0, %1, %2":"=v"(r):"v"(a),"v"(b));return r;}
typedef float f32x2_t __attribute__((ext_vector_type(2))); typedef __bf16 bf16x2_t __attribute__((ext_vector_type(2)));
__device__ __forceinline__ unsigned cvtpk_s(float lo,float hi){f32x2_t v={lo,hi};bf16x2_t b=__builtin_convertvector(v,bf16x2_t);return __builtin_bit_cast(unsigned,b);}
#define WAIT_BAR(N) asm volatile("s_waitcnt vmcnt(" #N ") lgkmcnt(0)\n\ts_barrier":::"memory")

__device__ __forceinline__ void qkt(f32x16&p0,f32x16&p1,const char*Kslot,const bf16x8*qr,const f32x16&negm,int r32,int hi){
  const char*kb=Kslot+hi*1024+r32*16;
  #pragma unroll
  for(int d0=0;d0<4;++d0){
    const bf16x8 b0=*reinterpret_cast<const bf16x8*>(kb+d0*2048);
    const bf16x8 b1=*reinterpret_cast<const bf16x8*>(kb+d0*2048+512);
    if(d0==0){p0=__builtin_amdgcn_mfma_f32_32x32x16_bf16(b0,qr[0],negm,0,0,0);p1=__builtin_amdgcn_mfma_f32_32x32x16_bf16(b1,qr[0],negm,0,0,0);}
    else{p0=__builtin_amdgcn_mfma_f32_32x32x16_bf16(b0,qr[d0],p0,0,0,0);p1=__builtin_amdgcn_mfma_f32_32x32x16_bf16(b1,qr[d0],p1,0,0,0);}}
}
typedef __attribute__((address_space(3))) const char* lds_cptr;
typedef short v4i16_t __attribute__((ext_vector_type(4)));
__device__ __forceinline__ void kload8(bf16x8*kf,lds_cptr kp){
  kf[0]=*(const __attribute__((address_space(3))) bf16x8*)(kp);      kf[1]=*(const __attribute__((address_space(3))) bf16x8*)(kp+512);
  kf[2]=*(const __attribute__((address_space(3))) bf16x8*)(kp+2048); kf[3]=*(const __attribute__((address_space(3))) bf16x8*)(kp+2560);
  kf[4]=*(const __attribute__((address_space(3))) bf16x8*)(kp+4096); kf[5]=*(const __attribute__((address_space(3))) bf16x8*)(kp+4608);
  kf[6]=*(const __attribute__((address_space(3))) bf16x8*)(kp+6144); kf[7]=*(const __attribute__((address_space(3))) bf16x8*)(kp+6656);
}
__device__ __forceinline__ void kload2(bf16x8*kf,lds_cptr kp,int j){ kf[2*j]=*(const __attribute__((address_space(3))) bf16x8*)(kp+j*2048); kf[2*j+1]=*(const __attribute__((address_space(3))) bf16x8*)(kp+j*2048+512); }
__device__ __forceinline__ s16x4 vtr(lds_cptr p){ return __builtin_bit_cast(s16x4,__builtin_amdgcn_ds_read_tr16_b64_v4i16((__attribute__((address_space(3))) v4i16_t*)p)); }
__device__ __forceinline__ float rowmax(const f32x16&p0,const f32x16&p1){
  float a=max3f(p0[0],p0[1],p1[0]),b=max3f(p0[2],p0[3],p1[1]);a=max3f(a,p1[2],p1[3]);
  #pragma unroll
  for(int r=4;r<16;r+=4){a=max3f(a,p0[r],p0[r+1]);b=max3f(b,p0[r+2],p0[r+3]);a=max3f(a,p1[r],p1[r+1]);b=max3f(b,p1[r+2],p1[r+3]);}
  const float m=max2f(a,b);
  auto rr=__builtin_amdgcn_permlane32_swap(__float_as_uint(m),__float_as_uint(m),false,false);
  return max2f(__uint_as_float(rr[0]),__uint_as_float(rr[1]));
}
__device__ __forceinline__ void pv(f32x16*o,int vb,bf16x8 pa0,bf16x8 pa1,bf16x8 pa2,bf16x8 pa3){
  #pragma unroll
  for(int d0=0;d0<2;++d0){s16x4 lo[4],hi[4];
    #pragma unroll
    for(int ks=0;ks<4;++ks){
      asm volatile("ds_read_b64_tr_b16 %0,%1 offset:%c2":"=&v"(lo[ks]):"v"(vb),"i"(d0*4096+ks*1024):"memory");
      asm volatile("ds_read_b64_tr_b16 %0,%1 offset:%c2":"=&v"(hi[ks]):"v"(vb),"i"(d0*4096+ks*1024+512):"memory");}
    asm volatile("s_waitcnt lgkmcnt(0)":::"memory");SBAR();
    #define PK(k) (bf16x8){lo[k][0],lo[k][1],lo[k][2],lo[k][3],hi[k][0],hi[k][1],hi[k][2],hi[k][3]}
    o[d0]=__builtin_amdgcn_mfma_f32_32x32x16_bf16(pa0,PK(0),o[d0],0,0,0);
    o[d0]=__builtin_amdgcn_mfma_f32_32x32x16_bf16(pa1,PK(1),o[d0],0,0,0);
    o[d0]=__builtin_amdgcn_mfma_f32_32x32x16_bf16(pa2,PK(2),o[d0],0,0,0);
    o[d0]=__builtin_amdgcn_mfma_f32_32x32x16_bf16(pa3,PK(3),o[d0],0,0,0);
    #undef PK
  }
}

#ifndef ATTN_STORE16
#define ATTN_STORE16(p,v) (*(u32x4*)(p)=(v))
#endif
template<int THRL> __device__ __forceinline__ void attn_unit(const bf16*Qu,const bf16*Kh,const bf16*Vh,bf16*Ou,const int NT,char*shm){
  const int tid=opaque_tid(),lane=tid&63,r32=lane&31,hi=lane>>5; const int wid=__builtin_amdgcn_readfirstlane(tid>>6);
  const bf16*Qw=Qu+(long)(wid*QBLK)*QP;
  const unsigned lds0=(unsigned)(uintptr_t)shm;
  float*wsf=(float*)(shm+LDS_WS)+wid*64;
  const bf16*ksrc=Kh+(long)lane*KP+wid*8;
  const bf16*vsrc=Vh+(long)(16*(wid&3)+(lane>>2))*KP+(wid>>2)*32+(lane&3)*8;
  const unsigned kdst=lds0+LDS_K+wid*1024, vdst=lds0+LDS_V+wid*1024;
  #define DMA_K(t,slot) glds16(ksrc+(long)(t)*KVBLK*KP,(unsigned)__builtin_amdgcn_readfirstlane(kdst+(slot)))
  #define DMA_V(t,slot) glds16(vsrc+(long)(t)*KVBLK*KP,(unsigned)__builtin_amdgcn_readfirstlane(vdst+(slot)))
  const int vb0=(int)(lds0+LDS_V)+((lane>>4)&1)*32+(lane&3)*8+(4*hi+((lane&15)>>2))*64;
  const char*Kbase=shm+LDS_K; bf16x8 kf[8];
  const lds_cptr shm3=(lds_cptr)shm; const lds_cptr kp0=shm3+LDS_K+hi*1024+r32*16; const lds_cptr vp0=shm3+LDS_V+((lane>>4)&1)*32+(lane&3)*8+(4*hi+((lane&15)>>2))*64;
  DMA_K(0,0);DMA_V(0,0);DMA_K(1,SLOTB);
  bf16x8 qr[4];
  #pragma unroll
  for(int d0=0;d0<4;++d0)qr[d0]=*reinterpret_cast<const bf16x8*>(&Qw[(long)r32*QP+d0*16+hi*8]);
  float mhat=0.f,l_reg=0.f;f32x16 o[2];o[0]=f32x16{};o[1]=f32x16{};f32x16 negm=f32x16{};asm volatile("":"+v"(negm));
  #define CMASK(P0,P1,t) do{}while(0)
  bool resc=false;
  #define START(P0,P1) do{ const float rm=rowmax(P0,P1); resc=false; \
    { const float dl=rm; mhat=fadd_s(mhat,dl); \
      _Pragma("unroll") for(int r=0;r<16;++r){P0[r]=fsub_s(P0[r],dl);P1[r]=fsub_s(P1[r],dl);} \
      _Pragma("unroll") for(int r=0;r<16;++r)negm[r]=-mhat; asm volatile("":"+v"(negm)); } \
    _Pragma("unroll") for(int r=0;r<16;++r)P0[r]=__builtin_amdgcn_exp2f(P0[r]); }while(0)
  #define RESC() do{ if(resc){ asm volatile("s_waitcnt lgkmcnt(0)":::"memory"); \
      _Pragma("unroll") for(int d_=0;d_<2;++d_) _Pragma("unroll") for(int r=0;r<16;++r)o[d_][r]*=wsf[crow(r,hi)]; } }while(0)
  f32x16 pA0,pA1,pB0,pB1;
  int sl_prev=0,sl_cur=0,sl_next=SLOTB;
  #define ROT() do{sl_prev=sl_cur;sl_cur=sl_next;sl_next=(sl_next==(NSLOT-1)*SLOTB)?0:sl_next+SLOTB;}while(0)
  DMA_K(2,2*SLOTB);
  WAIT_BAR(3);
  qkt(pA0,pA1,Kbase,qr,negm,r32,hi);asm volatile("s_nop 15\n\ts_nop 7":"+v"(pA0),"+v"(pA1));CMASK(pA0,pA1,0);
  START(pA0,pA1);
  _Pragma("unroll") for(int r=0;r<16;++r)pA1[r]=__builtin_amdgcn_exp2f(pA1[r]);
  WAIT_BAR(0);
  DMA_K(3,0);DMA_V(1,SLOTB);
  ROT();
  kload8(kf,kp0+sl_cur);
  WAIT_BAR(2);
  s16x4 vlo[8],vhi[8]; u32x4 pw0,pw1,pw2,pw3;
  #define PKW(P,B) cvtpk_s(P[B],P[B+1])
  #define PAF(k) __builtin_bit_cast(bf16x8,pw##k)
  #define VFR(i) (bf16x8){vlo[i][0],vlo[i][1],vlo[i][2],vlo[i][3],vhi[i][0],vhi[i][1],vhi[i][2],vhi[i][3]}
  #define PIN(x) asm volatile("":"+v"(x))
  #define MX3(a,b,c) __builtin_fmaxf(__builtin_fmaxf((a),(b)),(c))
  #define GAPA(MF,A0,A1,A2,A3,W0,W1,PW) do{ MF; sacc+=A0; sacc+=A1; sacc+=A2; sacc+=A3; PIN(sacc); W0; W1; PIN(PW); SBAR(); }while(0)
  #define EX(v) __builtin_amdgcn_exp2f(v)
  #define GAPB(MF,X,B) do{ MF; X[B]=EX(X[B]); X[B+1]=EX(X[B+1]); X[B+2]=EX(X[B+2]); X[B+3]=EX(X[B+3]); PIN(X); SBAR(); }while(0)
  #define VRD(i) do{ vlo[i]=vtr(vp_+(((i)>>2)*4096+((i)&3)*1024)); vhi[i]=vtr(vp_+(((i)>>2)*4096+((i)&3)*1024+512)); }while(0)
  #define KRD(G,j) do{ if(G){ kload2(kf,kp0+sl_next,j); SBAR(); } }while(0)
  #define STEP(C0,C1,P0,P1,t,GK,GV,GL) do{ SBAR(); \
    const lds_cptr vp_=vp0+sl_prev; \
    VRD(0); SBAR(); float sacc=(P0[0]+P0[1]); \
    GAPA(C0=__builtin_amdgcn_mfma_f32_32x32x16_bf16(kf[0],qr[0],negm,0,0,0), P0[2],P0[3],P0[4],P0[5],     pw0[0]=PKW(P0,0), pw0[1]=PKW(P0,2), pw0); \
    VRD(4); SBAR(); GAPA(C1=__builtin_amdgcn_mfma_f32_32x32x16_bf16(kf[1],qr[0],negm,0,0,0), P0[6],P0[7],P0[8],P0[9],     pw0[2]=PKW(P0,4), pw0[3]=PKW(P0,6), pw0); \
    VRD(1); SBAR(); GAPA(C0=__builtin_amdgcn_mfma_f32_32x32x16_bf16(kf[2],qr[1],C0,0,0,0),   P0[10],P0[11],P0[12],P0[13], pw1[0]=PKW(P0,8), pw1[1]=PKW(P0,10), pw1); \
    VRD(5); SBAR(); GAPA(C1=__builtin_amdgcn_mfma_f32_32x32x16_bf16(kf[3],qr[1],C1,0,0,0),   P0[14],P0[15],P1[0],P1[1],   pw1[2]=PKW(P0,12),pw1[3]=PKW(P0,14), pw1); \
    VRD(2); SBAR(); GAPA(C0=__builtin_amdgcn_mfma_f32_32x32x16_bf16(kf[4],qr[2],C0,0,0,0),   P1[2],P1[3],P1[4],P1[5],     pw2[0]=PKW(P1,0), pw2[1]=PKW(P1,2), pw2); \
    VRD(6); SBAR(); GAPA(C1=__builtin_amdgcn_mfma_f32_32x32x16_bf16(kf[5],qr[2],C1,0,0,0),   P1[6],P1[7],P1[8],P1[9],     pw2[2]=PKW(P1,4), pw2[3]=PKW(P1,6), pw2); \
    VRD(3); SBAR(); GAPA(C0=__builtin_amdgcn_mfma_f32_32x32x16_bf16(kf[6],qr[3],C0,0,0,0),   P1[10],P1[11],P1[12],P1[13], pw3[0]=PKW(P1,8), pw3[1]=PKW(P1,10), pw3); \
    VRD(7); SBAR(); GAPA(C1=__builtin_amdgcn_mfma_f32_32x32x16_bf16(kf[7],qr[3],C1,0,0,0),   P1[14],P1[15],0.f,0.f,       pw3[2]=PKW(P1,12),pw3[3]=PKW(P1,14), pw3); \
    l_reg+=sacc; \
    if(GK){DMA_K((t)+3,sl_cur);} if(GV){DMA_V((t)+1,sl_next);} \
    CMASK(C0,C1,t); \
    { float a=MX3(C0[0],C0[1],C1[0]),b=MX3(C0[2],C0[3],C1[1]); a=MX3(a,C1[2],C1[3]); \
      _Pragma("unroll") for(int r=4;r<16;r+=4){a=MX3(a,C0[r],C0[r+1]);b=MX3(b,C0[r+2],C0[r+3]);a=MX3(a,C1[r],C1[r+1]);b=MX3(b,C1[r+2],C1[r+3]);} \
      float rm=__builtin_fmaxf(a,b); { auto rr=__builtin_amdgcn_permlane32_swap(__float_as_uint(rm),__float_as_uint(rm),false,false); rm=__builtin_fmaxf(__uint_as_float(rr[0]),__uint_as_float(rr[1])); } \
      resc=false; \
      if(__builtin_expect(__any(rm>(float)THRL),0)){ const float dl=__builtin_fmaxf(rm,0.f); mhat+=dl; \
        _Pragma("unroll") for(int r=0;r<16;++r){C0[r]-=dl;C1[r]-=dl;} \
        _Pragma("unroll") for(int r=0;r<16;++r)negm[r]=-mhat; asm volatile("":"+v"(negm)); \
        const float f=__builtin_amdgcn_exp2f(-dl); l_reg*=f; if(hi==0)wsf[r32]=f; resc=true; } } \
    SBAR(); \
    GAPB(o[0]=__builtin_amdgcn_mfma_f32_32x32x16_bf16(PAF(0),VFR(0),o[0],0,0,0), C0,0); \
    GAPB(o[1]=__builtin_amdgcn_mfma_f32_32x32x16_bf16(PAF(0),VFR(4),o[1],0,0,0), C0,4); \
    KRD(GL,0); GAPB(o[0]=__builtin_amdgcn_mfma_f32_32x32x16_bf16(PAF(1),VFR(1),o[0],0,0,0), C0,8); \
    KRD(GL,1); GAPB(o[1]=__builtin_amdgcn_mfma_f32_32x32x16_bf16(PAF(1),VFR(5),o[1],0,0,0), C0,12); \
    KRD(GL,2); GAPB(o[0]=__builtin_amdgcn_mfma_f32_32x32x16_bf16(PAF(2),VFR(2),o[0],0,0,0), C1,0); \
    KRD(GL,3); GAPB(o[1]=__builtin_amdgcn_mfma_f32_32x32x16_bf16(PAF(2),VFR(6),o[1],0,0,0), C1,4); \
    GAPB(o[0]=__builtin_amdgcn_mfma_f32_32x32x16_bf16(PAF(3),VFR(3),o[0],0,0,0), C1,8); \
    GAPB(o[1]=__builtin_amdgcn_mfma_f32_32x32x16_bf16(PAF(3),VFR(7),o[1],0,0,0), C1,12); \
    }while(0)
  int t=1;
  #undef CMASK
  #define CMASK(P0,P1,t) do{}while(0)
  for(;t+5<NT;t+=2){
    STEP(pB0,pB1,pA0,pA1,t,true,true,true);     WAIT_BAR(2); RESC(); ROT();
    STEP(pA0,pA1,pB0,pB1,t+1,true,true,true);   WAIT_BAR(2); RESC(); ROT();
  }
  #undef CMASK
  #define CMASK(P0,P1,t) do{}while(0)
  #define ENDW(tt) do{ if((tt)+3<NT){WAIT_BAR(2);} else if((tt)+2<NT){WAIT_BAR(1);} else {WAIT_BAR(0);} }while(0)
  for(;t+1<NT;t+=2){
    STEP(pB0,pB1,pA0,pA1,t,(t+3<NT),(t+1<NT),(t+1<NT));       ENDW(t);   RESC(); ROT();
    STEP(pA0,pA1,pB0,pB1,t+1,(t+4<NT),(t+2<NT),(t+2<NT));     ENDW(t+1); RESC(); ROT();
  }
  STEP(pB0,pB1,pA0,pA1,NT-1,false,false,false); RESC();
  { float sacc=pB0[0]+pB0[1]; _Pragma("unroll") for(int r=2;r<16;++r)sacc+=pB0[r]; _Pragma("unroll") for(int r=0;r<16;++r)sacc+=pB1[r]; l_reg+=sacc;
    pw0=(u32x4){PKW(pB0,0),PKW(pB0,2),PKW(pB0,4),PKW(pB0,6)};pw1=(u32x4){PKW(pB0,8),PKW(pB0,10),PKW(pB0,12),PKW(pB0,14)};pw2=(u32x4){PKW(pB1,0),PKW(pB1,2),PKW(pB1,4),PKW(pB1,6)};pw3=(u32x4){PKW(pB1,8),PKW(pB1,10),PKW(pB1,12),PKW(pB1,14)};
    SBAR(); pv(o,vb0+sl_cur,PAF(0),PAF(1),PAF(2),PAF(3)); }
  #undef PKW
  #undef PAF
  #undef VFR
  #undef PIN
  #undef MX3
  #undef GAPA
  #undef GAPB
  #undef EX
  #undef VRD
  #undef KRD
  #undef STEP
  #undef ENDW
  {auto rr=__builtin_amdgcn_permlane32_swap(__float_as_uint(l_reg),__float_as_uint(l_reg),false,false);l_reg=__uint_as_float(rr[0])+__uint_as_float(rr[1]);}
  if(hi==0)wsf[32+r32]=l_reg;asm volatile("s_waitcnt lgkmcnt(0)":::"memory");
  float rli[16];
  #pragma unroll
  for(int r=0;r<16;++r)rli[r]=__builtin_amdgcn_rcpf(wsf[32+crow(r,hi)]);
  bf16*Ow=Ou+(long)(wid*QBLK)*OP;
  { bf16*stg=(bf16*)(shm+LDS_OST)+wid*2048;
    #pragma unroll
    for(int r=0;r<16;++r){const int orow=crow(r,hi);
      #pragma unroll
      for(int d0=0;d0<2;++d0)stg[orow*64+d0*32+r32]=__float2bfloat16(o[d0][r]*rli[r]);}
    asm volatile("s_waitcnt lgkmcnt(0)":::"memory");
    #pragma unroll
    for(int i=0;i<4;++i){const int row=i*8+(lane>>3),ch=lane&7; const u32x4 v=*(const u32x4*)(stg+row*64+ch*8); ATTN_STORE16(Ow+(long)row*OP+ch*8,v);} }
  asm volatile("s_waitcnt lgkmcnt(0)\n\ts_barrier":::"memory");
  #undef DMA_K
  #undef DMA_V
  #undef CMASK
  #undef START
  #undef RESC
  #undef ROT
}
constexpr int ATTN_LDS_BYTES=LDS_BYTES;
#undef SBAR
#undef WAIT_BAR
}

constexpr int NWAVES = 8;
#ifndef MK_N_LAUNCHES
#define MK_N_LAUNCHES 1
#endif
constexpr int DM = 1024, NBATCH = 8, SEQL = 4096, CTXL = 256, DEPTH = 2;
constexpr int RCTX = NBATCH * CTXL, RLAT = NBATCH * SEQL, RTOT = RCTX + RLAT;
constexpr int INW = 2560, NEXP = 32, NKEY = CTXL + SEQL, NPF = 34, NMOD = 6 * DM;
constexpr int ZC_U = 0, ZC_B = 256, ZC_C = 512, ZC_RQ = 768, ZC_RK = 1024, ZC_RV = 1280, ZC_RG = 1536, ZC_AQ = 1792, ZC_AK = 2304, ZC_AV = 2432;
constexpr float LN_EPS = 1e-6f, ALPHA = 1.41421356237309505f;
constexpr int N_PRO = 3, N_PER_LAYER = 10, N_PHASES = N_PRO + DEPTH * N_PER_LAYER;
constexpr int N_LAUNCHES = MK_N_LAUNCHES;

constexpr size_t MiB = 1u << 20;
constexpr size_t WS_CTL = 0, CTL_ZERO_BYTES = 1 * MiB;
constexpr size_t WS_MODP = 2 * MiB, WS_MODV = 6 * MiB, WS_ROPE = 7 * MiB;
constexpr size_t WS_RE = 8 * MiB, WS_RP = 9 * MiB, WS_RW = 10 * MiB, WS_SLOT = 11 * MiB, WS_ROWW = 12 * MiB;
constexpr size_t WS_WIN = 14 * MiB, WS_WOUT = 24 * MiB, WS_KVS = 28 * MiB, WS_SS = 62 * MiB, WS_AK = 80 * MiB, WS_AV = 89 * MiB, WS_AQ = 98 * MiB;
constexpr size_t WS_RQ = 132 * MiB, WS_RK = 149 * MiB, WS_WGU = 166 * MiB, WS_WD = 422 * MiB, WS_XSA = 550 * MiB, WS_XH = 618 * MiB, WS_Z = 686 * MiB;
constexpr size_t WS_MIX = 856 * MiB, WS_Y = 924 * MiB, WS_H2 = 992 * MiB, WS_XS2 = 1060 * MiB, WS_ACT = 1348 * MiB, WS_END = 1636 * MiB;
constexpr size_t WS_YB = WS_XS2;
constexpr int MAXTILES = 576;
static_assert(WS_MODP + (size_t)DEPTH * 8 * 9 * NMOD * 4 <= WS_MODV && WS_MODV + (size_t)DEPTH * 9 * NMOD * 4 <= WS_ROPE, "ws map");
static_assert(WS_WIN + (size_t)DEPTH * INW * DM * 2 <= WS_WOUT && WS_WOUT + (size_t)DEPTH * DM * DM * 2 <= WS_KVS, "ws map");
static_assert(WS_KVS + (size_t)NBATCH * 4 * NPF * 2 * 4096 * 4 <= WS_SS && WS_SS + (size_t)NBATCH * 4 * NPF * 2 * 4096 * 2 <= WS_AK, "ws map");
static_assert(WS_AK + (size_t)NBATCH * 2 * NKEY * 64 * 2 <= WS_AV && WS_AV + (size_t)NBATCH * 2 * NKEY * 64 * 2 <= WS_AQ && WS_AQ + (size_t)RTOT * 512 * 2 <= WS_RQ, "ws map");
static_assert(WS_RQ + (size_t)RTOT * 256 * 2 <= WS_RK && WS_RK + (size_t)RTOT * 256 * 2 <= WS_WGU && WS_WGU + (size_t)DEPTH * NEXP * 2048 * DM * 2 <= WS_WD, "ws map");
static_assert(WS_WD + (size_t)DEPTH * NEXP * DM * DM * 2 <= WS_XSA && WS_XSA + (size_t)RTOT * DM * 2 <= WS_XH && WS_XH + (size_t)RTOT * DM * 2 <= WS_Z, "ws map");
static_assert(WS_Z + (size_t)RTOT * INW * 2 <= WS_MIX && WS_MIX + (size_t)RTOT * DM * 2 <= WS_Y && WS_Y + (size_t)RTOT * DM * 2 <= WS_H2 && WS_H2 + (size_t)RTOT * DM * 2 <= WS_XS2, "ws map");
static_assert(WS_XS2 + (size_t)MAXTILES * 256 * DM * 2 <= WS_ACT && WS_ACT + (size_t)MAXTILES * 256 * DM * 2 <= WS_END, "ws map");
constexpr int CW_TMO = 0, CW_CODE = 1, CW_BAR = 4096, CW_GCNT = 8192;

constexpr int RING_OFF = 0, RING_BYTES = 131072;
constexpr int LDSCTL_OFF = RING_BYTES, MISC_OFF = LDSCTL_OFF + 320;
constexpr int OFFT_OFF = LDSCTL_OFF + 512, LCNT_OFF = LDSCTL_OFF + 768, LBASE_OFF = LDSCTL_OFF + 896, ENT_OFF = LDSCTL_OFF + 1024;
constexpr int VEC_OFF = LDSCTL_OFF + 5120;
constexpr int LDS_BYTES = 163840;
static_assert(ENT_OFF + 4096 <= VEC_OFF && VEC_OFF + 5 * 4096 <= LDS_BYTES, "LDS map");

#define GAS __attribute__((address_space(1)))
#define LAS __attribute__((address_space(3)))
typedef unsigned short bf16;
typedef unsigned v4u __attribute__((ext_vector_type(4)));
typedef float f32x4 __attribute__((ext_vector_type(4)));
typedef short bf16x8 __attribute__((ext_vector_type(8)));
typedef GAS unsigned gu32;
typedef GAS unsigned long long gu64;
#define RLX_AGENT __ATOMIC_RELAXED, __HIP_MEMORY_SCOPE_AGENT
#define LDS_WAIT() asm volatile("s_waitcnt lgkmcnt(0)" ::: "memory")
#define VM_WAIT() asm volatile("s_waitcnt vmcnt(0)" ::: "memory")
__device__ __forceinline__ unsigned long long rt() { return __builtin_amdgcn_s_memrealtime(); }
__device__ __forceinline__ unsigned f2bf(float f) { unsigned u = __builtin_bit_cast(unsigned, f); return (u + 0x7fffu + ((u >> 16) & 1u)) >> 16; }
__device__ __forceinline__ unsigned pk2(float lo, float hi) { return f2bf(lo) | (f2bf(hi) << 16); }

#define XB_TMO      128
#define XB_XCNT(j)  (256  + 64 * (j))
#define XB_XSUB(j)  (1280 + 64 * (j))
#define XB_XGEN(j)  (2304 + 64 * (j))
#define XB_TOP      3328
#define XB_TOPGEN   3392
#define XCD_BAR_WORDS 3456
#define XB_SPIN_CAP (1u << 18)

__device__ __forceinline__ unsigned xb_ld(unsigned* p)              { return __hip_atomic_load(p, __ATOMIC_RELAXED, __HIP_MEMORY_SCOPE_AGENT); }
__device__ __forceinline__ unsigned xb_add(unsigned* p, unsigned v) { return __hip_atomic_fetch_add(p, v, __ATOMIC_RELAXED, __HIP_MEMORY_SCOPE_AGENT); }
__device__ __forceinline__ unsigned xb_xcc_id() { return (unsigned)__builtin_amdgcn_s_getreg((3 << 11) | 20) & 0xFu; }
#define XB_SPIN(cond, bar) do { unsigned _sp = 0; while (cond) { __builtin_amdgcn_s_sleep(1); \
    if ((++_sp & 255u) == 0u) { if (xb_ld(&(bar)[XB_TMO])) break; if (_sp > XB_SPIN_CAP) { atomicAdd(&(bar)[XB_TMO], 1u); break; } } } } while (0)

struct XcdBarrier {
    unsigned* bar; unsigned x;
    volatile LAS unsigned* st;
};

__device__ __forceinline__ XcdBarrier xcd_barrier_post(unsigned* bar, volatile LAS unsigned* st) {
    XcdBarrier b; b.bar = bar; b.x = xb_xcc_id(); b.st = st;
    if (threadIdx.x == 0) (void)xb_add(&bar[XB_XCNT(b.x)], 1u);
    return b;
}
__device__ __forceinline__ void xcd_barrier_complete(unsigned* bar, unsigned x, unsigned& nloc, unsigned& nx) {
    const unsigned G = gridDim.x * gridDim.y * gridDim.z;
    unsigned sum, cnt, mine, sp = 0u;
    for (;;) {
        sum = 0u; cnt = 0u; mine = 0u;
#pragma unroll
        for (unsigned j = 0; j < 16; ++j) { const unsigned c = xb_ld(&bar[XB_XCNT(j)]); sum += c; cnt += (c > 0u) ? 1u : 0u; mine = (j == x) ? c : mine; }
        if (sum == G) break;
        __builtin_amdgcn_s_sleep(1);
        if ((++sp & 255u) == 0u) { if (xb_ld(&bar[XB_TMO])) break; if (sp > XB_SPIN_CAP) { atomicAdd(&bar[XB_TMO], 1u); break; } }
    }
    nloc = mine > 0u ? mine : 1u; nx = cnt > 0u ? cnt : 1u;
}

__device__ __forceinline__ void xcd_barrier(const XcdBarrier& b) {
    asm volatile("s_waitcnt vmcnt(0)" ::: "memory");
    __syncthreads();
    if (threadIdx.x == 0) {
        unsigned* bar = b.bar;
        __builtin_amdgcn_s_waitcnt(0);
        unsigned nloc = b.st[0], nx = b.st[1];
        if (nloc == 0u) { xcd_barrier_complete(bar, b.x, nloc, nx); b.st[0] = nloc; b.st[1] = nx; }
        const unsigned old = xb_add(&bar[XB_XSUB(b.x)], 1u);
        const unsigned gen = old / nloc;
        if (old + 1u == (gen + 1u) * nloc) {
            __builtin_amdgcn_fence(__ATOMIC_RELEASE, "agent");
            asm volatile("s_waitcnt vmcnt(0)" ::: "memory");
            const unsigned og = xb_add(&bar[XB_TOP], 1u);
            const unsigned tg = og / nx;
            if (og + 1u == (tg + 1u) * nx) xb_add(&bar[XB_TOPGEN], 1u);
            else XB_SPIN(xb_ld(&bar[XB_TOPGEN]) == tg, bar);
            __builtin_amdgcn_fence(__ATOMIC_ACQUIRE, "agent");
            xb_add(&bar[XB_XGEN(b.x)], 1u);
            asm volatile("s_waitcnt vmcnt(0)" ::: "memory");
        } else {
            XB_SPIN(xb_ld(&bar[XB_XGEN(b.x)]) == gen, bar);
            __builtin_amdgcn_fence(__ATOMIC_ACQUIRE, "agent");
            asm volatile("s_waitcnt vmcnt(0)" ::: "memory");
        }
    }
    __syncthreads();
}

struct Args { const float* in[21]; float* out; unsigned char* ws; int ph_lo, ph_hi, li, pad; };
template <int OFF> __device__ __forceinline__ const float* karg_ptr() {
    const float* p;
    asm volatile("s_load_dwordx2 %0, %1, %2\n\ts_waitcnt lgkmcnt(0)\n\ts_nop 4" : "=s"(p) : "s"(__builtin_amdgcn_kernarg_segment_ptr()), "i"(OFF) : "memory");
    return p;
}
#define KIN(i) karg_ptr<8 * (i)>()
#define KOUT() ((float*)karg_ptr<8 * 21>())
#define KWS() ((unsigned char*)karg_ptr<8 * 22>())
typedef float f32x16 __attribute__((ext_vector_type(16)));
typedef unsigned v2u __attribute__((ext_vector_type(2)));
__device__ __forceinline__ float bflo(unsigned u) { return __builtin_bit_cast(float, u << 16); }
__device__ __forceinline__ float bfhi(unsigned u) { return __builtin_bit_cast(float, u & 0xffff0000u); }
__device__ __forceinline__ float bf1(unsigned short h) { return __builtin_bit_cast(float, (unsigned)h << 16); }
__device__ __forceinline__ float wave_sum(float v) {
#pragma unroll
    for (int o = 1; o < 64; o <<= 1) v += __shfl_xor(v, o);
    return v;
}
__device__ __forceinline__ int mod_row(int r) { return r < RCTX ? 8 : ((r - RCTX) >> 12); }
__device__ __forceinline__ void load_row_f32(const float* p, int lane, f32x4 (&v)[4]) {
#pragma unroll
    for (int j = 0; j < 4; ++j) v[j] = *(const f32x4*)(p + 256 * j + 4 * lane);
}
__device__ __forceinline__ void load_row_bf16(const bf16* p, int lane, f32x4 (&v)[4]) {
#pragma unroll
    for (int j = 0; j < 4; ++j) { const uint2 u = *(const uint2*)(p + 256 * j + 4 * lane); v[j] = (f32x4){bflo(u.x), bfhi(u.x), bflo(u.y), bfhi(u.y)}; }
}
__device__ __forceinline__ void store_row_bf16(bf16* p, int lane, const f32x4 (&v)[4]) {
#pragma unroll
    for (int j = 0; j < 4; ++j) { uint2 u; u.x = pk2(v[j][0], v[j][1]); u.y = pk2(v[j][2], v[j][3]); *(uint2*)(p + 256 * j + 4 * lane) = u; }
}
__device__ __forceinline__ void store_row_f32(float* p, int lane, const f32x4 (&v)[4]) {
#pragma unroll
    for (int j = 0; j < 4; ++j) *(f32x4*)(p + 256 * j + 4 * lane) = v[j];
}
__device__ __forceinline__ void ln_row(f32x4 (&v)[4], const float* g, const float* b, int lane) {
    float s = 0.f;
#pragma unroll
    for (int j = 0; j < 4; ++j) s += (v[j][0] + v[j][1]) + (v[j][2] + v[j][3]);
    const float mean = wave_sum(s) * (1.0f / DM); float s2 = 0.f;
#pragma unroll
    for (int j = 0; j < 4; ++j) { v[j] = v[j] - mean; s2 += (v[j][0] * v[j][0] + v[j][1] * v[j][1]) + (v[j][2] * v[j][2] + v[j][3] * v[j][3]); }
    const float rstd = 1.0f / sqrtf(wave_sum(s2) * (1.0f / DM) + LN_EPS);
#pragma unroll
    for (int j = 0; j < 4; ++j) { const f32x4 gg = *(const f32x4*)(g + 256 * j + 4 * lane), bb = *(const f32x4*)(b + 256 * j + 4 * lane); v[j] = v[j] * rstd * gg + bb; }
}
__device__ __forceinline__ void modulate(const f32x4 (&v)[4], const float* sc, const float* sh, int lane, f32x4 (&o)[4]) {
#pragma unroll
    for (int j = 0; j < 4; ++j) { const f32x4 s = *(const f32x4*)(sc + 256 * j + 4 * lane), h = *(const f32x4*)(sh + 256 * j + 4 * lane); o[j] = v[j] * (1.0f + s) + h; }
}
__device__ __forceinline__ float log2_gamma(float dexp) { return log1pf(-exp2f(-dexp)) * 1.4426950408889634f; }

struct P0Item { const float* src; unsigned char* dst; int N, f8; float scale; };
__device__ __forceinline__ bool p0_item(int it, int lane, const float* in_win, const float* in_wout, const float* in_wgu, const float* in_wd, unsigned char* ws, P0Item& I) {
    constexpr int I_IN = 16 * 40, I_OUT = 16 * 16, I_GU = 16 * 32, I_DN = 16 * 16;
    constexpr int T_IN = DEPTH * I_IN, T_OUT = DEPTH * I_OUT, T_GU = DEPTH * NEXP * I_GU, T_DN = DEPTH * NEXP * I_DN;
    if (it >= T_IN + T_OUT + T_GU + T_DN) return false;
    int r = it;
    if (r < T_IN) { const int l = r / I_IN, q = r % I_IN, kb = q / 40, nb = q % 40;
        I.src = in_win + (size_t)l * DM * INW + (size_t)(64 * kb) * INW + 64 * nb + lane; I.N = INW; I.f8 = 0; I.scale = 1.f;
        I.dst = ws + WS_WIN + ((size_t)l * INW * DM + (size_t)(64 * nb) * DM + 64 * kb) * 2; return true; }
    r -= T_IN;
    if (r < T_OUT) { const int l = r / I_OUT, q = r % I_OUT, kb = q / 16, nb = q % 16;
        I.src = in_wout + (size_t)l * DM * DM + (size_t)(64 * kb) * DM + 64 * nb + lane; I.N = DM; I.f8 = 0; I.scale = 1.f;
        I.dst = ws + WS_WOUT + ((size_t)l * DM * DM + (size_t)(64 * nb) * DM + 64 * kb) * 2; return true; }
    r -= T_OUT;
    if (r < T_GU) { const int le = r / I_GU, q = r % I_GU, kb = q / 32, nb = q % 32; const int n0 = 64 * nb;
        const int dest = (n0 < 1024) ? ((n0 >> 7) * 256 + (n0 & 127)) : ((((n0 - 1024) >> 7) * 256) + 128 + ((n0 - 1024) & 127));
        I.src = in_wgu + (size_t)le * DM * 2048 + (size_t)(64 * kb) * 2048 + n0 + lane; I.N = 2048; I.f8 = 1; I.scale = 32.f;
        I.dst = ws + WS_WGU + (size_t)le * 2048 * DM + (size_t)dest * DM + 64 * kb; return true; }
    r -= T_GU;
    { const int le = r / I_DN, q = r % I_DN, kb = q / 16, nb = q % 16;
        I.src = in_wd + (size_t)le * DM * DM + (size_t)(64 * kb) * DM + 64 * nb + lane; I.N = DM; I.f8 = 1; I.scale = 64.f;
        I.dst = ws + WS_WD + (size_t)le * DM * DM + (size_t)(64 * nb) * DM + 64 * kb; return true; }
}
__device__ __forceinline__ void p0_item_load(const P0Item& I, float (&v)[64]) {
#pragma unroll
    for (int k = 0; k < 64; ++k) v[k] = I.src[(size_t)k * I.N];
}
__device__ __forceinline__ void p0_item_store(const P0Item& I, const float (&v)[64], LAS unsigned* T, int lane) {
    if (I.f8) {
#pragma unroll
        for (int kq = 0; kq < 16; ++kq) T[lane * 20 + kq] = (unsigned)__builtin_amdgcn_cvt_pk_fp8_f32(v[4 * kq + 2] * I.scale, v[4 * kq + 3] * I.scale, __builtin_amdgcn_cvt_pk_fp8_f32(v[4 * kq] * I.scale, v[4 * kq + 1] * I.scale, 0, false), true);
        LDS_WAIT(); asm volatile("" ::: "memory");
        const int c = lane & 3, nr = lane >> 2;
#pragma unroll
        for (int j = 0; j < 4; ++j) { const int n = nr + 16 * j; const v4u o = *(const LAS v4u*)(T + n * 20 + 4 * c); *(GAS v4u*)(I.dst + (size_t)n * DM + 16 * c) = o; }
    } else {
#pragma unroll
        for (int kp = 0; kp < 32; ++kp) T[lane * 36 + kp] = pk2(v[2 * kp], v[2 * kp + 1]);
        LDS_WAIT(); asm volatile("" ::: "memory");
        const int c = lane & 7, nr = lane >> 3;
#pragma unroll
        for (int j = 0; j < 8; ++j) { const int n = nr + 8 * j; const v4u o = *(const LAS v4u*)(T + n * 36 + 4 * c); *(GAS v4u*)(I.dst + (size_t)n * DM * 2 + 16 * c) = o; }
    }
    LDS_WAIT(); asm volatile("" ::: "memory");
}
__device__ __forceinline__ void p0a(const Args& A, LAS unsigned char* lds, int tid, int lane, int wave) {
    unsigned char* ws = KWS();
    const int G = gridDim.x, wg = opaque_bid();
    const float* in_c = KIN(1); const float* in_cctx = KIN(3); const float* in_wmod = KIN(4); const float* in_bmod = KIN(5);
    {
        LAS float* sl = (LAS float*)(lds + RING_OFF);
        float* MODP = (float*)(ws + WS_MODP);
        for (int u = wg; u < DEPTH * 8 * 12; u += G) {
            const int l = u / 96, rem = u % 96, kp = rem / 12, cb = rem % 12;
            for (int i = tid; i < 9 * 128; i += NWAVES * 64) { const int r = i >> 7, k = i & 127;
                const float cv = (r < 8) ? in_c[r * DM + kp * 128 + k] : in_cctx[kp * 128 + k];
                sl[i] = cv / (1.0f + expf(-cv)); }
            __syncthreads();
            const int col = cb * 512 + tid;
            float acc[9];
#pragma unroll
            for (int r = 0; r < 9; ++r) acc[r] = (kp == 0) ? in_bmod[l * NMOD + col] : 0.f;
            const float* wp = in_wmod + ((size_t)l * DM + kp * 128) * NMOD + col;
#pragma unroll 8
            for (int k = 0; k < 128; ++k) { const float w = wp[(size_t)k * NMOD];
#pragma unroll
                for (int r = 0; r < 9; ++r) acc[r] += sl[r * 128 + k] * w; }
#pragma unroll
            for (int r = 0; r < 9; ++r) MODP[((size_t)(l * 8 + kp) * 9 + r) * NMOD + col] = acc[r];
            __syncthreads();
        }
    }
    if (wg == G - 1) {
        const float invf[16] = {1.0f, 0.5623413251903491f, 0.31622776601683794f, 0.1778279410038923f, 0.1f, 0.05623413251903491f, 0.03162277660168379f, 0.01778279410038923f,
                                0.01f, 0.005623413251903491f, 0.0031622776601683794f, 0.0017782794100389228f, 0.001f, 0.0005623413251903491f, 0.00031622776601683794f, 0.00017782794100389227f};
        float2* rope = (float2*)(ws + WS_ROPE);
        for (int i = tid; i < 1024; i += NWAVES * 64) { const int f = i & 15; float fr = invf[0];
#pragma unroll
            for (int q = 1; q < 16; ++q) fr = (f == q) ? invf[q] : fr;
            const float ang = (float)(i >> 4) * fr; rope[i] = make_float2(cosf(ang), sinf(ang)); }
    }
    {
        LAS unsigned* scr = (LAS unsigned*)(lds + RING_OFF + wave * 16384);
        const float* in_win = KIN(6); const float* in_wout = KIN(12); const float* in_wgu = KIN(17); const float* in_wd = KIN(19);
        const int gw = wg * NWAVES + wave, NGW = G * NWAVES;
        P0Item Ia, Ib; float va[64], vb[64];
        bool ha = p0_item(gw, lane, in_win, in_wout, in_wgu, in_wd, ws, Ia), hb = false;
        if (ha) p0_item_load(Ia, va);
        for (int it = gw; ha; it += 2 * NGW) {
            hb = p0_item(it + NGW, lane, in_win, in_wout, in_wgu, in_wd, ws, Ib);
            if (hb) p0_item_load(Ib, vb);
            p0_item_store(Ia, va, scr, lane);
            if (!hb) break;
            ha = p0_item(it + 2 * NGW, lane, in_win, in_wout, in_wgu, in_wd, ws, Ia);
            if (ha) p0_item_load(Ia, va);
            p0_item_store(Ib, vb, scr, lane);
        }
    }
    __syncthreads();
}
__device__ __forceinline__ void p0b(const Args& A, int tid) {
    const float* MODP = (const float*)(KWS() + WS_MODP); float* MODV = (float*)(KWS() + WS_MODV);
    for (int i = opaque_bid() * (NWAVES * 64) + tid; i < DEPTH * 9 * NMOD; i += gridDim.x * NWAVES * 64) {
        const int l = i / (9 * NMOD), rc = i % (9 * NMOD); float s = 0.f;
#pragma unroll
        for (int kp = 0; kp < 8; ++kp) s += MODP[(size_t)(l * 8 + kp) * 9 * NMOD + rc];
        MODV[i] = s;
    }
}
__device__ __forceinline__ void p0c(const Args& A, int lane, int wave) {
    const float* MODV = (const float*)(KWS() + WS_MODV); bf16* XH = (bf16*)(KWS() + WS_XH);
    const int gw = opaque_bid() * NWAVES + wave, NGW = gridDim.x * NWAVES, RPW = (RTOT + NGW - 1) / NGW;
    for (int r = gw * RPW; r < (gw + 1) * RPW && r < RTOT; ++r) {
        const float* src = (r < RCTX) ? KIN(2) + (size_t)r * DM : KIN(0) + (size_t)(r - RCTX) * DM;
        const float* mv = MODV + (size_t)mod_row(r) * NMOD;
        f32x4 v[4], o[4]; load_row_f32(src, lane, v); modulate(v, mv + 1 * DM, mv + 0 * DM, lane, o); store_row_bf16(XH + (size_t)r * DM, lane, o);
    }
}

__device__ __forceinline__ void unpack4(uint2 u, float (&x)[4]) { x[0] = bflo(u.x); x[1] = bfhi(u.x); x[2] = bflo(u.y); x[3] = bfhi(u.y); }
__device__ __forceinline__ uint2 pack4(const float (&x)[4]) { uint2 u; u.x = pk2(x[0], x[1]); u.y = pk2(x[2], x[3]); return u; }
__device__ __forceinline__ void rope4(float (&x1)[4], float (&x2)[4], const float2* rope, int pos, int f0, bool apply, float scale) {
    if (apply) { const f32x4 a = *(const f32x4*)(rope + pos * 16 + f0), b = *(const f32x4*)(rope + pos * 16 + f0 + 2);
        const float cs[4] = {a[0], a[2], b[0], b[2]}, sn[4] = {a[1], a[3], b[1], b[3]};
#pragma unroll
        for (int i = 0; i < 4; ++i) { const float p = x1[i] * cs[i] - x2[i] * sn[i], q = x1[i] * sn[i] + x2[i] * cs[i]; x1[i] = p; x2[i] = q; } }
#pragma unroll
    for (int i = 0; i < 4; ++i) { x1[i] *= scale; x2[i] *= scale; }
}
struct P2Raw { uint2 bb, r1, r2, q1, q2, k1, k2, vv; };
__device__ __forceinline__ void p2_load(const bf16* Z, int r, int lane, P2Raw& R) {
    const bf16* zr = Z + (size_t)r * INW; const int j4 = 4 * (lane & 3);
    R.bb = *(const uint2*)(zr + ZC_B + 4 * lane);
    { const bf16* s = zr + ((lane >> 5) ? ZC_RK : ZC_RQ) + ((lane >> 2) & 7) * 32 + j4; R.r1 = *(const uint2*)s; R.r2 = *(const uint2*)(s + 16); }
    { const bf16* s = zr + ZC_AQ + (lane >> 2) * 32 + j4; R.q1 = *(const uint2*)s; R.q2 = *(const uint2*)(s + 16); }
    { const bf16* s = zr + ZC_AK + ((lane & 15) >> 2) * 32 + j4; R.k1 = *(const uint2*)s; R.k2 = *(const uint2*)(s + 16); }
    R.vv = *(const uint2*)(zr + ZC_AV + (lane & 31) * 4);
}
__device__ __forceinline__ void p2_load_uc(const bf16* Z, int r, int lane, uint2& u, uint2& c) { const bf16* zr = Z + (size_t)r * INW; u = *(const uint2*)(zr + ZC_U + 4 * lane); c = *(const uint2*)(zr + ZC_C + 4 * lane); }
__device__ __forceinline__ void p2_prod(uint2 u, uint2 c, float (&v)[4]) { float a[4], d[4]; unpack4(u, a); unpack4(c, d);
#pragma unroll
    for (int i = 0; i < 4; ++i) v[i] = a[i] * d[i]; }
__device__ __forceinline__ void p2_norm_rope(float (&x1)[4], float (&x2)[4], float rn, const f32x4& g1, const f32x4& g2, const float (&cs)[4], const float (&sn)[4], float scale) {
#pragma unroll
    for (int i = 0; i < 4; ++i) { const float a = x1[i] * rn * g1[i], d = x2[i] * rn * g2[i]; x1[i] = (a * cs[i] - d * sn[i]) * scale; x2[i] = (a * sn[i] + d * cs[i]) * scale; }
}
__device__ __forceinline__ void p2_rows(const Args& A, int l, int r0, int n, bool last, int lane) {
    unsigned char* ws = KWS();
    const bf16* Z = (const bf16*)(ws + WS_Z); const float2* rope = (const float2*)(ws + WS_ROPE);
    bf16* MIX = (bf16*)(ws + WS_MIX); bf16* RQK = (bf16*)(ws + ((lane >> 5) ? WS_RK : WS_RQ)); bf16* AQ = (bf16*)(ws + WS_AQ); bf16* AK = (bf16*)(ws + WS_AK); bf16* AV = (bf16*)(ws + WS_AV);
    const int j = lane & 3, axis = (lane >> 2) & 1, c0 = 4 * lane;
    const float* cw = KIN(7) + (size_t)l * 256 * 3 + c0 * 3; const f32x4 w0 = *(const f32x4*)cw, w1 = *(const f32x4*)(cw + 4), w2 = *(const f32x4*)(cw + 8);
    const float wf[12] = {w0[0], w0[1], w0[2], w0[3], w1[0], w1[1], w1[2], w1[3], w2[0], w2[1], w2[2], w2[3]};
    const float* qg = KIN(10) + l * 64 + axis * 32 + 4 * j; const f32x4 qg1 = *(const f32x4*)qg, qg2 = *(const f32x4*)(qg + 16);
    const float* kg = KIN(11) + l * 64 + axis * 32 + 4 * j; const f32x4 kg1 = *(const f32x4*)kg, kg2 = *(const f32x4*)(kg + 16);
    const f32x4 one4 = {1.f, 1.f, 1.f, 1.f};
    if (n <= 0) return;
    float vp[4], vc[4]; uint2 un, cn;
    { uint2 u, c; p2_load_uc(Z, r0 > 0 ? r0 - 1 : 0, lane, u, c); p2_prod(u, c, vp); p2_load_uc(Z, r0, lane, u, c); p2_prod(u, c, vc); p2_load_uc(Z, r0 + 1 < RTOT ? r0 + 1 : RTOT - 1, lane, un, cn); }
    P2Raw cur, nxt; p2_load(Z, r0, lane, cur);
    for (int i = 0; i < n; ++i) {
        const int r = r0 + i;
        const bool isctx = r < RCTX; const int b = isctx ? (r >> 8) : ((r - RCTX) >> 12), t = isctx ? (r & 255) : ((r - RCTX) & 4095), tlen = isctx ? CTXL : SEQL;
        const bool need_out = !(isctx && last);
        float cs[4] = {1.f, 1.f, 1.f, 1.f}, sn[4] = {0.f, 0.f, 0.f, 0.f};
        if (!isctx) { const int pos = axis ? (t & 63) : (t >> 6); const f32x4 a = *(const f32x4*)(rope + pos * 16 + 4 * j), d = *(const f32x4*)(rope + pos * 16 + 4 * j + 2);
            cs[0] = a[0]; sn[0] = a[1]; cs[1] = a[2]; sn[1] = a[3]; cs[2] = d[0]; sn[2] = d[1]; cs[3] = d[2]; sn[3] = d[3]; }
        p2_load(Z, (i + 1 < n) ? r + 1 : r, lane, nxt);
        uint2 un2, cn2; p2_load_uc(Z, r + 2 < RTOT ? r + 2 : RTOT - 1, lane, un2, cn2);
        float vn[4]; p2_prod(un, cn, vn);
        if (need_out) { float bb[4], y[4]; unpack4(cur.bb, bb); const float mp = (t > 0) ? 1.f : 0.f, mn = (t < tlen - 1) ? 1.f : 0.f;
#pragma unroll
            for (int q = 0; q < 4; ++q) y[q] = bb[q] * (wf[3 * q] * (vp[q] * mp) + wf[3 * q + 1] * vc[q] + wf[3 * q + 2] * (vn[q] * mn));
            *(uint2*)(MIX + (size_t)r * DM + c0) = pack4(y); }
        { float x1[4], x2[4]; unpack4(cur.r1, x1); unpack4(cur.r2, x2);
            p2_norm_rope(x1, x2, 1.0f, one4, one4, cs, sn, (lane >> 5) ? 0.125f : 1.0f);
            bf16* dst = RQK + (size_t)r * 256 + ((lane >> 2) & 7) * 32 + 4 * j; *(uint2*)dst = pack4(x1); *(uint2*)(dst + 16) = pack4(x2); }
        { float x1[4], x2[4]; unpack4(cur.q1, x1); unpack4(cur.q2, x2); float ss = 0.f;
#pragma unroll
            for (int q = 0; q < 4; ++q) ss += x1[q] * x1[q] + x2[q] * x2[q];
            ss += __shfl_xor(ss, 1); ss += __shfl_xor(ss, 2); ss += __shfl_xor(ss, 4);
            p2_norm_rope(x1, x2, 1.0f / sqrtf(ss * (1.0f / 64.0f) + LN_EPS), qg1, qg2, cs, sn, attn_body::C2);
            if (need_out) { bf16* dst = AQ + (size_t)r * 512 + (lane >> 2) * 32 + 4 * j; *(uint2*)dst = pack4(x1); *(uint2*)(dst + 16) = pack4(x2); } }
        { float x1[4], x2[4]; unpack4(cur.k1, x1); unpack4(cur.k2, x2); float ss = 0.f;
#pragma unroll
            for (int q = 0; q < 4; ++q) ss += x1[q] * x1[q] + x2[q] * x2[q];
            ss += __shfl_xor(ss, 1); ss += __shfl_xor(ss, 2); ss += __shfl_xor(ss, 4);
            p2_norm_rope(x1, x2, 1.0f / sqrtf(ss * (1.0f / 64.0f) + LN_EPS), kg1, kg2, cs, sn, 1.0f);
            const int key = isctx ? t : CTXL + t, blk = (lane & 15) >> 2;
            if (lane < 16) { bf16* dst = AK + ((size_t)(b * 2 + (blk >> 1)) * NKEY + key) * 64 + (blk & 1) * 32 + 4 * j; *(uint2*)dst = pack4(x1); *(uint2*)(dst + 16) = pack4(x2); }
            if (lane >= 32) { const int c = (lane - 32) * 4; *(uint2*)(AV + ((size_t)(b * 2 + (c >> 6)) * NKEY + key) * 64 + (c & 63)) = cur.vv; } }
#pragma unroll
        for (int q = 0; q < 4; ++q) { vp[q] = vc[q]; vc[q] = vn[q]; }
        un = un2; cn = cn2; cur = nxt;
    }
}
constexpr int RT_PITCH = 136;
__device__ __forceinline__ void p2_kv_job(const Args& A, int l, int u, LAS unsigned char* lds, int tid, int lane, int wave) {
    unsigned char* ws = KWS();
    const int h = u & 3, pf = (u >> 2) % NPF, b = (u >> 2) / NPF;
    const bool isctx = pf < 2; const int row0 = isctx ? (b * CTXL + pf * 128) : (RCTX + b * SEQL + (pf - 2) * 128);
    const bf16* Z = (const bf16*)(ws + WS_Z); const float2* rope = (const float2*)(ws + WS_ROPE);
    LAS unsigned short* VT = (LAS unsigned short*)(lds + RING_OFF); LAS unsigned short* KFT = VT + 64 * RT_PITCH; LAS unsigned short* KBT = KFT + 64 * RT_PITCH;
    const float lgf = log2_gamma(KIN(8)[(l * 2 + 0) * 4 + h]), lgb = log2_gamma(KIN(8)[(l * 2 + 1) * 4 + h]);
#pragma unroll
    for (int i = 0; i < 2; ++i) { const int idx = tid + 512 * i, t = idx >> 3, eg = idx & 7;
        const v4u v = *(const v4u*)(Z + (size_t)(row0 + t) * INW + ZC_RV + h * 64 + eg * 8);
        LAS unsigned short* d = VT + (eg * 8) * RT_PITCH + t;
        d[0 * RT_PITCH] = (unsigned short)(v.x & 0xffffu); d[1 * RT_PITCH] = (unsigned short)(v.x >> 16); d[2 * RT_PITCH] = (unsigned short)(v.y & 0xffffu); d[3 * RT_PITCH] = (unsigned short)(v.y >> 16);
        d[4 * RT_PITCH] = (unsigned short)(v.z & 0xffffu); d[5 * RT_PITCH] = (unsigned short)(v.z >> 16); d[6 * RT_PITCH] = (unsigned short)(v.w & 0xffffu); d[7 * RT_PITCH] = (unsigned short)(v.w >> 16); }
    { const int t = tid >> 2, axis = (tid >> 1) & 1, fg = tid & 1;
        const bf16* src = Z + (size_t)(row0 + t) * INW + ZC_RK + h * 64 + axis * 32 + 8 * fg;
        const v4u a = *(const v4u*)src, c = *(const v4u*)(src + 16);
        float x1[8] = {bflo(a.x), bfhi(a.x), bflo(a.y), bfhi(a.y), bflo(a.z), bfhi(a.z), bflo(a.w), bfhi(a.w)};
        float x2[8] = {bflo(c.x), bfhi(c.x), bflo(c.y), bfhi(c.y), bflo(c.z), bfhi(c.z), bflo(c.w), bfhi(c.w)};
        if (!isctx) { const int tt = (pf - 2) * 128 + t, pos = axis ? (tt & 63) : (tt >> 6); const float2* rp = rope + pos * 16 + 8 * fg;
#pragma unroll
            for (int i = 0; i < 8; ++i) { const float2 cs = rp[i]; const float p = x1[i] * cs.x - x2[i] * cs.y, q = x1[i] * cs.y + x2[i] * cs.x; x1[i] = p; x2[i] = q; } }
        const float wf = exp2f((float)(127 - t) * lgf) * 0.125f, wb = exp2f((float)t * lgb) * 0.125f;
        const int d0 = axis * 32 + 8 * fg;
#pragma unroll
        for (int i = 0; i < 8; ++i) {
            KFT[(d0 + i) * RT_PITCH + t] = (unsigned short)f2bf(x1[i] * wf); KFT[(d0 + 16 + i) * RT_PITCH + t] = (unsigned short)f2bf(x2[i] * wf);
            KBT[(d0 + i) * RT_PITCH + t] = (unsigned short)f2bf(x1[i] * wb); KBT[(d0 + 16 + i) * RT_PITCH + t] = (unsigned short)f2bf(x2[i] * wb); }
    }
    __syncthreads();
    { const int dir = wave >> 2, te = (wave >> 1) & 1, td = wave & 1, r32 = lane & 31, hh = lane >> 5;
        const LAS unsigned short* KT = dir ? KBT : KFT;
        f32x16 acc = {};
#pragma unroll
        for (int s = 0; s < 8; ++s) {
            const bf16x8 a = *(const LAS bf16x8*)(VT + (te * 32 + r32) * RT_PITCH + s * 16 + hh * 8);
            const bf16x8 bq = *(const LAS bf16x8*)(KT + (td * 32 + r32) * RT_PITCH + s * 16 + hh * 8);
            acc = __builtin_amdgcn_mfma_f32_32x32x16_bf16(a, bq, acc, 0, 0, 0);
        }
        float* out = (float*)(ws + WS_KVS) + ((size_t)((b * 4 + h) * NPF + pf) * 2 + dir) * 4096;
#pragma unroll
        for (int q = 0; q < 16; ++q) { const int e = te * 32 + (q & 3) + 8 * (q >> 2) + 4 * hh; out[e * 64 + td * 32 + r32] = acc[q]; }
    }
    __syncthreads();
}
__device__ __forceinline__ void p2(const Args& A, int l, LAS unsigned char* lds, int tid, int lane, int wave) {
    const bool last = (l == DEPTH - 1);
    for (int u = opaque_bid(); u < NBATCH * NPF * 4; u += gridDim.x) p2_kv_job(A, l, u, lds, tid, lane, wave);
    const int gw = opaque_bid() * NWAVES + wave, NGW = gridDim.x * NWAVES, RPW = (RTOT + NGW - 1) / NGW;
    { const int r0 = gw * RPW; p2_rows(A, l, r0, (r0 + RPW <= RTOT) ? RPW : ((RTOT > r0) ? RTOT - r0 : 0), last, lane); }
}

__device__ __forceinline__ void p4_scan(const Args& A, int l, int tid) {
    const float* KVS = (const float*)(KWS() + WS_KVS); bf16* SS = (bf16*)(KWS() + WS_SS);
    for (int gid = opaque_bid() * (NWAVES * 64) + tid; gid < NBATCH * 4 * 4096; gid += gridDim.x * NWAVES * 64) {
        const int bh = gid >> 12, ed = gid & 4095, h = bh & 3;
        const float gf = exp2f(128.0f * log2_gamma(KIN(8)[(l * 2 + 0) * 4 + h])), gb = exp2f(128.0f * log2_gamma(KIN(8)[(l * 2 + 1) * 4 + h]));
        const size_t base = (size_t)bh * NPF * 2 * 4096 + ed;
        float S = 0.f;
        for (int pf = 0; pf < NPF; ++pf) { const size_t o = base + (size_t)(pf * 2 + 0) * 4096; SS[o] = (bf16)f2bf(S); S = gf * S + KVS[o]; }
        S = 0.f;
        for (int q = 0; q < NPF; ++q) { const int pf = (q == 0) ? 1 : (q == 1) ? 0 : (NPF + 1 - q);
            const size_t o = base + (size_t)(pf * 2 + 1) * 4096; SS[o] = (bf16)f2bf(S); S = gb * S + KVS[o]; }
    }
}
__device__ __forceinline__ void p4_attention(const Args& A, int l, char* lds_ring) {
    using abf = attn_body::bf16;
    const abf* AQ = (const abf*)(KWS() + WS_AQ); const abf* AK = (const abf*)(KWS() + WS_AK); const abf* AV = (const abf*)(KWS() + WS_AV); abf* MIX = (abf*)(KWS() + WS_MIX);
    const int c = opaque_bid(), G = gridDim.x;
    const int x = c & 7, m = c >> 3, per = G >> 3, b = x;
    for (int i = 0; i < 5; ++i) {
        const bool isctx = (i == 4);
        if (isctx && (l == DEPTH - 1 || m >= 8)) break;
        const int uu = m + per * i; if (!isctx && uu >= 128) break;
        const int h = isctx ? m : (uu >> 4), kvh = h >> 2, NT = isctx ? (CTXL / 64) : (NKEY / 64);
        const size_t qrow = isctx ? (size_t)b * CTXL : (size_t)RCTX + (size_t)b * SEQL + (size_t)(uu & 15) * 256;
        attn_body::attn_unit<8>(AQ + qrow * 512 + h * 64, AK + (size_t)(b * 2 + kvh) * NKEY * 64, AV + (size_t)(b * 2 + kvh) * NKEY * 64, MIX + qrow * DM + 512 + h * 64, NT, lds_ring);
    }
}

__device__ __forceinline__ void p5_unit(const Args& A, int l, int g, int hp, LAS unsigned char* lds, int tid, int lane, int wave) {
    unsigned char* ws = KWS();
    const bf16* Z = (const bf16*)(ws + WS_Z); const bf16* RQ = (const bf16*)(ws + WS_RQ); const bf16* RK = (const bf16*)(ws + WS_RK); const bf16* SS = (const bf16*)(ws + WS_SS);
    bf16* MIX = (bf16*)(ws + WS_MIX);
    const int row0 = g * 128;
    int b, pf; if (g < 16) { b = g >> 1; pf = g & 1; } else { b = (g - 16) >> 5; pf = 2 + ((g - 16) & 31); }
    LAS unsigned short* VT = (LAS unsigned short*)(lds + RING_OFF);
#pragma unroll
    for (int i = 0; i < 4; ++i) { const int idx = tid + 512 * i, hl = idx >> 10, t = (idx >> 3) & 127, eg = idx & 7;
        const v4u v = *(const v4u*)(Z + (size_t)(row0 + t) * INW + ZC_RV + (2 * hp + hl) * 64 + eg * 8);
        LAS unsigned short* d = VT + (hl * 64 + eg * 8) * RT_PITCH + t;
        d[0 * RT_PITCH] = (unsigned short)(v.x & 0xffffu); d[1 * RT_PITCH] = (unsigned short)(v.x >> 16); d[2 * RT_PITCH] = (unsigned short)(v.y & 0xffffu); d[3 * RT_PITCH] = (unsigned short)(v.y >> 16);
        d[4 * RT_PITCH] = (unsigned short)(v.z & 0xffffu); d[5 * RT_PITCH] = (unsigned short)(v.z >> 16); d[6 * RT_PITCH] = (unsigned short)(v.w & 0xffffu); d[7 * RT_PITCH] = (unsigned short)(v.w >> 16); }
    __syncthreads();
    {
        const int hl = wave >> 2, h = 2 * hp + hl, ib = wave & 3, r32 = lane & 31, hh = lane >> 5;
        const float lgf = log2_gamma(KIN(8)[(l * 2 + 0) * 4 + h]), lgb = log2_gamma(KIN(8)[(l * 2 + 1) * 4 + h]);
        const int iloc = ib * 32 + r32;
        bf16x8 qf[4];
#pragma unroll
        for (int s = 0; s < 4; ++s) qf[s] = *(const bf16x8*)(RQ + (size_t)(row0 + iloc) * 256 + h * 64 + s * 16 + hh * 8);
        const bf16* Sf = SS + ((size_t)((b * 4 + h) * NPF + pf) * 2 + 0) * 4096; const bf16* Sb = Sf + 4096;
        f32x16 Y[2];
        {
            const float af = exp2f((float)(iloc + 1) * lgf), ab = exp2f((float)(128 - iloc) * lgb);
#pragma unroll
            for (int et = 0; et < 2; ++et) {
                f32x16 cf = {}, cb = {};
#pragma unroll
                for (int s = 0; s < 4; ++s) {
                    const bf16x8 a0 = *(const bf16x8*)(Sf + (et * 32 + r32) * 64 + s * 16 + hh * 8), a1 = *(const bf16x8*)(Sb + (et * 32 + r32) * 64 + s * 16 + hh * 8);
                    cf = __builtin_amdgcn_mfma_f32_32x32x16_bf16(a0, qf[s], cf, 0, 0, 0); cb = __builtin_amdgcn_mfma_f32_32x32x16_bf16(a1, qf[s], cb, 0, 0, 0);
                }
#pragma unroll
                for (int q = 0; q < 16; ++q) Y[et][q] = af * cf[q] + ab * cb[q];
            }
        }
        const LAS unsigned short* VTh = VT + hl * 64 * RT_PITCH;
        bf16x8 ka[4], kn[4];
#pragma unroll
        for (int s = 0; s < 4; ++s) ka[s] = *(const bf16x8*)(RK + (size_t)(row0 + r32) * 256 + h * 64 + s * 16 + hh * 8);
#pragma unroll 1
        for (int jt = 0; jt < 4; ++jt) {
            f32x16 X = {};
            { const int jn = (jt < 3) ? jt + 1 : jt;
#pragma unroll
                for (int s = 0; s < 4; ++s) kn[s] = *(const bf16x8*)(RK + (size_t)(row0 + jn * 32 + r32) * 256 + h * 64 + s * 16 + hh * 8); }
#pragma unroll
            for (int s = 0; s < 4; ++s) X = __builtin_amdgcn_mfma_f32_32x32x16_bf16(ka[s], qf[s], X, 0, 0, 0);
#pragma unroll
            for (int q = 0; q < 16; ++q) { const int jloc = jt * 32 + (q & 3) + 8 * (q >> 2) + 4 * hh; const int dl = iloc - jloc;
                X[q] *= __builtin_amdgcn_exp2f((dl >= 0) ? (float)dl * lgf : (float)(-dl) * lgb); }
#pragma unroll
            for (int s = 0; s < 2; ++s) {
                v4u pw; pw.x = pk2(X[8 * s + 0], X[8 * s + 1]); pw.y = pk2(X[8 * s + 2], X[8 * s + 3]); pw.z = pk2(X[8 * s + 4], X[8 * s + 5]); pw.w = pk2(X[8 * s + 6], X[8 * s + 7]);
                const bf16x8 bfrag = __builtin_bit_cast(bf16x8, pw);
#pragma unroll
                for (int et = 0; et < 2; ++et) {
                    const LAS unsigned short* vp = VTh + (et * 32 + r32) * RT_PITCH + jt * 32 + 16 * s + 4 * hh;
                    const v2u lo = *(const LAS v2u*)vp, hi2 = *(const LAS v2u*)(vp + 8);
                    v4u aw; aw.x = lo.x; aw.y = lo.y; aw.z = hi2.x; aw.w = hi2.y;
                    Y[et] = __builtin_amdgcn_mfma_f32_32x32x16_bf16(__builtin_bit_cast(bf16x8, aw), bfrag, Y[et], 0, 0, 0);
                }
            }
#pragma unroll
            for (int s = 0; s < 4; ++s) ka[s] = kn[s];
        }
        float s1 = 0.f;
#pragma unroll
        for (int q = 0; q < 16; ++q) s1 += Y[0][q] + Y[1][q];
        s1 += __shfl_xor(s1, 32); const float mu = s1 * (1.0f / 64.0f); float s2 = 0.f;
#pragma unroll
        for (int q = 0; q < 16; ++q) { const float d0 = Y[0][q] - mu, d1 = Y[1][q] - mu; s2 += d0 * d0 + d1 * d1; }
        s2 += __shfl_xor(s2, 32); const float rstd = 1.0f / sqrtf(s2 * (1.0f / 64.0f) + LN_EPS);
        const size_t row = (size_t)(row0 + iloc); const float* gng = KIN(9) + l * 256 + h * 64;
#pragma unroll
        for (int et = 0; et < 2; ++et)
#pragma unroll
            for (int q4 = 0; q4 < 4; ++q4) { const int e0 = et * 32 + 8 * q4 + 4 * hh;
                float gz[4]; unpack4(*(const uint2*)(Z + row * INW + ZC_RG + h * 64 + e0), gz);
                const f32x4 gn = *(const f32x4*)(gng + e0);
                float o[4];
#pragma unroll
                for (int i = 0; i < 4; ++i) { const float yn = (Y[et][4 * q4 + i] - mu) * rstd * gn[i]; o[i] = yn * gz[i] * __builtin_amdgcn_rcpf(1.0f + __builtin_amdgcn_exp2f(gz[i] * -1.4426950408889634f)); }
                *(uint2*)(MIX + row * DM + 256 + h * 64 + e0) = pack4(o); }
    }
    __syncthreads();
}
__device__ __forceinline__ void p5(const Args& A, int l, LAS unsigned char* lds, int tid, int lane, int wave) {
    const int g0 = (l == DEPTH - 1) ? 16 : 0;
    for (int u = opaque_bid(); u < (272 - g0) * 2; u += gridDim.x) p5_unit(A, l, g0 + (u >> 1), u & 1, lds, tid, lane, wave);
}

__device__ __forceinline__ float reduce32(float (&v)[32], int lane) {
#pragma unroll
    for (int i = 0; i < 16; ++i) { const bool up = lane & 32; const float send = up ? v[i] : v[i + 16], keep = up ? v[i + 16] : v[i]; v[i] = keep + __shfl_xor(send, 32); }
#pragma unroll
    for (int i = 0; i < 8; ++i) { const bool up = lane & 16; const float send = up ? v[i] : v[i + 8], keep = up ? v[i + 8] : v[i]; v[i] = keep + __shfl_xor(send, 16); }
#pragma unroll
    for (int i = 0; i < 4; ++i) { const bool up = lane & 8; const float send = up ? v[i] : v[i + 4], keep = up ? v[i + 4] : v[i]; v[i] = keep + __shfl_xor(send, 8); }
#pragma unroll
    for (int i = 0; i < 2; ++i) { const bool up = lane & 4; const float send = up ? v[i] : v[i + 2], keep = up ? v[i + 2] : v[i]; v[i] = keep + __shfl_xor(send, 4); }
    { const bool up = lane & 2; const float send = up ? v[0] : v[1], keep = up ? v[1] : v[0]; v[0] = keep + __shfl_xor(send, 2); }
    return v[0] + __shfl_xor(v[0], 1);
}
struct P7Raw { v4u x[4]; uint2 y[4]; };
__device__ __forceinline__ void p7_load(int l, int r, int lane, const float* xin_lat, const float* xin_ctx, const bf16* XSA, const bf16* Y, P7Raw& R) {
    if (l == 0) { const float* p = (r < RCTX) ? xin_ctx + (size_t)r * DM : xin_lat + (size_t)(r - RCTX) * DM;
#pragma unroll
        for (int j = 0; j < 4; ++j) R.x[j] = *(const v4u*)(p + 256 * j + 4 * lane); }
    else { const bf16* p = XSA + (size_t)r * DM;
#pragma unroll
        for (int j = 0; j < 4; ++j) { const uint2 u = *(const uint2*)(p + 256 * j + 4 * lane); R.x[j] = (v4u){u.x, u.y, 0u, 0u}; } }
    const bf16* q = Y + (size_t)r * DM;
#pragma unroll
    for (int j = 0; j < 4; ++j) R.y[j] = *(const uint2*)(q + 256 * j + 4 * lane);
}
__device__ __forceinline__ void p7_pre(int l, int lane, const P7Raw& R, const LAS float* g1v, f32x4 (&v)[4]) {
#pragma unroll
    for (int j = 0; j < 4; ++j) {
        f32x4 x;
        if (l == 0) x = __builtin_bit_cast(f32x4, R.x[j]);
        else { const unsigned a = R.x[j][0], b = R.x[j][1]; x = (f32x4){bflo(a), bfhi(a), bflo(b), bfhi(b)}; }
        const f32x4 y = (f32x4){bflo(R.y[j].x), bfhi(R.y[j].x), bflo(R.y[j].y), bfhi(R.y[j].y)};
        const f32x4 g1 = *(const LAS f32x4*)(g1v + 256 * j + 4 * lane); v[j] = ALPHA * x + g1 * y; }
}
__device__ __forceinline__ void p7_post(int lane, const f32x4 (&v)[4], const LAS float* sc, const LAS float* sh, bf16* xs_row, unsigned char* h2_row, f32x4 (&hv)[4]) {
    store_row_bf16(xs_row, lane, v);
#pragma unroll
    for (int j = 0; j < 4; ++j) { const f32x4 s = *(const LAS f32x4*)(sc + 256 * j + 4 * lane), h = *(const LAS f32x4*)(sh + 256 * j + 4 * lane); hv[j] = v[j] * (1.0f + s) + h; }
#pragma unroll
    for (int j = 0; j < 4; ++j) *(unsigned*)(h2_row + 256 * j + 4 * lane) = (unsigned)__builtin_amdgcn_cvt_pk_fp8_f32(hv[j][2], hv[j][3], __builtin_amdgcn_cvt_pk_fp8_f32(hv[j][0], hv[j][1], 0, false), true);
}
__device__ __forceinline__ void ln_row2(f32x4 (&a)[4], f32x4 (&b)[4], const LAS float* g, const LAS float* bb, int lane) {
    float sa = 0.f, sb = 0.f;
#pragma unroll
    for (int j = 0; j < 4; ++j) { sa += (a[j][0] + a[j][1]) + (a[j][2] + a[j][3]); sb += (b[j][0] + b[j][1]) + (b[j][2] + b[j][3]); }
#pragma unroll
    for (int o = 1; o < 64; o <<= 1) { const float ta = __shfl_xor(sa, o), tb = __shfl_xor(sb, o); sa += ta; sb += tb; }
    const float ma = sa * (1.0f / DM), mb = sb * (1.0f / DM); float qa = 0.f, qb = 0.f;
#pragma unroll
    for (int j = 0; j < 4; ++j) { a[j] = a[j] - ma; b[j] = b[j] - mb; qa += (a[j][0] * a[j][0] + a[j][1] * a[j][1]) + (a[j][2] * a[j][2] + a[j][3] * a[j][3]); qb += (b[j][0] * b[j][0] + b[j][1] * b[j][1]) + (b[j][2] * b[j][2] + b[j][3] * b[j][3]); }
#pragma unroll
    for (int o = 1; o < 64; o <<= 1) { const float ta = __shfl_xor(qa, o), tb = __shfl_xor(qb, o); qa += ta; qb += tb; }
    const float ra = 1.0f / sqrtf(qa * (1.0f / DM) + LN_EPS), rb = 1.0f / sqrtf(qb * (1.0f / DM) + LN_EPS);
#pragma unroll
    for (int j = 0; j < 4; ++j) { const f32x4 gg = *(const LAS f32x4*)(g + 256 * j + 4 * lane), b0 = *(const LAS f32x4*)(bb + 256 * j + 4 * lane); a[j] = a[j] * ra * gg + b0; b[j] = b[j] * rb * gg + b0; }
}
__device__ __forceinline__ void reduce32_2(float (&u)[32], float (&w)[32], int lane, float& ru, float& rw) {
#define P7_HALVE(N, BIT) _Pragma("unroll") for (int i = 0; i < (N); ++i) { const bool up = lane & (BIT); \
        const float su = up ? u[i] : u[i + (N)], ku = up ? u[i + (N)] : u[i], sw = up ? w[i] : w[i + (N)], kw = up ? w[i + (N)] : w[i]; \
        const float tu = __shfl_xor(su, (BIT)), tw = __shfl_xor(sw, (BIT)); u[i] = ku + tu; w[i] = kw + tw; }
    P7_HALVE(16, 32) P7_HALVE(8, 16) P7_HALVE(4, 8) P7_HALVE(2, 4) P7_HALVE(1, 2)
#undef P7_HALVE
    const float tu = __shfl_xor(u[0], 1), tw = __shfl_xor(w[0], 1); ru = u[0] + tu; rw = w[0] + tw;
}
__device__ __forceinline__ void p7_route2(float lgA, float lgB, int rA, int rB, bool okB, int wg_row0, int lane, LAS int* lcnt, LAS int* ent, float* RWout) {
    float va = lgA, vb = lgB; const int idx = lane >> 1; float ta[4], tb[4]; int ea[4], eb[4];
#pragma unroll
    for (int k = 0; k < 4; ++k) {
        float xa = va, xb = vb; int ia = idx, ib = idx;
#pragma unroll
        for (int o = 1; o < 64; o <<= 1) { const float oa = __shfl_xor(xa, o), ob = __shfl_xor(xb, o); const int ja = __shfl_xor(ia, o), jb = __shfl_xor(ib, o);
            const bool ka = (oa > xa) || (oa == xa && ja < ia), kb = (ob > xb) || (ob == xb && jb < ib); xa = ka ? oa : xa; ia = ka ? ja : ia; xb = kb ? ob : xb; ib = kb ? jb : ib; }
        ta[k] = xa; ea[k] = ia; va = (idx == ia) ? -INFINITY : va; tb[k] = xb; eb[k] = ib; vb = (idx == ib) ? -INFINITY : vb;
    }
    constexpr float L2E = 1.4426950408889634f;
    const float a1 = __builtin_amdgcn_exp2f((ta[1] - ta[0]) * L2E), a2 = __builtin_amdgcn_exp2f((ta[2] - ta[0]) * L2E), a3 = __builtin_amdgcn_exp2f((ta[3] - ta[0]) * L2E), ai = 1.0f / (1.0f + a1 + a2 + a3);
    const float b1 = __builtin_amdgcn_exp2f((tb[1] - tb[0]) * L2E), b2 = __builtin_amdgcn_exp2f((tb[2] - tb[0]) * L2E), b3 = __builtin_amdgcn_exp2f((tb[3] - tb[0]) * L2E), bi = 1.0f / (1.0f + b1 + b2 + b3);
    if (lane < 4 || (lane < 8 && okB)) {
        const bool isB = lane >= 4; const int k = lane & 3;
        const int e = isB ? ((k == 0) ? eb[0] : (k == 1) ? eb[1] : (k == 2) ? eb[2] : eb[3]) : ((k == 0) ? ea[0] : (k == 1) ? ea[1] : (k == 2) ? ea[2] : ea[3]);
        const float w = isB ? (((k == 0) ? 1.0f : (k == 1) ? b1 : (k == 2) ? b2 : b3) * bi) : (((k == 0) ? 1.0f : (k == 1) ? a1 : (k == 2) ? a2 : a3) * ai);
        const int r = isB ? rB : rA;
        const int lp = __hip_atomic_fetch_add(lcnt + e, 1, __ATOMIC_RELAXED, __HIP_MEMORY_SCOPE_WORKGROUP);
        ent[(r - wg_row0) * 4 + k] = e | (lp << 8);
        RWout[(size_t)r * 4 + k] = w;
    }
}
template <bool DRY> __device__ __forceinline__ void p7(const Args& A, int l, LAS unsigned char* lds, int tid, int lane, int wave) {
    unsigned char* ws = KWS();
    const int wgid = opaque_bid(); int wg_row0, wg_rows;
    if (l == DEPTH - 1) { wg_row0 = RCTX + wgid * 128; wg_rows = 128; }
    else if (wgid < 16) { wg_row0 = wgid * 128; wg_rows = 128; }
    else { const int bb_ = (wgid - 16) / 30, jj_ = (wgid - 16) % 30, s0 = (jj_ * SEQL) / 30, s1 = ((jj_ + 1) * SEQL) / 30; wg_row0 = RCTX + bb_ * SEQL + s0; wg_rows = s1 - s0; }
    const int mrow = mod_row(wg_row0);
    LAS f32x4* WL = (LAS f32x4*)(lds + RING_OFF);
    LAS int* lcnt = (LAS int*)(lds + LCNT_OFF); LAS int* lbase = (LAS int*)(lds + LBASE_OFF); LAS int* ent = (LAS int*)(lds + ENT_OFF);
    const float* wr = KIN(15) + (size_t)l * DM * NEXP;
    for (int s = tid; s < 8192; s += NWAVES * 64) { const int ln = s & 63, eg = (s >> 6) & 7, jc = s >> 9; const int k = 256 * (jc >> 2) + 4 * ln + (jc & 3);
        WL[s] = *(const f32x4*)(wr + (size_t)k * NEXP + 4 * eg); }
    if (tid < 32) lcnt[tid] = 0;
    LAS float* VEC = (LAS float*)(lds + VEC_OFF);
    { const float* lg_ = KIN(13) + (size_t)(l * 2 + 0) * DM; const float* lb_ = KIN(14) + (size_t)(l * 2 + 0) * DM; const float* mv_ = (const float*)(ws + WS_MODV) + (size_t)(l * 9 + mrow) * NMOD;
        for (int i = tid; i < DM; i += NWAVES * 64) { VEC[i] = lg_[i]; VEC[DM + i] = lb_[i]; VEC[2 * DM + i] = mv_[2 * DM + i]; VEC[3 * DM + i] = mv_[4 * DM + i]; VEC[4 * DM + i] = mv_[3 * DM + i]; } }
    __syncthreads();
    const float bias_e = KIN(16)[l * NEXP + (lane >> 1)];
    const int q_ = wg_rows >> 3, rem_ = wg_rows & 7, w_row0 = wg_row0 + wave * q_ + (wave < rem_ ? wave : rem_), nmy = q_ + (wave < rem_ ? 1 : 0);
    const float* xin_lat = KIN(0); const float* xin_ctx = KIN(2); const LAS float* lng = VEC; const LAS float* lnb = VEC + DM;
    bf16* XSA = (bf16*)(ws + WS_XSA); const bf16* Yb = (const bf16*)(ws + WS_Y); unsigned char* H2 = ws + (DRY ? WS_XS2 + 128 * MiB : WS_H2); const float* MODV = (const float*)(ws + WS_MODV);
    bf16* XSAo = DRY ? (bf16*)(ws + WS_XS2) : XSA; float* RWo = (float*)(ws + (DRY ? WS_XS2 + 256 * MiB : WS_RW));
    P7Raw curA, curB;
    if (nmy > 0) { p7_load(l, w_row0, lane, xin_lat, xin_ctx, XSA, Yb, curA); p7_load(l, (w_row0 + 1 < RTOT) ? w_row0 + 1 : w_row0, lane, xin_lat, xin_ctx, XSA, Yb, curB); }
    for (int i = 0; i < nmy; i += 2) {
        const int rA = w_row0 + i; const bool okB = (i + 1 < nmy); const int rB = (rA + 1 < RTOT) ? rA + 1 : rA;
        f32x4 vA[4], vB[4], hA[4], hB[4];
        p7_pre(l, lane, curA, VEC + 2 * DM, vA); p7_pre(l, lane, curB, VEC + 2 * DM, vB);
        { const int nA = (rA + 2 < RTOT) ? rA + 2 : RTOT - 1, nB = (rA + 3 < RTOT) ? rA + 3 : RTOT - 1;
          p7_load(l, nA, lane, xin_lat, xin_ctx, XSA, Yb, curA); p7_load(l, nB, lane, xin_lat, xin_ctx, XSA, Yb, curB); }
        ln_row2(vA, vB, lng, lnb, lane);
        p7_post(lane, vA, VEC + 3 * DM, VEC + 4 * DM, XSAo + (size_t)rA * DM, H2 + (size_t)rA * DM, hA);
        p7_post(lane, vB, VEC + 3 * DM, VEC + 4 * DM, okB ? XSAo + (size_t)rB * DM : (bf16*)(ws + WS_XS2 + 64 * MiB), okB ? H2 + (size_t)rB * DM : ws + WS_XS2 + 65 * MiB, hB);
        f32x4 accA[8], accB[8];
#pragma unroll
        for (int eg = 0; eg < 8; ++eg) { accA[eg] = (f32x4){0.f, 0.f, 0.f, 0.f}; accB[eg] = (f32x4){0.f, 0.f, 0.f, 0.f}; }
#pragma unroll
        for (int j = 0; j < 4; ++j)
#pragma unroll
            for (int c = 0; c < 4; ++c) { const float xa = hA[j][c], xb = hB[j][c];
#pragma unroll
                for (int eg = 0; eg < 8; ++eg) { const f32x4 w = WL[((j * 4 + c) * 8 + eg) * 64 + lane]; accA[eg] = w * xa + accA[eg]; accB[eg] = w * xb + accB[eg]; } }
        float a0[32], b0[32];
#pragma unroll
        for (int e = 0; e < 32; ++e) { a0[e] = accA[e >> 2][e & 3]; b0[e] = accB[e >> 2][e & 3]; }
        float lgA, lgB; reduce32_2(a0, b0, lane, lgA, lgB);
        p7_route2(lgA + bias_e, lgB + bias_e, rA, rB, okB, wg_row0, lane, lcnt, ent, RWo);
    }
    __syncthreads();
    if (DRY) return;
    if (tid < 32) lbase[tid] = (int)__hip_atomic_fetch_add((unsigned*)(ws + WS_CTL) + CW_GCNT + (l * 32 + tid) * 16, (unsigned)lcnt[tid], __ATOMIC_RELAXED, __HIP_MEMORY_SCOPE_AGENT);
    __syncthreads();
    { const int nent = wg_rows * 4; int* RE = (int*)(ws + WS_RE); int* RP = (int*)(ws + WS_RP);
        for (int i = tid; i < nent; i += NWAVES * 64) { const int row = wg_row0 + (i >> 2); if (row < RTOT) { const int v = ent[i], e = v & 255, lp = v >> 8;
            RE[(size_t)row * 4 + (i & 3)] = e; RP[(size_t)row * 4 + (i & 3)] = lbase[e] + lp; } } }
    __syncthreads();
}
__device__ __forceinline__ void moe_offsets(const Args& A, int l, LAS unsigned char* lds, int tid) {
    volatile LAS int* offt = (volatile LAS int*)(lds + OFFT_OFF);
    if (tid < 64) {
        const unsigned c = __hip_atomic_load((unsigned*)(KWS() + WS_CTL) + CW_GCNT + (l * 32 + (tid & 31)) * 16, __ATOMIC_RELAXED, __HIP_MEMORY_SCOPE_AGENT);
        int x = (int)((c + 255u) >> 8);
#pragma unroll
        for (int o = 1; o < 32; o <<= 1) { const int v = __shfl_up(x, o); if ((tid & 31) >= o) x += v; }
        if (tid < 32) offt[tid + 1] = x;
        if (tid == 0) offt[0] = 0;
    }
    __syncthreads();
}
__device__ __forceinline__ void p8(const Args& A, int l, LAS unsigned char* lds, int tid, int lane, int wave) {
    unsigned char* ws = KWS();
    moe_offsets(A, l, lds, tid);
    volatile LAS int* offt = (volatile LAS int*)(lds + OFFT_OFF);
    const int row_lo = (l == DEPTH - 1) ? RCTX : 0, nrows = RTOT - row_lo;
    const int NGW = gridDim.x * NWAVES, RPW = (nrows + NGW - 1) / NGW, w_row0 = row_lo + (opaque_bid() * NWAVES + wave) * RPW;
    const int* RE = (const int*)(ws + WS_RE); const int* RP = (const int*)(ws + WS_RP); const float* RW = (const float*)(ws + WS_RW);
    int* SLOT = (int*)(ws + WS_SLOT); float* ROWW = (float*)(ws + WS_ROWW); const unsigned char* H2 = ws + WS_H2; unsigned char* XS2 = ws + WS_XS2;
    const int nmy = (w_row0 + RPW <= RTOT) ? RPW : ((RTOT > w_row0) ? RTOT - w_row0 : 0);
    int sa = 0, sb = 0; float wa = 0.f, wb = 0.f;
    if (lane < nmy * 4) { const size_t q = (size_t)w_row0 * 4 + lane; sa = offt[RE[q] & 31] * 256 + RP[q]; wa = RW[q]; SLOT[q] = sa; ROWW[sa] = wa; }
    if (64 + lane < nmy * 4) { const size_t q = (size_t)w_row0 * 4 + 64 + lane; sb = offt[RE[q] & 31] * 256 + RP[q]; wb = RW[q]; SLOT[q] = sb; ROWW[sb] = wb; }
    v4u cur = {0u, 0u, 0u, 0u}, nxt;
    if (nmy > 0) cur = *(const v4u*)(H2 + (size_t)w_row0 * DM + 16 * lane);
    for (int i = 0; i < nmy; ++i) {
        const int r = w_row0 + i;
        nxt = *(const v4u*)(H2 + (size_t)((i + 1 < nmy) ? r + 1 : r) * DM + 16 * lane);
#pragma unroll
        for (int k = 0; k < 4; ++k) { const int idx = 4 * i + k; const int slot = (idx < 64) ? __builtin_amdgcn_readlane(sa, idx & 63) : __builtin_amdgcn_readlane(sb, idx & 63);
            *(v4u*)(XS2 + (size_t)slot * DM + 16 * lane) = cur; }
        cur = nxt;
    }
}
__device__ __forceinline__ void moe_order(pg8::MoeOrder& S, LAS unsigned char* lds, int sh) {
    volatile LAS int* offt = (volatile LAS int*)(lds + OFFT_OFF);
#pragma unroll
    for (int j = 0; j < 11; ++j) { unsigned w = 0;
#pragma unroll
        for (int q = 0; q < 3; ++q) { const int k = 3 * j + q + 1; if (k <= 32) w |= ((unsigned)offt[k] & 1023u) << (10 * q); }
        S.pk[j] = (unsigned)__builtin_amdgcn_readfirstlane((int)w); }
    S.nt = __builtin_amdgcn_readfirstlane(offt[32]); S.sh = sh; S.G = gridDim.x; S.c = opaque_bid();
}
__device__ __forceinline__ void ln_row_lds(f32x4 (&v)[4], const LAS float* g, const LAS float* b, int lane) {
    float s = 0.f;
#pragma unroll
    for (int j = 0; j < 4; ++j) s += (v[j][0] + v[j][1]) + (v[j][2] + v[j][3]);
    const float mean = wave_sum(s) * (1.0f / DM); float s2 = 0.f;
#pragma unroll
    for (int j = 0; j < 4; ++j) { v[j] = v[j] - mean; s2 += (v[j][0] * v[j][0] + v[j][1] * v[j][1]) + (v[j][2] * v[j][2] + v[j][3] * v[j][3]); }
    const float rstd = 1.0f / sqrtf(wave_sum(s2) * (1.0f / DM) + LN_EPS);
#pragma unroll
    for (int j = 0; j < 4; ++j) { const f32x4 gg = *(const LAS f32x4*)(g + 256 * j + 4 * lane), bb = *(const LAS f32x4*)(b + 256 * j + 4 * lane); v[j] = v[j] * rstd * gg + bb; }
}
struct P11Raw { unsigned y[4][4]; uint2 x[4]; };
__device__ __forceinline__ void p11_load(int r, int lane, int s0, int s1, int s2, int s3, const unsigned char* YB, const bf16* XSA, P11Raw& R) {
    const int sl[4] = {s0, s1, s2, s3};
#pragma unroll
    for (int k = 0; k < 4; ++k) { const unsigned char* p = YB + (size_t)sl[k] * DM;
#pragma unroll
        for (int j = 0; j < 4; ++j) R.y[k][j] = *(const unsigned*)(p + 256 * j + 4 * lane); }
    const bf16* q = XSA + (size_t)r * DM;
#pragma unroll
    for (int j = 0; j < 4; ++j) R.x[j] = *(const uint2*)(q + 256 * j + 4 * lane);
}
template <bool DRY> __device__ __forceinline__ void p11(const Args& A, int l, LAS unsigned char* lds, int tid, int lane, int wave) {
    unsigned char* ws = KWS();
    const bool last = (l == DEPTH - 1);
    const int row_lo = last ? RCTX : 0, nrows = RTOT - row_lo;
    const int NGW = gridDim.x * NWAVES, RPW = (nrows + NGW - 1) / NGW, w_row0 = row_lo + (opaque_bid() * NWAVES + wave) * RPW;
    const int* SLOT = (const int*)(ws + WS_SLOT); const unsigned char* YB = ws + WS_YB; bf16* XSA = (bf16*)(ws + WS_XSA); bf16* XH = (bf16*)(ws + WS_XH);
    const float* MODV = (const float*)(ws + WS_MODV); float* outp = DRY ? (float*)(ws + WS_ACT) : KOUT();
    bf16* XSAo = DRY ? (bf16*)(ws + WS_ACT) : XSA; if (DRY) XH = (bf16*)(ws + WS_ACT + 128 * MiB);
    const int nmy = (w_row0 + RPW <= RTOT) ? RPW : ((RTOT > w_row0) ? RTOT - w_row0 : 0);
    LAS float* VEC = (LAS float*)(lds + RING_OFF);
    const int wg_r0 = row_lo + opaque_bid() * NWAVES * RPW, wg_r1 = (wg_r0 + NWAVES * RPW <= RTOT) ? wg_r0 + NWAVES * RPW - 1 : RTOT - 1;
    const int mr0 = mod_row(wg_r0 < RTOT ? wg_r0 : RTOT - 1), mr1 = mod_row(wg_r1);
    { const float* lg_ = KIN(13) + (size_t)(l * 2 + 1) * DM; const float* lb_ = KIN(14) + (size_t)(l * 2 + 1) * DM;
        const float* m0 = MODV + (size_t)(l * 9 + mr0) * NMOD; const float* m1 = MODV + (size_t)(l * 9 + mr1) * NMOD;
        const float* n0 = MODV + (size_t)((last ? l : l + 1) * 9 + mr0) * NMOD; const float* n1 = MODV + (size_t)((last ? l : l + 1) * 9 + mr1) * NMOD;
        for (int i = tid; i < DM; i += NWAVES * 64) { VEC[i] = lg_[i]; VEC[DM + i] = lb_[i];
            VEC[2 * DM + i] = m0[5 * DM + i]; VEC[3 * DM + i] = n0[1 * DM + i]; VEC[4 * DM + i] = n0[0 * DM + i];
            VEC[5 * DM + i] = m1[5 * DM + i]; VEC[6 * DM + i] = n1[1 * DM + i]; VEC[7 * DM + i] = n1[0 * DM + i]; } }
    __syncthreads();
    const LAS float* lng = VEC; const LAS float* lnb = VEC + DM;
    const int sa = (lane < nmy * 4) ? SLOT[(size_t)w_row0 * 4 + lane] : 0, sb = (64 + lane < nmy * 4) ? SLOT[(size_t)w_row0 * 4 + 64 + lane] : 0;
    const float* RW = (const float*)(ws + WS_RW);
    const float wa = (lane < nmy * 4) ? RW[(size_t)w_row0 * 4 + lane] : 0.f, wb = (64 + lane < nmy * 4) ? RW[(size_t)w_row0 * 4 + 64 + lane] : 0.f;
#define P11_SLOT(idx) (((idx) < 64) ? __builtin_amdgcn_readlane(sa, (idx) & 63) : __builtin_amdgcn_readlane(sb, (idx) & 63))
    P11Raw cur, nxt;
    if (nmy > 0) p11_load(w_row0, lane, P11_SLOT(0), P11_SLOT(1), P11_SLOT(2), P11_SLOT(3), YB, XSA, cur);
    for (int i = 0; i < nmy; ++i) {
        const int r = w_row0 + i;
        { const int in = (i + 1 < nmy) ? i + 1 : i, q = 4 * in; p11_load(w_row0 + in, lane, P11_SLOT(q), P11_SLOT(q + 1), P11_SLOT(q + 2), P11_SLOT(q + 3), YB, XSA, nxt); }
        const LAS float* mv = VEC + ((mod_row(r) == mr0) ? 2 : 5) * DM;
        float wk[4];
#pragma unroll
        for (int k = 0; k < 4; ++k) { const int idx = 4 * i + k; wk[k] = __builtin_bit_cast(float, (idx < 64) ? __builtin_amdgcn_readlane(__builtin_bit_cast(int, wa), idx & 63) : __builtin_amdgcn_readlane(__builtin_bit_cast(int, wb), idx & 63)); }
        f32x4 v[4];
#pragma unroll
        for (int j = 0; j < 4; ++j) {
            f32x4 f = {0.f, 0.f, 0.f, 0.f};
#pragma unroll
            for (int k = 0; k < 4; ++k) { typedef float f32x2_ __attribute__((ext_vector_type(2))); const f32x2_ lo = __builtin_amdgcn_cvt_pk_f32_fp8((int)cur.y[k][j], false), hi = __builtin_amdgcn_cvt_pk_f32_fp8((int)cur.y[k][j], true); f += (f32x4){lo[0], lo[1], hi[0], hi[1]} * wk[k]; }
            const f32x4 x = (f32x4){bflo(cur.x[j].x), bfhi(cur.x[j].x), bflo(cur.x[j].y), bfhi(cur.x[j].y)};
            const f32x4 g2 = *(const LAS f32x4*)(mv + 256 * j + 4 * lane); v[j] = ALPHA * x + g2 * f; }
        ln_row_lds(v, lng, lnb, lane);
        if (last) store_row_f32(outp + (size_t)(r - RCTX) * DM, lane, v);
        else { store_row_bf16(XSAo + (size_t)r * DM, lane, v);
            f32x4 o[4];
#pragma unroll
            for (int j = 0; j < 4; ++j) { const f32x4 s = *(const LAS f32x4*)(mv + DM + 256 * j + 4 * lane), h = *(const LAS f32x4*)(mv + 2 * DM + 256 * j + 4 * lane); o[j] = v[j] * (1.0f + s) + h; }
            store_row_bf16(XH + (size_t)r * DM, lane, o); }
        cur = nxt;
    }
#undef P11_SLOT
}

#define GRID_BAR() do { if (N_LAUNCHES == 1) { xcd_barrier(bar); } } while (0)
#define IN(k) (lo <= (k) && (k) < hi)
#define SEAM(k) do { if (IN(k) && IN((k) + 1)) { GRID_BAR(); if (((PROBE_MASK) >> 15) & 1) GRID_BAR(); } } while (0)
#ifndef PROBE_MASK
#define PROBE_MASK 0
#endif
#define REP(p) for (int rep_ = 0; rep_ < (((PROBE_MASK) >> (p)) & 1) + 1; ++rep_)
#define IDS() const int tid = opaque_tid(), lane = tid & 63, wave = __builtin_amdgcn_readfirstlane(tid >> 6); (void)lane; (void)wave
template <int L> __device__ __forceinline__ void layer_phases(const Args& args, LAS unsigned char* lds, unsigned char* lds_raw, const XcdBarrier& bar, int lo, int hi) {
        constexpr int l = L;
        const int pb = N_PRO + l * N_PER_LAYER; const bool last = (l == DEPTH - 1);
        if (IN(pb + 0)) REP(0) { unsigned char* ws = KWS();
            pg8::Gemm g{(const bf16*)(ws + WS_XH), (const bf16*)(ws + WS_WIN) + (size_t)l * INW * DM, RTOT, INW, DM}; pg8::StaticOrder S; S.init(RTOT, INW, (int)gridDim.x, opaque_bid());
            pg8::EpiBf16 E{(bf16*)(ws + WS_Z), INW};
            pg8::gemm_phase<pg8::EpiBf16, pg8::StaticOrder, true, true>(lds + RING_OFF, g, S, E);
        } SEAM(pb + 0);
        if (IN(pb + 1)) REP(1) { IDS(); p2(args, l, lds, tid, lane, wave); } SEAM(pb + 1);
        if (IN(pb + 2)) REP(2) { IDS(); p4_scan(args, l, tid); p4_attention(args, l, (char*)lds_raw + RING_OFF); } SEAM(pb + 2);
        if (IN(pb + 3)) REP(3) { IDS(); p5(args, l, lds, tid, lane, wave); } SEAM(pb + 3);
        if (IN(pb + 4)) REP(4) { unsigned char* ws = KWS();
            const int r0 = last ? RCTX : 0, M = RTOT - r0;
            pg8::Gemm g{(const bf16*)(ws + WS_MIX) + (size_t)r0 * DM, (const bf16*)(ws + WS_WOUT) + (size_t)l * DM * DM, M, DM, DM}; pg8::StaticOrder S; S.init(M, DM, (int)gridDim.x, opaque_bid());
            pg8::EpiBf16 E{(bf16*)(ws + WS_Y) + (size_t)r0 * DM, DM};
            pg8::gemm_phase<pg8::EpiBf16, pg8::StaticOrder, true, true>(lds + RING_OFF, g, S, E);
        } SEAM(pb + 4);
        if (IN(pb + 5)) { IDS(); if (((PROBE_MASK) >> 13) & 1) p7<true>(args, l, lds, tid, lane, wave); p7<false>(args, l, lds, tid, lane, wave); } SEAM(pb + 5);
        if (IN(pb + 6)) REP(6) { IDS(); p8(args, l, lds, tid, lane, wave); } SEAM(pb + 6);
        if (IN(pb + 7)) {
            { IDS(); unsigned char* ws = KWS();
            moe_offsets(args, l, lds, tid);
            pg8::MoeOrder S; moe_order(S, lds, 3);
            pg8::Gemm g{(const bf16*)(ws + WS_XS2), (const bf16*)(ws + WS_WGU + (size_t)l * NEXP * 2048 * DM), MAXTILES * 256, NEXP * 2048, DM / 2};
            pg8::EpiSwiglu E{ws + WS_ACT, KIN(18) + (size_t)l * NEXP * 2048};
            pg8::gemm_phase<pg8::EpiSwiglu, pg8::MoeOrder, true, true, true>(lds + RING_OFF, g, S, E);
        }
            if (((PROBE_MASK) >> 16) & 1) { IDS(); unsigned char* ws = KWS();
            moe_offsets(args, l, lds, tid);
            pg8::MoeOrder S; moe_order(S, lds, 3);
            pg8::Gemm g{(const bf16*)(ws + WS_XS2), (const bf16*)(ws + WS_WGU + (size_t)l * NEXP * 2048 * DM), MAXTILES * 256, NEXP * 2048, DM / 2};
            pg8::EpiSwiglu E{ws + WS_ACT, KIN(18) + (size_t)l * NEXP * 2048};
            pg8::gemm_phase<pg8::EpiSwiglu, pg8::MoeOrder, true, true, true>(lds + RING_OFF, g, S, E);
        }
        } SEAM(pb + 7);
        if (IN(pb + 8)) {
            { IDS(); unsigned char* ws = KWS();
            moe_offsets(args, l, lds, tid);
            pg8::MoeOrder S; moe_order(S, lds, 2);
            pg8::Gemm g{(const bf16*)(ws + WS_ACT), (const bf16*)(ws + WS_WD + (size_t)l * NEXP * DM * DM), MAXTILES * 256, NEXP * DM, DM / 2};
            pg8::EpiDown E{ws + WS_YB, KIN(20) + (size_t)l * NEXP * DM};
            pg8::gemm_phase<pg8::EpiDown, pg8::MoeOrder, true, true, true>(lds + RING_OFF, g, S, E);
        }
            if (((PROBE_MASK) >> 17) & 1) { IDS(); unsigned char* ws = KWS();
            moe_offsets(args, l, lds, tid);
            pg8::MoeOrder S; moe_order(S, lds, 2);
            pg8::Gemm g{(const bf16*)(ws + WS_ACT), (const bf16*)(ws + WS_WD + (size_t)l * NEXP * DM * DM), MAXTILES * 256, NEXP * DM, DM / 2};
            pg8::EpiDown E{ws + WS_YB, KIN(20) + (size_t)l * NEXP * DM};
            pg8::gemm_phase<pg8::EpiDown, pg8::MoeOrder, true, true, true>(lds + RING_OFF, g, S, E);
        }
        } SEAM(pb + 8);
        if (IN(pb + 9)) { IDS(); if (((PROBE_MASK) >> 14) & 1) p11<true>(args, l, lds, tid, lane, wave); p11<false>(args, l, lds, tid, lane, wave); } SEAM(pb + 9);
}

__global__ void __launch_bounds__(NWAVES * 64, 2) mk_fwd(Args args) {
    extern __shared__ __attribute__((aligned(16))) unsigned char lds_raw[];
    LAS unsigned char* lds = (LAS unsigned char*)lds_raw;
    volatile LAS unsigned* MISC = (volatile LAS unsigned*)(lds + MISC_OFF);
    gu32* ctl = (gu32*)(KWS() + WS_CTL);
    for (int u = threadIdx.x; u < (LDS_BYTES - LDSCTL_OFF) / 4; u += NWAVES * 64) ((LAS unsigned*)(lds + LDSCTL_OFF))[u] = 0u;
    __syncthreads();
    XcdBarrier bar; bar.bar = (unsigned*)(ctl + CW_BAR); bar.x = 0; bar.st = nullptr;
    if (N_LAUNCHES == 1) bar = xcd_barrier_post((unsigned*)(ctl + CW_BAR), MISC + 8);
    const int lo = args.ph_lo, hi = args.ph_hi;

    if (IN(0)) REP(10) { IDS(); p0a(args, lds, tid, lane, wave); } SEAM(0);
    if (IN(1)) REP(11) { IDS(); p0b(args, tid); } SEAM(1);
    if (IN(2)) REP(12) { IDS(); p0c(args, lane, wave); } SEAM(2);

    layer_phases<0>(args, lds, lds_raw, bar, lo, hi);
    layer_phases<1>(args, lds, lds_raw, bar, lo, hi);
    static_assert(DEPTH == 2, "two layer instances");
}
#undef IN
#undef IDS
#undef SEAM
#undef GRID_BAR

extern "C" void kernel_launch(void* const* d_in, const int* in_sizes, int n_in, void* d_out, int out_size, void* d_ws, size_t ws_size, hipStream_t stream) {
    static int grid = 0;
    if (grid == 0) {
        if (n_in != 21 || in_sizes[0] != RLAT * DM || out_size != RLAT * DM || ws_size < WS_END) { fprintf(stderr, "kernel_launch: unexpected shapes / workspace (n_in %d, ws %zu < %zu); nothing launched\n", n_in, ws_size, (size_t)WS_END); grid = -1; return; }
        int dev = 0, cus = 0, per_cu = 0;
        if (hipGetDevice(&dev) != hipSuccess || hipDeviceGetAttribute(&cus, hipDeviceAttributeMultiprocessorCount, dev) != hipSuccess) { grid = -1; return; }
        if (hipFuncSetAttribute((const void*)mk_fwd, hipFuncAttributeMaxDynamicSharedMemorySize, LDS_BYTES) != hipSuccess) { fprintf(stderr, "kernel_launch: hipFuncSetAttribute failed\n"); grid = -1; return; }
        if (hipOccupancyMaxActiveBlocksPerMultiprocessor(&per_cu, (const void*)mk_fwd, NWAVES * 64, LDS_BYTES) != hipSuccess || per_cu < 1) fprintf(stderr, "kernel_launch: occupancy query reports %d\n", per_cu);
        (void)hipGetLastError();
        grid = cus;
        if (grid != 256) { fprintf(stderr, "kernel_launch: built for 256 CUs, found %d; nothing launched\n", grid); grid = -1; return; }
    }
    if (grid < 0) return;
    if (hipMemsetAsync((char*)d_ws + WS_CTL, 0, CTL_ZERO_BYTES, stream) != hipSuccess) return;
    Args a{};
    for (int i = 0; i < 21; ++i) a.in[i] = (const float*)d_in[i];
    a.out = (float*)d_out; a.ws = (unsigned char*)d_ws; a.pad = 0;
    for (int li = 0; li < N_LAUNCHES; ++li) {
        a.ph_lo = (N_LAUNCHES == 1) ? 0 : li; a.ph_hi = (N_LAUNCHES == 1) ? N_PHASES : li + 1; a.li = li;
        hipLaunchKernelGGL(mk_fwd, dim3(grid), dim3(NWAVES * 64), LDS_BYTES, stream, a);
        const hipError_t le = hipPeekAtLastError();
        if (le != hipSuccess) { fprintf(stderr, "kernel_launch: launch %d failed: %s\n", li, hipGetErrorName(le)); break; }
    }
}
```
